# Optimizing an MI355X kernel written in HIP

```python
import math
import jax, jax.numpy as jnp
from jax import lax
import numpy as np

D_MODEL = 1024
BATCH = 8
SEQ = 4096
DEPTH = 4

N_MIXERS = 4
NORM_EPS = 1e-6
NEG_INF = -1e30
D_FF = 2816

RET_HEADS = 4
RET_DK = D_MODEL // RET_HEADS
RET_DV = 2 * RET_DK
RET_CHUNK = 128
ROPE_BASE = 10000.0

NSA_HEADS = 16
NSA_GROUPS = 4
NSA_HPG = NSA_HEADS // NSA_GROUPS
NSA_DH = D_MODEL // NSA_HEADS
NSA_CMP_LEN = 32
NSA_CMP_STRIDE = 16
NSA_CMP_HID = 4 * NSA_DH
NSA_SEL_LEN = 64
NSA_N_SEL = 16
NSA_WINDOW = 512
NSA_Q_BLOCK = 32
NSA_FORCE_BONUS = 1e4

SSD_D_INNER = 2 * D_MODEL
SSD_HEADDIM = 64
SSD_HEADS = SSD_D_INNER // SSD_HEADDIM
SSD_GROUPS = 4
SSD_HPG = SSD_HEADS // SSD_GROUPS
SSD_STATE = 128
SSD_CONV = 4
SSD_CONV_DIM = SSD_D_INNER + 2 * SSD_GROUPS * SSD_STATE
SSD_CHUNK = 256

DIL_PATTERN = ((128, 1), (512, 4), (2048, 16))
DIL_HEADS = 8
DIL_DH = D_MODEL // DIL_HEADS
DIL_Q_BLOCK = 128

kernel_name = "hybrid_interleaved_retnet_nsa_ssd_dilated"


def _rmsnorm(x, g):
    xf = x.astype(jnp.float32)
    y = xf * lax.rsqrt(jnp.mean(xf * xf, axis=-1, keepdims=True) + NORM_EPS)
    return (y * g.astype(jnp.float32)).astype(x.dtype)


def _swiglu(u, w_in, w_out):
    a, b = jnp.split(u @ w_in, 2, axis=-1)
    return (jax.nn.silu(a) * b) @ w_out


def _masked_softmax(s, mask):
    s = jnp.where(mask, s.astype(jnp.float32), NEG_INF)
    m = jnp.max(s, axis=-1, keepdims=True)
    e = jnp.where(mask, jnp.exp(s - m), 0.0)
    den = jnp.maximum(jnp.sum(e, axis=-1, keepdims=True), 1e-30)
    return e / den, (m + jnp.log(den))[..., 0]


def _rotary(t, pos):
    half = t.shape[-1] // 2
    inv = ROPE_BASE ** (-jnp.arange(half, dtype=jnp.float32) / half)
    ang = pos.astype(jnp.float32)[:, None] * inv[None, :]
    cos = jnp.cos(ang)[None, :, None, :]
    sin = jnp.sin(ang)[None, :, None, :]
    tf = t.astype(jnp.float32)
    t1, t2 = tf[..., :half], tf[..., half:]
    return jnp.concatenate([t1 * cos - t2 * sin, t1 * sin + t2 * cos], axis=-1).astype(t.dtype)


def _retention(u, w_in, gn_gain, w_out):
    b, s, _ = u.shape
    hk, hv = RET_HEADS * RET_DK, RET_HEADS * RET_DV
    q, k, v, g = jnp.split(u @ w_in, [hk, 2 * hk, 2 * hk + hv], axis=-1)
    pos = jnp.arange(s)
    q = _rotary(q.reshape(b, s, RET_HEADS, RET_DK), pos)
    k = _rotary(k.reshape(b, s, RET_HEADS, RET_DK), pos) * (RET_DK ** -0.5)
    v = v.reshape(b, s, RET_HEADS, RET_DV)
    n_ch = s // RET_CHUNK

    def to_chunks(t):
        return t.astype(jnp.float32).reshape(b, n_ch, RET_CHUNK, RET_HEADS, -1).transpose(1, 0, 3, 2, 4)

    log_gamma = jnp.log1p(-jnp.exp2(-5.0 - jnp.arange(RET_HEADS, dtype=jnp.float32)))
    idx = jnp.arange(RET_CHUNK, dtype=jnp.float32)
    rel = idx[:, None] - idx[None, :]
    causal = rel >= 0
    inner_decay = jnp.where(causal, jnp.exp(jnp.where(causal, rel, 0.0) * log_gamma[:, None, None]), 0.0)
    q_decay = jnp.exp((idx + 1.0) * log_gamma[:, None])[None, :, :, None]
    k_decay = jnp.exp((RET_CHUNK - 1.0 - idx) * log_gamma[:, None])[None, :, :, None]
    chunk_decay = jnp.exp(RET_CHUNK * log_gamma)[None, :, None, None]

    def step(state, qkv):
        qc, kc, vc = qkv
        sc = jnp.einsum('bhid,bhjd->bhij', qc, kc) * inner_decay
        o = jnp.einsum('bhij,bhje->bhie', sc, vc) + jnp.einsum('bhid,bhde->bhie', qc, state) * q_decay
        state = state * chunk_decay + jnp.einsum('bhjd,bhje->bhde', kc * k_decay, vc)
        return state, o

    state0 = jnp.zeros((b, RET_HEADS, RET_DK, RET_DV), jnp.float32)
    _, o = lax.scan(step, state0, (to_chunks(q), to_chunks(k), to_chunks(v)))
    o = o.transpose(1, 0, 3, 2, 4).reshape(b, s, RET_HEADS, RET_DV)
    o = _rmsnorm(o, gn_gain.reshape(RET_HEADS, RET_DV)).astype(u.dtype).reshape(b, s, hv)
    return (jax.nn.silu(g) * o) @ w_out


def _nsa(u, w_in, cmp_pos, cmp_w1, cmp_w2, w_out):
    b, s, _ = u.shape
    G, HPG, DH, QB = NSA_GROUPS, NSA_HPG, NSA_DH, NSA_Q_BLOCK
    hq, hkv = NSA_HEADS * DH, G * DH
    q, kv, gates = jnp.split(u @ w_in, [hq, hq + 6 * hkv], axis=-1)
    q = q.reshape(b, s, G, HPG, DH).transpose(0, 2, 3, 1, 4)
    kv = kv.reshape(b, s, 3, 2, G, DH).transpose(2, 3, 0, 4, 1, 5)
    gates = jax.nn.sigmoid(gates.reshape(b, s, 3, G, HPG).transpose(2, 0, 3, 4, 1))
    scale = DH ** -0.5

    n_cmp = (s - NSA_CMP_LEN) // NSA_CMP_STRIDE + 1
    blk = jnp.arange(n_cmp)[:, None] * NSA_CMP_STRIDE + jnp.arange(NSA_CMP_LEN)[None, :]

    def compress(t, c):
        tb = t[:, :, blk, :] + cmp_pos[c]
        hid = jax.nn.silu(tb.reshape(b, G, n_cmp, NSA_CMP_LEN * DH) @ cmp_w1[c])
        return hid @ cmp_w2[c]

    k_cmp, v_cmp = compress(kv[0, 0], 0), compress(kv[0, 1], 1)
    cmp_end = jnp.arange(n_cmp) * NSA_CMP_STRIDE + NSA_CMP_LEN - 1

    nb = s // NSA_SEL_LEN
    n_sel = min(NSA_N_SEL, nb)
    k_sel = kv[1, 0].reshape(b, G, nb, NSA_SEL_LEN, DH)
    v_sel = kv[1, 1].reshape(b, G, nb, NSA_SEL_LEN, DH)
    ratio = NSA_SEL_LEN // NSA_CMP_STRIDE
    span = NSA_CMP_LEN // NSA_CMP_STRIDE
    pad_r = ratio * nb + ratio + 1 - n_cmp
    gather = jax.vmap(jax.vmap(lambda tb, ib: tb[ib]))

    pad_w = ((0, 0), (0, 0), (NSA_WINDOW, 0), (0, 0))
    k_win, v_win = jnp.pad(kv[2, 0], pad_w), jnp.pad(kv[2, 1], pad_w)

    def block(c):
        t0 = c * QB
        t = t0 + jnp.arange(QB)
        qc = lax.dynamic_slice_in_dim(q, t0, QB, axis=3)
        gc = lax.dynamic_slice_in_dim(gates, t0, QB, axis=4)
        s_c = jnp.einsum('bghqd,bgnd->bghqn', qc, k_cmp) * scale
        p_c, _ = _masked_softmax(s_c, cmp_end[None, :] <= t[:, None])
        o_c = jnp.einsum('bghqn,bgnd->bghqd', p_c.astype(v_cmp.dtype), v_cmp)
        imp = jnp.pad(p_c.sum(axis=2), ((0, 0), (0, 0), (0, 0), (span - 1, pad_r)))
        imp_sel = 0.0
        for m in range(ratio):
            for n in range(span):
                imp_sel = imp_sel + imp[..., m + n: m + n + ratio * nb: ratio]
        cur = (t // NSA_SEL_LEN)[:, None]
        jb = jnp.arange(nb)[None, :]
        forced = (jb == 0) | (jb == cur) | (jb == cur - 1)
        score = jnp.where(jb <= cur, imp_sel + jnp.where(forced, NSA_FORCE_BONUS, 0.0), NEG_INF)
        top_val, top_idx = lax.top_k(score, n_sel)
        valid = top_val > 0.5 * NEG_INF
        k_g = gather(k_sel, top_idx).reshape(b, G, QB, n_sel * NSA_SEL_LEN, DH)
        v_g = gather(v_sel, top_idx).reshape(b, G, QB, n_sel * NSA_SEL_LEN, DH)
        key_pos = top_idx[..., None] * NSA_SEL_LEN + jnp.arange(NSA_SEL_LEN)
        m_sel = (valid[..., None] & (key_pos <= t[:, None, None])).reshape(b, G, 1, QB, n_sel * NSA_SEL_LEN)
        s_s = jnp.einsum('bghqd,bgqkd->bghqk', qc, k_g) * scale
        p_s, _ = _masked_softmax(s_s, m_sel)
        o_s = jnp.einsum('bghqk,bgqkd->bghqd', p_s.astype(v_g.dtype), v_g)
        kw = lax.dynamic_slice_in_dim(k_win, t0, NSA_WINDOW + QB, axis=2)
        vw = lax.dynamic_slice_in_dim(v_win, t0, NSA_WINDOW + QB, axis=2)
        kpos = (t0 - NSA_WINDOW + jnp.arange(NSA_WINDOW + QB))[None, :]
        m_w = (kpos <= t[:, None]) & (kpos > t[:, None] - NSA_WINDOW) & (kpos >= 0)
        s_w = jnp.einsum('bghqd,bgkd->bghqk', qc, kw) * scale
        p_w, _ = _masked_softmax(s_w, m_w)
        o_w = jnp.einsum('bghqk,bgkd->bghqd', p_w.astype(vw.dtype), vw)
        return gc[0][..., None] * o_c + gc[1][..., None] * o_s + gc[2][..., None] * o_w

    out = lax.map(block, jnp.arange(s // QB))
    out = out.transpose(1, 0, 4, 2, 3, 5).reshape(b, s, hq)
    return out.astype(u.dtype) @ w_out


def _ssd(u, w_in, conv_w, conv_b, dt_bias, a_log, d_skip, norm_g, w_out):
    b, s, _ = u.shape
    G, R, P, N, L = SSD_GROUPS, SSD_HPG, SSD_HEADDIM, SSD_STATE, SSD_CHUNK
    f32 = jnp.float32
    z, xbc, dt = jnp.split(u @ w_in, [SSD_D_INNER, SSD_D_INNER + SSD_CONV_DIM], axis=-1)
    xp = jnp.pad(xbc, ((0, 0), (SSD_CONV - 1, 0), (0, 0)))
    conv = conv_b
    for k in range(SSD_CONV):
        conv = conv + xp[:, k:k + s] * conv_w[k]
    xbc = jax.nn.silu(conv)
    xs, bm, cm = jnp.split(xbc, [SSD_D_INNER, SSD_D_INNER + G * N], axis=-1)
    xs = xs.astype(f32).reshape(b, s, G, R, P)
    bm = bm.astype(f32).reshape(b, s, G, N)
    cm = cm.astype(f32).reshape(b, s, G, N)
    dt = jax.nn.softplus(dt.astype(f32) + dt_bias.astype(f32)).reshape(b, s, G, R)
    A = -jnp.exp(a_log.astype(f32)).reshape(G, R)
    n_ch = -(-s // L)
    pad = n_ch * L - s

    def to_chunks(t):
        t = jnp.pad(t, ((0, 0), (0, pad)) + ((0, 0),) * (t.ndim - 2))
        return t.reshape((b, n_ch, L) + t.shape[2:]).swapaxes(0, 1)

    causal = jnp.tril(jnp.ones((L, L), bool))[None, :, :, None, None]

    def step(state, inp):
        xc, dtc, bc, cc = inp
        acs = jnp.cumsum(dtc * A, axis=1)
        seg = jnp.where(causal, jnp.exp(jnp.where(causal, acs[:, :, None] - acs[:, None, :], 0.0)), 0.0)
        cb = jnp.einsum('bign,bjgn->bijg', cc, bc)
        w = cb[..., None] * seg * dtc[:, None]
        y = jnp.einsum('bijgr,bjgrp->bigrp', w, xc)
        y = y + jnp.einsum('bign,bgrpn->bigrp', cc, state) * jnp.exp(acs)[..., None]
        to_end = jnp.exp(acs[:, -1:] - acs) * dtc
        state = state * jnp.exp(acs[:, -1])[..., None, None] + jnp.einsum('bjgn,bjgr,bjgrp->bgrpn', bc, to_end, xc)
        return state, y

    state0 = jnp.zeros((b, G, R, P, N), f32)
    _, y = lax.scan(step, state0, (to_chunks(xs), to_chunks(dt), to_chunks(bm), to_chunks(cm)))
    y = y.swapaxes(0, 1).reshape(b, n_ch * L, G, R, P)[:, :s]
    y = y + d_skip.astype(f32).reshape(G, R)[..., None] * xs
    yz = y.reshape(b, s, G, R * P) * jax.nn.silu(z.astype(f32)).reshape(b, s, G, R * P)
    y = _rmsnorm(yz, norm_g.reshape(G, R * P)).reshape(b, s, SSD_D_INNER).astype(u.dtype)
    return y @ w_out


def _dilated_group(q, k, v, r, n_back):
    b, s, h, dh = q.shape
    QB = DIL_Q_BLOCK
    L = s // r
    nb = -(-L // QB)
    Lp = nb * QB

    def to_sub(t):
        t = t.reshape(b, L, r, h, dh).transpose(0, 2, 3, 1, 4)
        return jnp.pad(t, ((0, 0), (0, 0), (0, 0), (0, Lp - L), (0, 0)))

    def band(t):
        tp = jnp.pad(to_sub(t), ((0, 0), (0, 0), (0, 0), (QB, 0), (0, 0))).reshape(b, r, h, nb + 1, QB, dh)
        return jnp.concatenate([tp[:, :, :, :-1], tp[:, :, :, 1:]], axis=4)

    qs = to_sub(q).reshape(b, r, h, nb, QB, dh)
    kb, vb = band(k), band(v)
    qi = jnp.arange(QB)[:, None]
    kj = jnp.arange(2 * QB)[None, :]
    dist = qi + QB - kj
    key_sub = jnp.arange(nb)[:, None, None] * QB - QB + kj[None]
    mask = (dist >= 0) & (dist <= n_back) & (key_sub >= 0)
    sc = jnp.einsum('bchnqd,bchnkd->bchnqk', qs, kb) * (dh ** -0.5)
    p, lse = _masked_softmax(sc, mask)
    o = jnp.einsum('bchnqk,bchnkd->bchnqd', p.astype(vb.dtype), vb)
    o = o.reshape(b, r, h, Lp, dh)[:, :, :, :L].transpose(0, 3, 1, 2, 4).reshape(b, s, h, dh)
    lse = lse.reshape(b, r, h, Lp)[:, :, :, :L].transpose(0, 3, 1, 2).reshape(b, s, h)
    return o, lse


def _dilated(u, w_in, w_out):
    b, s, _ = u.shape
    proj = (u @ w_in).reshape(b, s, len(DIL_PATTERN), 3, DIL_HEADS, DIL_DH)
    outs, lses = [], []
    for g, (win, r) in enumerate(DIL_PATTERN):
        o, lse = _dilated_group(proj[:, :, g, 0], proj[:, :, g, 1], proj[:, :, g, 2], r, win // r)
        outs.append(o)
        lses.append(lse)
    wts = jax.nn.softmax(jnp.stack(lses), axis=0)
    o = jnp.einsum('gbsh,gbshd->bshd', wts.astype(u.dtype), jnp.stack(outs))
    return o.reshape(b, s, DIL_HEADS * DIL_DH) @ w_out


def setup_inputs(seed: int = 0) -> dict:
    key = jax.random.key(seed)
    ks = iter(jax.random.split(key, 32))
    f32 = jnp.float32

    def nrm(shape, scale):
        return jax.random.normal(next(ks), shape, f32) * scale

    def gain(shape):
        return 1.0 + 0.01 * jax.random.normal(next(ks), shape, f32)

    n_a, n_b, n_c, n_d = (len(range(m, DEPTH, N_MIXERS)) for m in range(N_MIXERS))
    dt0 = jnp.exp(jax.random.uniform(next(ks), (n_c, SSD_HEADS), f32, math.log(1e-3), math.log(1e-1)))
    return {
        "x": nrm((BATCH, SEQ, D_MODEL), 1.0),
        "norm_ffn1": gain((DEPTH, D_MODEL)),
        "ffn1_w_in": nrm((DEPTH, D_MODEL, 2 * D_FF), D_MODEL ** -0.5),
        "ffn1_w_out": nrm((DEPTH, D_FF, D_MODEL), D_FF ** -0.5),
        "norm_mix": gain((DEPTH, D_MODEL)),
        "norm_ffn2": gain((DEPTH, D_MODEL)),
        "ffn2_w_in": nrm((DEPTH, D_MODEL, 2 * D_FF), D_MODEL ** -0.5),
        "ffn2_w_out": nrm((DEPTH, D_FF, D_MODEL), D_FF ** -0.5),
        "norm_final": gain((D_MODEL,)),
        "ret_w_in": nrm((n_a, D_MODEL, 2 * RET_HEADS * RET_DK + 2 * RET_HEADS * RET_DV), D_MODEL ** -0.5),
        "ret_gn_gain": gain((n_a, RET_HEADS * RET_DV)),
        "ret_w_out": nrm((n_a, RET_HEADS * RET_DV, D_MODEL), (RET_HEADS * RET_DV) ** -0.5),
        "nsa_w_in": nrm((n_b, D_MODEL, NSA_HEADS * NSA_DH + 6 * NSA_GROUPS * NSA_DH + 3 * NSA_HEADS), D_MODEL ** -0.5),
        "nsa_cmp_pos": nrm((n_b, 2, NSA_CMP_LEN, NSA_DH), 0.02),
        "nsa_cmp_w1": nrm((n_b, 2, NSA_CMP_LEN * NSA_DH, NSA_CMP_HID), (NSA_CMP_LEN * NSA_DH) ** -0.5),
        "nsa_cmp_w2": nrm((n_b, 2, NSA_CMP_HID, NSA_DH), NSA_CMP_HID ** -0.5),
        "nsa_w_out": nrm((n_b, NSA_HEADS * NSA_DH, D_MODEL), (NSA_HEADS * NSA_DH) ** -0.5),
        "ssd_w_in": nrm((n_c, D_MODEL, SSD_D_INNER + SSD_CONV_DIM + SSD_HEADS), D_MODEL ** -0.5),
        "ssd_conv_w": nrm((n_c, SSD_CONV, SSD_CONV_DIM), SSD_CONV ** -0.5),
        "ssd_conv_b": nrm((n_c, SSD_CONV_DIM), 0.01),
        "ssd_dt_bias": dt0 + jnp.log(-jnp.expm1(-dt0)),
        "ssd_a_log": jnp.log(jax.random.uniform(next(ks), (n_c, SSD_HEADS), f32, 1.0, 16.0)),
        "ssd_d": gain((n_c, SSD_HEADS)),
        "ssd_norm": gain((n_c, SSD_D_INNER)),
        "ssd_w_out": nrm((n_c, SSD_D_INNER, D_MODEL), SSD_D_INNER ** -0.5),
        "dil_w_in": nrm((n_d, D_MODEL, len(DIL_PATTERN) * 3 * DIL_HEADS * DIL_DH), D_MODEL ** -0.5),
        "dil_w_out": nrm((n_d, DIL_HEADS * DIL_DH, D_MODEL), (DIL_HEADS * DIL_DH) ** -0.5),
    }


def reference(x, norm_ffn1, ffn1_w_in, ffn1_w_out, norm_mix, norm_ffn2, ffn2_w_in, ffn2_w_out, norm_final,
              ret_w_in, ret_gn_gain, ret_w_out,
              nsa_w_in, nsa_cmp_pos, nsa_cmp_w1, nsa_cmp_w2, nsa_w_out,
              ssd_w_in, ssd_conv_w, ssd_conv_b, ssd_dt_bias, ssd_a_log, ssd_d, ssd_norm, ssd_w_out,
              dil_w_in, dil_w_out):
    h = x
    for i in range(DEPTH):
        h = h + 0.5 * _swiglu(_rmsnorm(h, norm_ffn1[i]), ffn1_w_in[i], ffn1_w_out[i])
        u = _rmsnorm(h, norm_mix[i])
        m, j = i % N_MIXERS, i // N_MIXERS
        if m == 0:
            y = _retention(u, ret_w_in[j], ret_gn_gain[j], ret_w_out[j])
        elif m == 1:
            y = _nsa(u, nsa_w_in[j], nsa_cmp_pos[j], nsa_cmp_w1[j], nsa_cmp_w2[j], nsa_w_out[j])
        elif m == 2:
            y = _ssd(u, ssd_w_in[j], ssd_conv_w[j], ssd_conv_b[j], ssd_dt_bias[j], ssd_a_log[j],
                     ssd_d[j], ssd_norm[j], ssd_w_out[j])
        else:
            y = _dilated(u, dil_w_in[j], dil_w_out[j])
        h = h + y
        h = h + 0.5 * _swiglu(_rmsnorm(h, norm_ffn2[i]), ffn2_w_in[i], ffn2_w_out[i])
    return _rmsnorm(h, norm_final)
```

```cpp
#include <hip/hip_runtime.h>
#include <hip/hip_cooperative_groups.h>
#include <cstdio>
#include <cstdint>
namespace cg = cooperative_groups;

namespace pg8 {
#define PG8_LAS __attribute__((address_space(3)))
typedef unsigned short bf16_t;
typedef short bf16x8 __attribute__((ext_vector_type(8)));
typedef float f32x4 __attribute__((ext_vector_type(4)));
typedef unsigned u32x4 __attribute__((ext_vector_type(4)));
constexpr int BM = 256, BK = 64, HALF = 128, HTB = HALF * BK * 2  , STAGE_BYTES = 8 * HTB, NXCD = 8, WGM = 8;

__host__ __device__ __forceinline__ int lds_byte(int r, int c) { const int st = (r >> 4) * 2 + (c >> 5), rr = r & 15, cc = c & 31, ob = rr * 64 + cc * 2; return st * 1024 + (ob ^ (((ob >> 9) & 1) << 5)); }
__host__ __device__ __forceinline__ void stage_rc(int b, int& R, int& C) { const int st = b / 1024, sb = b % 1024, swz = sb ^ (((sb >> 9) & 1) << 5); R = (st >> 1) * 16 + swz / 64; C = (st & 1) * 32 + (swz % 64) / 2; }
__host__ __device__ __forceinline__ int perm32(int rho) { const int n = rho >> 4, i = rho & 15; return 8 * (i >> 2) + 4 * n + (i & 3); }

struct Unit { int pm, pn; };
struct Gemm { const bf16_t* A; const bf16_t* Bt; int M, N, K, lda; };

struct StaticOrder {
    int nM, nN, nwg, G, c;
    __host__ __device__ void init(int M, int N, int G_, int c_) { nM = M / BM; nN = N / BM; nwg = nM * nN; G = G_; c = c_; }
    __host__ __device__ bool next(int i, Unit& u) const {
        const long L = (long)i * G + c; if (L >= nwg) return false;
        int wgid = (int)L; { const int q = nwg / NXCD, r = nwg % NXCD, xcd = wgid % NXCD, off = wgid / NXCD; wgid = (xcd < r ? xcd * (q + 1) : r * (q + 1) + (xcd - r) * q) + off; }
        const int nig = WGM * nN, gid = wgid / nig, fm = gid * WGM, gsz = (nM - fm) < WGM ? (nM - fm) : WGM;
        u.pm = fm + ((wgid % nig) % gsz); u.pn = (wgid % nig) / gsz; return true;
    }
    __device__ __forceinline__ void a_ready(const Unit&) const {}
    __device__ __forceinline__ void done(const Unit&) const {}
};

typedef float f32x2_t __attribute__((ext_vector_type(2))); typedef __bf16 bf16x2_t __attribute__((ext_vector_type(2)));
__device__ __forceinline__ unsigned cvt_pk_bf16(float lo, float hi) { f32x2_t v = {lo, hi}; bf16x2_t b = __builtin_convertvector(v, bf16x2_t); return __builtin_bit_cast(unsigned, b); }
__device__ __forceinline__ float bf_lo(unsigned w) { return __uint_as_float(w << 16); }
__device__ __forceinline__ float bf_hi(unsigned w) { return __uint_as_float(w & 0xffff0000u); }
__device__ __forceinline__ float silu_f(float x) { return x / (1.0f + __expf(-x)); }
__device__ __forceinline__ float sigmoid_f(float x) { return 1.0f / (1.0f + __expf(-x)); }

enum { EPI_BF16 = 0, EPI_SWIGLU = 1, EPI_RESID = 2, EPI_RETQKV = 3, EPI_GATEMUL = 4, EPI_SSD = 5, EPI_SILU = 6 };
template <int MODE> struct Epi {
    static constexpr bool PERM = true, AFTER_DRAIN = false;
    bf16_t* O; int ldc;
    float* Hout; const float* Hbase; float scale;
    const float* rot;
    float* aux;
    __device__ __forceinline__ void operator()(const f32x4 (&acc)[2][2][4][2], const Unit& u, int wr, int wc, int fr, int fq) const {
        const int row0 = u.pm * BM + wr * 64 + fr;
        const int cl = wc * 32 + 8 * fq;
        if constexpr (MODE == EPI_SWIGLU) {
#pragma unroll
            for (int ai = 0; ai < 2; ++ai)
#pragma unroll
                for (int m = 0; m < 4; ++m) {
                    bf16_t* rowp = O + (size_t)(row0 + ai * HALF + m * 16) * ldc + u.pn * 128 + cl;
                    f32x4 a0 = acc[ai][0][m][0], a1 = acc[ai][0][m][1], b0 = acc[ai][1][m][0], b1 = acc[ai][1][m][1];
                    u32x4 w;
                    w.x = cvt_pk_bf16(silu_f(a0[0]) * b0[0], silu_f(a0[1]) * b0[1]); w.y = cvt_pk_bf16(silu_f(a0[2]) * b0[2], silu_f(a0[3]) * b0[3]);
                    w.z = cvt_pk_bf16(silu_f(a1[0]) * b1[0], silu_f(a1[1]) * b1[1]); w.w = cvt_pk_bf16(silu_f(a1[2]) * b1[2], silu_f(a1[3]) * b1[3]);
                    *(u32x4*)rowp = w;
                }
        } else if constexpr (MODE == EPI_RESID) {
#pragma unroll
            for (int ai = 0; ai < 2; ++ai)
#pragma unroll
                for (int m = 0; m < 4; ++m) {
                    const size_t off = (size_t)(row0 + ai * HALF + m * 16) * ldc + u.pn * BM + cl;
#pragma unroll
                    for (int bj = 0; bj < 2; ++bj)
#pragma unroll
                        for (int n = 0; n < 2; ++n) {
                            const f32x4 b = *(const f32x4*)(Hbase + off + bj * HALF + 4 * n);
                            *(f32x4*)(Hout + off + bj * HALF + 4 * n) = b + acc[ai][bj][m][n] * scale;
                        }
                }
        } else if constexpr (MODE == EPI_RETQKV) {
            if (u.pn < 8) {
                const float ks = (u.pn >= 4) ? 0.0625f : 1.0f;
#pragma unroll
                for (int ai = 0; ai < 2; ++ai)
#pragma unroll
                    for (int m = 0; m < 4; ++m) {
                        const int r = row0 + ai * HALF + m * 16; const int pos = r & 4095;
                        bf16_t* rowp = O + (size_t)r * ldc + u.pn * BM + cl;
                        u32x4 w1, w2; unsigned* p1 = (unsigned*)&w1; unsigned* p2 = (unsigned*)&w2;
#pragma unroll
                        for (int n = 0; n < 2; ++n) {
                            const f32x4 c = *(const f32x4*)(rot + (size_t)pos * 128 + cl + 4 * n);
                            const f32x4 s = *(const f32x4*)(rot + (size_t)4096 * 128 + (size_t)pos * 128 + cl + 4 * n);
                            const f32x4 t1 = acc[ai][0][m][n] * ks, t2 = acc[ai][1][m][n] * ks;
                            const f32x4 o1 = t1 * c - t2 * s, o2 = t1 * s + t2 * c;
                            p1[2 * n] = cvt_pk_bf16(o1[0], o1[1]); p1[2 * n + 1] = cvt_pk_bf16(o1[2], o1[3]);
                            p2[2 * n] = cvt_pk_bf16(o2[0], o2[1]); p2[2 * n + 1] = cvt_pk_bf16(o2[2], o2[3]);
                        }
                        *(u32x4*)rowp = w1; *(u32x4*)(rowp + HALF) = w2;
                    }
            } else {
#pragma unroll
                for (int ai = 0; ai < 2; ++ai)
#pragma unroll
                    for (int m = 0; m < 4; ++m) {
                        bf16_t* rowp = O + (size_t)(row0 + ai * HALF + m * 16) * ldc + u.pn * BM + cl;
#pragma unroll
                        for (int bj = 0; bj < 2; ++bj) { const f32x4 v0 = acc[ai][bj][m][0], v1 = acc[ai][bj][m][1]; u32x4 w;
                            w.x = cvt_pk_bf16(v0[0], v0[1]); w.y = cvt_pk_bf16(v0[2], v0[3]); w.z = cvt_pk_bf16(v1[0], v1[1]); w.w = cvt_pk_bf16(v1[2], v1[3]);
                            *(u32x4*)(rowp + bj * HALF) = w; }
                    }
            }
        } else if constexpr (MODE == EPI_GATEMUL) {
#pragma unroll
            for (int ai = 0; ai < 2; ++ai)
#pragma unroll
                for (int m = 0; m < 4; ++m) {
                    bf16_t* rowp = O + (size_t)(row0 + ai * HALF + m * 16) * ldc + u.pn * BM + cl;
#pragma unroll
                    for (int bj = 0; bj < 2; ++bj) { const f32x4 v0 = acc[ai][bj][m][0], v1 = acc[ai][bj][m][1]; const u32x4 old = *(const u32x4*)(rowp + bj * HALF); u32x4 w;
                        w.x = cvt_pk_bf16(silu_f(v0[0]) * bf_lo(old.x), silu_f(v0[1]) * bf_hi(old.x)); w.y = cvt_pk_bf16(silu_f(v0[2]) * bf_lo(old.y), silu_f(v0[3]) * bf_hi(old.y));
                        w.z = cvt_pk_bf16(silu_f(v1[0]) * bf_lo(old.z), silu_f(v1[1]) * bf_hi(old.z)); w.w = cvt_pk_bf16(silu_f(v1[2]) * bf_lo(old.w), silu_f(v1[3]) * bf_hi(old.w));
                        *(u32x4*)(rowp + bj * HALF) = w; }
                }
        } else {
            if (MODE == EPI_SSD && u.pn == 20) {
                if (wc == 0) {
#pragma unroll
                    for (int ai = 0; ai < 2; ++ai)
#pragma unroll
                        for (int m = 0; m < 4; ++m) { float* p = aux + (size_t)(row0 + ai * HALF + m * 16) * 32 + cl;
                            *(f32x4*)p = acc[ai][0][m][0]; *(f32x4*)(p + 4) = acc[ai][0][m][1]; }
                }
                return;
            }
#pragma unroll
            for (int ai = 0; ai < 2; ++ai)
#pragma unroll
                for (int m = 0; m < 4; ++m) {
                    bf16_t* rowp = O + (size_t)(row0 + ai * HALF + m * 16) * ldc + u.pn * BM + cl;
#pragma unroll
                    for (int bj = 0; bj < 2; ++bj) { f32x4 v0 = acc[ai][bj][m][0], v1 = acc[ai][bj][m][1]; u32x4 w;
                        if (MODE == EPI_SILU) { v0 = (f32x4){silu_f(v0[0]), silu_f(v0[1]), silu_f(v0[2]), silu_f(v0[3])}; v1 = (f32x4){silu_f(v1[0]), silu_f(v1[1]), silu_f(v1[2]), silu_f(v1[3])}; }
                        w.x = cvt_pk_bf16(v0[0], v0[1]); w.y = cvt_pk_bf16(v0[2], v0[3]); w.z = cvt_pk_bf16(v1[0], v1[1]); w.w = cvt_pk_bf16(v1[2], v1[3]);
                        *(u32x4*)(rowp + bj * HALF) = w; }
                }
        }
    }
};
template <class Epi, class Sched, bool ALIGN_EPI = false, bool SP2 = false>
__device__ __forceinline__ void gemm_phase(PG8_LAS unsigned char* lds, const Gemm g, const Sched& S, const Epi& E) {
    int tid_ = threadIdx.x; asm volatile("" : "+v"(tid_)); const int tid = tid_, wid = __builtin_amdgcn_readfirstlane(tid >> 6), lane = tid & 63, wr = wid >> 2, wc = wid & 3, fr = lane & 15, fq = lane >> 4;
    const int K = g.K, nt = K / BK;
    unsigned voffA[2], voffB[2];
#pragma unroll
    for (int i = 0; i < 2; ++i) { int R, C; stage_rc(tid * 16 + i * 8192, R, C); const int Rb = Epi::PERM ? ((R & ~31) + perm32(R & 31)) : R;
        voffA[i] = (unsigned)(R * g.lda + C) * 2u; voffB[i] = (unsigned)(Rb * K + C) * 2u; }
    const size_t kstep = (size_t)(BK * 2);
    const size_t hstepA = (size_t)HALF * g.lda * 2, hstepB = (size_t)HALF * K * 2;
    const size_t tstepA = 2 * hstepA, tstepB = 2 * hstepB;
    const unsigned ldsw = (unsigned)wid * 1024u;
    const int aoff = lds_byte(wr * 64 + fr, fq * 8), boff = lds_byte(wc * 32 + fr, fq * 8);
#define PG8_SA(b, h) (((b) * 2 + (h)) * HTB)
#define PG8_SB(b, h) ((4 + (b) * 2 + (h)) * HTB)
#define PG8_STAGE(bufoff, gbase, voff) do { _Pragma("unroll") for (int _i = 0; _i < 2; ++_i) \
        __builtin_amdgcn_global_load_lds((const unsigned*)((const char*)(gbase) + (voff)[_i]), (PG8_LAS unsigned*)(lds + (bufoff) + ldsw + _i * 8192), 16, 0, 0); } while (0)
#define PG8_LDA(dst, b, h) do { _Pragma("unroll") for (int m = 0; m < 4; ++m) _Pragma("unroll") for (int k = 0; k < 2; ++k) dst[m][k] = *(const PG8_LAS bf16x8*)(lds + PG8_SA(b, h) + aoff + m * 2048 + k * 1024); } while (0)
#define PG8_LDB(dst, b, h) do { _Pragma("unroll") for (int n = 0; n < 2; ++n) _Pragma("unroll") for (int k = 0; k < 2; ++k) dst[n][k] = *(const PG8_LAS bf16x8*)(lds + PG8_SB(b, h) + boff + n * 2048 + k * 1024); } while (0)
#define PG8_MMA(ai, bj, At, Bt) do { __builtin_amdgcn_s_setprio(1); _Pragma("unroll") for (int m = 0; m < 4; ++m) _Pragma("unroll") for (int n = 0; n < 2; ++n) _Pragma("unroll") for (int k = 0; k < 2; ++k) \
        acc[ai][bj][m][n] = __builtin_amdgcn_mfma_f32_16x16x32_bf16(Bt[n][k], At[m][k], acc[ai][bj][m][n], 0, 0, 0); __builtin_amdgcn_s_setprio(0); } while (0)
#define PG8_WAIT_V(n) asm volatile("s_waitcnt vmcnt(" #n ")" ::: "memory")
#define PG8_WAIT_L(n) asm volatile("s_waitcnt lgkmcnt(" #n ")" ::: "memory")
#define PG8_BAR __builtin_amdgcn_s_barrier()
#define PG8_SCHED __builtin_amdgcn_sched_barrier(0)
    Unit cur, nxt; int ui = 0;
    if (!S.next(0, cur)) return;
    f32x4 acc[2][2][4][2];
#pragma unroll
    for (int a = 0; a < 2; ++a)
#pragma unroll
        for (int b = 0; b < 2; ++b)
#pragma unroll
            for (int m = 0; m < 4; ++m)
#pragma unroll
                for (int n = 0; n < 2; ++n) acc[a][b][m][n] = (f32x4){0.f, 0.f, 0.f, 0.f};
    bf16x8 At[4][2], B0[2][2], B1[2][2];
    const char* cA = (const char*)g.A + (size_t)cur.pm * tstepA; const char* cB = (const char*)g.Bt + (size_t)cur.pn * tstepB;
    S.a_ready(cur);
    if constexpr (SP2) {
        PG8_STAGE(PG8_SB(0, 0), cB, voffB); PG8_STAGE(PG8_SB(0, 1), cB + hstepB, voffB); PG8_STAGE(PG8_SA(0, 0), cA, voffA); PG8_STAGE(PG8_SA(0, 1), cA + hstepA, voffA);
        if (wr == 1) PG8_BAR;
        PG8_WAIT_V(2); PG8_BAR;
        PG8_STAGE(PG8_SB(1, 0), cB + kstep, voffB); PG8_STAGE(PG8_SA(1, 0), cA + kstep, voffA); PG8_STAGE(PG8_SB(1, 1), cB + hstepB + kstep, voffB);
        PG8_WAIT_V(6); PG8_BAR;
    } else {
        PG8_STAGE(PG8_SB(0, 0), cB, voffB); PG8_STAGE(PG8_SA(0, 0), cA, voffA); PG8_STAGE(PG8_SB(0, 1), cB + hstepB, voffB); PG8_STAGE(PG8_SA(0, 1), cA + hstepA, voffA);
        if (wr == 1) PG8_BAR;
        PG8_WAIT_V(4); PG8_BAR;
        PG8_STAGE(PG8_SB(1, 0), cB + kstep, voffB); PG8_STAGE(PG8_SA(1, 0), cA + kstep, voffA); PG8_STAGE(PG8_SB(1, 1), cB + hstepB + kstep, voffB);
        PG8_WAIT_V(6); PG8_BAR;
    }
    for (;;) {
        const bool has_next = S.next(ui + 1, nxt);
        const char* nA = has_next ? (const char*)g.A + (size_t)nxt.pm * tstepA : cA; const char* nB = has_next ? (const char*)g.Bt + (size_t)nxt.pn * tstepB : cB;
        for (int t = 0; t < nt; t += 2) {
            const bool last = (t == nt - 2);
            const char* a1 = cA + (size_t)(t + 1) * kstep;
            const char* a2 = last ? nA : cA + (size_t)(t + 2) * kstep; const char* b2 = last ? nB : cB + (size_t)(t + 2) * kstep;
            const char* a3 = a2 + kstep; const char* b3 = b2 + kstep;
            if (last && has_next) S.a_ready(nxt);
            if constexpr (SP2) {
            PG8_LDB(B0, 0, 0); PG8_LDB(B1, 0, 1); PG8_SCHED; PG8_LDA(At, 0, 0); PG8_STAGE(PG8_SA(1, 1), a1 + hstepA, voffA);
            PG8_WAIT_V(8); PG8_WAIT_L(0); PG8_BAR; PG8_MMA(0, 0, At, B0); PG8_MMA(0, 1, At, B1); PG8_BAR; PG8_SCHED;
            PG8_LDA(At, 0, 1); PG8_STAGE(PG8_SB(0, 0), b2, voffB); PG8_STAGE(PG8_SB(0, 1), b2 + hstepB, voffB); PG8_STAGE(PG8_SA(0, 0), a2, voffA);
            PG8_WAIT_V(8); PG8_WAIT_L(0); PG8_BAR; PG8_MMA(1, 0, At, B0); PG8_MMA(1, 1, At, B1); PG8_BAR; PG8_SCHED;
            PG8_LDB(B0, 1, 0); PG8_LDB(B1, 1, 1); PG8_SCHED; PG8_LDA(At, 1, 0); PG8_STAGE(PG8_SA(0, 1), a2 + hstepA, voffA);
            PG8_WAIT_V(8); PG8_WAIT_L(0); PG8_BAR; PG8_MMA(0, 0, At, B0); PG8_MMA(0, 1, At, B1); PG8_BAR; PG8_SCHED;
            PG8_LDA(At, 1, 1); PG8_STAGE(PG8_SB(1, 0), b3, voffB); PG8_STAGE(PG8_SB(1, 1), b3 + hstepB, voffB); PG8_STAGE(PG8_SA(1, 0), a3, voffA);
            PG8_WAIT_V(8); PG8_WAIT_L(0); PG8_BAR; PG8_MMA(1, 0, At, B0); PG8_MMA(1, 1, At, B1); PG8_BAR; PG8_SCHED;
            } else {
            PG8_LDB(B0, 0, 0); PG8_SCHED; PG8_LDA(At, 0, 0); PG8_STAGE(PG8_SA(1, 1), a1 + hstepA, voffA);
            PG8_WAIT_L(8); PG8_BAR; PG8_WAIT_L(0); PG8_MMA(0, 0, At, B0); PG8_BAR; PG8_SCHED;
            PG8_LDB(B1, 0, 1); PG8_STAGE(PG8_SB(0, 0), b2, voffB);
            PG8_BAR; PG8_WAIT_L(0); PG8_MMA(0, 1, At, B1); PG8_BAR;
            PG8_LDA(At, 0, 1); PG8_STAGE(PG8_SA(0, 0), a2, voffA);
            PG8_BAR; PG8_WAIT_L(0); PG8_MMA(1, 0, At, B0); PG8_BAR; PG8_SCHED;
            PG8_STAGE(PG8_SB(0, 1), b2 + hstepB, voffB);
            PG8_WAIT_V(6); PG8_BAR; PG8_MMA(1, 1, At, B1); PG8_BAR;
            PG8_LDB(B0, 1, 0); PG8_SCHED; PG8_LDA(At, 1, 0); PG8_STAGE(PG8_SA(0, 1), a2 + hstepA, voffA);
            PG8_WAIT_L(8); PG8_BAR; PG8_WAIT_L(0); PG8_MMA(0, 0, At, B0); PG8_BAR; PG8_SCHED;
            PG8_LDB(B1, 1, 1); PG8_STAGE(PG8_SB(1, 0), b3, voffB);
            PG8_BAR; PG8_WAIT_L(0); PG8_MMA(0, 1, At, B1); PG8_BAR;
            PG8_LDA(At, 1, 1); PG8_STAGE(PG8_SA(1, 0), a3, voffA);
            PG8_BAR; PG8_WAIT_L(0); PG8_MMA(1, 0, At, B0); PG8_BAR; PG8_SCHED;
            PG8_STAGE(PG8_SB(1, 1), b3 + hstepB, voffB);
            PG8_WAIT_V(6); PG8_BAR; PG8_MMA(1, 1, At, B1); PG8_BAR;
            }
        }
        if constexpr (ALIGN_EPI) { if (wr == 0) PG8_BAR; }
        if constexpr (!Epi::AFTER_DRAIN) { E(acc, cur, wr, wc, fr, fq); S.done(cur); }
        if (!has_next) break;
#pragma unroll
        for (int a = 0; a < 2; ++a)
#pragma unroll
            for (int b = 0; b < 2; ++b)
#pragma unroll
                for (int m = 0; m < 4; ++m)
#pragma unroll
                    for (int n = 0; n < 2; ++n) acc[a][b][m][n] = (f32x4){0.f, 0.f, 0.f, 0.f};
        cur = nxt; cA = nA; cB = nB; ++ui;
        if constexpr (ALIGN_EPI) { if (wr == 1) PG8_BAR; }
    }
    PG8_WAIT_V(0);
    if constexpr (!ALIGN_EPI) { if (wr == 0) PG8_BAR; }
    PG8_BAR;
    if constexpr (Epi::AFTER_DRAIN) { E.fused(acc, cur, wr, wc, fr, fq, lds, wid, lane); S.done(cur); }
#undef PG8_SA
#undef PG8_SB
#undef PG8_STAGE
#undef PG8_LDA
#undef PG8_LDB
#undef PG8_MMA
#undef PG8_WAIT_V
#undef PG8_WAIT_L
#undef PG8_BAR
#undef PG8_SCHED
}
}
#define GAS __attribute__((address_space(1)))
#define LAS __attribute__((address_space(3)))
typedef unsigned short bf16;
typedef unsigned v4u __attribute__((ext_vector_type(4)));
typedef unsigned v2u __attribute__((ext_vector_type(2)));
typedef float f32x4 __attribute__((ext_vector_type(4)));
typedef short bf16x8 __attribute__((ext_vector_type(8)));
typedef short s16x4 __attribute__((ext_vector_type(4)));
using pg8::cvt_pk_bf16; using pg8::bf_lo; using pg8::bf_hi; using pg8::silu_f; using pg8::sigmoid_f;

constexpr int NWAVES = 8, NTHR = 512;
constexpr int BATCH = 8, SEQ = 4096, T = BATCH * SEQ, D = 1024, FF = 2816, DEPTH = 4;
constexpr float NORM_EPS = 1e-6f;
constexpr int LDS_BYTES = 147456;
constexpr size_t MiB = 1u << 20;
constexpr size_t WS_ROT = 1 * MiB;
constexpr size_t WS_W = 8 * MiB;
constexpr size_t WS_WIN1 = WS_W, WS_WOUT1 = WS_W + 11 * MiB, WS_WIN2 = WS_W + 17 * MiB, WS_WOUT2 = WS_W + 28 * MiB, WS_WMIX = WS_W + 34 * MiB;
constexpr size_t WS_U = 64 * MiB;
constexpr size_t WS_SCR = 128 * MiB;
constexpr size_t WS_NEED = 484 * MiB;

struct Args { const float* in[27]; float* out; unsigned char* ws; int ph_lo, ph_hi; };

__device__ __forceinline__ float wave_sum(float v) {
#pragma unroll
    for (int o = 1; o < 64; o <<= 1) v += __shfl_xor(v, o);
    return v;
}
__device__ __forceinline__ unsigned pk2(float lo, float hi) { return cvt_pk_bf16(lo, hi); }

template <int MAP> __device__ __forceinline__ void transpose_w(const float* W, int K, int N, int Npad, bf16* WT, LAS float* scr, int gw, int NGW, int lane) {
    asm volatile("" : "+v"(lane));
    const int nblk = Npad / 32, nitems = (K / 64) * nblk;
    for (int item = gw; item < nitems; item += NGW) {
        const int kb = item / nblk, nb = item % nblk, k0 = 64 * kb, n0 = 32 * nb;
        const int nn = n0 + (lane & 31);
#pragma unroll 8
        for (int i = 0; i < 32; ++i) { const int kk = 2 * i + (lane >> 5); scr[kk * 33 + (lane & 31)] = (nn < N) ? W[(size_t)(k0 + kk) * N + nn] : 0.f; }
        asm volatile("s_waitcnt lgkmcnt(0)" ::: "memory");
        int r0 = n0;
        if (MAP == 1) { r0 = (n0 < FF) ? (n0 / 128) * 256 + (n0 % 128) : ((n0 - FF) / 128) * 256 + 128 + ((n0 - FF) % 128); }
        const int c = lane & 7;
#pragma unroll
        for (int j = 0; j < 4; ++j) { const int n = (lane >> 3) + 8 * j; const LAS float* s = scr + (8 * c) * 33 + n;
            v4u o; o.x = pk2(s[0 * 33], s[1 * 33]); o.y = pk2(s[2 * 33], s[3 * 33]); o.z = pk2(s[4 * 33], s[5 * 33]); o.w = pk2(s[6 * 33], s[7 * 33]);
            *(v4u*)(WT + (size_t)(r0 + n) * K + k0 + 8 * c) = o; }
        asm volatile("s_waitcnt lgkmcnt(0)" ::: "memory");
    }
}

__device__ __forceinline__ void rms_rows(const float* X, const float* gain, bf16* U, float* Hcopy, int gw, int NGW, int lane) {
    asm volatile("" : "+v"(lane));
    f32x4 g[4];
#pragma unroll
    for (int j = 0; j < 4; ++j) g[j] = ((const f32x4*)gain)[lane + 64 * j];
    for (int m = gw; m < T; m += NGW) {
        const f32x4* xr = (const f32x4*)(X + (size_t)m * D) + lane;
        f32x4 v[4]; float s = 0.f;
#pragma unroll
        for (int j = 0; j < 4; ++j) { v[j] = xr[64 * j]; s += (v[j].x * v[j].x + v[j].y * v[j].y) + (v[j].z * v[j].z + v[j].w * v[j].w); }
        const float rstd = rsqrtf(wave_sum(s) * (1.f / D) + NORM_EPS);
        if (Hcopy) { f32x4* hr = (f32x4*)(Hcopy + (size_t)m * D) + lane;
#pragma unroll
            for (int j = 0; j < 4; ++j) hr[64 * j] = v[j]; }
        v2u* o8 = (v2u*)(U + (size_t)m * D) + lane;
#pragma unroll
        for (int j = 0; j < 4; ++j) { v2u w; w.x = pk2(v[j].x * rstd * g[j].x, v[j].y * rstd * g[j].y); w.y = pk2(v[j].z * rstd * g[j].z, v[j].w * rstd * g[j].w); o8[64 * j] = w; }
    }
}
__device__ __forceinline__ void rms_final(float* X, const float* gain, int gw, int NGW, int lane) {
    asm volatile("" : "+v"(lane));
    f32x4 g[4];
#pragma unroll
    for (int j = 0; j < 4; ++j) g[j] = ((const f32x4*)gain)[lane + 64 * j];
    for (int m = gw; m < T; m += NGW) {
        f32x4* xr = (f32x4*)(X + (size_t)m * D) + lane;
        f32x4 v[4]; float s = 0.f;
#pragma unroll
        for (int j = 0; j < 4; ++j) { v[j] = xr[64 * j]; s += (v[j].x * v[j].x + v[j].y * v[j].y) + (v[j].z * v[j].z + v[j].w * v[j].w); }
        const float rstd = rsqrtf(wave_sum(s) * (1.f / D) + NORM_EPS);
#pragma unroll
        for (int j = 0; j < 4; ++j) xr[64 * j] = v[j] * rstd * g[j];
    }
}

template <int MODE> __device__ __forceinline__ void run_gemm(LAS unsigned char* lds, const bf16* A, int lda, const bf16* Bt, int M, int N, int K, const pg8::Epi<MODE>& E) {
    pg8::Gemm g{A, Bt, M, N, K, lda}; pg8::StaticOrder S; S.init(M, N, (int)gridDim.x, (int)blockIdx.x);
    pg8::gemm_phase<pg8::Epi<MODE>, pg8::StaticOrder, true, true>(lds, g, S, E);
}
typedef short v4i16_t __attribute__((ext_vector_type(4)));
__device__ __forceinline__ s16x4 ldtr(const LAS unsigned char* p) { return __builtin_bit_cast(s16x4, __builtin_amdgcn_ds_read_tr16_b64_v4i16((LAS v4i16_t*)p)); }
__device__ __forceinline__ bf16x8 tr2(const LAS unsigned char* p, int stride4) { const s16x4 a = ldtr(p), b = ldtr(p + stride4); return (bf16x8){a[0], a[1], a[2], a[3], b[0], b[1], b[2], b[3]}; }
__device__ __forceinline__ f32x4 mfma16(bf16x8 a, bf16x8 b, f32x4 c) { return __builtin_amdgcn_mfma_f32_16x16x32_bf16(a, b, c, 0, 0, 0); }
__device__ __forceinline__ bf16x8 ldrow(const LAS unsigned char* p) { return *(const LAS bf16x8*)p; }
__device__ __forceinline__ float softplus_f(float x) { return x > 20.f ? x : log1pf(__expf(x)); }

template <int DK, bool SSD>
__device__ __forceinline__ void scan_item(LAS unsigned char* lds, const bf16* Qg, const bf16* Kg, const bf16* Vg, int pitch, bf16* Og, int opitch,
                                          float lg, const float* dtraw, float dtbias, float Aneg, float Dskip) {
    constexpr int KS = (DK + 8) * 2, VS = 144;
    constexpr int OFF_K = 0, OFF_ST = OFF_K + 64 * KS, OFF_VS = OFF_ST + 64 * KS, OFF_VW = OFF_VS + 64 * VS, OFF_SD = OFF_VW + 64 * VS;
    constexpr int NKS = DK / 32, NMT = DK / 128, NKP = DK / 64;
    int tid_ = threadIdx.x; asm volatile("" : "+v"(tid_));
    const int tid = tid_, lane = tid & 63, wave = __builtin_amdgcn_readfirstlane(tid >> 6);
    const int it = wave & 3, hf = wave >> 2, l15 = lane & 15, g = lane >> 4, q4 = l15 >> 2, p4 = l15 & 3;
    for (int i = tid; i < 64 * KS / 4; i += NTHR) ((LAS unsigned*)(lds + OFF_ST))[i] = 0u;
    f32x4 st[NMT * 4];
#pragma unroll
    for (int i = 0; i < NMT * 4; ++i) st[i] = (f32x4){0.f, 0.f, 0.f, 0.f};
    v4u kreg[NKP]; v4u vreg; bf16x8 qreg[NKS]; float dtv = 0.f;
    const int vrow = tid >> 3, vpc = tid & 7;
    {
#pragma unroll
        for (int i = 0; i < NKP; ++i) { const int idx = tid + NTHR * i, row = idx / (DK / 8), pc = idx % (DK / 8); kreg[i] = *(const v4u*)(Kg + (size_t)row * pitch + pc * 8); }
        vreg = *(const v4u*)(Vg + (size_t)vrow * pitch + vpc * 8);
#pragma unroll
        for (int kk = 0; kk < NKS; ++kk) qreg[kk] = *(const bf16x8*)(Qg + (size_t)(16 * it + l15) * pitch + 8 * g + 32 * kk);
        if (SSD) dtv = dtraw[(size_t)lane * 32];
    }
    for (int c = 0; c < 64; ++c) {
        const int t0 = c * 64;
        float aj, vsj;
        if (SSD) { const float dt = softplus_f(dtv + dtbias); aj = dt * Aneg; vsj = dt; } else { aj = lg; vsj = 1.f; }
        float Lv = aj;
#pragma unroll
        for (int o = 1; o < 64; o <<= 1) { const float t = __shfl_up(Lv, o); if (lane >= o) Lv += t; }
        const float Llast = __shfl(Lv, 63);
        const float wv = __expf(Llast - Lv);
#pragma unroll
        for (int i = 0; i < NKP; ++i) { const int idx = tid + NTHR * i, row = idx / (DK / 8), pc = idx % (DK / 8); *(LAS v4u*)(lds + OFF_K + row * KS + pc * 16) = kreg[i]; }
        {
            const float vs = __shfl(vsj, vrow & 63), ww = __shfl(wv, vrow & 63) * vs;
            const float x0 = bf_lo(vreg.x), x1 = bf_hi(vreg.x), x2 = bf_lo(vreg.y), x3 = bf_hi(vreg.y), x4 = bf_lo(vreg.z), x5 = bf_hi(vreg.z), x6 = bf_lo(vreg.w), x7 = bf_hi(vreg.w);
            v4u a, b;
            a.x = pk2(x0 * vs, x1 * vs); a.y = pk2(x2 * vs, x3 * vs); a.z = pk2(x4 * vs, x5 * vs); a.w = pk2(x6 * vs, x7 * vs);
            b.x = pk2(x0 * ww, x1 * ww); b.y = pk2(x2 * ww, x3 * ww); b.z = pk2(x4 * ww, x5 * ww); b.w = pk2(x6 * ww, x7 * ww);
            *(LAS v4u*)(lds + OFF_VS + vrow * VS + vpc * 16) = a; *(LAS v4u*)(lds + OFF_VW + vrow * VS + vpc * 16) = b;
        }
        bf16x8 qc[NKS];
#pragma unroll
        for (int kk = 0; kk < NKS; ++kk) qc[kk] = qreg[kk];
        if (c + 1 < 64) {
            const int t1 = t0 + 64;
#pragma unroll
            for (int i = 0; i < NKP; ++i) { const int idx = tid + NTHR * i, row = idx / (DK / 8), pc = idx % (DK / 8); kreg[i] = *(const v4u*)(Kg + (size_t)(t1 + row) * pitch + pc * 8); }
            vreg = *(const v4u*)(Vg + (size_t)(t1 + vrow) * pitch + vpc * 8);
#pragma unroll
            for (int kk = 0; kk < NKS; ++kk) qreg[kk] = *(const bf16x8*)(Qg + (size_t)(t1 + 16 * it + l15) * pitch + 8 * g + 32 * kk);
            if (SSD) dtv = dtraw[(size_t)(t1 + lane) * 32];
        }
        __syncthreads();
        const float Li = __shfl(Lv, 16 * it + l15);
#pragma unroll
        for (int jj = 0; jj < 2; ++jj) {
            const int jt = 2 * hf + jj;
            f32x4 s = (f32x4){0.f, 0.f, 0.f, 0.f};
            if (jt <= it) {
#pragma unroll
                for (int kk = 0; kk < NKS; ++kk) s = mfma16(ldrow(lds + OFF_K + (16 * jt + l15) * KS + (8 * g + 32 * kk) * 2), qc[kk], s);
            }
            float o[4];
#pragma unroll
            for (int r = 0; r < 4; ++r) { const int j = 16 * jt + 4 * g + r; const float Lj = __shfl(Lv, j); o[r] = (j <= 16 * it + l15) ? s[r] * __expf(Li - Lj) : 0.f; }
            v2u w; w.x = pk2(o[0], o[1]); w.y = pk2(o[2], o[3]);
            *(LAS v2u*)(lds + OFF_SD + (16 * it + l15) * VS + (16 * jt + 4 * g) * 2) = w;
        }
        f32x4 o2[2];
#pragma unroll
        for (int dd = 0; dd < 2; ++dd) {
            const int dt = 2 * hf + dd; f32x4 a = (f32x4){0.f, 0.f, 0.f, 0.f};
#pragma unroll
            for (int kk = 0; kk < NKS; ++kk) a = mfma16(qc[kk], ldrow(lds + OFF_ST + (16 * dt + l15) * KS + (8 * g + 32 * kk) * 2), a);
            o2[dd] = a;
        }
        __syncthreads();
        float ei[4];
#pragma unroll
        for (int r = 0; r < 4; ++r) ei[r] = __expf(__shfl(Lv, 16 * it + 4 * g + r));
#pragma unroll
        for (int dd = 0; dd < 2; ++dd) {
            const int dt = 2 * hf + dd; f32x4 a = (f32x4){0.f, 0.f, 0.f, 0.f};
#pragma unroll
            for (int kk = 0; kk < 2; ++kk)
                a = mfma16(ldrow(lds + OFF_SD + (16 * it + l15) * VS + (8 * g + 32 * kk) * 2), tr2(lds + OFF_VS + (32 * kk + 8 * g + q4) * VS + (16 * dt + 4 * p4) * 2, 4 * VS), a);
#pragma unroll
            for (int r = 0; r < 4; ++r) {
                const int i = 16 * it + 4 * g + r, col = 16 * dt + l15;
                float o = a[r] + o2[dd][r] * ei[r];
                bf16* op = Og + (size_t)(t0 + i) * opitch + col;
                if (SSD) { const float xs = __uint_as_float((unsigned)Vg[(size_t)(t0 + i) * pitch + col] << 16), z = __uint_as_float((unsigned)(*op) << 16); o = (o + Dskip * xs) * silu_f(z); }
                *op = (bf16)(pk2(o, 0.f) & 0xffffu);
            }
        }
        const float cd = __expf(Llast);
#pragma unroll
        for (int i = 0; i < NMT * 4; ++i) st[i] = st[i] * cd;
#pragma unroll
        for (int mm = 0; mm < NMT; ++mm) {
            const int mt = NMT * wave + mm;
#pragma unroll
            for (int kk = 0; kk < 2; ++kk) {
                const bf16x8 a = tr2(lds + OFF_K + (32 * kk + 8 * g + q4) * KS + (16 * mt + 4 * p4) * 2, 4 * KS);
#pragma unroll
                for (int dt = 0; dt < 4; ++dt) st[mm * 4 + dt] = mfma16(a, tr2(lds + OFF_VW + (32 * kk + 8 * g + q4) * VS + (16 * dt + 4 * p4) * 2, 4 * VS), st[mm * 4 + dt]);
            }
#pragma unroll
            for (int dt = 0; dt < 4; ++dt) { const f32x4 s = st[mm * 4 + dt]; v2u w; w.x = pk2(s[0], s[1]); w.y = pk2(s[2], s[3]);
                *(LAS v2u*)(lds + OFF_ST + (16 * dt + l15) * KS + (16 * mt + 4 * g) * 2) = w; }
        }
        __syncthreads();
    }
}

__device__ __forceinline__ void gnorm_rows(bf16* X, int pitch, const float* gain, int gw, int NGW, int lane) {
    asm volatile("" : "+v"(lane));
    for (int m = gw; m < T * 4; m += NGW) {
        const int row = m >> 2, gq = m & 3;
        v4u* p = (v4u*)(X + (size_t)row * pitch + gq * 512) + lane;
        const v4u v = *p;
        float x[8] = {bf_lo(v.x), bf_hi(v.x), bf_lo(v.y), bf_hi(v.y), bf_lo(v.z), bf_hi(v.z), bf_lo(v.w), bf_hi(v.w)};
        float s = 0.f;
#pragma unroll
        for (int e = 0; e < 8; ++e) s += x[e] * x[e];
        const float rstd = rsqrtf(wave_sum(s) * (1.f / 512.f) + NORM_EPS);
        const f32x4 g0 = *(const f32x4*)(gain + gq * 512 + lane * 8), g1 = *(const f32x4*)(gain + gq * 512 + lane * 8 + 4);
        v4u o; o.x = pk2(x[0] * rstd * g0.x, x[1] * rstd * g0.y); o.y = pk2(x[2] * rstd * g0.z, x[3] * rstd * g0.w); o.z = pk2(x[4] * rstd * g1.x, x[5] * rstd * g1.y); o.w = pk2(x[6] * rstd * g1.z, x[7] * rstd * g1.w);
        *p = o;
    }
}
constexpr int SSD_PITCH = 5376, SSD_XBC0 = 2048, SSD_XBCW = 3072;
__device__ __forceinline__ void ssd_halo_save(const bf16* PROJ, bf16* HALO, int gtid, int GT) {
    asm volatile("" : "+v"(gtid));
    for (int idx = gtid; idx < 512 * 3 * 384; idx += GT) {
        const int c8 = idx % 384, r = (idx / 384) % 3, seg = idx / (3 * 384), t0 = seg * 64;
        v4u v = (v4u){0u, 0u, 0u, 0u};
        if ((t0 & 4095) != 0) v = *(const v4u*)(PROJ + (size_t)(t0 - 3 + r) * SSD_PITCH + SSD_XBC0 + c8 * 8);
        *(v4u*)(HALO + ((size_t)seg * 3 + r) * SSD_XBCW + c8 * 8) = v;
    }
}
__device__ __forceinline__ void unpack8(const v4u v, float (&x)[8]) { x[0] = bf_lo(v.x); x[1] = bf_hi(v.x); x[2] = bf_lo(v.y); x[3] = bf_hi(v.y); x[4] = bf_lo(v.z); x[5] = bf_hi(v.z); x[6] = bf_lo(v.w); x[7] = bf_hi(v.w); }
__device__ __forceinline__ void ssd_conv(bf16* PROJ, const bf16* HALO, const float* cw, const float* cb, int gtid, int GT) {
    asm volatile("" : "+v"(gtid));
    for (int idx = gtid; idx < 512 * 384; idx += GT) {
        const int c8 = idx % 384, seg = idx / 384, t0 = seg * 64;
        float w0[8], w1[8], w2[8], w3[8], bb[8], xa[8], xb[8], xc[8], xd[8];
#pragma unroll
        for (int e = 0; e < 8; ++e) { w0[e] = cw[c8 * 8 + e]; w1[e] = cw[SSD_XBCW + c8 * 8 + e]; w2[e] = cw[2 * SSD_XBCW + c8 * 8 + e]; w3[e] = cw[3 * SSD_XBCW + c8 * 8 + e]; bb[e] = cb[c8 * 8 + e]; }
        unpack8(*(const v4u*)(HALO + ((size_t)seg * 3 + 0) * SSD_XBCW + c8 * 8), xa);
        unpack8(*(const v4u*)(HALO + ((size_t)seg * 3 + 1) * SSD_XBCW + c8 * 8), xb);
        unpack8(*(const v4u*)(HALO + ((size_t)seg * 3 + 2) * SSD_XBCW + c8 * 8), xc);
        bf16* p = PROJ + (size_t)t0 * SSD_PITCH + SSD_XBC0 + c8 * 8;
        for (int tt = 0; tt < 64; ++tt, p += SSD_PITCH) {
            unpack8(*(const v4u*)p, xd);
            float o[8];
#pragma unroll
            for (int e = 0; e < 8; ++e) { o[e] = silu_f(bb[e] + w0[e] * xa[e] + w1[e] * xb[e] + w2[e] * xc[e] + w3[e] * xd[e]); xa[e] = xb[e]; xb[e] = xc[e]; xc[e] = xd[e]; }
            v4u w; w.x = pk2(o[0], o[1]); w.y = pk2(o[2], o[3]); w.z = pk2(o[4], o[5]); w.w = pk2(o[6], o[7]);
            *(v4u*)p = w;
        }
    }
}
template <int DH> struct FaState { float m, l; f32x4 o[DH / 16]; };
template <int DH> __device__ __forceinline__ void fa_init(FaState<DH>& st) { st.m = -1e30f; st.l = 0.f;
#pragma unroll
    for (int i = 0; i < DH / 16; ++i) st.o[i] = (f32x4){0.f, 0.f, 0.f, 0.f}; }
__device__ __forceinline__ float fexp2(float x) { return __builtin_amdgcn_exp2f(x); }

template <int DH, class Mask>
__device__ __forceinline__ void fa_tile(const LAS unsigned char* Kt, const LAS unsigned char* Vt, const bf16x8 (&qf)[DH / 32], FaState<DH>& st, float sc2, const Mask& mk, int key0, int l15, int g, int q4, int p4) {
    constexpr int KS = (DH + 8) * 2;
    f32x4 s0 = (f32x4){0.f, 0.f, 0.f, 0.f}, s1 = s0;
#pragma unroll
    for (int kk = 0; kk < DH / 32; ++kk) {
        s0 = mfma16(ldrow(Kt + l15 * KS + (8 * g + 32 * kk) * 2), qf[kk], s0);
        s1 = mfma16(ldrow(Kt + (16 + l15) * KS + (8 * g + 32 * kk) * 2), qf[kk], s1);
    }
    float v[8]; bool ok[8]; float tm = -1e30f;
#pragma unroll
    for (int r = 0; r < 4; ++r) {
        ok[r] = mk.valid(key0 + 4 * g + r); ok[4 + r] = mk.valid(key0 + 16 + 4 * g + r);
        v[r] = ok[r] ? s0[r] * sc2 : -1e30f; v[4 + r] = ok[4 + r] ? s1[r] * sc2 : -1e30f;
        tm = fmaxf(tm, fmaxf(v[r], v[4 + r]));
    }
    tm = fmaxf(tm, __shfl_xor(tm, 16)); tm = fmaxf(tm, __shfl_xor(tm, 32));
    const float mn = fmaxf(st.m, tm), alpha = fexp2(st.m - mn);
    float p[8], ps = 0.f;
#pragma unroll
    for (int e = 0; e < 8; ++e) { p[e] = ok[e] ? fexp2(v[e] - mn) : 0.f; ps += p[e]; }
    ps += __shfl_xor(ps, 16); ps += __shfl_xor(ps, 32);
    st.l = st.l * alpha + ps; st.m = mn;
    v4u pbu; pbu.x = pk2(p[0], p[1]); pbu.y = pk2(p[2], p[3]); pbu.z = pk2(p[4], p[5]); pbu.w = pk2(p[6], p[7]);
    const bf16x8 pb = __builtin_bit_cast(bf16x8, pbu);
#pragma unroll
    for (int dt = 0; dt < DH / 16; ++dt) {
        const s16x4 a = ldtr(Vt + (4 * g + q4) * KS + (16 * dt + 4 * p4) * 2), b = ldtr(Vt + (16 + 4 * g + q4) * KS + (16 * dt + 4 * p4) * 2);
        st.o[dt] = mfma16((bf16x8){a[0], a[1], a[2], a[3], b[0], b[1], b[2], b[3]}, pb, st.o[dt] * alpha);
    }
}

template <int DH, class Src, class Mask>
__device__ __forceinline__ void fa_stream(LAS unsigned char* lds, int tid, int s_begin, int s_end, const Src& src, const Mask& mk, const bf16x8 (&qf)[DH / 32], FaState<DH>& st, float sc2) {
    constexpr int KS = (DH + 8) * 2, TB = 32 * KS;
    if (s_begin >= s_end) return;
    const int lane = tid & 63, l15 = lane & 15, g = lane >> 4, q4 = l15 >> 2, p4 = l15 & 3;
    v4u rk, rv;
    int lj, lpc; bool isv = false;
    if constexpr (DH == 128) { lj = tid >> 4; lpc = tid & 15; } else { lj = (tid & 255) >> 3; lpc = tid & 7; isv = tid >= 256; }
    auto issue = [&](int s) {
        if constexpr (DH == 128) { rk = *(const v4u*)(src.krow(s, lj) + lpc * 8); rv = *(const v4u*)(src.vrow(s, lj) + lpc * 8); }
        else { rk = *(const v4u*)((isv ? src.vrow(s, lj) : src.krow(s, lj)) + lpc * 8); }
    };
    auto commit = [&](int buf) {
        if constexpr (DH == 128) { *(LAS v4u*)(lds + buf * TB + lj * KS + lpc * 16) = rk; *(LAS v4u*)(lds + (2 + buf) * TB + lj * KS + lpc * 16) = rv; }
        else { *(LAS v4u*)(lds + ((isv ? 2 : 0) + buf) * TB + lj * KS + lpc * 16) = rk; }
    };
    issue(s_begin); commit(0);
    __syncthreads();
    for (int s = s_begin; s < s_end; ++s) {
        const int cur = (s - s_begin) & 1;
        if (s + 1 < s_end) issue(s + 1);
        if (mk.wave_needs(s)) fa_tile<DH, Mask>(lds + cur * TB, lds + (2 + cur) * TB, qf, st, sc2, mk, mk.key0(s), l15, g, q4, p4);
        if (s + 1 < s_end) commit(cur ^ 1);
        __syncthreads();
    }
}

constexpr int DIL_PITCH = 3072;
struct DilSrc { const bf16* kbase; int band0, r, c;
    __device__ __forceinline__ const bf16* krow(int s, int j) const { int a = band0 + 32 * s + j; a = a < 0 ? 0 : a; return kbase + (size_t)(a * r + c) * DIL_PITCH; }
    __device__ __forceinline__ const bf16* vrow(int s, int j) const { return krow(s, j) + 1024; } };
struct DilMask { int aq, band0, w;
    __device__ __forceinline__ bool valid(int ak) const { return ak >= 0 && ak <= aq && aq - ak <= 128; }
    __device__ __forceinline__ bool wave_needs(int s) const { return 32 * s + 31 >= 16 * w && 32 * s <= 16 * w + 143; }
    __device__ __forceinline__ int key0(int s) const { return band0 + 32 * s; } };

__device__ __forceinline__ void dilated_phase(LAS unsigned char* lds, const bf16* PROJD, bf16* OACC, float* LSE, int gi, int G) {
    int tid_ = threadIdx.x; asm volatile("" : "+v"(tid_));
    const int tid = tid_, lane = tid & 63, wave = __builtin_amdgcn_readfirstlane(tid >> 6), l15 = lane & 15, g = lane >> 4;
    const int r = (gi == 0) ? 1 : (gi == 1 ? 4 : 16);
    const float sc2 = 0.08838834764831845f * 1.4426950408889634f;
    for (int item = blockIdx.x; item < 2048; item += G) {
        const int bh = item >> 5, b = bh >> 3, h = bh & 7, rem = item & 31, c = rem % r, qt = rem / r;
        const bf16* base = PROJD + (size_t)b * SEQ * DIL_PITCH + h * 128;
        const int aq = 128 * qt + 16 * wave + l15, tq = aq * r + c;
        bf16x8 qf[4];
#pragma unroll
        for (int kk = 0; kk < 4; ++kk) qf[kk] = *(const bf16x8*)(base + (size_t)tq * DIL_PITCH + 8 * g + 32 * kk);
        DilSrc src{base + 1024, 128 * qt - 128, r, c};
        DilMask mk{aq, 128 * qt - 128, wave};
        FaState<128> st; fa_init<128>(st);
        fa_stream<128, DilSrc, DilMask>(lds, tid, qt == 0 ? 4 : 0, 8, src, mk, qf, st, sc2);
        const float inv = 1.f / fmaxf(st.l, 1e-30f);
        float lse = (st.m + __log2f(fmaxf(st.l, 1e-30f))) * 0.6931471805599453f;
        const size_t trow = (size_t)b * SEQ + tq;
        float wp = 0.f, wn = 1.f;
        if (gi > 0) { const float lp = LSE[trow * 8 + h]; const float mx = fmaxf(lp, lse); const float ep = __expf(lp - mx), en = __expf(lse - mx); const float den = ep + en; wp = ep / den; wn = en / den; lse = mx + __logf(den); }
        bf16* op = OACC + trow * 1024 + h * 128 + 4 * g;
#pragma unroll
        for (int dt = 0; dt < 8; ++dt) {
            f32x4 o = st.o[dt] * (inv * wn);
            if (gi > 0) { const v2u old = *(const v2u*)(op + 16 * dt); o[0] += wp * bf_lo(old.x); o[1] += wp * bf_hi(old.x); o[2] += wp * bf_lo(old.y); o[3] += wp * bf_hi(old.y); }
            v2u w; w.x = pk2(o[0], o[1]); w.y = pk2(o[2], o[3]);
            *(v2u*)(op + 16 * dt) = w;
        }
        if (g == 0) LSE[trow * 8 + h] = lse;
    }
}
constexpr int NSA_PITCH = 2816;
__device__ __forceinline__ void nsa_im2col(const bf16* PROJN, const float* pos, bf16* ACMP, int gtid, int GT) {
    asm volatile("" : "+v"(gtid));
    for (int idx = gtid; idx < 2 * 8192 * 256; idx += GT) {
        const int pc = idx & 255, row = (idx >> 8) & 8191, kv = idx >> 21;
        const int l = pc >> 3, d0 = (pc & 7) * 8, n = row & 255, bg = row >> 8, b = bg >> 2, gq = bg & 3;
        v4u o = (v4u){0u, 0u, 0u, 0u};
        if (n < 255) {
            const v4u v = *(const v4u*)(PROJN + (size_t)(b * SEQ + 16 * n + l) * NSA_PITCH + 1024 + kv * 256 + gq * 64 + d0);
            const f32x4 p0 = *(const f32x4*)(pos + kv * 2048 + l * 64 + d0), p1 = *(const f32x4*)(pos + kv * 2048 + l * 64 + d0 + 4);
            o.x = pk2(bf_lo(v.x) + p0.x, bf_hi(v.x) + p0.y); o.y = pk2(bf_lo(v.y) + p0.z, bf_hi(v.y) + p0.w);
            o.z = pk2(bf_lo(v.z) + p1.x, bf_hi(v.z) + p1.y); o.w = pk2(bf_lo(v.w) + p1.z, bf_hi(v.w) + p1.w);
        }
        *(v4u*)(ACMP + ((size_t)kv * 8192 + row) * 2048 + pc * 8) = o;
    }
}
struct TokSrc { const bf16* kbase; const bf16* vbase; const LAS int* list;
    __device__ __forceinline__ int tile(int s) const { return list ? list[s] : s; }
    __device__ __forceinline__ const bf16* krow(int s, int j) const { return kbase + (size_t)(32 * tile(s) + j) * NSA_PITCH; }
    __device__ __forceinline__ const bf16* vrow(int s, int j) const { return vbase + (size_t)(32 * tile(s) + j) * NSA_PITCH; } };
struct SelMask { unsigned lo, hi; int t; const LAS int* list;
    __device__ __forceinline__ bool valid(int tok) const { const int jb = tok >> 6; const unsigned bit = (jb < 32) ? (lo >> jb) & 1u : (hi >> (jb - 32)) & 1u; return bit != 0u && tok <= t; }
    __device__ __forceinline__ bool wave_needs(int) const { return true; }
    __device__ __forceinline__ int key0(int s) const { return 32 * list[s]; } };
struct WinMask { int t;
    __device__ __forceinline__ bool valid(int tok) const { return tok <= t && tok > t - 512; }
    __device__ __forceinline__ bool wave_needs(int) const { return true; }
    __device__ __forceinline__ int key0(int s) const { return 32 * s; } };

__device__ __forceinline__ void nsa_phase(LAS unsigned char* lds, const bf16* PROJN, const bf16* KVC, bf16* ONSA, int G) {
    constexpr int KS = 144, OFF_KC = 18432, OFF_VC = OFF_KC + 256 * KS, OFF_IMP = OFF_VC + 256 * KS, OFF_SEL = OFF_IMP + 32 * 256 * 4, OFF_UNI = OFF_SEL + 256, OFF_TL = OFF_UNI + 64, OFF_NT = OFF_TL + 512;
    int tid_ = threadIdx.x; asm volatile("" : "+v"(tid_));
    const int tid = tid_, lane = tid & 63, wave = __builtin_amdgcn_readfirstlane(tid >> 6), l15 = lane & 15, g = lane >> 4, q4 = l15 >> 2, p4 = l15 & 3;
    const float sc2 = 0.125f * 1.4426950408889634f;
    LAS float* IMP = (LAS float*)(lds + OFF_IMP);
    LAS unsigned* SEL = (LAS unsigned*)(lds + OFF_SEL);
    LAS unsigned* UNI = (LAS unsigned*)(lds + OFF_UNI);
    LAS int* TL = (LAS int*)(lds + OFF_TL);
    LAS int* NT = (LAS int*)(lds + OFF_NT);
    for (int item = blockIdx.x; item < 4096; item += G) {
        const int qb = item & 127, bg = item >> 7, b = bg >> 2, gq = bg & 3, t0 = 32 * qb, cur = t0 >> 6;
        const int ql = 4 * wave + q4, hp = p4, t = t0 + ql;
        const bf16* prow = PROJN + (size_t)b * SEQ * NSA_PITCH;
        bf16x8 qf[2];
#pragma unroll
        for (int kk = 0; kk < 2; ++kk) qf[kk] = *(const bf16x8*)(prow + (size_t)t * NSA_PITCH + gq * 256 + hp * 64 + 8 * g + 32 * kk);
        int ncv = (t0 >> 4) + 1; ncv = ncv > 255 ? 255 : ncv; const int ntc = (ncv + 31) >> 5;
        for (int i = tid; i < ntc * 32 * 8 * 2; i += NTHR) {
            const int kv = (i >= ntc * 256) ? 1 : 0, ii = i - kv * ntc * 256, n = ii >> 3, pc = ii & 7;
            *(LAS v4u*)(lds + (kv ? OFF_VC : OFF_KC) + n * KS + pc * 16) = *(const v4u*)(KVC + ((size_t)kv * 8192 + bg * 256 + n) * 256 + pc * 8);
        }
        __syncthreads();
        f32x4 oc[4];
#pragma unroll
        for (int i = 0; i < 4; ++i) oc[i] = (f32x4){0.f, 0.f, 0.f, 0.f};
        {
            f32x4 sc[8][2]; float mx = -1e30f;
#pragma unroll
            for (int s = 0; s < 8; ++s) {
                sc[s][0] = (f32x4){-1e30f, -1e30f, -1e30f, -1e30f}; sc[s][1] = sc[s][0];
                if (s < ntc) {
                    f32x4 a0 = (f32x4){0.f, 0.f, 0.f, 0.f}, a1 = a0;
#pragma unroll
                    for (int kk = 0; kk < 2; ++kk) {
                        a0 = mfma16(ldrow(lds + OFF_KC + (32 * s + l15) * KS + (8 * g + 32 * kk) * 2), qf[kk], a0);
                        a1 = mfma16(ldrow(lds + OFF_KC + (32 * s + 16 + l15) * KS + (8 * g + 32 * kk) * 2), qf[kk], a1);
                    }
#pragma unroll
                    for (int r = 0; r < 4; ++r) {
                        const int n0 = 32 * s + 4 * g + r, n1 = n0 + 16;
                        sc[s][0][r] = (16 * n0 + 31 <= t && n0 < 255) ? a0[r] * sc2 : -1e30f;
                        sc[s][1][r] = (16 * n1 + 31 <= t && n1 < 255) ? a1[r] * sc2 : -1e30f;
                        mx = fmaxf(mx, fmaxf(sc[s][0][r], sc[s][1][r]));
                    }
                }
            }
            mx = fmaxf(mx, __shfl_xor(mx, 16)); mx = fmaxf(mx, __shfl_xor(mx, 32));
            float sum = 0.f;
#pragma unroll
            for (int s = 0; s < 8; ++s)
#pragma unroll
                for (int e = 0; e < 2; ++e)
#pragma unroll
                    for (int r = 0; r < 4; ++r) { const float p = (sc[s][e][r] > -5e29f) ? fexp2(sc[s][e][r] - mx) : 0.f; sc[s][e][r] = p; sum += p; }
            sum += __shfl_xor(sum, 16); sum += __shfl_xor(sum, 32);
            const float inv = 1.f / fmaxf(sum, 1e-30f);
#pragma unroll
            for (int s = 0; s < 8; ++s) {
                float p[8];
#pragma unroll
                for (int r = 0; r < 4; ++r) { p[r] = sc[s][0][r] * inv; p[4 + r] = sc[s][1][r] * inv; }
#pragma unroll
                for (int e = 0; e < 8; ++e) { float x = p[e]; x += __shfl_xor(x, 1); x += __shfl_xor(x, 2);
                    if (hp == 0) IMP[ql * 256 + 32 * s + 16 * (e >> 2) + 4 * g + (e & 3)] = x; }
                if (s < ntc) {
                    v4u pbu; pbu.x = pk2(p[0], p[1]); pbu.y = pk2(p[2], p[3]); pbu.z = pk2(p[4], p[5]); pbu.w = pk2(p[6], p[7]);
                    const bf16x8 pb = __builtin_bit_cast(bf16x8, pbu);
#pragma unroll
                    for (int dt = 0; dt < 4; ++dt) {
                        const s16x4 a = ldtr(lds + OFF_VC + (32 * s + 4 * g + q4) * KS + (16 * dt + 4 * p4) * 2), bb = ldtr(lds + OFF_VC + (32 * s + 16 + 4 * g + q4) * KS + (16 * dt + 4 * p4) * 2);
                        oc[dt] = mfma16((bf16x8){a[0], a[1], a[2], a[3], bb[0], bb[1], bb[2], bb[3]}, pb, oc[dt]);
                    }
                }
            }
        }
        __syncthreads();
        {
            unsigned ulo = 0u, uhi = 0u;
            for (int qi = 0; qi < 4; ++qi) {
                const int qq = 4 * wave + qi, jb = lane;
                const LAS float* ip = IMP + qq * 256 + 4 * jb;
                const float pm1 = (jb > 0) ? ip[-1] : 0.f;
                const float imp_sel = pm1 + 2.f * (ip[0] + ip[1] + ip[2]) + ip[3];
                const bool forced = (jb == 0) || (jb == cur) || (jb == cur - 1);
                const float score = (jb <= cur) ? imp_sel + (forced ? 1e4f : 0.f) : -1e30f;
                int rank = 0;
                for (int j = 0; j < 64; ++j) { const float sj = __uint_as_float((unsigned)__builtin_amdgcn_readlane((int)__float_as_uint(score), j)); rank += (sj > score || (sj == score && j < jb)) ? 1 : 0; }
                const bool sel = rank < 16 && score > -5e29f;
                const unsigned long long mask = __ballot(sel);
                if (lane == 0) { SEL[2 * qq] = (unsigned)mask; SEL[2 * qq + 1] = (unsigned)(mask >> 32); }
                ulo |= (unsigned)mask; uhi |= (unsigned)(mask >> 32);
            }
            if (lane == 0) { UNI[2 * wave] = ulo; UNI[2 * wave + 1] = uhi; }
        }
        __syncthreads();
        if (tid == 0) {
            unsigned ulo = 0u, uhi = 0u;
            for (int w = 0; w < 8; ++w) { ulo |= UNI[2 * w]; uhi |= UNI[2 * w + 1]; }
            int cnt = 0;
            for (int s = 0; s <= qb; ++s) { const int jb = s >> 1; const unsigned bit = (jb < 32) ? (ulo >> jb) & 1u : (uhi >> (jb - 32)) & 1u; if (bit) TL[cnt++] = s; }
            NT[0] = cnt;
        }
        __syncthreads();
        const int nts = NT[0];
        FaState<64> ss; fa_init<64>(ss);
        {
            TokSrc src{prow + 1536 + gq * 64, prow + 1792 + gq * 64, TL};
            SelMask mk{SEL[2 * ql], SEL[2 * ql + 1], t, TL};
            fa_stream<64, TokSrc, SelMask>(lds, tid, 0, nts, src, mk, qf, ss, sc2);
        }
        FaState<64> sw; fa_init<64>(sw);
        {
            TokSrc src{prow + 2048 + gq * 64, prow + 2304 + gq * 64, nullptr};
            WinMask mk{t};
            const int sb = (t0 - 512) < 0 ? 0 : (t0 - 512) >> 5;
            fa_stream<64, TokSrc, WinMask>(lds, tid, sb, qb + 1, src, mk, qf, sw, sc2);
        }
        {
            const bf16* gp = prow + (size_t)t * NSA_PITCH + 2560 + gq * 4 + hp;
            const float g0 = sigmoid_f(__uint_as_float((unsigned)gp[0] << 16)), g1 = sigmoid_f(__uint_as_float((unsigned)gp[16] << 16)), g2 = sigmoid_f(__uint_as_float((unsigned)gp[32] << 16));
            const float is = g1 / fmaxf(ss.l, 1e-30f), iw = g2 / fmaxf(sw.l, 1e-30f);
            bf16* op = ONSA + ((size_t)b * SEQ + t) * 1024 + gq * 256 + hp * 64 + 4 * g;
#pragma unroll
            for (int dt = 0; dt < 4; ++dt) { const f32x4 o = oc[dt] * g0 + ss.o[dt] * is + sw.o[dt] * iw; v2u w; w.x = pk2(o[0], o[1]); w.y = pk2(o[2], o[3]); *(v2u*)(op + 16 * dt) = w; }
        }
        __syncthreads();
    }
}
#ifndef RET_SCAN
#define RET_SCAN 1
#define RET_GNORM 1
#define RET_GATE 1
#endif
#ifndef ENABLE_SSD
#define ENABLE_SSD 1
#endif
constexpr size_t WS_DTRAW = WS_SCR + 340 * MiB, WS_HALO = WS_SCR + 344 * MiB;
#define MIXER_CONVERT \
    if (mix == 1) { transpose_w<0>(args.in[12], D, 2608, 2816, WMIX, scr, gw, NGW, lane); \
        for (int c = 0; c < 2; ++c) { transpose_w<0>(args.in[14] + (size_t)c * 2048 * 256, 2048, 256, 256, WMIX + 3 * MiB + (size_t)c * 256 * 2048, scr, gw, NGW, lane); \
            transpose_w<0>(args.in[15] + (size_t)c * 256 * 64, 256, 64, 256, WMIX + 4 * MiB + (size_t)c * 256 * 256, scr, gw, NGW, lane); } \
        transpose_w<0>(args.in[16], D, D, D, WMIX + 5 * MiB, scr, gw, NGW, lane); } \
    if (mix == 3) { transpose_w<0>(args.in[25], D, 9216, 9216, WMIX, scr, gw, NGW, lane); transpose_w<0>(args.in[26], D, D, D, WMIX + (size_t)9216 * 1024, scr, gw, NGW, lane); } \
    if (mix == 0) { transpose_w<0>(args.in[9], D, 6144, 6144, WMIX, scr, gw, NGW, lane); transpose_w<0>(args.in[11], 2048, D, D, WMIX + (size_t)6144 * 1024, scr, gw, NGW, lane); } \
    if (mix == 2) { transpose_w<0>(args.in[17], D, 5152, 5376, WMIX, scr, gw, NGW, lane); transpose_w<0>(args.in[24], 2048, D, D, WMIX + (size_t)6144 * 1024, scr, gw, NGW, lane); }

#define MIXER_PHASES \
    if (mix == 0) { \
        bf16* PROJ = (bf16*)(ws + WS_SCR); \
        PHASE_BEGIN { pg8::Epi<pg8::EPI_RETQKV> E{}; E.O = PROJ; E.ldc = 4096; E.rot = ROT; run_gemm<pg8::EPI_RETQKV>(lds, U, D, WMIX, T, 4096, D, E); } PHASE_END \
        if (RET_SCAN) PHASE_BEGIN \
            for (int item = blockIdx.x; item < 256; item += G) { \
                const int b = item >> 5, h = (item >> 3) & 3, s8 = item & 7; \
                bf16* base = PROJ + (size_t)b * SEQ * 4096; \
                scan_item<256, false>(lds, base + h * 256, base + 1024 + h * 256, base + 2048 + h * 512 + s8 * 64, 4096, base + 2048 + h * 512 + s8 * 64, 4096, log1pf(-exp2f(-5.f - (float)h)), nullptr, 0.f, 0.f, 0.f); \
                __syncthreads(); \
            } \
        PHASE_END \
        if (RET_GNORM) PHASE_BEGIN gnorm_rows(PROJ + 2048, 4096, args.in[10], gw, NGW, lane); PHASE_END \
        if (RET_GATE) PHASE_BEGIN { pg8::Epi<pg8::EPI_GATEMUL> E{}; E.O = PROJ + 2048; E.ldc = 4096; run_gemm<pg8::EPI_GATEMUL>(lds, U, D, WMIX + (size_t)4096 * 1024, T, 2048, D, E); } PHASE_END \
        PHASE_BEGIN { pg8::Epi<pg8::EPI_RESID> E{}; E.Hout = H; E.Hbase = H; E.scale = 1.0f; E.ldc = D; run_gemm<pg8::EPI_RESID>(lds, PROJ + 2048, 4096, WMIX + (size_t)6144 * 1024, T, D, 2048, E); } PHASE_END \
    } \
    if (mix == 2 && ENABLE_SSD) { \
        bf16* PROJ = (bf16*)(ws + WS_SCR); float* DTRAW = (float*)(ws + WS_DTRAW); bf16* HALO = (bf16*)(ws + WS_HALO); \
        PHASE_BEGIN { pg8::Epi<pg8::EPI_SSD> E{}; E.O = PROJ; E.ldc = SSD_PITCH; E.aux = DTRAW; run_gemm<pg8::EPI_SSD>(lds, U, D, WMIX, T, SSD_PITCH, D, E); } PHASE_END \
        PHASE_BEGIN ssd_halo_save(PROJ, HALO, blockIdx.x * NTHR + tid, G * NTHR); PHASE_END \
        PHASE_BEGIN ssd_conv(PROJ, HALO, args.in[18], args.in[19], blockIdx.x * NTHR + tid, G * NTHR); PHASE_END \
        PHASE_BEGIN \
            for (int item = blockIdx.x; item < 256; item += G) { \
                const int b = item >> 5, gq = (item >> 3) & 3, r = item & 7, hd = gq * 8 + r; \
                bf16* base = PROJ + (size_t)b * SEQ * SSD_PITCH; \
                scan_item<128, true>(lds, base + 4608 + gq * 128, base + 4096 + gq * 128, base + 2048 + gq * 512 + r * 64, SSD_PITCH, base + gq * 512 + r * 64, SSD_PITCH, 0.f, \
                                     DTRAW + (size_t)b * SEQ * 32 + hd, args.in[20][hd], -__expf(args.in[21][hd]), args.in[22][hd]); \
                __syncthreads(); \
            } \
        PHASE_END \
        PHASE_BEGIN gnorm_rows(PROJ, SSD_PITCH, args.in[23], gw, NGW, lane); PHASE_END \
        PHASE_BEGIN { pg8::Epi<pg8::EPI_RESID> E{}; E.Hout = H; E.Hbase = H; E.scale = 1.0f; E.ldc = D; run_gemm<pg8::EPI_RESID>(lds, PROJ, SSD_PITCH, WMIX + (size_t)6144 * 1024, T, D, 2048, E); } PHASE_END \
    } \
    if (mix == 3) { \
        bf16* PROJD = (bf16*)(ws + WS_SCR); bf16* OACC = (bf16*)(ws + WS_SCR + 192 * MiB); float* LSE = (float*)(ws + WS_SCR + 256 * MiB); \
        for (int gi = 0; gi < 3; ++gi) { \
            PHASE_BEGIN { pg8::Epi<pg8::EPI_BF16> E{}; E.O = PROJD; E.ldc = DIL_PITCH; run_gemm<pg8::EPI_BF16>(lds, U, D, WMIX + (size_t)gi * 3072 * 1024, T, 3072, D, E); } PHASE_END \
            PHASE_BEGIN dilated_phase(lds, PROJD, OACC, LSE, gi, G); PHASE_END \
        } \
        PHASE_BEGIN { pg8::Epi<pg8::EPI_RESID> E{}; E.Hout = H; E.Hbase = H; E.scale = 1.0f; E.ldc = D; run_gemm<pg8::EPI_RESID>(lds, OACC, D, WMIX + (size_t)9216 * 1024, T, D, D, E); } PHASE_END \
    } \
    if (mix == 1) { \
        bf16* PROJN = (bf16*)(ws + WS_SCR); bf16* ACMP = (bf16*)(ws + WS_SCR + 176 * MiB); bf16* HIDC = (bf16*)(ws + WS_SCR + 240 * MiB); bf16* KVC = (bf16*)(ws + WS_SCR + 248 * MiB); bf16* ONSA = (bf16*)(ws + WS_SCR + 256 * MiB); \
        PHASE_BEGIN { pg8::Epi<pg8::EPI_BF16> E{}; E.O = PROJN; E.ldc = NSA_PITCH; run_gemm<pg8::EPI_BF16>(lds, U, D, WMIX, T, NSA_PITCH, D, E); } PHASE_END \
        PHASE_BEGIN nsa_im2col(PROJN, args.in[13], ACMP, blockIdx.x * NTHR + tid, G * NTHR); PHASE_END \
        PHASE_BEGIN for (int c = 0; c < 2; ++c) { pg8::Epi<pg8::EPI_SILU> E{}; E.O = HIDC + (size_t)c * 8192 * 256; E.ldc = 256; run_gemm<pg8::EPI_SILU>(lds, ACMP + (size_t)c * 8192 * 2048, 2048, WMIX + 3 * MiB + (size_t)c * 256 * 2048, 8192, 256, 2048, E); } PHASE_END \
        PHASE_BEGIN for (int c = 0; c < 2; ++c) { pg8::Epi<pg8::EPI_BF16> E{}; E.O = KVC + (size_t)c * 8192 * 256; E.ldc = 256; run_gemm<pg8::EPI_BF16>(lds, HIDC + (size_t)c * 8192 * 256, 256, WMIX + 4 * MiB + (size_t)c * 256 * 256, 8192, 256, 256, E); } PHASE_END \
        PHASE_BEGIN nsa_phase(lds, PROJN, KVC, ONSA, G); PHASE_END \
        PHASE_BEGIN { pg8::Epi<pg8::EPI_RESID> E{}; E.Hout = H; E.Hbase = H; E.scale = 1.0f; E.ldc = D; run_gemm<pg8::EPI_RESID>(lds, ONSA, D, WMIX + 5 * MiB, T, D, D, E); } PHASE_END \
    }
__global__ void __launch_bounds__(NTHR, 2) fwd_megakernel(Args args) {
    extern __shared__ __attribute__((aligned(16))) unsigned char lds_raw[];
    LAS unsigned char* lds = (LAS unsigned char*)lds_raw;
    cg::grid_group grid = cg::this_grid();
    const int G = gridDim.x;
#define PHASE_BEGIN {
#define PHASE_END   asm volatile("s_waitcnt vmcnt(0)" ::: "memory"); grid.sync(); __builtin_amdgcn_fence(__ATOMIC_ACQUIRE, "agent"); asm volatile("s_waitcnt vmcnt(0)" ::: "memory"); }
    for (int L = 0; L < DEPTH; ++L) {
        const int mix = L & 3;
        int tid_ = threadIdx.x; asm volatile("" : "+v"(tid_));
        const int tid = tid_, lane = tid & 63, wave = __builtin_amdgcn_readfirstlane(tid >> 6);
        const int gw = blockIdx.x * NWAVES + wave, NGW = G * NWAVES;
        unsigned char* ws = args.ws; asm volatile("" : "+s"(ws));
        float* H = args.out; asm volatile("" : "+s"(H));
        float* ROT = (float*)(ws + WS_ROT);
        bf16* WIN1 = (bf16*)(ws + WS_WIN1); bf16* WOUT1 = (bf16*)(ws + WS_WOUT1); bf16* WIN2 = (bf16*)(ws + WS_WIN2); bf16* WOUT2 = (bf16*)(ws + WS_WOUT2); bf16* WMIX = (bf16*)(ws + WS_WMIX);
        bf16* U = (bf16*)(ws + WS_U); bf16* HID = (bf16*)(ws + WS_SCR);
        LAS float* scr = (LAS float*)(lds + wave * 16384);
        PHASE_BEGIN
            transpose_w<1>(args.in[2] + (size_t)L * D * 2 * FF, D, 2 * FF, 2 * FF, WIN1, scr, gw, NGW, lane);
            transpose_w<0>(args.in[3] + (size_t)L * FF * D, FF, D, D, WOUT1, scr, gw, NGW, lane);
            transpose_w<1>(args.in[6] + (size_t)L * D * 2 * FF, D, 2 * FF, 2 * FF, WIN2, scr, gw, NGW, lane);
            transpose_w<0>(args.in[7] + (size_t)L * FF * D, FF, D, D, WOUT2, scr, gw, NGW, lane);
            MIXER_CONVERT
            if (L == 0) {
                for (int i = blockIdx.x * NTHR + tid; i < 4096 * 128; i += G * NTHR) {
                    const int pos = i >> 7, d = i & 127;
                    const float inv = exp2f(-(float)d * (13.287712379549449f / 128.f));
                    const float ang = (float)pos * inv;
                    const double x = (double)ang * 0.15915494309189535; const float fr = (float)(x - rint(x));
                    ROT[i] = __builtin_amdgcn_cosf(fr); ROT[4096 * 128 + i] = __builtin_amdgcn_sinf(fr);
                }
            }
            rms_rows(L == 0 ? args.in[0] : H, args.in[1] + L * D, U, nullptr, gw, NGW, lane);
        PHASE_END
        PHASE_BEGIN { pg8::Epi<pg8::EPI_SWIGLU> E{}; E.O = HID; E.ldc = FF; run_gemm<pg8::EPI_SWIGLU>(lds, U, D, WIN1, T, 2 * FF, D, E); } PHASE_END
        PHASE_BEGIN { pg8::Epi<pg8::EPI_RESID> E{}; E.Hout = H; E.Hbase = (L == 0) ? args.in[0] : H; E.scale = 0.5f; E.ldc = D; run_gemm<pg8::EPI_RESID>(lds, HID, FF, WOUT1, T, D, FF, E); } PHASE_END
        PHASE_BEGIN rms_rows(H, args.in[4] + L * D, U, nullptr, gw, NGW, lane); PHASE_END
        MIXER_PHASES
        PHASE_BEGIN rms_rows(H, args.in[5] + L * D, U, nullptr, gw, NGW, lane); PHASE_END
        PHASE_BEGIN { pg8::Epi<pg8::EPI_SWIGLU> E{}; E.O = HID; E.ldc = FF; run_gemm<pg8::EPI_SWIGLU>(lds, U, D, WIN2, T, 2 * FF, D, E); } PHASE_END
        PHASE_BEGIN { pg8::Epi<pg8::EPI_RESID> E{}; E.Hout = H; E.Hbase = H; E.scale = 0.5f; E.ldc = D; run_gemm<pg8::EPI_RESID>(lds, HID, FF, WOUT2, T, D, FF, E); } PHASE_END
    }
    { const int tid = threadIdx.x, lane = tid & 63, wave = __builtin_amdgcn_readfirstlane(tid >> 6); rms_final(args.out, args.in[8], blockIdx.x * NWAVES + wave, G * NWAVES, lane); }
}

extern "C" void kernel_launch(void* const* d_in, const int* in_sizes, int n_in, void* d_out, int out_size, void* d_ws, size_t ws_size, hipStream_t stream) {
    static int grid = 0;
    if (grid == 0) {
        if (n_in != 27 || out_size != T * D || ws_size < WS_NEED) { fprintf(stderr, "kernel_launch: unexpected problem (n_in %d, out %d, ws %zu)\n", n_in, out_size, ws_size); grid = -1; return; }
        int dev = 0, cus = 0, per_cu = 0;
        hipGetDevice(&dev); hipDeviceGetAttribute(&cus, hipDeviceAttributeMultiprocessorCount, dev);
        if (hipFuncSetAttribute((const void*)fwd_megakernel, hipFuncAttributeMaxDynamicSharedMemorySize, LDS_BYTES) != hipSuccess) { fprintf(stderr, "kernel_launch: hipFuncSetAttribute failed\n"); grid = -1; return; }
        if (hipOccupancyMaxActiveBlocksPerMultiprocessor(&per_cu, (const void*)fwd_megakernel, NTHR, LDS_BYTES) != hipSuccess || per_cu < 1) { fprintf(stderr, "kernel_launch: occupancy query gave %d\n", per_cu); per_cu = 1; }
        (void)hipGetLastError();
        grid = cus * 1;
    }
    if (grid < 0) return;
    Args a{};
    for (int i = 0; i < 27; ++i) a.in[i] = (const float*)d_in[i];
    a.out = (float*)d_out; a.ws = (unsigned char*)d_ws; a.ph_lo = 0; a.ph_hi = 1 << 20;
    void* kargs[] = {&a};
    hipError_t e = hipLaunchCooperativeKernel((const void*)fwd_megakernel, dim3(grid), dim3(NTHR), kargs, LDS_BYTES, stream);
    if (e != hipSuccess) fprintf(stderr, "kernel_launch: cooperative launch failed: %s (grid %d)\n", hipGetErrorString(e), grid);
}
```

```cpp
#include <hip/hip_runtime.h>
#include <hip/hip_cooperative_groups.h>
#include <cstdio>
#include <cstdint>
namespace cg = cooperative_groups;

__device__ __forceinline__ int lane_id_now() { int l; asm volatile("v_mbcnt_lo_u32_b32 %0, -1, 0\n\tv_mbcnt_hi_u32_b32 %0, -1, %0" : "=v"(l)); return l; }

namespace pg8 {
#define PG8_LAS __attribute__((address_space(3)))
typedef unsigned short bf16_t;
typedef short bf16x8 __attribute__((ext_vector_type(8)));
typedef float f32x4 __attribute__((ext_vector_type(4)));
typedef unsigned u32x4 __attribute__((ext_vector_type(4)));
constexpr int BM = 256, BK = 64, HALF = 128, HTB = HALF * BK * 2  , STAGE_BYTES = 8 * HTB, NXCD = 8, WGM = 8;

__host__ __device__ __forceinline__ int lds_byte(int r, int c) { const int st = (r >> 4) * 2 + (c >> 5), rr = r & 15, cc = c & 31, ob = rr * 64 + cc * 2; return st * 1024 + (ob ^ (((ob >> 9) & 1) << 5)); }
__host__ __device__ __forceinline__ void stage_rc(int b, int& R, int& C) { const int st = b / 1024, sb = b % 1024, swz = sb ^ (((sb >> 9) & 1) << 5); R = (st >> 1) * 16 + swz / 64; C = (st & 1) * 32 + (swz % 64) / 2; }
__host__ __device__ __forceinline__ int perm32(int rho) { const int n = rho >> 4, i = rho & 15; return 8 * (i >> 2) + 4 * n + (i & 3); }

struct Unit { int pm, pn; };
struct Gemm { const bf16_t* A; const bf16_t* Bt; int M, N, K, lda; };

struct StaticOrder {
    int nM, nN, nwg, G, c;
    __host__ __device__ void init(int M, int N, int G_, int c_) { nM = M / BM; nN = N / BM; nwg = nM * nN; G = G_; c = c_; }
    __host__ __device__ bool next(int i, Unit& u) const {
        const long L = (long)i * G + c; if (L >= nwg) return false;
        int wgid = (int)L; { const int q = nwg / NXCD, r = nwg % NXCD, xcd = wgid % NXCD, off = wgid / NXCD; wgid = (xcd < r ? xcd * (q + 1) : r * (q + 1) + (xcd - r) * q) + off; }
        const int nig = WGM * nN, gid = wgid / nig, fm = gid * WGM, gsz = (nM - fm) < WGM ? (nM - fm) : WGM;
        u.pm = fm + ((wgid % nig) % gsz); u.pn = (wgid % nig) / gsz; return true;
    }
    __device__ __forceinline__ void a_ready(const Unit&) const {}
    __device__ __forceinline__ void done(const Unit&) const {}
};

typedef float f32x2_t __attribute__((ext_vector_type(2))); typedef __bf16 bf16x2_t __attribute__((ext_vector_type(2)));
__device__ __forceinline__ unsigned cvt_pk_bf16(float lo, float hi) { f32x2_t v = {lo, hi}; bf16x2_t b = __builtin_convertvector(v, bf16x2_t); return __builtin_bit_cast(unsigned, b); }
__device__ __forceinline__ float bf_lo(unsigned w) { return __uint_as_float(w << 16); }
__device__ __forceinline__ float bf_hi(unsigned w) { return __uint_as_float(w & 0xffff0000u); }
__device__ __forceinline__ float silu_f(float x) { return x / (1.0f + __expf(-x)); }
__device__ __forceinline__ float sigmoid_f(float x) { return 1.0f / (1.0f + __expf(-x)); }

enum { EPI_BF16 = 0, EPI_SWIGLU = 1, EPI_RESID = 2, EPI_RETQKV = 3, EPI_GATEMUL = 4, EPI_SSD = 5, EPI_SILU = 6 };
template <int MODE> struct Epi {
    static constexpr bool PERM = true, AFTER_DRAIN = false;
    bf16_t* O; int ldc;
    float* Hout; const float* Hbase; float scale;
    const float* rot;
    float* aux;
    __device__ __forceinline__ void operator()(const f32x4 (&acc)[2][2][4][2], const Unit& u, int wr, int wc, int fr, int fq) const {
        const int row0 = u.pm * BM + wr * 64 + fr;
        const int cl = wc * 32 + 8 * fq;
        if constexpr (MODE == EPI_SWIGLU) {
#pragma unroll
            for (int ai = 0; ai < 2; ++ai)
#pragma unroll
                for (int m = 0; m < 4; ++m) {
                    bf16_t* rowp = O + (size_t)(row0 + ai * HALF + m * 16) * ldc + u.pn * 128 + cl;
                    f32x4 a0 = acc[ai][0][m][0], a1 = acc[ai][0][m][1], b0 = acc[ai][1][m][0], b1 = acc[ai][1][m][1];
                    u32x4 w;
                    w.x = cvt_pk_bf16(silu_f(a0[0]) * b0[0], silu_f(a0[1]) * b0[1]); w.y = cvt_pk_bf16(silu_f(a0[2]) * b0[2], silu_f(a0[3]) * b0[3]);
                    w.z = cvt_pk_bf16(silu_f(a1[0]) * b1[0], silu_f(a1[1]) * b1[1]); w.w = cvt_pk_bf16(silu_f(a1[2]) * b1[2], silu_f(a1[3]) * b1[3]);
                    *(u32x4*)rowp = w;
                }
        } else if constexpr (MODE == EPI_RESID) {
#pragma unroll
            for (int ai = 0; ai < 2; ++ai)
#pragma unroll
                for (int m = 0; m < 4; ++m) {
                    const size_t off = (size_t)(row0 + ai * HALF + m * 16) * ldc + u.pn * BM + cl;
#pragma unroll
                    for (int bj = 0; bj < 2; ++bj)
#pragma unroll
                        for (int n = 0; n < 2; ++n) {
                            const f32x4 b = *(const f32x4*)(Hbase + off + bj * HALF + 4 * n);
                            *(f32x4*)(Hout + off + bj * HALF + 4 * n) = b + acc[ai][bj][m][n] * scale;
                        }
                }
        } else if constexpr (MODE == EPI_RETQKV) {
            if (u.pn < 8) {
                const float ks = (u.pn >= 4) ? 0.0625f : 1.0f;
#pragma unroll
                for (int ai = 0; ai < 2; ++ai)
#pragma unroll
                    for (int m = 0; m < 4; ++m) {
                        const int r = row0 + ai * HALF + m * 16; const int pos = r & 4095;
                        bf16_t* rowp = O + (size_t)r * ldc + u.pn * BM + cl;
                        u32x4 w1, w2; unsigned* p1 = (unsigned*)&w1; unsigned* p2 = (unsigned*)&w2;
#pragma unroll
                        for (int n = 0; n < 2; ++n) {
                            const f32x4 c = *(const f32x4*)(rot + (size_t)pos * 128 + cl + 4 * n);
                            const f32x4 s = *(const f32x4*)(rot + (size_t)4096 * 128 + (size_t)pos * 128 + cl + 4 * n);
                            const f32x4 t1 = acc[ai][0][m][n] * ks, t2 = acc[ai][1][m][n] * ks;
                            const f32x4 o1 = t1 * c - t2 * s, o2 = t1 * s + t2 * c;
                            p1[2 * n] = cvt_pk_bf16(o1[0], o1[1]); p1[2 * n + 1] = cvt_pk_bf16(o1[2], o1[3]);
                            p2[2 * n] = cvt_pk_bf16(o2[0], o2[1]); p2[2 * n + 1] = cvt_pk_bf16(o2[2], o2[3]);
                        }
                        *(u32x4*)rowp = w1; *(u32x4*)(rowp + HALF) = w2;
                    }
            } else {
#pragma unroll
                for (int ai = 0; ai < 2; ++ai)
#pragma unroll
                    for (int m = 0; m < 4; ++m) {
                        bf16_t* rowp = O + (size_t)(row0 + ai * HALF + m * 16) * ldc + u.pn * BM + cl;
#pragma unroll
                        for (int bj = 0; bj < 2; ++bj) { const f32x4 v0 = acc[ai][bj][m][0], v1 = acc[ai][bj][m][1]; u32x4 w;
                            w.x = cvt_pk_bf16(v0[0], v0[1]); w.y = cvt_pk_bf16(v0[2], v0[3]); w.z = cvt_pk_bf16(v1[0], v1[1]); w.w = cvt_pk_bf16(v1[2], v1[3]);
                            *(u32x4*)(rowp + bj * HALF) = w; }
                    }
            }
        } else if constexpr (MODE == EPI_GATEMUL) {
#pragma unroll
            for (int ai = 0; ai < 2; ++ai)
#pragma unroll
                for (int m = 0; m < 4; ++m) {
                    bf16_t* rowp = O + (size_t)(row0 + ai * HALF + m * 16) * ldc + u.pn * BM + cl;
#pragma unroll
                    for (int bj = 0; bj < 2; ++bj) { const f32x4 v0 = acc[ai][bj][m][0], v1 = acc[ai][bj][m][1]; const u32x4 old = *(const u32x4*)(rowp + bj * HALF); u32x4 w;
                        w.x = cvt_pk_bf16(silu_f(v0[0]) * bf_lo(old.x), silu_f(v0[1]) * bf_hi(old.x)); w.y = cvt_pk_bf16(silu_f(v0[2]) * bf_lo(old.y), silu_f(v0[3]) * bf_hi(old.y));
                        w.z = cvt_pk_bf16(silu_f(v1[0]) * bf_lo(old.z), silu_f(v1[1]) * bf_hi(old.z)); w.w = cvt_pk_bf16(silu_f(v1[2]) * bf_lo(old.w), silu_f(v1[3]) * bf_hi(old.w));
                        *(u32x4*)(rowp + bj * HALF) = w; }
                }
        } else {
            if (MODE == EPI_SSD && u.pn == 20) {
                if (wc == 0) {
#pragma unroll
                    for (int ai = 0; ai < 2; ++ai)
#pragma unroll
                        for (int m = 0; m < 4; ++m) { float* p = aux + (size_t)(row0 + ai * HALF + m * 16) * 32 + cl;
                            *(f32x4*)p = acc[ai][0][m][0]; *(f32x4*)(p + 4) = acc[ai][0][m][1]; }
                }
                return;
            }
#pragma unroll
            for (int ai = 0; ai < 2; ++ai)
#pragma unroll
                for (int m = 0; m < 4; ++m) {
                    bf16_t* rowp = O + (size_t)(row0 + ai * HALF + m * 16) * ldc + u.pn * BM + cl;
#pragma unroll
                    for (int bj = 0; bj < 2; ++bj) { f32x4 v0 = acc[ai][bj][m][0], v1 = acc[ai][bj][m][1]; u32x4 w;
                        if (MODE == EPI_SILU) { v0 = (f32x4){silu_f(v0[0]), silu_f(v0[1]), silu_f(v0[2]), silu_f(v0[3])}; v1 = (f32x4){silu_f(v1[0]), silu_f(v1[1]), silu_f(v1[2]), silu_f(v1[3])}; }
                        w.x = cvt_pk_bf16(v0[0], v0[1]); w.y = cvt_pk_bf16(v0[2], v0[3]); w.z = cvt_pk_bf16(v1[0], v1[1]); w.w = cvt_pk_bf16(v1[2], v1[3]);
                        *(u32x4*)(rowp + bj * HALF) = w; }
                }
        }
    }
};
template <class Epi, class Sched, bool ALIGN_EPI = false, bool SP2 = false>
__device__ __forceinline__ void gemm_phase(PG8_LAS unsigned char* lds, const Gemm g, const Sched& S, const Epi& E, int wave_s) {
    int tid_ = wave_s * 64 + lane_id_now(); asm volatile("" : "+v"(tid_)); const int tid = tid_, wid = __builtin_amdgcn_readfirstlane(tid >> 6), lane = tid & 63, wr = wid >> 2, wc = wid & 3, fr = lane & 15, fq = lane >> 4;
    const int K = g.K, nt = K / BK;
    unsigned voffA[2], voffB[2];
#pragma unroll
    for (int i = 0; i < 2; ++i) { int R, C; stage_rc(tid * 16 + i * 8192, R, C); const int Rb = Epi::PERM ? ((R & ~31) + perm32(R & 31)) : R;
        voffA[i] = (unsigned)(R * g.lda + C) * 2u; voffB[i] = (unsigned)(Rb * K + C) * 2u; }
    const size_t kstep = (size_t)(BK * 2);
    const size_t hstepA = (size_t)HALF * g.lda * 2, hstepB = (size_t)HALF * K * 2;
    const size_t tstepA = 2 * hstepA, tstepB = 2 * hstepB;
    const unsigned ldsw = (unsigned)wid * 1024u;
    const int aoff = lds_byte(wr * 64 + fr, fq * 8), boff = lds_byte(wc * 32 + fr, fq * 8);
#define PG8_SA(b, h) (((b) * 2 + (h)) * HTB)
#define PG8_SB(b, h) ((4 + (b) * 2 + (h)) * HTB)
#define PG8_STAGE(bufoff, gbase, voff) do { _Pragma("unroll") for (int _i = 0; _i < 2; ++_i) \
        __builtin_amdgcn_global_load_lds((const unsigned*)((const char*)(gbase) + (voff)[_i]), (PG8_LAS unsigned*)(lds + (bufoff) + ldsw + _i * 8192), 16, 0, 0); } while (0)
#define PG8_LDA(dst, b, h) do { _Pragma("unroll") for (int m = 0; m < 4; ++m) _Pragma("unroll") for (int k = 0; k < 2; ++k) dst[m][k] = *(const PG8_LAS bf16x8*)(lds + PG8_SA(b, h) + aoff + m * 2048 + k * 1024); } while (0)
#define PG8_LDB(dst, b, h) do { _Pragma("unroll") for (int n = 0; n < 2; ++n) _Pragma("unroll") for (int k = 0; k < 2; ++k) dst[n][k] = *(const PG8_LAS bf16x8*)(lds + PG8_SB(b, h) + boff + n * 2048 + k * 1024); } while (0)
#define PG8_MMA(ai, bj, At, Bt) do { __builtin_amdgcn_s_setprio(1); _Pragma("unroll") for (int m = 0; m < 4; ++m) _Pragma("unroll") for (int n = 0; n < 2; ++n) _Pragma("unroll") for (int k = 0; k < 2; ++k) \
        acc[ai][bj][m][n] = __builtin_amdgcn_mfma_f32_16x16x32_bf16(Bt[n][k], At[m][k], acc[ai][bj][m][n], 0, 0, 0); __builtin_amdgcn_s_setprio(0); } while (0)
#define PG8_WAIT_V(n) asm volatile("s_waitcnt vmcnt(" #n ")" ::: "memory")
#define PG8_WAIT_L(n) asm volatile("s_waitcnt lgkmcnt(" #n ")" ::: "memory")
#define PG8_BAR __builtin_amdgcn_s_barrier()
#define PG8_SCHED __builtin_amdgcn_sched_barrier(0)
    Unit cur, nxt; int ui = 0;
    if (!S.next(0, cur)) return;
    f32x4 acc[2][2][4][2];
#pragma unroll
    for (int a = 0; a < 2; ++a)
#pragma unroll
        for (int b = 0; b < 2; ++b)
#pragma unroll
            for (int m = 0; m < 4; ++m)
#pragma unroll
                for (int n = 0; n < 2; ++n) acc[a][b][m][n] = (f32x4){0.f, 0.f, 0.f, 0.f};
    bf16x8 At[4][2], B0[2][2], B1[2][2];
    const char* cA = (const char*)g.A + (size_t)cur.pm * tstepA; const char* cB = (const char*)g.Bt + (size_t)cur.pn * tstepB;
    S.a_ready(cur);
    if constexpr (SP2) {
        PG8_STAGE(PG8_SB(0, 0), cB, voffB); PG8_STAGE(PG8_SB(0, 1), cB + hstepB, voffB); PG8_STAGE(PG8_SA(0, 0), cA, voffA); PG8_STAGE(PG8_SA(0, 1), cA + hstepA, voffA);
        if (wr == 1) PG8_BAR;
        PG8_WAIT_V(2); PG8_BAR;
        PG8_STAGE(PG8_SB(1, 0), cB + kstep, voffB); PG8_STAGE(PG8_SA(1, 0), cA + kstep, voffA); PG8_STAGE(PG8_SB(1, 1), cB + hstepB + kstep, voffB);
        PG8_WAIT_V(6); PG8_BAR;
    } else {
        PG8_STAGE(PG8_SB(0, 0), cB, voffB); PG8_STAGE(PG8_SA(0, 0), cA, voffA); PG8_STAGE(PG8_SB(0, 1), cB + hstepB, voffB); PG8_STAGE(PG8_SA(0, 1), cA + hstepA, voffA);
        if (wr == 1) PG8_BAR;
        PG8_WAIT_V(4); PG8_BAR;
        PG8_STAGE(PG8_SB(1, 0), cB + kstep, voffB); PG8_STAGE(PG8_SA(1, 0), cA + kstep, voffA); PG8_STAGE(PG8_SB(1, 1), cB + hstepB + kstep, voffB);
        PG8_WAIT_V(6); PG8_BAR;
    }
    for (;;) {
        const bool has_next = S.next(ui + 1, nxt);
        const char* nA = has_next ? (const char*)g.A + (size_t)nxt.pm * tstepA : cA; const char* nB = has_next ? (const char*)g.Bt + (size_t)nxt.pn * tstepB : cB;
        for (int t = 0; t < nt; t += 2) {
            const bool last = (t == nt - 2);
            const char* a1 = cA + (size_t)(t + 1) * kstep;
            const char* a2 = last ? nA : cA + (size_t)(t + 2) * kstep; const char* b2 = last ? nB : cB + (size_t)(t + 2) * kstep;
            const char* a3 = a2 + kstep; const char* b3 = b2 + kstep;
            if (last && has_next) S.a_ready(nxt);
            if constexpr (SP2) {
            PG8_LDB(B0, 0, 0); PG8_LDB(B1, 0, 1); PG8_SCHED; PG8_LDA(At, 0, 0); PG8_STAGE(PG8_SA(1, 1), a1 + hstepA, voffA);
            PG8_WAIT_V(8); PG8_WAIT_L(0); PG8_BAR; PG8_MMA(0, 0, At, B0); PG8_MMA(0, 1, At, B1); PG8_BAR; PG8_SCHED;
            PG8_LDA(At, 0, 1); PG8_STAGE(PG8_SB(0, 0), b2, voffB); PG8_STAGE(PG8_SB(0, 1), b2 + hstepB, voffB); PG8_STAGE(PG8_SA(0, 0), a2, voffA);
            PG8_WAIT_V(8); PG8_WAIT_L(0); PG8_BAR; PG8_MMA(1, 0, At, B0); PG8_MMA(1, 1, At, B1); PG8_BAR; PG8_SCHED;
            PG8_LDB(B0, 1, 0); PG8_LDB(B1, 1, 1); PG8_SCHED; PG8_LDA(At, 1, 0); PG8_STAGE(PG8_SA(0, 1), a2 + hstepA, voffA);
            PG8_WAIT_V(8); PG8_WAIT_L(0); PG8_BAR; PG8_MMA(0, 0, At, B0); PG8_MMA(0, 1, At, B1); PG8_BAR; PG8_SCHED;
            PG8_LDA(At, 1, 1); PG8_STAGE(PG8_SB(1, 0), b3, voffB); PG8_STAGE(PG8_SB(1, 1), b3 + hstepB, voffB); PG8_STAGE(PG8_SA(1, 0), a3, voffA);
            PG8_WAIT_V(8); PG8_WAIT_L(0); PG8_BAR; PG8_MMA(1, 0, At, B0); PG8_MMA(1, 1, At, B1); PG8_BAR; PG8_SCHED;
            } else {
            PG8_LDB(B0, 0, 0); PG8_SCHED; PG8_LDA(At, 0, 0); PG8_STAGE(PG8_SA(1, 1), a1 + hstepA, voffA);
            PG8_WAIT_L(8); PG8_BAR; PG8_WAIT_L(0); PG8_MMA(0, 0, At, B0); PG8_BAR; PG8_SCHED;
            PG8_LDB(B1, 0, 1); PG8_STAGE(PG8_SB(0, 0), b2, voffB);
            PG8_BAR; PG8_WAIT_L(0); PG8_MMA(0, 1, At, B1); PG8_BAR;
            PG8_LDA(At, 0, 1); PG8_STAGE(PG8_SA(0, 0), a2, voffA);
            PG8_BAR; PG8_WAIT_L(0); PG8_MMA(1, 0, At, B0); PG8_BAR; PG8_SCHED;
            PG8_STAGE(PG8_SB(0, 1), b2 + hstepB, voffB);
            PG8_WAIT_V(6); PG8_BAR; PG8_MMA(1, 1, At, B1); PG8_BAR;
            PG8_LDB(B0, 1, 0); PG8_SCHED; PG8_LDA(At, 1, 0); PG8_STAGE(PG8_SA(0, 1), a2 + hstepA, voffA);
            PG8_WAIT_L(8); PG8_BAR; PG8_WAIT_L(0); PG8_MMA(0, 0, At, B0); PG8_BAR; PG8_SCHED;
            PG8_LDB(B1, 1, 1); PG8_STAGE(PG8_SB(1, 0), b3, voffB);
            PG8_BAR; PG8_WAIT_L(0); PG8_MMA(0, 1, At, B1); PG8_BAR;
            PG8_LDA(At, 1, 1); PG8_STAGE(PG8_SA(1, 0), a3, voffA);
            PG8_BAR; PG8_WAIT_L(0); PG8_MMA(1, 0, At, B0); PG8_BAR; PG8_SCHED;
            PG8_STAGE(PG8_SB(1, 1), b3 + hstepB, voffB);
            PG8_WAIT_V(6); PG8_BAR; PG8_MMA(1, 1, At, B1); PG8_BAR;
            }
        }
        if constexpr (ALIGN_EPI) { if (wr == 0) PG8_BAR; }
        if constexpr (!Epi::AFTER_DRAIN) { E(acc, cur, wr, wc, fr, fq); S.done(cur); }
        if (!has_next) break;
#pragma unroll
        for (int a = 0; a < 2; ++a)
#pragma unroll
            for (int b = 0; b < 2; ++b)
#pragma unroll
                for (int m = 0; m < 4; ++m)
#pragma unroll
                    for (int n = 0; n < 2; ++n) acc[a][b][m][n] = (f32x4){0.f, 0.f, 0.f, 0.f};
        cur = nxt; cA = nA; cB = nB; ++ui;
        if constexpr (ALIGN_EPI) { if (wr == 1) PG8_BAR; }
    }
    PG8_WAIT_V(0);
    if constexpr (!ALIGN_EPI) { if (wr == 0) PG8_BAR; }
    PG8_BAR;
    if constexpr (Epi::AFTER_DRAIN) { E.fused(acc, cur, wr, wc, fr, fq, lds, wid, lane); S.done(cur); }
#undef PG8_SA
#undef PG8_SB
#undef PG8_STAGE
#undef PG8_LDA
#undef PG8_LDB
#undef PG8_MMA
#undef PG8_WAIT_V
#undef PG8_WAIT_L
#undef PG8_BAR
#undef PG8_SCHED
}
}
#define GAS __attribute__((address_space(1)))
#define LAS __attribute__((address_space(3)))
typedef unsigned short bf16;
typedef unsigned v4u __attribute__((ext_vector_type(4)));
typedef unsigned v2u __attribute__((ext_vector_type(2)));
typedef float f32x4 __attribute__((ext_vector_type(4)));
typedef short bf16x8 __attribute__((ext_vector_type(8)));
typedef short s16x4 __attribute__((ext_vector_type(4)));
using pg8::cvt_pk_bf16; using pg8::bf_lo; using pg8::bf_hi; using pg8::silu_f; using pg8::sigmoid_f;

constexpr int NWAVES = 8, NTHR = 512;
constexpr int BATCH = 8, SEQ = 4096, T = BATCH * SEQ, D = 1024, FF = 2816, DEPTH = 4;
constexpr float NORM_EPS = 1e-6f;
constexpr int LDS_BYTES = 147456;
constexpr size_t MiB = 1u << 20;
constexpr size_t WS_ROT = 1 * MiB;
constexpr size_t WS_W = 8 * MiB;
constexpr size_t WS_WIN1 = WS_W, WS_WOUT1 = WS_W + 11 * MiB, WS_WIN2 = WS_W + 17 * MiB, WS_WOUT2 = WS_W + 28 * MiB, WS_WMIX = WS_W + 34 * MiB;
constexpr size_t WS_U = 64 * MiB;
constexpr size_t WS_SCR = 128 * MiB;
constexpr size_t WS_NEED = 484 * MiB;

struct Args { const float* in[27]; float* out; unsigned char* ws; int ph_lo, ph_hi; };

__device__ __forceinline__ float wave_sum(float v) {
#pragma unroll
    for (int o = 1; o < 64; o <<= 1) v += __shfl_xor(v, o);
    return v;
}
__device__ __forceinline__ unsigned pk2(float lo, float hi) { return cvt_pk_bf16(lo, hi); }

template <int MAP> __device__ __forceinline__ void transpose_w(const float* W, int K, int N, int Npad, bf16* WT, LAS float* scr, int gw, int NGW, int lane) {
    asm volatile("" : "+v"(lane));
    const int nblk = Npad / 32, nitems = (K / 64) * nblk;
    for (int item = gw; item < nitems; item += NGW) {
        const int kb = item / nblk, nb = item % nblk, k0 = 64 * kb, n0 = 32 * nb;
        const int nn = n0 + (lane & 31);
#pragma unroll 8
        for (int i = 0; i < 32; ++i) { const int kk = 2 * i + (lane >> 5); scr[kk * 33 + (lane & 31)] = (nn < N) ? W[(size_t)(k0 + kk) * N + nn] : 0.f; }
        asm volatile("s_waitcnt lgkmcnt(0)" ::: "memory");
        int r0 = n0;
        if (MAP == 1) { r0 = (n0 < FF) ? (n0 / 128) * 256 + (n0 % 128) : ((n0 - FF) / 128) * 256 + 128 + ((n0 - FF) % 128); }
        const int c = lane & 7;
#pragma unroll
        for (int j = 0; j < 4; ++j) { const int n = (lane >> 3) + 8 * j; const LAS float* s = scr + (8 * c) * 33 + n;
            v4u o; o.x = pk2(s[0 * 33], s[1 * 33]); o.y = pk2(s[2 * 33], s[3 * 33]); o.z = pk2(s[4 * 33], s[5 * 33]); o.w = pk2(s[6 * 33], s[7 * 33]);
            *(v4u*)(WT + (size_t)(r0 + n) * K + k0 + 8 * c) = o; }
        asm volatile("s_waitcnt lgkmcnt(0)" ::: "memory");
    }
}

__device__ __forceinline__ void rms_rows(const float* X, const float* gain, bf16* U, float* Hcopy, int gw, int NGW, int lane) {
    asm volatile("" : "+v"(lane));
    f32x4 g[4];
#pragma unroll
    for (int j = 0; j < 4; ++j) g[j] = ((const f32x4*)gain)[lane + 64 * j];
    for (int m = gw; m < T; m += NGW) {
        const f32x4* xr = (const f32x4*)(X + (size_t)m * D) + lane;
        f32x4 v[4]; float s = 0.f;
#pragma unroll
        for (int j = 0; j < 4; ++j) { v[j] = xr[64 * j]; s += (v[j].x * v[j].x + v[j].y * v[j].y) + (v[j].z * v[j].z + v[j].w * v[j].w); }
        const float rstd = rsqrtf(wave_sum(s) * (1.f / D) + NORM_EPS);
        if (Hcopy) { f32x4* hr = (f32x4*)(Hcopy + (size_t)m * D) + lane;
#pragma unroll
            for (int j = 0; j < 4; ++j) hr[64 * j] = v[j]; }
        v2u* o8 = (v2u*)(U + (size_t)m * D) + lane;
#pragma unroll
        for (int j = 0; j < 4; ++j) { v2u w; w.x = pk2(v[j].x * rstd * g[j].x, v[j].y * rstd * g[j].y); w.y = pk2(v[j].z * rstd * g[j].z, v[j].w * rstd * g[j].w); o8[64 * j] = w; }
    }
}
__device__ __forceinline__ void rms_final(float* X, const float* gain, int gw, int NGW, int lane) {
    asm volatile("" : "+v"(lane));
    f32x4 g[4];
#pragma unroll
    for (int j = 0; j < 4; ++j) g[j] = ((const f32x4*)gain)[lane + 64 * j];
    for (int m = gw; m < T; m += NGW) {
        f32x4* xr = (f32x4*)(X + (size_t)m * D) + lane;
        f32x4 v[4]; float s = 0.f;
#pragma unroll
        for (int j = 0; j < 4; ++j) { v[j] = xr[64 * j]; s += (v[j].x * v[j].x + v[j].y * v[j].y) + (v[j].z * v[j].z + v[j].w * v[j].w); }
        const float rstd = rsqrtf(wave_sum(s) * (1.f / D) + NORM_EPS);
#pragma unroll
        for (int j = 0; j < 4; ++j) xr[64 * j] = v[j] * rstd * g[j];
    }
}

template <int MODE> __device__ __forceinline__ void run_gemm(LAS unsigned char* lds, const bf16* A, int lda, const bf16* Bt, int M, int N, int K, const pg8::Epi<MODE>& E, int wave_s) {
    pg8::Gemm g{A, Bt, M, N, K, lda}; pg8::StaticOrder S; S.init(M, N, (int)gridDim.x, (int)blockIdx.x);
    pg8::gemm_phase<pg8::Epi<MODE>, pg8::StaticOrder, true, true>(lds, g, S, E, wave_s);
}
#define XB_TMO      128
#define XB_XCNT(j)  (256  + 64 * (j))
#define XB_XSUB(j)  (1280 + 64 * (j))
#define XB_XGEN(j)  (2304 + 64 * (j))
#define XB_TOP      3328
#define XB_TOPGEN   3392
#define XCD_BAR_WORDS 3456
#define XB_SPIN_CAP (1u << 18)

__device__ __forceinline__ unsigned xb_ld(unsigned* p)              { return __hip_atomic_load(p, __ATOMIC_RELAXED, __HIP_MEMORY_SCOPE_AGENT); }
__device__ __forceinline__ unsigned xb_add(unsigned* p, unsigned v) { return __hip_atomic_fetch_add(p, v, __ATOMIC_RELAXED, __HIP_MEMORY_SCOPE_AGENT); }
__device__ __forceinline__ unsigned xb_xcc_id() { return (unsigned)__builtin_amdgcn_s_getreg((3 << 11) | 20) & 0xFu; }
#define XB_SPIN(cond, bar) do { unsigned _sp = 0; while (cond) { __builtin_amdgcn_s_sleep(1); \
    if ((++_sp & 255u) == 0u) { if (xb_ld(&(bar)[XB_TMO])) break; if (_sp > XB_SPIN_CAP) { atomicAdd(&(bar)[XB_TMO], 1u); break; } } } } while (0)

struct XcdBarrier {
    unsigned* bar; unsigned x;
    volatile LAS unsigned* st;
};

__device__ __forceinline__ XcdBarrier xcd_barrier_post(unsigned* bar, volatile LAS unsigned* st) {
    XcdBarrier b; b.bar = bar; b.x = xb_xcc_id(); b.st = st;
    if (threadIdx.x == 0) (void)xb_add(&bar[XB_XCNT(b.x)], 1u);
    return b;
}
__device__ __forceinline__ void xcd_barrier_complete(unsigned* bar, unsigned x, unsigned& nloc, unsigned& nx) {
    const unsigned G = gridDim.x * gridDim.y * gridDim.z;
    unsigned sum, cnt, mine, sp = 0u;
    for (;;) {
        sum = 0u; cnt = 0u; mine = 0u;
#pragma unroll
        for (unsigned j = 0; j < 16; ++j) { const unsigned c = xb_ld(&bar[XB_XCNT(j)]); sum += c; cnt += (c > 0u) ? 1u : 0u; mine = (j == x) ? c : mine; }
        if (sum == G) break;
        __builtin_amdgcn_s_sleep(1);
        if ((++sp & 255u) == 0u) { if (xb_ld(&bar[XB_TMO])) break; if (sp > XB_SPIN_CAP) { atomicAdd(&bar[XB_TMO], 1u); break; } }
    }
    nloc = mine > 0u ? mine : 1u; nx = cnt > 0u ? cnt : 1u;
}

__device__ __forceinline__ void xcd_barrier(const XcdBarrier& b) {
    asm volatile("s_waitcnt vmcnt(0)" ::: "memory");
    __syncthreads();
    if (threadIdx.x == 0) {
        unsigned* bar = b.bar;
        __builtin_amdgcn_s_waitcnt(0);
        unsigned nloc = b.st[0], nx = b.st[1];
        if (nloc == 0u) { xcd_barrier_complete(bar, b.x, nloc, nx); b.st[0] = nloc; b.st[1] = nx; }
        const unsigned old = xb_add(&bar[XB_XSUB(b.x)], 1u);
        const unsigned gen = old / nloc;
        if (old + 1u == (gen + 1u) * nloc) {
            __builtin_amdgcn_fence(__ATOMIC_RELEASE, "agent");
            asm volatile("s_waitcnt vmcnt(0)" ::: "memory");
            const unsigned og = xb_add(&bar[XB_TOP], 1u);
            const unsigned tg = og / nx;
            if (og + 1u == (tg + 1u) * nx) xb_add(&bar[XB_TOPGEN], 1u);
            else XB_SPIN(xb_ld(&bar[XB_TOPGEN]) == tg, bar);
            __builtin_amdgcn_fence(__ATOMIC_ACQUIRE, "agent");
            xb_add(&bar[XB_XGEN(b.x)], 1u);
            asm volatile("s_waitcnt vmcnt(0)" ::: "memory");
        } else {
            XB_SPIN(xb_ld(&bar[XB_XGEN(b.x)]) == gen, bar);
            __builtin_amdgcn_fence(__ATOMIC_ACQUIRE, "agent");
            asm volatile("s_waitcnt vmcnt(0)" ::: "memory");
        }
    }
    __syncthreads();
}
typedef short v4i16_t __attribute__((ext_vector_type(4)));
__device__ __forceinline__ s16x4 ldtr(const LAS unsigned char* p) { return __builtin_bit_cast(s16x4, __builtin_amdgcn_ds_read_tr16_b64_v4i16((LAS v4i16_t*)p)); }
__device__ __forceinline__ bf16x8 tr2(const LAS unsigned char* p, int stride4) { const s16x4 a = ldtr(p), b = ldtr(p + stride4); return (bf16x8){a[0], a[1], a[2], a[3], b[0], b[1], b[2], b[3]}; }
__device__ __forceinline__ f32x4 mfma16(bf16x8 a, bf16x8 b, f32x4 c) { return __builtin_amdgcn_mfma_f32_16x16x32_bf16(a, b, c, 0, 0, 0); }
__device__ __forceinline__ bf16x8 ldrow(const LAS unsigned char* p) { return *(const LAS bf16x8*)p; }
__device__ __forceinline__ float softplus_f(float x) { return x > 20.f ? x : log1pf(__expf(x)); }

template <int DK, bool SSD>
__device__ __forceinline__ void scan_item(LAS unsigned char* lds, const bf16* Qg, const bf16* Kg, const bf16* Vg, int pitch, bf16* Og, int opitch,
                                          float lg, const float* dtraw, float dtbias, float Aneg, float Dskip, int wave_s) {
    constexpr int KS = (DK + 8) * 2, VS = 144;
    constexpr int OFF_K = 0, OFF_ST = OFF_K + 64 * KS, OFF_VS = OFF_ST + 64 * KS, OFF_VW = OFF_VS + 64 * VS, OFF_SD = OFF_VW + 64 * VS;
    constexpr int NKS = DK / 32, NMT = DK / 128, NKP = DK / 64;
    int tid_ = wave_s * 64 + lane_id_now(); asm volatile("" : "+v"(tid_));
    const int tid = tid_, lane = tid & 63, wave = __builtin_amdgcn_readfirstlane(tid >> 6);
    const int it = wave & 3, hf = wave >> 2, l15 = lane & 15, g = lane >> 4, q4 = l15 >> 2, p4 = l15 & 3;
    for (int i = tid; i < 64 * KS / 4; i += NTHR) ((LAS unsigned*)(lds + OFF_ST))[i] = 0u;
    f32x4 st[NMT * 4];
#pragma unroll
    for (int i = 0; i < NMT * 4; ++i) st[i] = (f32x4){0.f, 0.f, 0.f, 0.f};
    v4u kreg[NKP]; v4u vreg; bf16x8 qreg[NKS]; float dtv = 0.f;
    const int vrow = tid >> 3, vpc = tid & 7;
    {
#pragma unroll
        for (int i = 0; i < NKP; ++i) { const int idx = tid + NTHR * i, row = idx / (DK / 8), pc = idx % (DK / 8); kreg[i] = *(const v4u*)(Kg + (size_t)row * pitch + pc * 8); }
        vreg = *(const v4u*)(Vg + (size_t)vrow * pitch + vpc * 8);
#pragma unroll
        for (int kk = 0; kk < NKS; ++kk) qreg[kk] = *(const bf16x8*)(Qg + (size_t)(16 * it + l15) * pitch + 8 * g + 32 * kk);
        if (SSD) dtv = dtraw[(size_t)lane * 32];
    }
    for (int c = 0; c < 64; ++c) {
        const int t0 = c * 64;
        float aj, vsj;
        if (SSD) { const float dt = softplus_f(dtv + dtbias); aj = dt * Aneg; vsj = dt; } else { aj = lg; vsj = 1.f; }
        float Lv = aj;
#pragma unroll
        for (int o = 1; o < 64; o <<= 1) { const float t = __shfl_up(Lv, o); if (lane >= o) Lv += t; }
        const float Llast = __shfl(Lv, 63);
        const float wv = __expf(Llast - Lv);
#pragma unroll
        for (int i = 0; i < NKP; ++i) { const int idx = tid + NTHR * i, row = idx / (DK / 8), pc = idx % (DK / 8); *(LAS v4u*)(lds + OFF_K + row * KS + pc * 16) = kreg[i]; }
        {
            const float vs = __shfl(vsj, vrow & 63), ww = __shfl(wv, vrow & 63) * vs;
            const float x0 = bf_lo(vreg.x), x1 = bf_hi(vreg.x), x2 = bf_lo(vreg.y), x3 = bf_hi(vreg.y), x4 = bf_lo(vreg.z), x5 = bf_hi(vreg.z), x6 = bf_lo(vreg.w), x7 = bf_hi(vreg.w);
            v4u a, b;
            a.x = pk2(x0 * vs, x1 * vs); a.y = pk2(x2 * vs, x3 * vs); a.z = pk2(x4 * vs, x5 * vs); a.w = pk2(x6 * vs, x7 * vs);
            b.x = pk2(x0 * ww, x1 * ww); b.y = pk2(x2 * ww, x3 * ww); b.z = pk2(x4 * ww, x5 * ww); b.w = pk2(x6 * ww, x7 * ww);
            *(LAS v4u*)(lds + OFF_VS + vrow * VS + vpc * 16) = a; *(LAS v4u*)(lds + OFF_VW + vrow * VS + vpc * 16) = b;
        }
        bf16x8 qc[NKS];
#pragma unroll
        for (int kk = 0; kk < NKS; ++kk) qc[kk] = qreg[kk];
        if (c + 1 < 64) {
            const int t1 = t0 + 64;
#pragma unroll
            for (int i = 0; i < NKP; ++i) { const int idx = tid + NTHR * i, row = idx / (DK / 8), pc = idx % (DK / 8); kreg[i] = *(const v4u*)(Kg + (size_t)(t1 + row) * pitch + pc * 8); }
            vreg = *(const v4u*)(Vg + (size_t)(t1 + vrow) * pitch + vpc * 8);
#pragma unroll
            for (int kk = 0; kk < NKS; ++kk) qreg[kk] = *(const bf16x8*)(Qg + (size_t)(t1 + 16 * it + l15) * pitch + 8 * g + 32 * kk);
            if (SSD) dtv = dtraw[(size_t)(t1 + lane) * 32];
        }
        __syncthreads();
        const float Li = __shfl(Lv, 16 * it + l15);
#pragma unroll
        for (int jj = 0; jj < 2; ++jj) {
            const int jt = 2 * hf + jj;
            f32x4 s = (f32x4){0.f, 0.f, 0.f, 0.f};
            if (jt <= it) {
#pragma unroll
                for (int kk = 0; kk < NKS; ++kk) s = mfma16(ldrow(lds + OFF_K + (16 * jt + l15) * KS + (8 * g + 32 * kk) * 2), qc[kk], s);
            }
            float o[4];
#pragma unroll
            for (int r = 0; r < 4; ++r) { const int j = 16 * jt + 4 * g + r; const float Lj = __shfl(Lv, j); o[r] = (j <= 16 * it + l15) ? s[r] * __expf(Li - Lj) : 0.f; }
            v2u w; w.x = pk2(o[0], o[1]); w.y = pk2(o[2], o[3]);
            *(LAS v2u*)(lds + OFF_SD + (16 * it + l15) * VS + (16 * jt + 4 * g) * 2) = w;
        }
        f32x4 o2[2];
#pragma unroll
        for (int dd = 0; dd < 2; ++dd) {
            const int dt = 2 * hf + dd; f32x4 a = (f32x4){0.f, 0.f, 0.f, 0.f};
#pragma unroll
            for (int kk = 0; kk < NKS; ++kk) a = mfma16(qc[kk], ldrow(lds + OFF_ST + (16 * dt + l15) * KS + (8 * g + 32 * kk) * 2), a);
            o2[dd] = a;
        }
        __syncthreads();
        float ei[4];
#pragma unroll
        for (int r = 0; r < 4; ++r) ei[r] = __expf(__shfl(Lv, 16 * it + 4 * g + r));
#pragma unroll
        for (int dd = 0; dd < 2; ++dd) {
            const int dt = 2 * hf + dd; f32x4 a = (f32x4){0.f, 0.f, 0.f, 0.f};
#pragma unroll
            for (int kk = 0; kk < 2; ++kk)
                a = mfma16(ldrow(lds + OFF_SD + (16 * it + l15) * VS + (8 * g + 32 * kk) * 2), tr2(lds + OFF_VS + (32 * kk + 8 * g + q4) * VS + (16 * dt + 4 * p4) * 2, 4 * VS), a);
#pragma unroll
            for (int r = 0; r < 4; ++r) {
                const int i = 16 * it + 4 * g + r, col = 16 * dt + l15;
                float o = a[r] + o2[dd][r] * ei[r];
                bf16* op = Og + (size_t)(t0 + i) * opitch + col;
                if (SSD) { const float xs = __uint_as_float((unsigned)Vg[(size_t)(t0 + i) * pitch + col] << 16), z = __uint_as_float((unsigned)(*op) << 16); o = (o + Dskip * xs) * silu_f(z); }
                *op = (bf16)(pk2(o, 0.f) & 0xffffu);
            }
        }
        const float cd = __expf(Llast);
#pragma unroll
        for (int i = 0; i < NMT * 4; ++i) st[i] = st[i] * cd;
#pragma unroll
        for (int mm = 0; mm < NMT; ++mm) {
            const int mt = NMT * wave + mm;
#pragma unroll
            for (int kk = 0; kk < 2; ++kk) {
                const bf16x8 a = tr2(lds + OFF_K + (32 * kk + 8 * g + q4) * KS + (16 * mt + 4 * p4) * 2, 4 * KS);
#pragma unroll
                for (int dt = 0; dt < 4; ++dt) st[mm * 4 + dt] = mfma16(a, tr2(lds + OFF_VW + (32 * kk + 8 * g + q4) * VS + (16 * dt + 4 * p4) * 2, 4 * VS), st[mm * 4 + dt]);
            }
#pragma unroll
            for (int dt = 0; dt < 4; ++dt) { const f32x4 s = st[mm * 4 + dt]; v2u w; w.x = pk2(s[0], s[1]); w.y = pk2(s[2], s[3]);
                *(LAS v2u*)(lds + OFF_ST + (16 * dt + l15) * KS + (16 * mt + 4 * g) * 2) = w; }
        }
        __syncthreads();
    }
}

__device__ __forceinline__ void gnorm_rows(bf16* X, int pitch, const float* gain, int gw, int NGW, int lane) {
    asm volatile("" : "+v"(lane));
    for (int m = gw; m < T * 4; m += NGW) {
        const int row = m >> 2, gq = m & 3;
        v4u* p = (v4u*)(X + (size_t)row * pitch + gq * 512) + lane;
        const v4u v = *p;
        float x[8] = {bf_lo(v.x), bf_hi(v.x), bf_lo(v.y), bf_hi(v.y), bf_lo(v.z), bf_hi(v.z), bf_lo(v.w), bf_hi(v.w)};
        float s = 0.f;
#pragma unroll
        for (int e = 0; e < 8; ++e) s += x[e] * x[e];
        const float rstd = rsqrtf(wave_sum(s) * (1.f / 512.f) + NORM_EPS);
        const f32x4 g0 = *(const f32x4*)(gain + gq * 512 + lane * 8), g1 = *(const f32x4*)(gain + gq * 512 + lane * 8 + 4);
        v4u o; o.x = pk2(x[0] * rstd * g0.x, x[1] * rstd * g0.y); o.y = pk2(x[2] * rstd * g0.z, x[3] * rstd * g0.w); o.z = pk2(x[4] * rstd * g1.x, x[5] * rstd * g1.y); o.w = pk2(x[6] * rstd * g1.z, x[7] * rstd * g1.w);
        *p = o;
    }
}
constexpr int SSD_PITCH = 5376, SSD_XBC0 = 2048, SSD_XBCW = 3072;
__device__ __forceinline__ void ssd_halo_save(const bf16* PROJ, bf16* HALO, int gtid, int GT) {
    asm volatile("" : "+v"(gtid));
    for (int idx = gtid; idx < 512 * 3 * 384; idx += GT) {
        const int c8 = idx % 384, r = (idx / 384) % 3, seg = idx / (3 * 384), t0 = seg * 64;
        v4u v = (v4u){0u, 0u, 0u, 0u};
        if ((t0 & 4095) != 0) v = *(const v4u*)(PROJ + (size_t)(t0 - 3 + r) * SSD_PITCH + SSD_XBC0 + c8 * 8);
        *(v4u*)(HALO + ((size_t)seg * 3 + r) * SSD_XBCW + c8 * 8) = v;
    }
}
__device__ __forceinline__ void unpack8(const v4u v, float (&x)[8]) { x[0] = bf_lo(v.x); x[1] = bf_hi(v.x); x[2] = bf_lo(v.y); x[3] = bf_hi(v.y); x[4] = bf_lo(v.z); x[5] = bf_hi(v.z); x[6] = bf_lo(v.w); x[7] = bf_hi(v.w); }
__device__ __forceinline__ void ssd_conv(bf16* PROJ, const bf16* HALO, const float* cw, const float* cb, int gtid, int GT) {
    asm volatile("" : "+v"(gtid));
    for (int idx = gtid; idx < 512 * 384; idx += GT) {
        const int c8 = idx % 384, seg = idx / 384, t0 = seg * 64;
        float w0[8], w1[8], w2[8], w3[8], bb[8], xa[8], xb[8], xc[8], xd[8];
#pragma unroll
        for (int e = 0; e < 8; ++e) { w0[e] = cw[c8 * 8 + e]; w1[e] = cw[SSD_XBCW + c8 * 8 + e]; w2[e] = cw[2 * SSD_XBCW + c8 * 8 + e]; w3[e] = cw[3 * SSD_XBCW + c8 * 8 + e]; bb[e] = cb[c8 * 8 + e]; }
        unpack8(*(const v4u*)(HALO + ((size_t)seg * 3 + 0) * SSD_XBCW + c8 * 8), xa);
        unpack8(*(const v4u*)(HALO + ((size_t)seg * 3 + 1) * SSD_XBCW + c8 * 8), xb);
        unpack8(*(const v4u*)(HALO + ((size_t)seg * 3 + 2) * SSD_XBCW + c8 * 8), xc);
        bf16* p = PROJ + (size_t)t0 * SSD_PITCH + SSD_XBC0 + c8 * 8;
        for (int tt = 0; tt < 64; ++tt, p += SSD_PITCH) {
            unpack8(*(const v4u*)p, xd);
            float o[8];
#pragma unroll
            for (int e = 0; e < 8; ++e) { o[e] = silu_f(bb[e] + w0[e] * xa[e] + w1[e] * xb[e] + w2[e] * xc[e] + w3[e] * xd[e]); xa[e] = xb[e]; xb[e] = xc[e]; xc[e] = xd[e]; }
            v4u w; w.x = pk2(o[0], o[1]); w.y = pk2(o[2], o[3]); w.z = pk2(o[4], o[5]); w.w = pk2(o[6], o[7]);
            *(v4u*)p = w;
        }
    }
}
template <int DH> struct FaState { float m, l; f32x4 o[DH / 16]; };
template <int DH> __device__ __forceinline__ void fa_init(FaState<DH>& st) { st.m = -1e30f; st.l = 0.f;
#pragma unroll
    for (int i = 0; i < DH / 16; ++i) st.o[i] = (f32x4){0.f, 0.f, 0.f, 0.f}; }
__device__ __forceinline__ float fexp2(float x) { return __builtin_amdgcn_exp2f(x); }

template <int DH, class Mask>
__device__ __forceinline__ void fa_tile(const LAS unsigned char* Kt, const LAS unsigned char* Vt, const bf16x8 (&qf)[DH / 32], FaState<DH>& st, float sc2, const Mask& mk, int key0, int l15, int g, int q4, int p4) {
    constexpr int KS = (DH + 8) * 2;
    f32x4 s0 = (f32x4){0.f, 0.f, 0.f, 0.f}, s1 = s0;
#pragma unroll
    for (int kk = 0; kk < DH / 32; ++kk) {
        s0 = mfma16(ldrow(Kt + l15 * KS + (8 * g + 32 * kk) * 2), qf[kk], s0);
        s1 = mfma16(ldrow(Kt + (16 + l15) * KS + (8 * g + 32 * kk) * 2), qf[kk], s1);
    }
    float v[8]; bool ok[8]; float tm = -1e30f;
#pragma unroll
    for (int r = 0; r < 4; ++r) {
        ok[r] = mk.valid(key0 + 4 * g + r); ok[4 + r] = mk.valid(key0 + 16 + 4 * g + r);
        v[r] = ok[r] ? s0[r] * sc2 : -1e30f; v[4 + r] = ok[4 + r] ? s1[r] * sc2 : -1e30f;
        tm = fmaxf(tm, fmaxf(v[r], v[4 + r]));
    }
    tm = fmaxf(tm, __shfl_xor(tm, 16)); tm = fmaxf(tm, __shfl_xor(tm, 32));
    const float mn = fmaxf(st.m, tm), alpha = fexp2(st.m - mn);
    float p[8], ps = 0.f;
#pragma unroll
    for (int e = 0; e < 8; ++e) { p[e] = ok[e] ? fexp2(v[e] - mn) : 0.f; ps += p[e]; }
    ps += __shfl_xor(ps, 16); ps += __shfl_xor(ps, 32);
    st.l = st.l * alpha + ps; st.m = mn;
    v4u pbu; pbu.x = pk2(p[0], p[1]); pbu.y = pk2(p[2], p[3]); pbu.z = pk2(p[4], p[5]); pbu.w = pk2(p[6], p[7]);
    const bf16x8 pb = __builtin_bit_cast(bf16x8, pbu);
#pragma unroll
    for (int dt = 0; dt < DH / 16; ++dt) {
        const s16x4 a = ldtr(Vt + (4 * g + q4) * KS + (16 * dt + 4 * p4) * 2), b = ldtr(Vt + (16 + 4 * g + q4) * KS + (16 * dt + 4 * p4) * 2);
        st.o[dt] = mfma16((bf16x8){a[0], a[1], a[2], a[3], b[0], b[1], b[2], b[3]}, pb, st.o[dt] * alpha);
    }
}

template <int DH, int NSUB, class Src, class Mask>
__device__ __forceinline__ void fa_stream(LAS unsigned char* lds, int tid, int t_begin, int t_end, const Src& src, const Mask& mk, const bf16x8 (&qf)[DH / 32], FaState<DH>& st, float sc2) {
    constexpr int KS = (DH + 8) * 2, TB = 32 * KS, SB = NSUB * TB;
    if (t_begin >= t_end) return;
    const int lane = tid & 63, l15 = lane & 15, g = lane >> 4, q4 = l15 >> 2, p4 = l15 & 3;
    v4u rk[NSUB], rv[NSUB];
    int lj, lpc; bool isv = false;
    if constexpr (DH == 128) { lj = tid >> 4; lpc = tid & 15; } else { lj = (tid & 255) >> 3; lpc = tid & 7; isv = tid >= 256; }
    const int nst = (t_end - t_begin + NSUB - 1) / NSUB;
    auto issue = [&](int k) {
#pragma unroll
        for (int u = 0; u < NSUB; ++u) { int ti = t_begin + k * NSUB + u; ti = ti < t_end ? ti : t_end - 1;
            if constexpr (DH == 128) { rk[u] = *(const v4u*)(src.krow(ti, lj) + lpc * 8); rv[u] = *(const v4u*)(src.vrow(ti, lj) + lpc * 8); }
            else { rk[u] = *(const v4u*)((isv ? src.vrow(ti, lj) : src.krow(ti, lj)) + lpc * 8); } }
    };
    auto commit = [&](int buf) {
#pragma unroll
        for (int u = 0; u < NSUB; ++u) {
            if constexpr (DH == 128) { *(LAS v4u*)(lds + buf * SB + u * TB + lj * KS + lpc * 16) = rk[u]; *(LAS v4u*)(lds + (2 + buf) * SB + u * TB + lj * KS + lpc * 16) = rv[u]; }
            else { *(LAS v4u*)(lds + ((isv ? 2 : 0) + buf) * SB + u * TB + lj * KS + lpc * 16) = rk[u]; } }
    };
    issue(0); commit(0);
    __syncthreads();
    for (int k = 0; k < nst; ++k) {
        const int cur = k & 1;
        if (k + 1 < nst) issue(k + 1);
#pragma unroll
        for (int u = 0; u < NSUB; ++u) { const int ti = t_begin + k * NSUB + u;
            if (ti < t_end && mk.wave_needs(ti)) fa_tile<DH, Mask>(lds + cur * SB + u * TB, lds + (2 + cur) * SB + u * TB, qf, st, sc2, mk, mk.key0(ti), l15, g, q4, p4); }
        if (k + 1 < nst) commit(cur ^ 1);
        __syncthreads();
    }
}

constexpr int DIL_PITCH = 3072;
struct DilSrc { const bf16* kbase; int band0, r, c;
    __device__ __forceinline__ const bf16* krow(int s, int j) const { int a = band0 + 32 * s + j; a = a < 0 ? 0 : a; return kbase + (size_t)(a * r + c) * DIL_PITCH; }
    __device__ __forceinline__ const bf16* vrow(int s, int j) const { return krow(s, j) + 1024; } };
struct DilMask { int aq, band0, w;
    __device__ __forceinline__ bool valid(int ak) const { return ak >= 0 && ak <= aq && aq - ak <= 128; }
    __device__ __forceinline__ bool wave_needs(int s) const { return 32 * s + 31 >= 16 * w && 32 * s <= 16 * w + 143; }
    __device__ __forceinline__ int key0(int s) const { return band0 + 32 * s; } };

__device__ __forceinline__ void dilated_phase(LAS unsigned char* lds, const bf16* PROJD, bf16* OACC, float* LSE, int gi, int G, int wave_s) {
    int tid_ = wave_s * 64 + lane_id_now(); asm volatile("" : "+v"(tid_));
    const int tid = tid_, lane = tid & 63, wave = __builtin_amdgcn_readfirstlane(tid >> 6), l15 = lane & 15, g = lane >> 4;
    const int r = (gi == 0) ? 1 : (gi == 1 ? 4 : 16);
    const float sc2 = 0.08838834764831845f * 1.4426950408889634f;
    for (int item = blockIdx.x; item < 2048; item += G) {
        const int bh = item >> 5, b = bh >> 3, h = bh & 7, rem = item & 31, c = rem % r, qt = rem / r;
        const bf16* base = PROJD + (size_t)b * SEQ * DIL_PITCH + h * 128;
        const int aq = 128 * qt + 16 * wave + l15, tq = aq * r + c;
        bf16x8 qf[4];
#pragma unroll
        for (int kk = 0; kk < 4; ++kk) qf[kk] = *(const bf16x8*)(base + (size_t)tq * DIL_PITCH + 8 * g + 32 * kk);
        DilSrc src{base + 1024, 128 * qt - 128, r, c};
        DilMask mk{aq, 128 * qt - 128, wave};
        FaState<128> st; fa_init<128>(st);
        fa_stream<128, 2, DilSrc, DilMask>(lds, tid, qt == 0 ? 4 : 0, 8, src, mk, qf, st, sc2);
        const float inv = 1.f / fmaxf(st.l, 1e-30f);
        float lse = (st.m + __log2f(fmaxf(st.l, 1e-30f))) * 0.6931471805599453f;
        const size_t trow = (size_t)b * SEQ + tq;
        float wp = 0.f, wn = 1.f;
        if (gi > 0) { const float lp = LSE[trow * 8 + h]; const float mx = fmaxf(lp, lse); const float ep = __expf(lp - mx), en = __expf(lse - mx); const float den = ep + en; wp = ep / den; wn = en / den; lse = mx + __logf(den); }
        bf16* op = OACC + trow * 1024 + h * 128 + 4 * g;
#pragma unroll
        for (int dt = 0; dt < 8; ++dt) {
            f32x4 o = st.o[dt] * (inv * wn);
            if (gi > 0) { const v2u old = *(const v2u*)(op + 16 * dt); o[0] += wp * bf_lo(old.x); o[1] += wp * bf_hi(old.x); o[2] += wp * bf_lo(old.y); o[3] += wp * bf_hi(old.y); }
            v2u w; w.x = pk2(o[0], o[1]); w.y = pk2(o[2], o[3]);
            *(v2u*)(op + 16 * dt) = w;
        }
        if (g == 0) LSE[trow * 8 + h] = lse;
    }
}
constexpr int NSA_PITCH = 2816;
__device__ __forceinline__ void nsa_im2col(const bf16* PROJN, const float* pos, bf16* ACMP, int gtid, int GT) {
    asm volatile("" : "+v"(gtid));
    for (int idx = gtid; idx < 2 * 8192 * 256; idx += GT) {
        const int pc = idx & 255, row = (idx >> 8) & 8191, kv = idx >> 21;
        const int l = pc >> 3, d0 = (pc & 7) * 8, n = row & 255, bg = row >> 8, b = bg >> 2, gq = bg & 3;
        v4u o = (v4u){0u, 0u, 0u, 0u};
        if (n < 255) {
            const v4u v = *(const v4u*)(PROJN + (size_t)(b * SEQ + 16 * n + l) * NSA_PITCH + 1024 + kv * 256 + gq * 64 + d0);
            const f32x4 p0 = *(const f32x4*)(pos + kv * 2048 + l * 64 + d0), p1 = *(const f32x4*)(pos + kv * 2048 + l * 64 + d0 + 4);
            o.x = pk2(bf_lo(v.x) + p0.x, bf_hi(v.x) + p0.y); o.y = pk2(bf_lo(v.y) + p0.z, bf_hi(v.y) + p0.w);
            o.z = pk2(bf_lo(v.z) + p1.x, bf_hi(v.z) + p1.y); o.w = pk2(bf_lo(v.w) + p1.z, bf_hi(v.w) + p1.w);
        }
        *(v4u*)(ACMP + ((size_t)kv * 8192 + row) * 2048 + pc * 8) = o;
    }
}
struct TokSrc { const bf16* kbase; const bf16* vbase; const LAS int* list;
    __device__ __forceinline__ int tile(int s) const { return list ? list[s] : s; }
    __device__ __forceinline__ const bf16* krow(int s, int j) const { return kbase + (size_t)(32 * tile(s) + j) * NSA_PITCH; }
    __device__ __forceinline__ const bf16* vrow(int s, int j) const { return vbase + (size_t)(32 * tile(s) + j) * NSA_PITCH; } };
struct SelMask { unsigned lo, hi; int t; const LAS int* list;
    __device__ __forceinline__ bool valid(int tok) const { const int jb = tok >> 6; const unsigned bit = (jb < 32) ? (lo >> jb) & 1u : (hi >> (jb - 32)) & 1u; return bit != 0u && tok <= t; }
    __device__ __forceinline__ bool wave_needs(int) const { return true; }
    __device__ __forceinline__ int key0(int s) const { return 32 * list[s]; } };
struct WinMask { int t;
    __device__ __forceinline__ bool valid(int tok) const { return tok <= t && tok > t - 512; }
    __device__ __forceinline__ bool wave_needs(int) const { return true; }
    __device__ __forceinline__ int key0(int s) const { return 32 * s; } };

__device__ __forceinline__ void nsa_phase(LAS unsigned char* lds, const bf16* PROJN, const bf16* KVC, bf16* ONSA, int G, int wave_s) {
    constexpr int KS = 144, OFF_KC = 0, OFF_VC = OFF_KC + 256 * KS, OFF_IMP = OFF_VC + 256 * KS, OFF_SEL = OFF_IMP + 32 * 256 * 4, OFF_UNI = OFF_SEL + 256, OFF_TL = OFF_UNI + 64, OFF_NT = OFF_TL + 512;
    int tid_ = wave_s * 64 + lane_id_now(); asm volatile("" : "+v"(tid_));
    const int tid = tid_, lane = tid & 63, wave = __builtin_amdgcn_readfirstlane(tid >> 6), l15 = lane & 15, g = lane >> 4, q4 = l15 >> 2, p4 = l15 & 3;
    const float sc2 = 0.125f * 1.4426950408889634f;
    LAS float* IMP = (LAS float*)(lds + OFF_IMP);
    LAS unsigned* SEL = (LAS unsigned*)(lds + OFF_SEL);
    LAS unsigned* UNI = (LAS unsigned*)(lds + OFF_UNI);
    LAS int* TL = (LAS int*)(lds + OFF_TL);
    LAS int* NT = (LAS int*)(lds + OFF_NT);
    for (int item = blockIdx.x; item < 4096; item += G) {
        const int qb = item & 127, bg = item >> 7, b = bg >> 2, gq = bg & 3, t0 = 32 * qb, cur = t0 >> 6;
        const int ql = 4 * wave + q4, hp = p4, t = t0 + ql;
        const bf16* prow = PROJN + (size_t)b * SEQ * NSA_PITCH;
        bf16x8 qf[2];
#pragma unroll
        for (int kk = 0; kk < 2; ++kk) qf[kk] = *(const bf16x8*)(prow + (size_t)t * NSA_PITCH + gq * 256 + hp * 64 + 8 * g + 32 * kk);
        int ncv = (t0 >> 4) + 1; ncv = ncv > 255 ? 255 : ncv; const int ntc = (ncv + 31) >> 5;
        for (int i = tid; i < ntc * 32 * 8 * 2; i += NTHR) {
            const int kv = (i >= ntc * 256) ? 1 : 0, ii = i - kv * ntc * 256, n = ii >> 3, pc = ii & 7;
            *(LAS v4u*)(lds + (kv ? OFF_VC : OFF_KC) + n * KS + pc * 16) = *(const v4u*)(KVC + ((size_t)kv * 8192 + bg * 256 + n) * 256 + pc * 8);
        }
        __syncthreads();
        f32x4 oc[4];
#pragma unroll
        for (int i = 0; i < 4; ++i) oc[i] = (f32x4){0.f, 0.f, 0.f, 0.f};
        {
            f32x4 sc[8][2]; float mx = -1e30f;
#pragma unroll
            for (int s = 0; s < 8; ++s) {
                sc[s][0] = (f32x4){-1e30f, -1e30f, -1e30f, -1e30f}; sc[s][1] = sc[s][0];
                if (s < ntc) {
                    f32x4 a0 = (f32x4){0.f, 0.f, 0.f, 0.f}, a1 = a0;
#pragma unroll
                    for (int kk = 0; kk < 2; ++kk) {
                        a0 = mfma16(ldrow(lds + OFF_KC + (32 * s + l15) * KS + (8 * g + 32 * kk) * 2), qf[kk], a0);
                        a1 = mfma16(ldrow(lds + OFF_KC + (32 * s + 16 + l15) * KS + (8 * g + 32 * kk) * 2), qf[kk], a1);
                    }
#pragma unroll
                    for (int r = 0; r < 4; ++r) {
                        const int n0 = 32 * s + 4 * g + r, n1 = n0 + 16;
                        sc[s][0][r] = (16 * n0 + 31 <= t && n0 < 255) ? a0[r] * sc2 : -1e30f;
                        sc[s][1][r] = (16 * n1 + 31 <= t && n1 < 255) ? a1[r] * sc2 : -1e30f;
                        mx = fmaxf(mx, fmaxf(sc[s][0][r], sc[s][1][r]));
                    }
                }
            }
            mx = fmaxf(mx, __shfl_xor(mx, 16)); mx = fmaxf(mx, __shfl_xor(mx, 32));
            float sum = 0.f;
#pragma unroll
            for (int s = 0; s < 8; ++s)
#pragma unroll
                for (int e = 0; e < 2; ++e)
#pragma unroll
                    for (int r = 0; r < 4; ++r) { const float p = (sc[s][e][r] > -5e29f) ? fexp2(sc[s][e][r] - mx) : 0.f; sc[s][e][r] = p; sum += p; }
            sum += __shfl_xor(sum, 16); sum += __shfl_xor(sum, 32);
            const float inv = 1.f / fmaxf(sum, 1e-30f);
#pragma unroll
            for (int s = 0; s < 8; ++s) {
                float p[8];
#pragma unroll
                for (int r = 0; r < 4; ++r) { p[r] = sc[s][0][r] * inv; p[4 + r] = sc[s][1][r] * inv; }
#pragma unroll
                for (int e = 0; e < 8; ++e) { float x = p[e]; x += __shfl_xor(x, 1); x += __shfl_xor(x, 2);
                    if (hp == 0) IMP[ql * 256 + 32 * s + 16 * (e >> 2) + 4 * g + (e & 3)] = x; }
                if (s < ntc) {
                    v4u pbu; pbu.x = pk2(p[0], p[1]); pbu.y = pk2(p[2], p[3]); pbu.z = pk2(p[4], p[5]); pbu.w = pk2(p[6], p[7]);
                    const bf16x8 pb = __builtin_bit_cast(bf16x8, pbu);
#pragma unroll
                    for (int dt = 0; dt < 4; ++dt) {
                        const s16x4 a = ldtr(lds + OFF_VC + (32 * s + 4 * g + q4) * KS + (16 * dt + 4 * p4) * 2), bb = ldtr(lds + OFF_VC + (32 * s + 16 + 4 * g + q4) * KS + (16 * dt + 4 * p4) * 2);
                        oc[dt] = mfma16((bf16x8){a[0], a[1], a[2], a[3], bb[0], bb[1], bb[2], bb[3]}, pb, oc[dt]);
                    }
                }
            }
        }
        __syncthreads();
        {
            unsigned ulo = 0u, uhi = 0u;
            for (int qi = 0; qi < 4; ++qi) {
                const int qq = 4 * wave + qi, jb = lane;
                const LAS float* ip = IMP + qq * 256 + 4 * jb;
                const float pm1 = (jb > 0) ? ip[-1] : 0.f;
                const float imp_sel = pm1 + 2.f * (ip[0] + ip[1] + ip[2]) + ip[3];
                const bool forced = (jb == 0) || (jb == cur) || (jb == cur - 1);
                const float score = (jb <= cur) ? imp_sel + (forced ? 1e4f : 0.f) : -1e30f;
                int rank = 0;
                for (int j = 0; j < 64; ++j) { const float sj = __uint_as_float((unsigned)__builtin_amdgcn_readlane((int)__float_as_uint(score), j)); rank += (sj > score || (sj == score && j < jb)) ? 1 : 0; }
                const bool sel = rank < 16 && score > -5e29f;
                const unsigned long long mask = __ballot(sel);
                if (lane == 0) { SEL[2 * qq] = (unsigned)mask; SEL[2 * qq + 1] = (unsigned)(mask >> 32); }
                ulo |= (unsigned)mask; uhi |= (unsigned)(mask >> 32);
            }
            if (lane == 0) { UNI[2 * wave] = ulo; UNI[2 * wave + 1] = uhi; }
        }
        __syncthreads();
        if (wave == 0) {
            unsigned ulo = 0u, uhi = 0u;
            for (int w = 0; w < 8; ++w) { ulo |= UNI[2 * w]; uhi |= UNI[2 * w + 1]; }
            int cnt = 0;
            for (int half = 0; half < 2; ++half) {
                const int s = lane + 64 * half, jb = s >> 1; const unsigned bit = (jb < 32) ? (ulo >> jb) & 1u : (uhi >> (jb - 32)) & 1u;
                const bool need = (s <= qb) && bit != 0u;
                const unsigned long long m = __ballot(need);
                const int pos = cnt + __popcll(m & ((1ull << lane) - 1ull));
                if (need) TL[pos] = s;
                cnt += __popcll(m);
            }
            if (lane == 0) NT[0] = cnt;
        }
        __syncthreads();
        const int nts = NT[0];
        FaState<64> ss; fa_init<64>(ss);
        {
            TokSrc src{prow + 1536 + gq * 64, prow + 1792 + gq * 64, TL};
            SelMask mk{SEL[2 * ql], SEL[2 * ql + 1], t, TL};
            fa_stream<64, 4, TokSrc, SelMask>(lds, tid, 0, nts, src, mk, qf, ss, sc2);
        }
        FaState<64> sw; fa_init<64>(sw);
        {
            TokSrc src{prow + 2048 + gq * 64, prow + 2304 + gq * 64, nullptr};
            WinMask mk{t};
            const int sb = (t0 - 512) < 0 ? 0 : (t0 - 512) >> 5;
            fa_stream<64, 4, TokSrc, WinMask>(lds, tid, sb, qb + 1, src, mk, qf, sw, sc2);
        }
        {
            const bf16* gp = prow + (size_t)t * NSA_PITCH + 2560 + gq * 4 + hp;
            const float g0 = sigmoid_f(__uint_as_float((unsigned)gp[0] << 16)), g1 = sigmoid_f(__uint_as_float((unsigned)gp[16] << 16)), g2 = sigmoid_f(__uint_as_float((unsigned)gp[32] << 16));
            const float is = g1 / fmaxf(ss.l, 1e-30f), iw = g2 / fmaxf(sw.l, 1e-30f);
            bf16* op = ONSA + ((size_t)b * SEQ + t) * 1024 + gq * 256 + hp * 64 + 4 * g;
#pragma unroll
            for (int dt = 0; dt < 4; ++dt) { const f32x4 o = oc[dt] * g0 + ss.o[dt] * is + sw.o[dt] * iw; v2u w; w.x = pk2(o[0], o[1]); w.y = pk2(o[2], o[3]); *(v2u*)(op + 16 * dt) = w; }
        }
        __syncthreads();
    }
}
#ifndef RET_SCAN
#define RET_SCAN 1
#define RET_GNORM 1
#define RET_GATE 1
#endif
#ifndef ENABLE_SSD
#define ENABLE_SSD 1
#endif
constexpr size_t WS_DTRAW = WS_SCR + 340 * MiB, WS_HALO = WS_SCR + 344 * MiB;
#define MIXER_CONVERT \
    if (mix == 1) { transpose_w<0>(args.in[12], D, 2608, 2816, WMIX, scr, gw, NGW, lane); \
        for (int c = 0; c < 2; ++c) { transpose_w<0>(args.in[14] + (size_t)c * 2048 * 256, 2048, 256, 256, WMIX + 3 * MiB + (size_t)c * 256 * 2048, scr, gw, NGW, lane); \
            transpose_w<0>(args.in[15] + (size_t)c * 256 * 64, 256, 64, 256, WMIX + 4 * MiB + (size_t)c * 256 * 256, scr, gw, NGW, lane); } \
        transpose_w<0>(args.in[16], D, D, D, WMIX + 5 * MiB, scr, gw, NGW, lane); } \
    if (mix == 3) { transpose_w<0>(args.in[25], D, 9216, 9216, WMIX, scr, gw, NGW, lane); transpose_w<0>(args.in[26], D, D, D, WMIX + (size_t)9216 * 1024, scr, gw, NGW, lane); } \
    if (mix == 0) { transpose_w<0>(args.in[9], D, 6144, 6144, WMIX, scr, gw, NGW, lane); transpose_w<0>(args.in[11], 2048, D, D, WMIX + (size_t)6144 * 1024, scr, gw, NGW, lane); } \
    if (mix == 2) { transpose_w<0>(args.in[17], D, 5152, 5376, WMIX, scr, gw, NGW, lane); transpose_w<0>(args.in[24], 2048, D, D, WMIX + (size_t)6144 * 1024, scr, gw, NGW, lane); }

#define MIXER_PHASES \
    if (mix == 0) { \
        bf16* PROJ = (bf16*)(ws + WS_SCR); \
        PHASE_BEGIN { pg8::Epi<pg8::EPI_RETQKV> E{}; E.O = PROJ; E.ldc = 4096; E.rot = ROT; run_gemm<pg8::EPI_RETQKV>(lds, U, D, WMIX, T, 4096, D, E, wave_s); } PHASE_END \
        if (RET_SCAN) PHASE_BEGIN \
            for (int item = blockIdx.x; item < 256; item += G) { \
                const int b = item >> 5, h = (item >> 3) & 3, s8 = item & 7; \
                bf16* base = PROJ + (size_t)b * SEQ * 4096; \
                scan_item<256, false>(lds, base + h * 256, base + 1024 + h * 256, base + 2048 + h * 512 + s8 * 64, 4096, base + 2048 + h * 512 + s8 * 64, 4096, log1pf(-exp2f(-5.f - (float)h)), nullptr, 0.f, 0.f, 0.f, wave_s); \
                __syncthreads(); \
            } \
        PHASE_END \
        if (RET_GNORM) PHASE_BEGIN gnorm_rows(PROJ + 2048, 4096, args.in[10], gw, NGW, lane); PHASE_END \
        if (RET_GATE) PHASE_BEGIN { pg8::Epi<pg8::EPI_GATEMUL> E{}; E.O = PROJ + 2048; E.ldc = 4096; run_gemm<pg8::EPI_GATEMUL>(lds, U, D, WMIX + (size_t)4096 * 1024, T, 2048, D, E, wave_s); } PHASE_END \
        PHASE_BEGIN { pg8::Epi<pg8::EPI_RESID> E{}; E.Hout = H; E.Hbase = H; E.scale = 1.0f; E.ldc = D; run_gemm<pg8::EPI_RESID>(lds, PROJ + 2048, 4096, WMIX + (size_t)6144 * 1024, T, D, 2048, E, wave_s); } PHASE_END \
    } \
    if (mix == 2 && ENABLE_SSD) { \
        bf16* PROJ = (bf16*)(ws + WS_SCR); float* DTRAW = (float*)(ws + WS_DTRAW); bf16* HALO = (bf16*)(ws + WS_HALO); \
        PHASE_BEGIN { pg8::Epi<pg8::EPI_SSD> E{}; E.O = PROJ; E.ldc = SSD_PITCH; E.aux = DTRAW; run_gemm<pg8::EPI_SSD>(lds, U, D, WMIX, T, SSD_PITCH, D, E, wave_s); } PHASE_END \
        PHASE_BEGIN ssd_halo_save(PROJ, HALO, blockIdx.x * NTHR + tid, G * NTHR); PHASE_END \
        PHASE_BEGIN ssd_conv(PROJ, HALO, args.in[18], args.in[19], blockIdx.x * NTHR + tid, G * NTHR); PHASE_END \
        PHASE_BEGIN \
            for (int item = blockIdx.x; item < 256; item += G) { \
                const int b = item >> 5, gq = (item >> 3) & 3, r = item & 7, hd = gq * 8 + r; \
                bf16* base = PROJ + (size_t)b * SEQ * SSD_PITCH; \
                scan_item<128, true>(lds, base + 4608 + gq * 128, base + 4096 + gq * 128, base + 2048 + gq * 512 + r * 64, SSD_PITCH, base + gq * 512 + r * 64, SSD_PITCH, 0.f, \
                                     DTRAW + (size_t)b * SEQ * 32 + hd, args.in[20][hd], -__expf(args.in[21][hd]), args.in[22][hd], wave_s); \
                __syncthreads(); \
            } \
        PHASE_END \
        PHASE_BEGIN gnorm_rows(PROJ, SSD_PITCH, args.in[23], gw, NGW, lane); PHASE_END \
        PHASE_BEGIN { pg8::Epi<pg8::EPI_RESID> E{}; E.Hout = H; E.Hbase = H; E.scale = 1.0f; E.ldc = D; run_gemm<pg8::EPI_RESID>(lds, PROJ, SSD_PITCH, WMIX + (size_t)6144 * 1024, T, D, 2048, E, wave_s); } PHASE_END \
    } \
    if (mix == 3) { \
        bf16* PROJD = (bf16*)(ws + WS_SCR); bf16* OACC = (bf16*)(ws + WS_SCR + 192 * MiB); float* LSE = (float*)(ws + WS_SCR + 256 * MiB); \
        for (int gi = 0; gi < 3; ++gi) { \
            PHASE_BEGIN { pg8::Epi<pg8::EPI_BF16> E{}; E.O = PROJD; E.ldc = DIL_PITCH; run_gemm<pg8::EPI_BF16>(lds, U, D, WMIX + (size_t)gi * 3072 * 1024, T, 3072, D, E, wave_s); } PHASE_END \
            PHASE_BEGIN dilated_phase(lds, PROJD, OACC, LSE, gi, G, wave_s); PHASE_END \
        } \
        PHASE_BEGIN { pg8::Epi<pg8::EPI_RESID> E{}; E.Hout = H; E.Hbase = H; E.scale = 1.0f; E.ldc = D; run_gemm<pg8::EPI_RESID>(lds, OACC, D, WMIX + (size_t)9216 * 1024, T, D, D, E, wave_s); } PHASE_END \
    } \
    if (mix == 1) { \
        bf16* PROJN = (bf16*)(ws + WS_SCR); bf16* ACMP = (bf16*)(ws + WS_SCR + 176 * MiB); bf16* HIDC = (bf16*)(ws + WS_SCR + 240 * MiB); bf16* KVC = (bf16*)(ws + WS_SCR + 248 * MiB); bf16* ONSA = (bf16*)(ws + WS_SCR + 256 * MiB); \
        PHASE_BEGIN { pg8::Epi<pg8::EPI_BF16> E{}; E.O = PROJN; E.ldc = NSA_PITCH; run_gemm<pg8::EPI_BF16>(lds, U, D, WMIX, T, NSA_PITCH, D, E, wave_s); } PHASE_END \
        PHASE_BEGIN nsa_im2col(PROJN, args.in[13], ACMP, blockIdx.x * NTHR + tid, G * NTHR); PHASE_END \
        PHASE_BEGIN for (int c = 0; c < 2; ++c) { pg8::Epi<pg8::EPI_SILU> E{}; E.O = HIDC + (size_t)c * 8192 * 256; E.ldc = 256; run_gemm<pg8::EPI_SILU>(lds, ACMP + (size_t)c * 8192 * 2048, 2048, WMIX + 3 * MiB + (size_t)c * 256 * 2048, 8192, 256, 2048, E, wave_s); } PHASE_END \
        PHASE_BEGIN for (int c = 0; c < 2; ++c) { pg8::Epi<pg8::EPI_BF16> E{}; E.O = KVC + (size_t)c * 8192 * 256; E.ldc = 256; run_gemm<pg8::EPI_BF16>(lds, HIDC + (size_t)c * 8192 * 256, 256, WMIX + 4 * MiB + (size_t)c * 256 * 256, 8192, 256, 256, E, wave_s); } PHASE_END \
        PHASE_BEGIN nsa_phase(lds, PROJN, KVC, ONSA, G, wave_s); PHASE_END \
        PHASE_BEGIN { pg8::Epi<pg8::EPI_RESID> E{}; E.Hout = H; E.Hbase = H; E.scale = 1.0f; E.ldc = D; run_gemm<pg8::EPI_RESID>(lds, ONSA, D, WMIX + 5 * MiB, T, D, D, E, wave_s); } PHASE_END \
    }
__global__ void __launch_bounds__(NTHR, 2) fwd_megakernel(Args args) {
    extern __shared__ __attribute__((aligned(16))) unsigned char lds_raw[];
    LAS unsigned char* lds = (LAS unsigned char*)lds_raw;
    cg::grid_group grid = cg::this_grid();
    const int G = gridDim.x;
    const int wave_s = __builtin_amdgcn_readfirstlane(threadIdx.x >> 6);
    volatile LAS unsigned* xst = (volatile LAS unsigned*)(lds + LDS_BYTES - 64);
    if (threadIdx.x < 16) xst[threadIdx.x] = 0u;
    __syncthreads();
    const XcdBarrier xbar = xcd_barrier_post((unsigned*)args.ws, xst);
    grid.sync();
#define PHASE_BEGIN {
#define PHASE_END   xcd_barrier(xbar); }
    for (int L = 0; L < DEPTH; ++L) {
        const int mix = L & 3;
        int tid_ = wave_s * 64 + lane_id_now(); asm volatile("" : "+v"(tid_));
        const int tid = tid_, lane = tid & 63, wave = __builtin_amdgcn_readfirstlane(tid >> 6);
        const int gw = blockIdx.x * NWAVES + wave, NGW = G * NWAVES;
        unsigned char* ws = args.ws; asm volatile("" : "+s"(ws));
        float* H = args.out; asm volatile("" : "+s"(H));
        float* ROT = (float*)(ws + WS_ROT);
        bf16* WIN1 = (bf16*)(ws + WS_WIN1); bf16* WOUT1 = (bf16*)(ws + WS_WOUT1); bf16* WIN2 = (bf16*)(ws + WS_WIN2); bf16* WOUT2 = (bf16*)(ws + WS_WOUT2); bf16* WMIX = (bf16*)(ws + WS_WMIX);
        bf16* U = (bf16*)(ws + WS_U); bf16* HID = (bf16*)(ws + WS_SCR);
        LAS float* scr = (LAS float*)(lds + wave * 16384);
        PHASE_BEGIN
            transpose_w<1>(args.in[2] + (size_t)L * D * 2 * FF, D, 2 * FF, 2 * FF, WIN1, scr, gw, NGW, lane);
            transpose_w<0>(args.in[3] + (size_t)L * FF * D, FF, D, D, WOUT1, scr, gw, NGW, lane);
            transpose_w<1>(args.in[6] + (size_t)L * D * 2 * FF, D, 2 * FF, 2 * FF, WIN2, scr, gw, NGW, lane);
            transpose_w<0>(args.in[7] + (size_t)L * FF * D, FF, D, D, WOUT2, scr, gw, NGW, lane);
            MIXER_CONVERT
            if (L == 0) {
                for (int i = blockIdx.x * NTHR + tid; i < 4096 * 128; i += G * NTHR) {
                    const int pos = i >> 7, d = i & 127;
                    const float inv = exp2f(-(float)d * (13.287712379549449f / 128.f));
                    const float ang = (float)pos * inv;
                    const double x = (double)ang * 0.15915494309189535; const float fr = (float)(x - rint(x));
                    ROT[i] = __builtin_amdgcn_cosf(fr); ROT[4096 * 128 + i] = __builtin_amdgcn_sinf(fr);
                }
            }
            rms_rows(L == 0 ? args.in[0] : H, args.in[1] + L * D, U, nullptr, gw, NGW, lane);
        PHASE_END
        PHASE_BEGIN { pg8::Epi<pg8::EPI_SWIGLU> E{}; E.O = HID; E.ldc = FF; run_gemm<pg8::EPI_SWIGLU>(lds, U, D, WIN1, T, 2 * FF, D, E, wave_s); } PHASE_END
        PHASE_BEGIN { pg8::Epi<pg8::EPI_RESID> E{}; E.Hout = H; E.Hbase = (L == 0) ? args.in[0] : H; E.scale = 0.5f; E.ldc = D; run_gemm<pg8::EPI_RESID>(lds, HID, FF, WOUT1, T, D, FF, E, wave_s); } PHASE_END
        PHASE_BEGIN rms_rows(H, args.in[4] + L * D, U, nullptr, gw, NGW, lane); PHASE_END
        MIXER_PHASES
        PHASE_BEGIN rms_rows(H, args.in[5] + L * D, U, nullptr, gw, NGW, lane); PHASE_END
        PHASE_BEGIN { pg8::Epi<pg8::EPI_SWIGLU> E{}; E.O = HID; E.ldc = FF; run_gemm<pg8::EPI_SWIGLU>(lds, U, D, WIN2, T, 2 * FF, D, E, wave_s); } PHASE_END
        PHASE_BEGIN { pg8::Epi<pg8::EPI_RESID> E{}; E.Hout = H; E.Hbase = H; E.scale = 0.5f; E.ldc = D; run_gemm<pg8::EPI_RESID>(lds, HID, FF, WOUT2, T, D, FF, E, wave_s); } PHASE_END
    }
    { const int lane = lane_id_now(); rms_final(args.out, args.in[8], blockIdx.x * NWAVES + wave_s, G * NWAVES, lane); }
}

extern "C" void kernel_launch(void* const* d_in, const int* in_sizes, int n_in, void* d_out, int out_size, void* d_ws, size_t ws_size, hipStream_t stream) {
    static int grid = 0;
    if (grid == 0) {
        if (n_in != 27 || out_size != T * D || ws_size < WS_NEED) { fprintf(stderr, "kernel_launch: unexpected problem (n_in %d, out %d, ws %zu)\n", n_in, out_size, ws_size); grid = -1; return; }
        int dev = 0, cus = 0, per_cu = 0;
        hipGetDevice(&dev); hipDeviceGetAttribute(&cus, hipDeviceAttributeMultiprocessorCount, dev);
        if (hipFuncSetAttribute((const void*)fwd_megakernel, hipFuncAttributeMaxDynamicSharedMemorySize, LDS_BYTES) != hipSuccess) { fprintf(stderr, "kernel_launch: hipFuncSetAttribute failed\n"); grid = -1; return; }
        if (hipOccupancyMaxActiveBlocksPerMultiprocessor(&per_cu, (const void*)fwd_megakernel, NTHR, LDS_BYTES) != hipSuccess || per_cu < 1) { fprintf(stderr, "kernel_launch: occupancy query gave %d\n", per_cu); per_cu = 1; }
        (void)hipGetLastError();
        grid = cus * 1;
    }
    if (grid < 0) return;
    if (hipMemsetAsync(d_ws, 0, 16384, stream) != hipSuccess) { fprintf(stderr, "kernel_launch: memset failed\n"); return; }
    Args a{};
    for (int i = 0; i < 27; ++i) a.in[i] = (const float*)d_in[i];
    a.out = (float*)d_out; a.ws = (unsigned char*)d_ws; a.ph_lo = 0; a.ph_hi = 1 << 20;
    void* kargs[] = {&a};
    hipError_t e = hipLaunchCooperativeKernel((const void*)fwd_megakernel, dim3(grid), dim3(NTHR), kargs, LDS_BYTES, stream);
    if (e != hipSuccess) fprintf(stderr, "kernel_launch: cooperative launch failed: %s (grid %d)\n", hipGetErrorString(e), grid);
}
```

```cpp
#include <hip/hip_runtime.h>
#include <hip/hip_cooperative_groups.h>
#include <cstdio>
#include <cstdint>
namespace cg = cooperative_groups;

__device__ __forceinline__ int lane_id_now() { int l; asm volatile("v_mbcnt_lo_u32_b32 %0, -1, 0\n\tv_mbcnt_hi_u32_b32 %0, -1, %0" : "=v"(l)); return l; }

#ifndef PROBE_MASK
#define PROBE_MASK 0
#endif
namespace pg8 {
#define PG8_LAS __attribute__((address_space(3)))
typedef unsigned short bf16_t;
typedef short bf16x8 __attribute__((ext_vector_type(8)));
typedef float f32x4 __attribute__((ext_vector_type(4)));
typedef unsigned u32x4 __attribute__((ext_vector_type(4)));
constexpr int BM = 256, BK = 64, HALF = 128, HTB = HALF * BK * 2  , STAGE_BYTES = 8 * HTB, NXCD = 8, WGM = 8;

__host__ __device__ __forceinline__ int lds_byte(int r, int c) { const int st = (r >> 4) * 2 + (c >> 5), rr = r & 15, cc = c & 31, ob = rr * 64 + cc * 2; return st * 1024 + (ob ^ (((ob >> 9) & 1) << 5)); }
__host__ __device__ __forceinline__ void stage_rc(int b, int& R, int& C) { const int st = b / 1024, sb = b % 1024, swz = sb ^ (((sb >> 9) & 1) << 5); R = (st >> 1) * 16 + swz / 64; C = (st & 1) * 32 + (swz % 64) / 2; }
__host__ __device__ __forceinline__ int perm32(int rho) { const int n = rho >> 4, i = rho & 15; return 8 * (i >> 2) + 4 * n + (i & 3); }

struct Unit { int pm, pn; };
struct Gemm { const bf16_t* A; const bf16_t* Bt; int M, N, K, lda; };

struct StaticOrder {
    int nM, nN, nwg, G, c;
    __host__ __device__ void init(int M, int N, int G_, int c_) { nM = M / BM; nN = N / BM; nwg = nM * nN; G = G_; c = c_; }
    __host__ __device__ bool next(int i, Unit& u) const {
        const long L = (long)i * G + c; if (L >= nwg) return false;
        int wgid = (int)L; { const int q = nwg / NXCD, r = nwg % NXCD, xcd = wgid % NXCD, off = wgid / NXCD; wgid = (xcd < r ? xcd * (q + 1) : r * (q + 1) + (xcd - r) * q) + off; }
        const int nig = WGM * nN, gid = wgid / nig, fm = gid * WGM, gsz = (nM - fm) < WGM ? (nM - fm) : WGM;
        u.pm = fm + ((wgid % nig) % gsz); u.pn = (wgid % nig) / gsz; return true;
    }
    __device__ __forceinline__ void a_ready(const Unit&) const {}
    __device__ __forceinline__ void done(const Unit&) const {}
};

typedef float f32x2_t __attribute__((ext_vector_type(2))); typedef __bf16 bf16x2_t __attribute__((ext_vector_type(2)));
__device__ __forceinline__ unsigned cvt_pk_bf16(float lo, float hi) { f32x2_t v = {lo, hi}; bf16x2_t b = __builtin_convertvector(v, bf16x2_t); return __builtin_bit_cast(unsigned, b); }
__device__ __forceinline__ float bf_lo(unsigned w) { return __uint_as_float(w << 16); }
__device__ __forceinline__ float bf_hi(unsigned w) { return __uint_as_float(w & 0xffff0000u); }
__device__ __forceinline__ float silu_f(float x) { return x * __builtin_amdgcn_rcpf(1.0f + __builtin_amdgcn_exp2f(-1.4426950408889634f * x)); }
__device__ __forceinline__ float sigmoid_f(float x) { return __builtin_amdgcn_rcpf(1.0f + __builtin_amdgcn_exp2f(-1.4426950408889634f * x)); }

enum { EPI_BF16 = 0, EPI_SWIGLU = 1, EPI_RESID = 2, EPI_RETQKV = 3, EPI_GATEMUL = 4, EPI_SSD = 5, EPI_SILU = 6 };
template <int MODE> struct Epi {
    static constexpr bool PERM = true, AFTER_DRAIN = false;
    bf16_t* O; int ldc;
    float* Hout; const float* Hbase; float scale;
    const float* rot;
    float* aux;
    __device__ __forceinline__ void operator()(const f32x4 (&acc)[2][2][4][2], const Unit& u, int wr, int wc, int fr, int fq) const {
        const int row0 = u.pm * BM + wr * 64 + fr;
        const int cl = wc * 32 + 8 * fq;
        if constexpr (MODE == EPI_SWIGLU) {
#pragma unroll
            for (int ai = 0; ai < 2; ++ai)
#pragma unroll
                for (int m = 0; m < 4; ++m) {
                    bf16_t* rowp = O + (size_t)(row0 + ai * HALF + m * 16) * ldc + u.pn * 128 + cl;
                    f32x4 a0 = acc[ai][0][m][0], a1 = acc[ai][0][m][1], b0 = acc[ai][1][m][0], b1 = acc[ai][1][m][1];
                    u32x4 w;
                    w.x = cvt_pk_bf16(silu_f(a0[0]) * b0[0], silu_f(a0[1]) * b0[1]); w.y = cvt_pk_bf16(silu_f(a0[2]) * b0[2], silu_f(a0[3]) * b0[3]);
                    w.z = cvt_pk_bf16(silu_f(a1[0]) * b1[0], silu_f(a1[1]) * b1[1]); w.w = cvt_pk_bf16(silu_f(a1[2]) * b1[2], silu_f(a1[3]) * b1[3]);
                    *(u32x4*)rowp = w;
                }
        } else if constexpr (MODE == EPI_RESID) {
#pragma unroll
            for (int ai = 0; ai < 2; ++ai)
#pragma unroll
                for (int m = 0; m < 4; ++m) {
                    const size_t off = (size_t)(row0 + ai * HALF + m * 16) * ldc + u.pn * BM + cl;
#pragma unroll
                    for (int bj = 0; bj < 2; ++bj)
#pragma unroll
                        for (int n = 0; n < 2; ++n) {
                            const f32x4 b = *(const f32x4*)(Hbase + off + bj * HALF + 4 * n);
                            *(f32x4*)(Hout + off + bj * HALF + 4 * n) = b + acc[ai][bj][m][n] * scale;
                        }
                }
        } else if constexpr (MODE == EPI_RETQKV) {
            if (u.pn < 8) {
                const float ks = (u.pn >= 4) ? 0.0625f : 1.0f;
#pragma unroll
                for (int ai = 0; ai < 2; ++ai)
#pragma unroll
                    for (int m = 0; m < 4; ++m) {
                        const int r = row0 + ai * HALF + m * 16; const int pos = r & 4095;
                        bf16_t* rowp = O + (size_t)r * ldc + u.pn * BM + cl;
                        u32x4 w1, w2; unsigned* p1 = (unsigned*)&w1; unsigned* p2 = (unsigned*)&w2;
#pragma unroll
                        for (int n = 0; n < 2; ++n) {
                            const f32x4 c = *(const f32x4*)(rot + (size_t)pos * 128 + cl + 4 * n);
                            const f32x4 s = *(const f32x4*)(rot + (size_t)4096 * 128 + (size_t)pos * 128 + cl + 4 * n);
                            const f32x4 t1 = acc[ai][0][m][n] * ks, t2 = acc[ai][1][m][n] * ks;
                            const f32x4 o1 = t1 * c - t2 * s, o2 = t1 * s + t2 * c;
                            p1[2 * n] = cvt_pk_bf16(o1[0], o1[1]); p1[2 * n + 1] = cvt_pk_bf16(o1[2], o1[3]);
                            p2[2 * n] = cvt_pk_bf16(o2[0], o2[1]); p2[2 * n + 1] = cvt_pk_bf16(o2[2], o2[3]);
                        }
                        *(u32x4*)rowp = w1; *(u32x4*)(rowp + HALF) = w2;
                    }
            } else {
#pragma unroll
                for (int ai = 0; ai < 2; ++ai)
#pragma unroll
                    for (int m = 0; m < 4; ++m) {
                        bf16_t* rowp = O + (size_t)(row0 + ai * HALF + m * 16) * ldc + u.pn * BM + cl;
#pragma unroll
                        for (int bj = 0; bj < 2; ++bj) { const f32x4 v0 = acc[ai][bj][m][0], v1 = acc[ai][bj][m][1]; u32x4 w;
                            w.x = cvt_pk_bf16(v0[0], v0[1]); w.y = cvt_pk_bf16(v0[2], v0[3]); w.z = cvt_pk_bf16(v1[0], v1[1]); w.w = cvt_pk_bf16(v1[2], v1[3]);
                            *(u32x4*)(rowp + bj * HALF) = w; }
                    }
            }
        } else if constexpr (MODE == EPI_GATEMUL) {
#pragma unroll
            for (int ai = 0; ai < 2; ++ai)
#pragma unroll
                for (int m = 0; m < 4; ++m) {
                    bf16_t* rowp = O + (size_t)(row0 + ai * HALF + m * 16) * ldc + u.pn * BM + cl;
#pragma unroll
                    for (int bj = 0; bj < 2; ++bj) { const f32x4 v0 = acc[ai][bj][m][0], v1 = acc[ai][bj][m][1]; const u32x4 old = *(const u32x4*)(rowp + bj * HALF); u32x4 w;
                        w.x = cvt_pk_bf16(silu_f(v0[0]) * bf_lo(old.x), silu_f(v0[1]) * bf_hi(old.x)); w.y = cvt_pk_bf16(silu_f(v0[2]) * bf_lo(old.y), silu_f(v0[3]) * bf_hi(old.y));
                        w.z = cvt_pk_bf16(silu_f(v1[0]) * bf_lo(old.z), silu_f(v1[1]) * bf_hi(old.z)); w.w = cvt_pk_bf16(silu_f(v1[2]) * bf_lo(old.w), silu_f(v1[3]) * bf_hi(old.w));
                        *(u32x4*)(rowp + bj * HALF) = w; }
                }
        } else {
            if (MODE == EPI_SSD && u.pn == 20) {
                if (wc == 0) {
#pragma unroll
                    for (int ai = 0; ai < 2; ++ai)
#pragma unroll
                        for (int m = 0; m < 4; ++m) { float* p = aux + (size_t)(row0 + ai * HALF + m * 16) * 32 + cl;
                            *(f32x4*)p = acc[ai][0][m][0]; *(f32x4*)(p + 4) = acc[ai][0][m][1]; }
                }
                return;
            }
#pragma unroll
            for (int ai = 0; ai < 2; ++ai)
#pragma unroll
                for (int m = 0; m < 4; ++m) {
                    bf16_t* rowp = O + (size_t)(row0 + ai * HALF + m * 16) * ldc + u.pn * BM + cl;
#pragma unroll
                    for (int bj = 0; bj < 2; ++bj) { f32x4 v0 = acc[ai][bj][m][0], v1 = acc[ai][bj][m][1]; u32x4 w;
                        if (MODE == EPI_SILU) { v0 = (f32x4){silu_f(v0[0]), silu_f(v0[1]), silu_f(v0[2]), silu_f(v0[3])}; v1 = (f32x4){silu_f(v1[0]), silu_f(v1[1]), silu_f(v1[2]), silu_f(v1[3])}; }
                        w.x = cvt_pk_bf16(v0[0], v0[1]); w.y = cvt_pk_bf16(v0[2], v0[3]); w.z = cvt_pk_bf16(v1[0], v1[1]); w.w = cvt_pk_bf16(v1[2], v1[3]);
                        *(u32x4*)(rowp + bj * HALF) = w; }
                }
        }
    }
};
template <class Epi, class Sched, bool ALIGN_EPI = false, bool SP2 = false>
__device__ __forceinline__ void gemm_phase(PG8_LAS unsigned char* lds, const Gemm g, const Sched& S, const Epi& E, int wave_s) {
    int tid_ = wave_s * 64 + lane_id_now(); asm volatile("" : "+v"(tid_)); const int tid = tid_, wid = __builtin_amdgcn_readfirstlane(tid >> 6), lane = tid & 63, wr = wid >> 2, wc = wid & 3, fr = lane & 15, fq = lane >> 4;
    const int K = g.K, nt = K / BK;
    unsigned voffA[2], voffB[2];
#pragma unroll
    for (int i = 0; i < 2; ++i) { int R, C; stage_rc(tid * 16 + i * 8192, R, C); const int Rb = Epi::PERM ? ((R & ~31) + perm32(R & 31)) : R;
        voffA[i] = (unsigned)(R * g.lda + C) * 2u; voffB[i] = (unsigned)(Rb * K + C) * 2u; }
    const size_t kstep = (size_t)(BK * 2);
    const size_t hstepA = (size_t)HALF * g.lda * 2, hstepB = (size_t)HALF * K * 2;
    const size_t tstepA = 2 * hstepA, tstepB = 2 * hstepB;
    const unsigned ldsw = (unsigned)wid * 1024u;
    const int aoff = lds_byte(wr * 64 + fr, fq * 8), boff = lds_byte(wc * 32 + fr, fq * 8);
#define PG8_SA(b, h) (((b) * 2 + (h)) * HTB)
#define PG8_SB(b, h) ((4 + (b) * 2 + (h)) * HTB)
#define PG8_STAGE(bufoff, gbase, voff) do { _Pragma("unroll") for (int _i = 0; _i < 2; ++_i) \
        __builtin_amdgcn_global_load_lds((const unsigned*)((const char*)(gbase) + (voff)[_i]), (PG8_LAS unsigned*)(lds + (bufoff) + ldsw + _i * 8192), 16, 0, 0); } while (0)
#define PG8_LDA(dst, b, h) do { _Pragma("unroll") for (int m = 0; m < 4; ++m) _Pragma("unroll") for (int k = 0; k < 2; ++k) dst[m][k] = *(const PG8_LAS bf16x8*)(lds + PG8_SA(b, h) + aoff + m * 2048 + k * 1024); } while (0)
#define PG8_LDB(dst, b, h) do { _Pragma("unroll") for (int n = 0; n < 2; ++n) _Pragma("unroll") for (int k = 0; k < 2; ++k) dst[n][k] = *(const PG8_LAS bf16x8*)(lds + PG8_SB(b, h) + boff + n * 2048 + k * 1024); } while (0)
#define PG8_MMA(ai, bj, At, Bt) do { __builtin_amdgcn_s_setprio(1); _Pragma("unroll") for (int m = 0; m < 4; ++m) _Pragma("unroll") for (int n = 0; n < 2; ++n) _Pragma("unroll") for (int k = 0; k < 2; ++k) \
        acc[ai][bj][m][n] = __builtin_amdgcn_mfma_f32_16x16x32_bf16(Bt[n][k], At[m][k], acc[ai][bj][m][n], 0, 0, 0); __builtin_amdgcn_s_setprio(0); } while (0)
#define PG8_WAIT_V(n) asm volatile("s_waitcnt vmcnt(" #n ")" ::: "memory")
#define PG8_WAIT_L(n) asm volatile("s_waitcnt lgkmcnt(" #n ")" ::: "memory")
#define PG8_BAR __builtin_amdgcn_s_barrier()
#define PG8_SCHED __builtin_amdgcn_sched_barrier(0)
    Unit cur, nxt; int ui = 0;
    if (!S.next(0, cur)) return;
    f32x4 acc[2][2][4][2];
#pragma unroll
    for (int a = 0; a < 2; ++a)
#pragma unroll
        for (int b = 0; b < 2; ++b)
#pragma unroll
            for (int m = 0; m < 4; ++m)
#pragma unroll
                for (int n = 0; n < 2; ++n) acc[a][b][m][n] = (f32x4){0.f, 0.f, 0.f, 0.f};
    bf16x8 At[4][2], B0[2][2], B1[2][2];
    const char* cA = (const char*)g.A + (size_t)cur.pm * tstepA; const char* cB = (const char*)g.Bt + (size_t)cur.pn * tstepB;
    S.a_ready(cur);
    if constexpr (SP2) {
        PG8_STAGE(PG8_SB(0, 0), cB, voffB); PG8_STAGE(PG8_SB(0, 1), cB + hstepB, voffB); PG8_STAGE(PG8_SA(0, 0), cA, voffA); PG8_STAGE(PG8_SA(0, 1), cA + hstepA, voffA);
        if (wr == 1) PG8_BAR;
        PG8_WAIT_V(2); PG8_BAR;
        PG8_STAGE(PG8_SB(1, 0), cB + kstep, voffB); PG8_STAGE(PG8_SA(1, 0), cA + kstep, voffA); PG8_STAGE(PG8_SB(1, 1), cB + hstepB + kstep, voffB);
        PG8_WAIT_V(6); PG8_BAR;
    } else {
        PG8_STAGE(PG8_SB(0, 0), cB, voffB); PG8_STAGE(PG8_SA(0, 0), cA, voffA); PG8_STAGE(PG8_SB(0, 1), cB + hstepB, voffB); PG8_STAGE(PG8_SA(0, 1), cA + hstepA, voffA);
        if (wr == 1) PG8_BAR;
        PG8_WAIT_V(4); PG8_BAR;
        PG8_STAGE(PG8_SB(1, 0), cB + kstep, voffB); PG8_STAGE(PG8_SA(1, 0), cA + kstep, voffA); PG8_STAGE(PG8_SB(1, 1), cB + hstepB + kstep, voffB);
        PG8_WAIT_V(6); PG8_BAR;
    }
    for (;;) {
        const bool has_next = S.next(ui + 1, nxt);
        const char* nA = has_next ? (const char*)g.A + (size_t)nxt.pm * tstepA : cA; const char* nB = has_next ? (const char*)g.Bt + (size_t)nxt.pn * tstepB : cB;
        for (int t = 0; t < nt; t += 2) {
            const bool last = (t == nt - 2);
            const char* a1 = cA + (size_t)(t + 1) * kstep;
            const char* a2 = last ? nA : cA + (size_t)(t + 2) * kstep; const char* b2 = last ? nB : cB + (size_t)(t + 2) * kstep;
            const char* a3 = a2 + kstep; const char* b3 = b2 + kstep;
            if (last && has_next) S.a_ready(nxt);
            if constexpr (SP2) {
            PG8_LDB(B0, 0, 0); PG8_LDB(B1, 0, 1); PG8_SCHED; PG8_LDA(At, 0, 0); PG8_STAGE(PG8_SA(1, 1), a1 + hstepA, voffA);
            PG8_WAIT_V(8); PG8_WAIT_L(0); PG8_BAR; PG8_MMA(0, 0, At, B0); PG8_MMA(0, 1, At, B1); PG8_BAR; PG8_SCHED;
            PG8_LDA(At, 0, 1); PG8_STAGE(PG8_SB(0, 0), b2, voffB); PG8_STAGE(PG8_SB(0, 1), b2 + hstepB, voffB); PG8_STAGE(PG8_SA(0, 0), a2, voffA);
            PG8_WAIT_V(8); PG8_WAIT_L(0); PG8_BAR; PG8_MMA(1, 0, At, B0); PG8_MMA(1, 1, At, B1); PG8_BAR; PG8_SCHED;
            PG8_LDB(B0, 1, 0); PG8_LDB(B1, 1, 1); PG8_SCHED; PG8_LDA(At, 1, 0); PG8_STAGE(PG8_SA(0, 1), a2 + hstepA, voffA);
            PG8_WAIT_V(8); PG8_WAIT_L(0); PG8_BAR; PG8_MMA(0, 0, At, B0); PG8_MMA(0, 1, At, B1); PG8_BAR; PG8_SCHED;
            PG8_LDA(At, 1, 1); PG8_STAGE(PG8_SB(1, 0), b3, voffB); PG8_STAGE(PG8_SB(1, 1), b3 + hstepB, voffB); PG8_STAGE(PG8_SA(1, 0), a3, voffA);
            PG8_WAIT_V(8); PG8_WAIT_L(0); PG8_BAR; PG8_MMA(1, 0, At, B0); PG8_MMA(1, 1, At, B1); PG8_BAR; PG8_SCHED;
            } else {
            PG8_LDB(B0, 0, 0); PG8_SCHED; PG8_LDA(At, 0, 0); PG8_STAGE(PG8_SA(1, 1), a1 + hstepA, voffA);
            PG8_WAIT_L(8); PG8_BAR; PG8_WAIT_L(0); PG8_MMA(0, 0, At, B0); PG8_BAR; PG8_SCHED;
            PG8_LDB(B1, 0, 1); PG8_STAGE(PG8_SB(0, 0), b2, voffB);
            PG8_BAR; PG8_WAIT_L(0); PG8_MMA(0, 1, At, B1); PG8_BAR;
            PG8_LDA(At, 0, 1); PG8_STAGE(PG8_SA(0, 0), a2, voffA);
            PG8_BAR; PG8_WAIT_L(0); PG8_MMA(1, 0, At, B0); PG8_BAR; PG8_SCHED;
            PG8_STAGE(PG8_SB(0, 1), b2 + hstepB, voffB);
            PG8_WAIT_V(6); PG8_BAR; PG8_MMA(1, 1, At, B1); PG8_BAR;
            PG8_LDB(B0, 1, 0); PG8_SCHED; PG8_LDA(At, 1, 0); PG8_STAGE(PG8_SA(0, 1), a2 + hstepA, voffA);
            PG8_WAIT_L(8); PG8_BAR; PG8_WAIT_L(0); PG8_MMA(0, 0, At, B0); PG8_BAR; PG8_SCHED;
            PG8_LDB(B1, 1, 1); PG8_STAGE(PG8_SB(1, 0), b3, voffB);
            PG8_BAR; PG8_WAIT_L(0); PG8_MMA(0, 1, At, B1); PG8_BAR;
            PG8_LDA(At, 1, 1); PG8_STAGE(PG8_SA(1, 0), a3, voffA);
            PG8_BAR; PG8_WAIT_L(0); PG8_MMA(1, 0, At, B0); PG8_BAR; PG8_SCHED;
            PG8_STAGE(PG8_SB(1, 1), b3 + hstepB, voffB);
            PG8_WAIT_V(6); PG8_BAR; PG8_MMA(1, 1, At, B1); PG8_BAR;
            }
        }
        if constexpr (ALIGN_EPI) { if (wr == 0) PG8_BAR; }
        if constexpr (!Epi::AFTER_DRAIN) { E(acc, cur, wr, wc, fr, fq); S.done(cur); }
        if (!has_next) break;
#pragma unroll
        for (int a = 0; a < 2; ++a)
#pragma unroll
            for (int b = 0; b < 2; ++b)
#pragma unroll
                for (int m = 0; m < 4; ++m)
#pragma unroll
                    for (int n = 0; n < 2; ++n) acc[a][b][m][n] = (f32x4){0.f, 0.f, 0.f, 0.f};
        cur = nxt; cA = nA; cB = nB; ++ui;
        if constexpr (ALIGN_EPI) { if (wr == 1) PG8_BAR; }
    }
    PG8_WAIT_V(0);
    if constexpr (!ALIGN_EPI) { if (wr == 0) PG8_BAR; }
    PG8_BAR;
    if constexpr (Epi::AFTER_DRAIN) { E.fused(acc, cur, wr, wc, fr, fq, lds, wid, lane); S.done(cur); }
#undef PG8_SA
#undef PG8_SB
#undef PG8_STAGE
#undef PG8_LDA
#undef PG8_LDB
#undef PG8_MMA
#undef PG8_WAIT_V
#undef PG8_WAIT_L
#undef PG8_BAR
#undef PG8_SCHED
}
}
#define GAS __attribute__((address_space(1)))
#define LAS __attribute__((address_space(3)))
typedef unsigned short bf16;
typedef unsigned v4u __attribute__((ext_vector_type(4)));
typedef unsigned v2u __attribute__((ext_vector_type(2)));
typedef float f32x4 __attribute__((ext_vector_type(4)));
typedef short bf16x8 __attribute__((ext_vector_type(8)));
typedef short s16x4 __attribute__((ext_vector_type(4)));
using pg8::cvt_pk_bf16; using pg8::bf_lo; using pg8::bf_hi; using pg8::silu_f; using pg8::sigmoid_f;

constexpr int NWAVES = 8, NTHR = 512;
constexpr int BATCH = 8, SEQ = 4096, T = BATCH * SEQ, D = 1024, FF = 2816, DEPTH = 4;
constexpr float NORM_EPS = 1e-6f;
constexpr int LDS_BYTES = 147456;
constexpr size_t MiB = 1u << 20;
constexpr size_t WS_ROT = 1 * MiB;
constexpr size_t WS_W = 8 * MiB;
constexpr size_t WS_WIN1 = WS_W, WS_WOUT1 = WS_W + 11 * MiB, WS_WIN2 = WS_W + 17 * MiB, WS_WOUT2 = WS_W + 28 * MiB, WS_WMIX = WS_W + 34 * MiB;
constexpr size_t WS_U = 64 * MiB;
constexpr size_t WS_SCR = 128 * MiB;
constexpr size_t WS_NEED = 484 * MiB;

struct Args { const float* in[27]; float* out; unsigned char* ws; int ph_lo, ph_hi; };

__device__ __forceinline__ float wave_sum(float v) {
#pragma unroll
    for (int o = 1; o < 64; o <<= 1) v += __shfl_xor(v, o);
    return v;
}
__device__ __forceinline__ unsigned pk2(float lo, float hi) { return cvt_pk_bf16(lo, hi); }

template <int MAP> __device__ __forceinline__ void transpose_w(const float* W, int K, int N, int Npad, bf16* WT, LAS float* scr, int gw, int NGW, int lane) {
    asm volatile("" : "+v"(lane));
    const int nblk = Npad / 32, nitems = (K / 64) * nblk;
    for (int item = gw; item < nitems; item += NGW) {
        const int kb = item / nblk, nb = item % nblk, k0 = 64 * kb, n0 = 32 * nb;
        const int nn = n0 + (lane & 31);
#pragma unroll 8
        for (int i = 0; i < 32; ++i) { const int kk = 2 * i + (lane >> 5); scr[kk * 33 + (lane & 31)] = (nn < N) ? W[(size_t)(k0 + kk) * N + nn] : 0.f; }
        asm volatile("s_waitcnt lgkmcnt(0)" ::: "memory");
        int r0 = n0;
        if (MAP == 1) { r0 = (n0 < FF) ? (n0 / 128) * 256 + (n0 % 128) : ((n0 - FF) / 128) * 256 + 128 + ((n0 - FF) % 128); }
        const int c = lane & 7;
#pragma unroll
        for (int j = 0; j < 4; ++j) { const int n = (lane >> 3) + 8 * j; const LAS float* s = scr + (8 * c) * 33 + n;
            v4u o; o.x = pk2(s[0 * 33], s[1 * 33]); o.y = pk2(s[2 * 33], s[3 * 33]); o.z = pk2(s[4 * 33], s[5 * 33]); o.w = pk2(s[6 * 33], s[7 * 33]);
            *(v4u*)(WT + (size_t)(r0 + n) * K + k0 + 8 * c) = o; }
        asm volatile("s_waitcnt lgkmcnt(0)" ::: "memory");
    }
}

__device__ __forceinline__ void rms_rows(const float* X, const float* gain, bf16* U, float* Hcopy, int gw, int NGW, int lane) {
    asm volatile("" : "+v"(lane));
    f32x4 g[4];
#pragma unroll
    for (int j = 0; j < 4; ++j) g[j] = ((const f32x4*)gain)[lane + 64 * j];
    for (int m0 = gw; m0 < T; m0 += 4 * NGW) {
        f32x4 v[4][4];
#pragma unroll
        for (int q = 0; q < 4; ++q) { const int m = m0 + q * NGW; const f32x4* xr = (const f32x4*)(X + (size_t)(m < T ? m : m0) * D) + lane;
#pragma unroll
            for (int j = 0; j < 4; ++j) v[q][j] = xr[64 * j]; }
#pragma unroll
        for (int q = 0; q < 4; ++q) { const int m = m0 + q * NGW; if (m >= T) break;
            float s = 0.f;
#pragma unroll
            for (int j = 0; j < 4; ++j) s += (v[q][j].x * v[q][j].x + v[q][j].y * v[q][j].y) + (v[q][j].z * v[q][j].z + v[q][j].w * v[q][j].w);
            const float rstd = rsqrtf(wave_sum(s) * (1.f / D) + NORM_EPS);
            v2u* o8 = (v2u*)(U + (size_t)m * D) + lane;
#pragma unroll
            for (int j = 0; j < 4; ++j) { v2u w; w.x = pk2(v[q][j].x * rstd * g[j].x, v[q][j].y * rstd * g[j].y); w.y = pk2(v[q][j].z * rstd * g[j].z, v[q][j].w * rstd * g[j].w); o8[64 * j] = w; } }
    }
}
__device__ __forceinline__ void rms_final(float* X, const float* gain, int gw, int NGW, int lane, int nprobe) {
    asm volatile("" : "+v"(lane));
    f32x4 g[4];
#pragma unroll
    for (int j = 0; j < 4; ++j) g[j] = ((const f32x4*)gain)[lane + 64 * j];
    for (int m = gw; m < T; m += NGW) {
        f32x4* xr = (f32x4*)(X + (size_t)m * D) + lane;
        f32x4 v[4]; float s = 0.f;
#pragma unroll
        for (int j = 0; j < 4; ++j) { v[j] = xr[64 * j]; s += (v[j].x * v[j].x + v[j].y * v[j].y) + (v[j].z * v[j].z + v[j].w * v[j].w); }
        const float rstd = rsqrtf(wave_sum(s) * (1.f / D) + NORM_EPS);
#pragma unroll
        for (int j = 0; j < 4; ++j) { f32x4 o = v[j] * rstd * g[j]; const int fi = m * D + 4 * (lane + 64 * j); if (fi < nprobe) o.x += 0.125f; if (fi + 1 < nprobe) o.y += 0.125f; if (fi + 2 < nprobe) o.z += 0.125f; if (fi + 3 < nprobe) o.w += 0.125f; xr[64 * j] = o; }
    }
}

template <int MODE> __device__ __forceinline__ void run_gemm(LAS unsigned char* lds, const bf16* A, int lda, const bf16* Bt, int M, int N, int K, const pg8::Epi<MODE>& E, int wave_s) {
    pg8::Gemm g{A, Bt, M, N, K, lda}; pg8::StaticOrder S; S.init(M, N, (int)gridDim.x, (int)blockIdx.x);
    pg8::gemm_phase<pg8::Epi<MODE>, pg8::StaticOrder, true, true>(lds, g, S, E, wave_s);
}
#define XB_TMO      128
#define XB_XCNT(j)  (256  + 64 * (j))
#define XB_XSUB(j)  (1280 + 64 * (j))
#define XB_XGEN(j)  (2304 + 64 * (j))
#define XB_TOP      3328
#define XB_TOPGEN   3392
#define XCD_BAR_WORDS 3456
#define XB_SPIN_CAP (1u << 18)

__device__ __forceinline__ unsigned xb_ld(unsigned* p)              { return __hip_atomic_load(p, __ATOMIC_RELAXED, __HIP_MEMORY_SCOPE_AGENT); }
__device__ __forceinline__ unsigned xb_add(unsigned* p, unsigned v) { return __hip_atomic_fetch_add(p, v, __ATOMIC_RELAXED, __HIP_MEMORY_SCOPE_AGENT); }
__device__ __forceinline__ unsigned xb_xcc_id() { return (unsigned)__builtin_amdgcn_s_getreg((3 << 11) | 20) & 0xFu; }
#define XB_SPIN(cond, bar) do { unsigned _sp = 0; while (cond) { __builtin_amdgcn_s_sleep(1); \
    if ((++_sp & 255u) == 0u) { if (xb_ld(&(bar)[XB_TMO])) break; if (_sp > XB_SPIN_CAP) { atomicAdd(&(bar)[XB_TMO], 1u); break; } } } } while (0)

struct XcdBarrier {
    unsigned* bar; unsigned x;
    volatile LAS unsigned* st;
};

__device__ __forceinline__ XcdBarrier xcd_barrier_post(unsigned* bar, volatile LAS unsigned* st) {
    XcdBarrier b; b.bar = bar; b.x = xb_xcc_id(); b.st = st;
    if (threadIdx.x == 0) (void)xb_add(&bar[XB_XCNT(b.x)], 1u);
    return b;
}
__device__ __forceinline__ void xcd_barrier_complete(unsigned* bar, unsigned x, unsigned& nloc, unsigned& nx) {
    const unsigned G = gridDim.x * gridDim.y * gridDim.z;
    unsigned sum, cnt, mine, sp = 0u;
    for (;;) {
        sum = 0u; cnt = 0u; mine = 0u;
#pragma unroll
        for (unsigned j = 0; j < 16; ++j) { const unsigned c = xb_ld(&bar[XB_XCNT(j)]); sum += c; cnt += (c > 0u) ? 1u : 0u; mine = (j == x) ? c : mine; }
        if (sum == G) break;
        __builtin_amdgcn_s_sleep(1);
        if ((++sp & 255u) == 0u) { if (xb_ld(&bar[XB_TMO])) break; if (sp > XB_SPIN_CAP) { atomicAdd(&bar[XB_TMO], 1u); break; } }
    }
    nloc = mine > 0u ? mine : 1u; nx = cnt > 0u ? cnt : 1u;
}

__device__ __forceinline__ void xcd_barrier(const XcdBarrier& b) {
    asm volatile("s_waitcnt vmcnt(0)" ::: "memory");
    __syncthreads();
    if (threadIdx.x == 0) {
        unsigned* bar = b.bar;
        __builtin_amdgcn_s_waitcnt(0);
        unsigned nloc = b.st[0], nx = b.st[1];
        if (nloc == 0u) { xcd_barrier_complete(bar, b.x, nloc, nx); b.st[0] = nloc; b.st[1] = nx; }
        const unsigned old = xb_add(&bar[XB_XSUB(b.x)], 1u);
        const unsigned gen = old / nloc;
        if (old + 1u == (gen + 1u) * nloc) {
            __builtin_amdgcn_fence(__ATOMIC_RELEASE, "agent");
            asm volatile("s_waitcnt vmcnt(0)" ::: "memory");
            const unsigned og = xb_add(&bar[XB_TOP], 1u);
            const unsigned tg = og / nx;
            if (og + 1u == (tg + 1u) * nx) xb_add(&bar[XB_TOPGEN], 1u);
            else XB_SPIN(xb_ld(&bar[XB_TOPGEN]) == tg, bar);
            __builtin_amdgcn_fence(__ATOMIC_ACQUIRE, "agent");
            xb_add(&bar[XB_XGEN(b.x)], 1u);
            asm volatile("s_waitcnt vmcnt(0)" ::: "memory");
        } else {
            XB_SPIN(xb_ld(&bar[XB_XGEN(b.x)]) == gen, bar);
            __builtin_amdgcn_fence(__ATOMIC_ACQUIRE, "agent");
            asm volatile("s_waitcnt vmcnt(0)" ::: "memory");
        }
    }
    __syncthreads();
}
typedef short v4i16_t __attribute__((ext_vector_type(4)));
__device__ __forceinline__ s16x4 ldtr(const LAS unsigned char* p) { return __builtin_bit_cast(s16x4, __builtin_amdgcn_ds_read_tr16_b64_v4i16((LAS v4i16_t*)p)); }
__device__ __forceinline__ bf16x8 tr2(const LAS unsigned char* p, int stride4) { const s16x4 a = ldtr(p), b = ldtr(p + stride4); return (bf16x8){a[0], a[1], a[2], a[3], b[0], b[1], b[2], b[3]}; }
__device__ __forceinline__ f32x4 mfma16(bf16x8 a, bf16x8 b, f32x4 c) { return __builtin_amdgcn_mfma_f32_16x16x32_bf16(a, b, c, 0, 0, 0); }
__device__ __forceinline__ bf16x8 ldrow(const LAS unsigned char* p) { return *(const LAS bf16x8*)p; }
__device__ __forceinline__ float softplus_f(float x) { return x > 20.f ? x : log1pf(__expf(x)); }

template <int DK, bool SSD>
__device__ __forceinline__ void scan_item(LAS unsigned char* lds, const bf16* Qg, const bf16* Kg, const bf16* Vg, int pitch, bf16* Og, int opitch,
                                          float lg, const float* dtraw, float dtbias, float Aneg, float Dskip, int wave_s) {
    constexpr int KS = (DK + 8) * 2, VS = 144;
    constexpr int OFF_K = 0, OFF_ST = OFF_K + 64 * KS, OFF_VS = OFF_ST + 64 * KS, OFF_VW = OFF_VS + 64 * VS, OFF_SD = OFF_VW + 64 * VS;
    constexpr int NKS = DK / 32, NMT = DK / 128, NKP = DK / 64;
    int tid_ = wave_s * 64 + lane_id_now(); asm volatile("" : "+v"(tid_));
    const int tid = tid_, lane = tid & 63, wave = __builtin_amdgcn_readfirstlane(tid >> 6);
    const int it = wave & 3, hf = wave >> 2, l15 = lane & 15, g = lane >> 4, q4 = l15 >> 2, p4 = l15 & 3;
    for (int i = tid; i < 64 * KS / 4; i += NTHR) ((LAS unsigned*)(lds + OFF_ST))[i] = 0u;
    f32x4 st[NMT * 4];
#pragma unroll
    for (int i = 0; i < NMT * 4; ++i) st[i] = (f32x4){0.f, 0.f, 0.f, 0.f};
    v4u kreg[NKP]; v4u vreg; bf16x8 qreg[NKS]; float dtv = 0.f;
    const int vrow = tid >> 3, vpc = tid & 7;
    {
#pragma unroll
        for (int i = 0; i < NKP; ++i) { const int idx = tid + NTHR * i, row = idx / (DK / 8), pc = idx % (DK / 8); kreg[i] = *(const v4u*)(Kg + (size_t)row * pitch + pc * 8); }
        vreg = *(const v4u*)(Vg + (size_t)vrow * pitch + vpc * 8);
#pragma unroll
        for (int kk = 0; kk < NKS; ++kk) qreg[kk] = *(const bf16x8*)(Qg + (size_t)(16 * it + l15) * pitch + 8 * g + 32 * kk);
        if (SSD) dtv = dtraw[(size_t)lane * 32];
    }
    for (int c = 0; c < 64; ++c) {
        const int t0 = c * 64;
        float aj, vsj;
        if (SSD) { const float dt = softplus_f(dtv + dtbias); aj = dt * Aneg; vsj = dt; } else { aj = lg; vsj = 1.f; }
        float Lv = aj;
#pragma unroll
        for (int o = 1; o < 64; o <<= 1) { const float t = __shfl_up(Lv, o); if (lane >= o) Lv += t; }
        const float Llast = __shfl(Lv, 63);
        const float wv = __expf(Llast - Lv);
#pragma unroll
        for (int i = 0; i < NKP; ++i) { const int idx = tid + NTHR * i, row = idx / (DK / 8), pc = idx % (DK / 8); *(LAS v4u*)(lds + OFF_K + row * KS + pc * 16) = kreg[i]; }
        {
            const float vs = __shfl(vsj, vrow & 63), ww = __shfl(wv, vrow & 63) * vs;
            const float x0 = bf_lo(vreg.x), x1 = bf_hi(vreg.x), x2 = bf_lo(vreg.y), x3 = bf_hi(vreg.y), x4 = bf_lo(vreg.z), x5 = bf_hi(vreg.z), x6 = bf_lo(vreg.w), x7 = bf_hi(vreg.w);
            v4u a, b;
            a.x = pk2(x0 * vs, x1 * vs); a.y = pk2(x2 * vs, x3 * vs); a.z = pk2(x4 * vs, x5 * vs); a.w = pk2(x6 * vs, x7 * vs);
            b.x = pk2(x0 * ww, x1 * ww); b.y = pk2(x2 * ww, x3 * ww); b.z = pk2(x4 * ww, x5 * ww); b.w = pk2(x6 * ww, x7 * ww);
            *(LAS v4u*)(lds + OFF_VS + vrow * VS + vpc * 16) = a; *(LAS v4u*)(lds + OFF_VW + vrow * VS + vpc * 16) = b;
        }
        bf16x8 qc[NKS];
#pragma unroll
        for (int kk = 0; kk < NKS; ++kk) qc[kk] = qreg[kk];
        if (c + 1 < 64) {
            const int t1 = t0 + 64;
#pragma unroll
            for (int i = 0; i < NKP; ++i) { const int idx = tid + NTHR * i, row = idx / (DK / 8), pc = idx % (DK / 8); kreg[i] = *(const v4u*)(Kg + (size_t)(t1 + row) * pitch + pc * 8); }
            vreg = *(const v4u*)(Vg + (size_t)(t1 + vrow) * pitch + vpc * 8);
#pragma unroll
            for (int kk = 0; kk < NKS; ++kk) qreg[kk] = *(const bf16x8*)(Qg + (size_t)(t1 + 16 * it + l15) * pitch + 8 * g + 32 * kk);
            if (SSD) dtv = dtraw[(size_t)(t1 + lane) * 32];
        }
        __syncthreads();
        const float Li = __shfl(Lv, 16 * it + l15);
#pragma unroll
        for (int jj = 0; jj < 2; ++jj) {
            const int jt = 2 * hf + jj;
            f32x4 s = (f32x4){0.f, 0.f, 0.f, 0.f};
            if (jt <= it) {
#pragma unroll
                for (int kk = 0; kk < NKS; ++kk) s = mfma16(ldrow(lds + OFF_K + (16 * jt + l15) * KS + (8 * g + 32 * kk) * 2), qc[kk], s);
            }
            float o[4];
#pragma unroll
            for (int r = 0; r < 4; ++r) { const int j = 16 * jt + 4 * g + r; const float Lj = __shfl(Lv, j); o[r] = (j <= 16 * it + l15) ? s[r] * __expf(Li - Lj) : 0.f; }
            v2u w; w.x = pk2(o[0], o[1]); w.y = pk2(o[2], o[3]);
            *(LAS v2u*)(lds + OFF_SD + (16 * it + l15) * VS + (16 * jt + 4 * g) * 2) = w;
        }
        f32x4 o2[2];
#pragma unroll
        for (int dd = 0; dd < 2; ++dd) {
            const int dt = 2 * hf + dd; f32x4 a = (f32x4){0.f, 0.f, 0.f, 0.f};
#pragma unroll
            for (int kk = 0; kk < NKS; ++kk) a = mfma16(qc[kk], ldrow(lds + OFF_ST + (16 * dt + l15) * KS + (8 * g + 32 * kk) * 2), a);
            o2[dd] = a;
        }
        __syncthreads();
        float ei[4];
#pragma unroll
        for (int r = 0; r < 4; ++r) ei[r] = __expf(__shfl(Lv, 16 * it + 4 * g + r));
#pragma unroll
        for (int dd = 0; dd < 2; ++dd) {
            const int dt = 2 * hf + dd; f32x4 a = (f32x4){0.f, 0.f, 0.f, 0.f};
#pragma unroll
            for (int kk = 0; kk < 2; ++kk)
                a = mfma16(ldrow(lds + OFF_SD + (16 * it + l15) * VS + (8 * g + 32 * kk) * 2), tr2(lds + OFF_VS + (32 * kk + 8 * g + q4) * VS + (16 * dt + 4 * p4) * 2, 4 * VS), a);
#pragma unroll
            for (int r = 0; r < 4; ++r) {
                const int i = 16 * it + 4 * g + r, col = 16 * dt + l15;
                float o = a[r] + o2[dd][r] * ei[r];
                bf16* op = Og + (size_t)(t0 + i) * opitch + col;
                if (SSD) { const float xs = __uint_as_float((unsigned)Vg[(size_t)(t0 + i) * pitch + col] << 16), z = __uint_as_float((unsigned)(*op) << 16); o = (o + Dskip * xs) * silu_f(z); }
                *op = (bf16)(pk2(o, 0.f) & 0xffffu);
            }
        }
        const float cd = __expf(Llast);
#pragma unroll
        for (int i = 0; i < NMT * 4; ++i) st[i] = st[i] * cd;
#pragma unroll
        for (int mm = 0; mm < NMT; ++mm) {
            const int mt = NMT * wave + mm;
#pragma unroll
            for (int kk = 0; kk < 2; ++kk) {
                const bf16x8 a = tr2(lds + OFF_K + (32 * kk + 8 * g + q4) * KS + (16 * mt + 4 * p4) * 2, 4 * KS);
#pragma unroll
                for (int dt = 0; dt < 4; ++dt) st[mm * 4 + dt] = mfma16(a, tr2(lds + OFF_VW + (32 * kk + 8 * g + q4) * VS + (16 * dt + 4 * p4) * 2, 4 * VS), st[mm * 4 + dt]);
            }
#pragma unroll
            for (int dt = 0; dt < 4; ++dt) { const f32x4 s = st[mm * 4 + dt]; v2u w; w.x = pk2(s[0], s[1]); w.y = pk2(s[2], s[3]);
                *(LAS v2u*)(lds + OFF_ST + (16 * dt + l15) * KS + (16 * mt + 4 * g) * 2) = w; }
        }
        __syncthreads();
    }
}

__device__ __forceinline__ void gnorm_rows(bf16* X, int pitch, const float* gain, int gw, int NGW, int lane) {
    asm volatile("" : "+v"(lane));
    for (int m0 = gw; m0 < T * 4; m0 += 4 * NGW) {
        v4u v[4];
#pragma unroll
        for (int q = 0; q < 4; ++q) { int m = m0 + q * NGW; m = m < T * 4 ? m : m0; v[q] = *((const v4u*)(X + (size_t)(m >> 2) * pitch + (m & 3) * 512) + lane); }
#pragma unroll
        for (int q = 0; q < 4; ++q) { const int m = m0 + q * NGW; if (m >= T * 4) break;
            const int row = m >> 2, gq = m & 3;
            float x[8] = {bf_lo(v[q].x), bf_hi(v[q].x), bf_lo(v[q].y), bf_hi(v[q].y), bf_lo(v[q].z), bf_hi(v[q].z), bf_lo(v[q].w), bf_hi(v[q].w)};
            float s = 0.f;
#pragma unroll
            for (int e = 0; e < 8; ++e) s += x[e] * x[e];
            const float rstd = rsqrtf(wave_sum(s) * (1.f / 512.f) + NORM_EPS);
            const f32x4 g0 = *(const f32x4*)(gain + gq * 512 + lane * 8), g1 = *(const f32x4*)(gain + gq * 512 + lane * 8 + 4);
            v4u o; o.x = pk2(x[0] * rstd * g0.x, x[1] * rstd * g0.y); o.y = pk2(x[2] * rstd * g0.z, x[3] * rstd * g0.w); o.z = pk2(x[4] * rstd * g1.x, x[5] * rstd * g1.y); o.w = pk2(x[6] * rstd * g1.z, x[7] * rstd * g1.w);
            *((v4u*)(X + (size_t)row * pitch + gq * 512) + lane) = o; }
    }
}
constexpr int SSD_PITCH = 5376, SSD_XBC0 = 2048, SSD_XBCW = 3072;
__device__ __forceinline__ void ssd_halo_save(const bf16* PROJ, bf16* HALO, int gtid, int GT) {
    asm volatile("" : "+v"(gtid));
    for (int idx = gtid; idx < 512 * 3 * 384; idx += GT) {
        const int c8 = idx % 384, r = (idx / 384) % 3, seg = idx / (3 * 384), t0 = seg * 64;
        v4u v = (v4u){0u, 0u, 0u, 0u};
        if ((t0 & 4095) != 0) v = *(const v4u*)(PROJ + (size_t)(t0 - 3 + r) * SSD_PITCH + SSD_XBC0 + c8 * 8);
        *(v4u*)(HALO + ((size_t)seg * 3 + r) * SSD_XBCW + c8 * 8) = v;
    }
}
__device__ __forceinline__ void unpack8(const v4u v, float (&x)[8]) { x[0] = bf_lo(v.x); x[1] = bf_hi(v.x); x[2] = bf_lo(v.y); x[3] = bf_hi(v.y); x[4] = bf_lo(v.z); x[5] = bf_hi(v.z); x[6] = bf_lo(v.w); x[7] = bf_hi(v.w); }
__device__ __forceinline__ void ssd_conv(bf16* PROJ, const bf16* HALO, const float* cw, const float* cb, int gtid, int GT) {
    asm volatile("" : "+v"(gtid));
    for (int idx = gtid; idx < 512 * 384; idx += GT) {
        const int c8 = idx % 384, seg = idx / 384, t0 = seg * 64;
        float w0[8], w1[8], w2[8], w3[8], bb[8], xa[8], xb[8], xc[8], xd[8];
#pragma unroll
        for (int e = 0; e < 8; ++e) { w0[e] = cw[c8 * 8 + e]; w1[e] = cw[SSD_XBCW + c8 * 8 + e]; w2[e] = cw[2 * SSD_XBCW + c8 * 8 + e]; w3[e] = cw[3 * SSD_XBCW + c8 * 8 + e]; bb[e] = cb[c8 * 8 + e]; }
        unpack8(*(const v4u*)(HALO + ((size_t)seg * 3 + 0) * SSD_XBCW + c8 * 8), xa);
        unpack8(*(const v4u*)(HALO + ((size_t)seg * 3 + 1) * SSD_XBCW + c8 * 8), xb);
        unpack8(*(const v4u*)(HALO + ((size_t)seg * 3 + 2) * SSD_XBCW + c8 * 8), xc);
        bf16* p = PROJ + (size_t)t0 * SSD_PITCH + SSD_XBC0 + c8 * 8;
        v4u nxt = *(const v4u*)p;
        for (int tt = 0; tt < 64; ++tt, p += SSD_PITCH) {
            unpack8(nxt, xd);
            if (tt + 1 < 64) nxt = *(const v4u*)(p + SSD_PITCH);
            float o[8];
#pragma unroll
            for (int e = 0; e < 8; ++e) { o[e] = silu_f(bb[e] + w0[e] * xa[e] + w1[e] * xb[e] + w2[e] * xc[e] + w3[e] * xd[e]); xa[e] = xb[e]; xb[e] = xc[e]; xc[e] = xd[e]; }
            v4u w; w.x = pk2(o[0], o[1]); w.y = pk2(o[2], o[3]); w.z = pk2(o[4], o[5]); w.w = pk2(o[6], o[7]);
            *(v4u*)p = w;
        }
    }
}
template <int DH> struct FaState { float m, l; f32x4 o[DH / 16]; };
template <int DH> __device__ __forceinline__ void fa_init(FaState<DH>& st) { st.m = -1e30f; st.l = 0.f;
#pragma unroll
    for (int i = 0; i < DH / 16; ++i) st.o[i] = (f32x4){0.f, 0.f, 0.f, 0.f}; }
__device__ __forceinline__ float fexp2(float x) { return __builtin_amdgcn_exp2f(x); }

__device__ __forceinline__ float gmax4(float x) {
    const auto r = __builtin_amdgcn_permlane16_swap(__float_as_uint(x), __float_as_uint(x), false, false);
    const float y = fmaxf(__uint_as_float(r[0]), __uint_as_float(r[1]));
    const auto r2 = __builtin_amdgcn_permlane32_swap(__float_as_uint(y), __float_as_uint(y), false, false);
    return fmaxf(__uint_as_float(r2[0]), __uint_as_float(r2[1]));
}
__device__ __forceinline__ float gsum4(float x) {
    const auto r = __builtin_amdgcn_permlane16_swap(__float_as_uint(x), __float_as_uint(x), false, false);
    const float y = __uint_as_float(r[0]) + __uint_as_float(r[1]);
    const auto r2 = __builtin_amdgcn_permlane32_swap(__float_as_uint(y), __float_as_uint(y), false, false);
    return __uint_as_float(r2[0]) + __uint_as_float(r2[1]);
}
template <int DH, class Mask>
__device__ __forceinline__ void fa_tile(const LAS unsigned char* Kt, const LAS unsigned char* Vt, const bf16x8 (&qf)[DH / 32], FaState<DH>& st, float sc2, const Mask& mk, int ti, int l15, int g, int q4, int p4) {
    constexpr int KS = (DH + 8) * 2;
    f32x4 s0 = (f32x4){0.f, 0.f, 0.f, 0.f}, s1 = s0;
#pragma unroll
    for (int kk = 0; kk < DH / 32; ++kk) {
        s0 = mfma16(ldrow(Kt + l15 * KS + (8 * g + 32 * kk) * 2), qf[kk], s0);
        s1 = mfma16(ldrow(Kt + (16 + l15) * KS + (8 * g + 32 * kk) * 2), qf[kk], s1);
    }
    float v[8]; float tm = -3.0e38f;
    const bool rok = mk.row_ok(ti);
    if (mk.need_check(ti)) {
        const int key0 = mk.key0(ti);
#pragma unroll
        for (int r = 0; r < 4; ++r) {
            v[r] = (rok && mk.valid(key0 + 4 * g + r)) ? s0[r] * sc2 : -3.0e38f; v[4 + r] = (rok && mk.valid(key0 + 16 + 4 * g + r)) ? s1[r] * sc2 : -3.0e38f;
        }
    } else {
#pragma unroll
        for (int r = 0; r < 4; ++r) { v[r] = rok ? s0[r] * sc2 : -3.0e38f; v[4 + r] = rok ? s1[r] * sc2 : -3.0e38f; }
    }
#pragma unroll
    for (int e = 0; e < 8; ++e) tm = fmaxf(tm, v[e]);
    tm = gmax4(tm);
    const float mn = fmaxf(st.m, tm), alpha = fexp2(st.m - mn);
    float p[8], ps = 0.f;
#pragma unroll
    for (int e = 0; e < 8; ++e) { p[e] = fexp2(v[e] - mn); ps += p[e]; }
    ps = gsum4(ps);
    st.l = st.l * alpha + ps; st.m = mn;
    v4u pbu; pbu.x = pk2(p[0], p[1]); pbu.y = pk2(p[2], p[3]); pbu.z = pk2(p[4], p[5]); pbu.w = pk2(p[6], p[7]);
    const bf16x8 pb = __builtin_bit_cast(bf16x8, pbu);
#pragma unroll
    for (int dt = 0; dt < DH / 16; ++dt) {
        const s16x4 a = ldtr(Vt + (4 * g + q4) * KS + (16 * dt + 4 * p4) * 2), b = ldtr(Vt + (16 + 4 * g + q4) * KS + (16 * dt + 4 * p4) * 2);
        st.o[dt] = mfma16((bf16x8){a[0], a[1], a[2], a[3], b[0], b[1], b[2], b[3]}, pb, st.o[dt] * alpha);
    }
}

template <int DH, int NSUB, class Src, class Mask>
__device__ __forceinline__ void fa_stream(LAS unsigned char* lds, int tid, int t_begin, int t_end, const Src& src, const Mask& mk, const bf16x8 (&qf)[DH / 32], FaState<DH>& st, float sc2) {
    constexpr int KS = (DH + 8) * 2, TB = 32 * KS, SB = NSUB * TB;
    if (t_begin >= t_end) return;
    const int lane = tid & 63, l15 = lane & 15, g = lane >> 4, q4 = l15 >> 2, p4 = l15 & 3;
    v4u rk[NSUB], rv[NSUB];
    int lj, lpc; bool isv = false;
    if constexpr (DH == 128) { lj = tid >> 4; lpc = tid & 15; } else { lj = (tid & 255) >> 3; lpc = tid & 7; isv = tid >= 256; }
    const int nst = (t_end - t_begin + NSUB - 1) / NSUB;
    auto issue = [&](int k) {
#pragma unroll
        for (int u = 0; u < NSUB; ++u) { int ti = t_begin + k * NSUB + u; ti = ti < t_end ? ti : t_end - 1;
            if constexpr (DH == 128) { rk[u] = *(const v4u*)(src.krow(ti, lj) + lpc * 8); rv[u] = *(const v4u*)(src.vrow(ti, lj) + lpc * 8); }
            else { rk[u] = *(const v4u*)((isv ? src.vrow(ti, lj) : src.krow(ti, lj)) + lpc * 8); } }
    };
    auto commit = [&](int buf) {
#pragma unroll
        for (int u = 0; u < NSUB; ++u) {
            if constexpr (DH == 128) { *(LAS v4u*)(lds + buf * SB + u * TB + lj * KS + lpc * 16) = rk[u]; *(LAS v4u*)(lds + (2 + buf) * SB + u * TB + lj * KS + lpc * 16) = rv[u]; }
            else { *(LAS v4u*)(lds + ((isv ? 2 : 0) + buf) * SB + u * TB + lj * KS + lpc * 16) = rk[u]; } }
    };
    issue(0); commit(0);
    __syncthreads();
    for (int k = 0; k < nst; ++k) {
        const int cur = k & 1;
        if (k + 1 < nst) issue(k + 1);
#pragma unroll
        for (int u = 0; u < NSUB; ++u) { const int ti = t_begin + k * NSUB + u;
            if (ti < t_end && mk.wave_needs(ti)) fa_tile<DH, Mask>(lds + cur * SB + u * TB, lds + (2 + cur) * SB + u * TB, qf, st, sc2, mk, ti, l15, g, q4, p4); }
        if (k + 1 < nst) commit(cur ^ 1);
        __syncthreads();
    }
}

constexpr int DIL_PITCH = 3072;
struct DilSrc { const bf16* kbase; int band0, r, c;
    __device__ __forceinline__ const bf16* krow(int s, int j) const { int a = band0 + 32 * s + j; a = a < 0 ? 0 : a; return kbase + (size_t)(a * r + c) * DIL_PITCH; }
    __device__ __forceinline__ const bf16* vrow(int s, int j) const { return krow(s, j) + 1024; } };
struct DilMask { int aq, band0, w;
    __device__ __forceinline__ bool valid(int ak) const { return ak >= 0 && ak <= aq && aq - ak <= 128; }
    __device__ __forceinline__ bool row_ok(int) const { return true; }
    __device__ __forceinline__ bool need_check(int) const { return true; }
    __device__ __forceinline__ bool wave_needs(int s) const { return 32 * s + 31 >= 16 * w && 32 * s <= 16 * w + 143; }
    __device__ __forceinline__ int key0(int s) const { return band0 + 32 * s; } };

__device__ __forceinline__ void dilated_phase(LAS unsigned char* lds, const bf16* PROJD, bf16* OACC, float* LSE, int gi, int G, int wave_s) {
    int tid_ = wave_s * 64 + lane_id_now(); asm volatile("" : "+v"(tid_));
    const int tid = tid_, lane = tid & 63, wave = __builtin_amdgcn_readfirstlane(tid >> 6), l15 = lane & 15, g = lane >> 4;
    const int r = (gi == 0) ? 1 : (gi == 1 ? 4 : 16);
    const float sc2 = 0.08838834764831845f * 1.4426950408889634f;
    for (int item = blockIdx.x; item < 2048; item += G) {
        const int bh = item >> 5, b = bh >> 3, h = bh & 7, rem = item & 31, c = rem % r, qt = rem / r;
        const bf16* base = PROJD + (size_t)b * SEQ * DIL_PITCH + h * 128;
        const int aq = 128 * qt + 16 * wave + l15, tq = aq * r + c;
        bf16x8 qf[4];
#pragma unroll
        for (int kk = 0; kk < 4; ++kk) qf[kk] = *(const bf16x8*)(base + (size_t)tq * DIL_PITCH + 8 * g + 32 * kk);
        DilSrc src{base + 1024, 128 * qt - 128, r, c};
        DilMask mk{aq, 128 * qt - 128, wave};
        FaState<128> st; fa_init<128>(st);
        fa_stream<128, 2, DilSrc, DilMask>(lds, tid, qt == 0 ? 4 : 0, 8, src, mk, qf, st, sc2);
        const float inv = 1.f / fmaxf(st.l, 1e-30f);
        float lse = (st.m + __log2f(fmaxf(st.l, 1e-30f))) * 0.6931471805599453f;
        const size_t trow = (size_t)b * SEQ + tq;
        float wp = 0.f, wn = 1.f;
        if (gi > 0) { const float lp = LSE[trow * 8 + h]; const float mx = fmaxf(lp, lse); const float ep = __expf(lp - mx), en = __expf(lse - mx); const float den = ep + en; wp = ep / den; wn = en / den; lse = mx + __logf(den); }
        bf16* op = OACC + trow * 1024 + h * 128 + 4 * g;
#pragma unroll
        for (int dt = 0; dt < 8; ++dt) {
            f32x4 o = st.o[dt] * (inv * wn);
            if (gi > 0) { const v2u old = *(const v2u*)(op + 16 * dt); o[0] += wp * bf_lo(old.x); o[1] += wp * bf_hi(old.x); o[2] += wp * bf_lo(old.y); o[3] += wp * bf_hi(old.y); }
            v2u w; w.x = pk2(o[0], o[1]); w.y = pk2(o[2], o[3]);
            *(v2u*)(op + 16 * dt) = w;
        }
        if (g == 0) LSE[trow * 8 + h] = lse;
    }
}
constexpr int NSA_PITCH = 2816;
__device__ __forceinline__ void nsa_im2col(const bf16* PROJN, const float* pos, bf16* ACMP, int gtid, int GT) {
    asm volatile("" : "+v"(gtid));
    for (int idx = gtid; idx < 2 * 8192 * 256; idx += GT) {
        const int pc = idx & 255, row = (idx >> 8) & 8191, kv = idx >> 21;
        const int l = pc >> 3, d0 = (pc & 7) * 8, n = row & 255, bg = row >> 8, b = bg >> 2, gq = bg & 3;
        v4u o = (v4u){0u, 0u, 0u, 0u};
        if (n < 255) {
            const v4u v = *(const v4u*)(PROJN + (size_t)(b * SEQ + 16 * n + l) * NSA_PITCH + 1024 + kv * 256 + gq * 64 + d0);
            const f32x4 p0 = *(const f32x4*)(pos + kv * 2048 + l * 64 + d0), p1 = *(const f32x4*)(pos + kv * 2048 + l * 64 + d0 + 4);
            o.x = pk2(bf_lo(v.x) + p0.x, bf_hi(v.x) + p0.y); o.y = pk2(bf_lo(v.y) + p0.z, bf_hi(v.y) + p0.w);
            o.z = pk2(bf_lo(v.z) + p1.x, bf_hi(v.z) + p1.y); o.w = pk2(bf_lo(v.w) + p1.z, bf_hi(v.w) + p1.w);
        }
        *(v4u*)(ACMP + ((size_t)kv * 8192 + row) * 2048 + pc * 8) = o;
    }
}
struct TokSrc { const bf16* kbase; const bf16* vbase; const LAS int* list;
    __device__ __forceinline__ int tile(int s) const { return list ? list[s] : s; }
    __device__ __forceinline__ const bf16* krow(int s, int j) const { return kbase + (size_t)(32 * tile(s) + j) * NSA_PITCH; }
    __device__ __forceinline__ const bf16* vrow(int s, int j) const { return vbase + (size_t)(32 * tile(s) + j) * NSA_PITCH; } };
struct SelMask { unsigned lo, hi, wlo, whi; int t, qb; const LAS int* list;
    __device__ __forceinline__ bool row_ok(int ti) const { const int jb = list[ti] >> 1; return ((jb < 32) ? (lo >> jb) & 1u : (hi >> (jb - 32)) & 1u) != 0u; }
    __device__ __forceinline__ bool need_check(int ti) const { return list[ti] == qb; }
    __device__ __forceinline__ bool valid(int tok) const { return tok <= t; }
    __device__ __forceinline__ bool wave_needs(int ti) const { const int jb = list[ti] >> 1; return ((jb < 32) ? (wlo >> jb) & 1u : (whi >> (jb - 32)) & 1u) != 0u; }
    __device__ __forceinline__ int key0(int ti) const { return 32 * list[ti]; } };
struct WinMask { int t, qb, sb;
    __device__ __forceinline__ bool row_ok(int) const { return true; }
    __device__ __forceinline__ bool need_check(int ti) const { return ti == qb || ti == sb; }
    __device__ __forceinline__ bool valid(int tok) const { return tok <= t && tok > t - 512; }
    __device__ __forceinline__ bool wave_needs(int) const { return true; }
    __device__ __forceinline__ int key0(int ti) const { return 32 * ti; } };

__device__ __forceinline__ void nsa_phase(LAS unsigned char* lds, const bf16* PROJN, const bf16* KVC, bf16* ONSA, int G, int wave_s, unsigned long long* pc_) {
#define NSA_STAMP(sec) do { if (PROBE_MASK != 0 && blockIdx.x == 0 && threadIdx.x == 0) { const unsigned long long now_ = __builtin_amdgcn_s_memrealtime(); if ((PROBE_MASK >> (8 + (sec))) & 1) pc_[1] += now_ - pc_[0]; pc_[0] = now_; } } while (0)
    constexpr int KS = 144, OFF_KC = 0, OFF_VC = OFF_KC + 256 * KS, OFF_IMP = OFF_VC + 256 * KS, OFF_SEL = OFF_IMP + 32 * 256 * 4, OFF_UNI = OFF_SEL + 256, OFF_TL = OFF_UNI + 64, OFF_NT = OFF_TL + 512;
    int tid_ = wave_s * 64 + lane_id_now(); asm volatile("" : "+v"(tid_));
    const int tid = tid_, lane = tid & 63, wave = __builtin_amdgcn_readfirstlane(tid >> 6), l15 = lane & 15, g = lane >> 4, q4 = l15 >> 2, p4 = l15 & 3;
    const float sc2 = 0.125f * 1.4426950408889634f;
    LAS float* IMP = (LAS float*)(lds + OFF_IMP);
    LAS unsigned* SEL = (LAS unsigned*)(lds + OFF_SEL);
    LAS unsigned* UNI = (LAS unsigned*)(lds + OFF_UNI);
    LAS int* TL = (LAS int*)(lds + OFF_TL);
    LAS int* NT = (LAS int*)(lds + OFF_NT);
    for (int item = blockIdx.x; item < 4096; item += G) {
        const int bg = item >> 7, qb = ((bg >> 1) & 1) ? 127 - (item & 127) : (item & 127), b = bg >> 2, gq = bg & 3, t0 = 32 * qb, cur = t0 >> 6;
        const int ql = 4 * wave + q4, hp = p4, t = t0 + ql;
        const bf16* prow = PROJN + (size_t)b * SEQ * NSA_PITCH;
        bf16x8 qf[2];
#pragma unroll
        for (int kk = 0; kk < 2; ++kk) qf[kk] = *(const bf16x8*)(prow + (size_t)t * NSA_PITCH + gq * 256 + hp * 64 + 8 * g + 32 * kk);
        int ncv = (t0 >> 4) + 1; ncv = ncv > 255 ? 255 : ncv; const int ntc = (ncv + 31) >> 5;
        {
            v4u tmp[8];
#pragma unroll
            for (int u = 0; u < 8; ++u) { const int i = tid + NTHR * u, kv = u >> 2, ii = i & 2047, n = ii >> 3, pc = ii & 7;
                if (n < 32 * ntc) tmp[u] = *(const v4u*)(KVC + ((size_t)kv * 8192 + bg * 256 + n) * 256 + pc * 8); }
#pragma unroll
            for (int u = 0; u < 8; ++u) { const int i = tid + NTHR * u, kv = u >> 2, ii = i & 2047, n = ii >> 3, pc = ii & 7;
                if (n < 32 * ntc) *(LAS v4u*)(lds + (kv ? OFF_VC : OFF_KC) + n * KS + pc * 16) = tmp[u]; }
        }
        __syncthreads();
        f32x4 oc[4];
#pragma unroll
        for (int i = 0; i < 4; ++i) oc[i] = (f32x4){0.f, 0.f, 0.f, 0.f};
        {
            f32x4 sc[8][2]; float mx = -1e30f;
#pragma unroll
            for (int s = 0; s < 8; ++s) {
                sc[s][0] = (f32x4){-1e30f, -1e30f, -1e30f, -1e30f}; sc[s][1] = sc[s][0];
                if (s < ntc) {
                    f32x4 a0 = (f32x4){0.f, 0.f, 0.f, 0.f}, a1 = a0;
#pragma unroll
                    for (int kk = 0; kk < 2; ++kk) {
                        a0 = mfma16(ldrow(lds + OFF_KC + (32 * s + l15) * KS + (8 * g + 32 * kk) * 2), qf[kk], a0);
                        a1 = mfma16(ldrow(lds + OFF_KC + (32 * s + 16 + l15) * KS + (8 * g + 32 * kk) * 2), qf[kk], a1);
                    }
#pragma unroll
                    for (int r = 0; r < 4; ++r) {
                        const int n0 = 32 * s + 4 * g + r, n1 = n0 + 16;
                        sc[s][0][r] = (16 * n0 + 31 <= t && n0 < 255) ? a0[r] * sc2 : -1e30f;
                        sc[s][1][r] = (16 * n1 + 31 <= t && n1 < 255) ? a1[r] * sc2 : -1e30f;
                        mx = fmaxf(mx, fmaxf(sc[s][0][r], sc[s][1][r]));
                    }
                }
            }
            mx = gmax4(mx);
            float sum = 0.f;
#pragma unroll
            for (int s = 0; s < 8; ++s)
#pragma unroll
                for (int e = 0; e < 2; ++e)
#pragma unroll
                    for (int r = 0; r < 4; ++r) { const float p = (sc[s][e][r] > -5e29f) ? fexp2(sc[s][e][r] - mx) : 0.f; sc[s][e][r] = p; sum += p; }
            sum = gsum4(sum);
            const float inv = 1.f / fmaxf(sum, 1e-30f);
#pragma unroll
            for (int s = 0; s < 8; ++s) {
                float p[8];
#pragma unroll
                for (int r = 0; r < 4; ++r) { p[r] = sc[s][0][r] * inv; p[4 + r] = sc[s][1][r] * inv; }
#pragma unroll
                for (int e = 0; e < 8; ++e) { float x = p[e]; x += __int_as_float(__builtin_amdgcn_update_dpp(0, __float_as_int(x), 0xB1, 0xf, 0xf, false)); x += __int_as_float(__builtin_amdgcn_update_dpp(0, __float_as_int(x), 0x4E, 0xf, 0xf, false));
                    if (hp == 0) IMP[ql * 256 + 32 * s + 16 * (e >> 2) + 4 * g + (e & 3)] = x; }
                if (s < ntc) {
                    v4u pbu; pbu.x = pk2(p[0], p[1]); pbu.y = pk2(p[2], p[3]); pbu.z = pk2(p[4], p[5]); pbu.w = pk2(p[6], p[7]);
                    const bf16x8 pb = __builtin_bit_cast(bf16x8, pbu);
#pragma unroll
                    for (int dt = 0; dt < 4; ++dt) {
                        const s16x4 a = ldtr(lds + OFF_VC + (32 * s + 4 * g + q4) * KS + (16 * dt + 4 * p4) * 2), bb = ldtr(lds + OFF_VC + (32 * s + 16 + 4 * g + q4) * KS + (16 * dt + 4 * p4) * 2);
                        oc[dt] = mfma16((bf16x8){a[0], a[1], a[2], a[3], bb[0], bb[1], bb[2], bb[3]}, pb, oc[dt]);
                    }
                }
            }
        }
        __syncthreads();
        NSA_STAMP(0);
        {
            unsigned ulo = 0u, uhi = 0u;
            for (int qi = 0; qi < 4; ++qi) {
                const int qq = 4 * wave + qi, jb = lane;
                const LAS float* ip = IMP + qq * 256 + 4 * jb;
                const float pm1 = (jb > 0) ? ip[-1] : 0.f;
                const float imp_sel = pm1 + 2.f * (ip[0] + ip[1] + ip[2]) + ip[3];
                const bool forced = (jb == 0) || (jb == cur) || (jb == cur - 1);
                const float score = (jb <= cur) ? imp_sel + (forced ? 1e4f : 0.f) : -1e30f;
                int rank = 0;
                for (int j = 0; j < 64; ++j) { const float sj = __uint_as_float((unsigned)__builtin_amdgcn_readlane((int)__float_as_uint(score), j)); rank += (sj > score || (sj == score && j < jb)) ? 1 : 0; }
                const bool sel = rank < 16 && score > -5e29f;
                const unsigned long long mask = __ballot(sel);
                if (lane == 0) { SEL[2 * qq] = (unsigned)mask; SEL[2 * qq + 1] = (unsigned)(mask >> 32); }
                ulo |= (unsigned)mask; uhi |= (unsigned)(mask >> 32);
            }
            if (lane == 0) { UNI[2 * wave] = ulo; UNI[2 * wave + 1] = uhi; }
        }
        __syncthreads();
        if (wave == 0) {
            unsigned ulo = 0u, uhi = 0u;
            for (int w = 0; w < 8; ++w) { ulo |= UNI[2 * w]; uhi |= UNI[2 * w + 1]; }
            int cnt = 0;
            for (int half = 0; half < 2; ++half) {
                const int s = lane + 64 * half, jb = s >> 1; const unsigned bit = (jb < 32) ? (ulo >> jb) & 1u : (uhi >> (jb - 32)) & 1u;
                const bool need = (s <= qb) && bit != 0u;
                const unsigned long long m = __ballot(need);
                const int pos = cnt + __popcll(m & ((1ull << lane) - 1ull));
                if (need) TL[pos] = s;
                cnt += __popcll(m);
            }
            if (lane == 0) NT[0] = cnt;
        }
        __syncthreads();
        const int nts = NT[0];
        NSA_STAMP(1);
        FaState<64> ss; fa_init<64>(ss);
        {
            TokSrc src{prow + 1536 + gq * 64, prow + 1792 + gq * 64, TL};
            SelMask mk{SEL[2 * ql], SEL[2 * ql + 1], (unsigned)__builtin_amdgcn_readfirstlane((int)UNI[2 * wave]), (unsigned)__builtin_amdgcn_readfirstlane((int)UNI[2 * wave + 1]), t, qb, TL};
            fa_stream<64, 4, TokSrc, SelMask>(lds, tid, 0, nts, src, mk, qf, ss, sc2);
        }
        NSA_STAMP(2);
        FaState<64> sw; fa_init<64>(sw);
        {
            TokSrc src{prow + 2048 + gq * 64, prow + 2304 + gq * 64, nullptr};
            const int sb = (t0 - 512) < 0 ? 0 : (t0 - 512) >> 5;
            WinMask mk{t, qb, sb};
            fa_stream<64, 4, TokSrc, WinMask>(lds, tid, sb, qb + 1, src, mk, qf, sw, sc2);
        }
        NSA_STAMP(3);
        {
            const bf16* gp = prow + (size_t)t * NSA_PITCH + 2560 + gq * 4 + hp;
            const float g0 = sigmoid_f(__uint_as_float((unsigned)gp[0] << 16)), g1 = sigmoid_f(__uint_as_float((unsigned)gp[16] << 16)), g2 = sigmoid_f(__uint_as_float((unsigned)gp[32] << 16));
            const float is = g1 / fmaxf(ss.l, 1e-30f), iw = g2 / fmaxf(sw.l, 1e-30f);
            bf16* op = ONSA + ((size_t)b * SEQ + t) * 1024 + gq * 256 + hp * 64 + 4 * g;
#pragma unroll
            for (int dt = 0; dt < 4; ++dt) { const f32x4 o = oc[dt] * g0 + ss.o[dt] * is + sw.o[dt] * iw; v2u w; w.x = pk2(o[0], o[1]); w.y = pk2(o[2], o[3]); *(v2u*)(op + 16 * dt) = w; }
        }
        __syncthreads();
        NSA_STAMP(4);
    }
}
#ifndef RET_SCAN
#define RET_SCAN 1
#define RET_GNORM 1
#define RET_GATE 1
#endif
#ifndef ENABLE_SSD
#define ENABLE_SSD 1
#endif
constexpr size_t WS_DTRAW = WS_SCR + 340 * MiB, WS_HALO = WS_SCR + 344 * MiB;
#define MIXER_CONVERT \
    if (mix == 1) { transpose_w<0>(args.in[12], D, 2608, 2816, WMIX, scr, gw, NGW, lane); \
        for (int c = 0; c < 2; ++c) { transpose_w<0>(args.in[14] + (size_t)c * 2048 * 256, 2048, 256, 256, WMIX + 3 * MiB + (size_t)c * 256 * 2048, scr, gw, NGW, lane); \
            transpose_w<0>(args.in[15] + (size_t)c * 256 * 64, 256, 64, 256, WMIX + 4 * MiB + (size_t)c * 256 * 256, scr, gw, NGW, lane); } \
        transpose_w<0>(args.in[16], D, D, D, WMIX + 5 * MiB, scr, gw, NGW, lane); } \
    if (mix == 3) { transpose_w<0>(args.in[25], D, 9216, 9216, WMIX, scr, gw, NGW, lane); transpose_w<0>(args.in[26], D, D, D, WMIX + (size_t)9216 * 1024, scr, gw, NGW, lane); } \
    if (mix == 0) { transpose_w<0>(args.in[9], D, 6144, 6144, WMIX, scr, gw, NGW, lane); transpose_w<0>(args.in[11], 2048, D, D, WMIX + (size_t)6144 * 1024, scr, gw, NGW, lane); } \
    if (mix == 2) { transpose_w<0>(args.in[17], D, 5152, 5376, WMIX, scr, gw, NGW, lane); transpose_w<0>(args.in[24], 2048, D, D, WMIX + (size_t)6144 * 1024, scr, gw, NGW, lane); }

#define MIXER_PHASES \
    if (mix == 0) { \
        bf16* PROJ = (bf16*)(ws + WS_SCR); \
        PHASE_BEGIN { pg8::Epi<pg8::EPI_RETQKV> E{}; E.O = PROJ; E.ldc = 4096; E.rot = ROT; run_gemm<pg8::EPI_RETQKV>(lds, U, D, WMIX, T, 4096, D, E, wave_s); } PHASE_END_C(3) \
        if (RET_SCAN) PHASE_BEGIN \
            for (int item = blockIdx.x; item < 256; item += G) { \
                const int b = item >> 5, h = (item >> 3) & 3, s8 = item & 7; \
                bf16* base = PROJ + (size_t)b * SEQ * 4096; \
                scan_item<256, false>(lds, base + h * 256, base + 1024 + h * 256, base + 2048 + h * 512 + s8 * 64, 4096, base + 2048 + h * 512 + s8 * 64, 4096, log1pf(-exp2f(-5.f - (float)h)), nullptr, 0.f, 0.f, 0.f, wave_s); \
                __syncthreads(); \
            } \
        PHASE_END_C(4) \
        if (RET_GNORM) PHASE_BEGIN gnorm_rows(PROJ + 2048, 4096, args.in[10], gw, NGW, lane); PHASE_END_C(7) \
        if (RET_GATE) PHASE_BEGIN { pg8::Epi<pg8::EPI_GATEMUL> E{}; E.O = PROJ + 2048; E.ldc = 4096; run_gemm<pg8::EPI_GATEMUL>(lds, U, D, WMIX + (size_t)4096 * 1024, T, 2048, D, E, wave_s); } PHASE_END_C(3) \
        PHASE_BEGIN { pg8::Epi<pg8::EPI_RESID> E{}; E.Hout = H; E.Hbase = H; E.scale = 1.0f; E.ldc = D; run_gemm<pg8::EPI_RESID>(lds, PROJ + 2048, 4096, WMIX + (size_t)6144 * 1024, T, D, 2048, E, wave_s); } PHASE_END_C(3) \
    } \
    if (mix == 2 && ENABLE_SSD) { \
        bf16* PROJ = (bf16*)(ws + WS_SCR); float* DTRAW = (float*)(ws + WS_DTRAW); bf16* HALO = (bf16*)(ws + WS_HALO); \
        PHASE_BEGIN { pg8::Epi<pg8::EPI_SSD> E{}; E.O = PROJ; E.ldc = SSD_PITCH; E.aux = DTRAW; run_gemm<pg8::EPI_SSD>(lds, U, D, WMIX, T, SSD_PITCH, D, E, wave_s); } PHASE_END_C(3) \
        PHASE_BEGIN ssd_halo_save(PROJ, HALO, blockIdx.x * NTHR + tid, G * NTHR); PHASE_END_C(7) \
        PHASE_BEGIN ssd_conv(PROJ, HALO, args.in[18], args.in[19], blockIdx.x * NTHR + tid, G * NTHR); PHASE_END_C(7) \
        PHASE_BEGIN \
            for (int item = blockIdx.x; item < 256; item += G) { \
                const int b = item >> 5, gq = (item >> 3) & 3, r = item & 7, hd = gq * 8 + r; \
                bf16* base = PROJ + (size_t)b * SEQ * SSD_PITCH; \
                scan_item<128, true>(lds, base + 4608 + gq * 128, base + 4096 + gq * 128, base + 2048 + gq * 512 + r * 64, SSD_PITCH, base + gq * 512 + r * 64, SSD_PITCH, 0.f, \
                                     DTRAW + (size_t)b * SEQ * 32 + hd, args.in[20][hd], -__expf(args.in[21][hd]), args.in[22][hd], wave_s); \
                __syncthreads(); \
            } \
        PHASE_END_C(4) \
        PHASE_BEGIN gnorm_rows(PROJ, SSD_PITCH, args.in[23], gw, NGW, lane); PHASE_END_C(7) \
        PHASE_BEGIN { pg8::Epi<pg8::EPI_RESID> E{}; E.Hout = H; E.Hbase = H; E.scale = 1.0f; E.ldc = D; run_gemm<pg8::EPI_RESID>(lds, PROJ, SSD_PITCH, WMIX + (size_t)6144 * 1024, T, D, 2048, E, wave_s); } PHASE_END_C(3) \
    } \
    if (mix == 3) { \
        bf16* PROJD = (bf16*)(ws + WS_SCR); bf16* OACC = (bf16*)(ws + WS_SCR + 192 * MiB); float* LSE = (float*)(ws + WS_SCR + 256 * MiB); \
        for (int gi = 0; gi < 3; ++gi) { \
            PHASE_BEGIN { pg8::Epi<pg8::EPI_BF16> E{}; E.O = PROJD; E.ldc = DIL_PITCH; run_gemm<pg8::EPI_BF16>(lds, U, D, WMIX + (size_t)gi * 3072 * 1024, T, 3072, D, E, wave_s); } PHASE_END_C(3) \
            PHASE_BEGIN dilated_phase(lds, PROJD, OACC, LSE, gi, G, wave_s); PHASE_END_C(6) \
        } \
        PHASE_BEGIN { pg8::Epi<pg8::EPI_RESID> E{}; E.Hout = H; E.Hbase = H; E.scale = 1.0f; E.ldc = D; run_gemm<pg8::EPI_RESID>(lds, OACC, D, WMIX + (size_t)9216 * 1024, T, D, D, E, wave_s); } PHASE_END_C(3) \
    } \
    if (mix == 1) { \
        bf16* PROJN = (bf16*)(ws + WS_SCR); bf16* ACMP = (bf16*)(ws + WS_SCR + 176 * MiB); bf16* HIDC = (bf16*)(ws + WS_SCR + 240 * MiB); bf16* KVC = (bf16*)(ws + WS_SCR + 248 * MiB); bf16* ONSA = (bf16*)(ws + WS_SCR + 256 * MiB); \
        PHASE_BEGIN { pg8::Epi<pg8::EPI_BF16> E{}; E.O = PROJN; E.ldc = NSA_PITCH; run_gemm<pg8::EPI_BF16>(lds, U, D, WMIX, T, NSA_PITCH, D, E, wave_s); } PHASE_END_C(3) \
        PHASE_BEGIN nsa_im2col(PROJN, args.in[13], ACMP, blockIdx.x * NTHR + tid, G * NTHR); PHASE_END_C(7) \
        PHASE_BEGIN for (int c = 0; c < 2; ++c) { pg8::Epi<pg8::EPI_SILU> E{}; E.O = HIDC + (size_t)c * 8192 * 256; E.ldc = 256; run_gemm<pg8::EPI_SILU>(lds, ACMP + (size_t)c * 8192 * 2048, 2048, WMIX + 3 * MiB + (size_t)c * 256 * 2048, 8192, 256, 2048, E, wave_s); } PHASE_END_C(3) \
        PHASE_BEGIN for (int c = 0; c < 2; ++c) { pg8::Epi<pg8::EPI_BF16> E{}; E.O = KVC + (size_t)c * 8192 * 256; E.ldc = 256; run_gemm<pg8::EPI_BF16>(lds, HIDC + (size_t)c * 8192 * 256, 256, WMIX + 4 * MiB + (size_t)c * 256 * 256, 8192, 256, 256, E, wave_s); } PHASE_END_C(3) \
        PHASE_BEGIN nsa_phase(lds, PROJN, KVC, ONSA, G, wave_s, (unsigned long long*)(args.ws + 32768)); PHASE_END_C(5) \
        PHASE_BEGIN { pg8::Epi<pg8::EPI_RESID> E{}; E.Hout = H; E.Hbase = H; E.scale = 1.0f; E.ldc = D; run_gemm<pg8::EPI_RESID>(lds, ONSA, D, WMIX + 5 * MiB, T, D, D, E, wave_s); } PHASE_END_C(3) \
    }
__global__ void __launch_bounds__(NTHR, 2) fwd_megakernel(Args args) {
    extern __shared__ __attribute__((aligned(16))) unsigned char lds_raw[];
    LAS unsigned char* lds = (LAS unsigned char*)lds_raw;
    cg::grid_group grid = cg::this_grid();
    const int G = gridDim.x;
    const int wave_s = __builtin_amdgcn_readfirstlane(threadIdx.x >> 6);
    volatile LAS unsigned* xst = (volatile LAS unsigned*)(lds + LDS_BYTES - 64);
    if (threadIdx.x < 16) xst[threadIdx.x] = 0u;
    __syncthreads();
    const XcdBarrier xbar = xcd_barrier_post((unsigned*)args.ws, xst);
    grid.sync();
    if (PROBE_MASK != 0 && blockIdx.x == 0 && threadIdx.x == 0) { ((unsigned long long*)(args.ws + 32768))[0] = __builtin_amdgcn_s_memrealtime(); }
#define PHASE_BEGIN {
#define PHASE_END_C(cat) xcd_barrier(xbar); if (PROBE_MASK != 0 && blockIdx.x == 0 && threadIdx.x == 0) { const unsigned long long now_ = __builtin_amdgcn_s_memrealtime(); unsigned long long* c_ = (unsigned long long*)(args.ws + 32768); if ((PROBE_MASK >> (cat)) & 1) c_[1] += now_ - c_[0]; c_[0] = now_; } }
    for (int L = 0; L < DEPTH; ++L) {
        const int mix = L & 3;
        int tid_ = wave_s * 64 + lane_id_now(); asm volatile("" : "+v"(tid_));
        const int tid = tid_, lane = tid & 63, wave = __builtin_amdgcn_readfirstlane(tid >> 6);
        const int gw = blockIdx.x * NWAVES + wave, NGW = G * NWAVES;
        unsigned char* ws = args.ws; asm volatile("" : "+s"(ws));
        float* H = args.out; asm volatile("" : "+s"(H));
        float* ROT = (float*)(ws + WS_ROT);
        bf16* WIN1 = (bf16*)(ws + WS_WIN1); bf16* WOUT1 = (bf16*)(ws + WS_WOUT1); bf16* WIN2 = (bf16*)(ws + WS_WIN2); bf16* WOUT2 = (bf16*)(ws + WS_WOUT2); bf16* WMIX = (bf16*)(ws + WS_WMIX);
        bf16* U = (bf16*)(ws + WS_U); bf16* HID = (bf16*)(ws + WS_SCR);
        LAS float* scr = (LAS float*)(lds + wave * 16384);
        PHASE_BEGIN
            transpose_w<1>(args.in[2] + (size_t)L * D * 2 * FF, D, 2 * FF, 2 * FF, WIN1, scr, gw, NGW, lane);
            transpose_w<0>(args.in[3] + (size_t)L * FF * D, FF, D, D, WOUT1, scr, gw, NGW, lane);
            transpose_w<1>(args.in[6] + (size_t)L * D * 2 * FF, D, 2 * FF, 2 * FF, WIN2, scr, gw, NGW, lane);
            transpose_w<0>(args.in[7] + (size_t)L * FF * D, FF, D, D, WOUT2, scr, gw, NGW, lane);
            MIXER_CONVERT
            if (L == 0) {
                for (int i = blockIdx.x * NTHR + tid; i < 4096 * 128; i += G * NTHR) {
                    const int pos = i >> 7, d = i & 127;
                    const float inv = exp2f(-(float)d * (13.287712379549449f / 128.f));
                    const float ang = (float)pos * inv;
                    const double x = (double)ang * 0.15915494309189535; const float fr = (float)(x - rint(x));
                    ROT[i] = __builtin_amdgcn_cosf(fr); ROT[4096 * 128 + i] = __builtin_amdgcn_sinf(fr);
                }
            }
            rms_rows(L == 0 ? args.in[0] : H, args.in[1] + L * D, U, nullptr, gw, NGW, lane);
        PHASE_END_C(0)
        PHASE_BEGIN { pg8::Epi<pg8::EPI_SWIGLU> E{}; E.O = HID; E.ldc = FF; run_gemm<pg8::EPI_SWIGLU>(lds, U, D, WIN1, T, 2 * FF, D, E, wave_s); } PHASE_END_C(1)
        PHASE_BEGIN { pg8::Epi<pg8::EPI_RESID> E{}; E.Hout = H; E.Hbase = (L == 0) ? args.in[0] : H; E.scale = 0.5f; E.ldc = D; run_gemm<pg8::EPI_RESID>(lds, HID, FF, WOUT1, T, D, FF, E, wave_s); } PHASE_END_C(1)
        PHASE_BEGIN rms_rows(H, args.in[4] + L * D, U, nullptr, gw, NGW, lane); PHASE_END_C(2)
        MIXER_PHASES
        PHASE_BEGIN rms_rows(H, args.in[5] + L * D, U, nullptr, gw, NGW, lane); PHASE_END_C(2)
        PHASE_BEGIN { pg8::Epi<pg8::EPI_SWIGLU> E{}; E.O = HID; E.ldc = FF; run_gemm<pg8::EPI_SWIGLU>(lds, U, D, WIN2, T, 2 * FF, D, E, wave_s); } PHASE_END_C(1)
        PHASE_BEGIN { pg8::Epi<pg8::EPI_RESID> E{}; E.Hout = H; E.Hbase = H; E.scale = 0.5f; E.ldc = D; run_gemm<pg8::EPI_RESID>(lds, HID, FF, WOUT2, T, D, FF, E, wave_s); } PHASE_END_C(1)
    }
    int nprobe = 0; if (PROBE_MASK != 0) { asm volatile("s_waitcnt vmcnt(0)" ::: "memory"); xcd_barrier(xbar); nprobe = (int)(__hip_atomic_load((unsigned long long*)(args.ws + 32768) + 1, __ATOMIC_RELAXED, __HIP_MEMORY_SCOPE_AGENT) >> 3); }
    { const int lane = lane_id_now(); rms_final(args.out, args.in[8], blockIdx.x * NWAVES + wave_s, G * NWAVES, lane, nprobe); }
}

extern "C" void kernel_launch(void* const* d_in, const int* in_sizes, int n_in, void* d_out, int out_size, void* d_ws, size_t ws_size, hipStream_t stream) {
    static int grid = 0;
    if (grid == 0) {
        if (n_in != 27 || out_size != T * D || ws_size < WS_NEED) { fprintf(stderr, "kernel_launch: unexpected problem (n_in %d, out %d, ws %zu)\n", n_in, out_size, ws_size); grid = -1; return; }
        int dev = 0, cus = 0, per_cu = 0;
        hipGetDevice(&dev); hipDeviceGetAttribute(&cus, hipDeviceAttributeMultiprocessorCount, dev);
        if (hipFuncSetAttribute((const void*)fwd_megakernel, hipFuncAttributeMaxDynamicSharedMemorySize, LDS_BYTES) != hipSuccess) { fprintf(stderr, "kernel_launch: hipFuncSetAttribute failed\n"); grid = -1; return; }
        if (hipOccupancyMaxActiveBlocksPerMultiprocessor(&per_cu, (const void*)fwd_megakernel, NTHR, LDS_BYTES) != hipSuccess || per_cu < 1) { fprintf(stderr, "kernel_launch: occupancy query gave %d\n", per_cu); per_cu = 1; }
        (void)hipGetLastError();
        grid = cus * 1;
    }
    if (grid < 0) return;
    if (hipMemsetAsync(d_ws, 0, 65536, stream) != hipSuccess) { fprintf(stderr, "kernel_launch: memset failed\n"); return; }
    Args a{};
    for (int i = 0; i < 27; ++i) a.in[i] = (const float*)d_in[i];
    a.out = (float*)d_out; a.ws = (unsigned char*)d_ws; a.ph_lo = 0; a.ph_hi = 1 << 20;
    void* kargs[] = {&a};
    hipError_t e = hipLaunchCooperativeKernel((const void*)fwd_megakernel, dim3(grid), dim3(NTHR), kargs, LDS_BYTES, stream);
    if (e != hipSuccess) fprintf(stderr, "kernel_launch: cooperative launch failed: %s (grid %d)\n", hipGetErrorString(e), grid);
}
```

```cpp
#include <hip/hip_runtime.h>
#include <hip/hip_cooperative_groups.h>
#include <cstdio>
#include <cstdint>
namespace cg = cooperative_groups;

__device__ __forceinline__ int lane_id_now() { int l; asm volatile("v_mbcnt_lo_u32_b32 %0, -1, 0\n\tv_mbcnt_hi_u32_b32 %0, -1, %0" : "=v"(l)); return l; }

#ifndef PROBE_MASK
#define PROBE_MASK 0
#endif
namespace pg8 {
#define PG8_LAS __attribute__((address_space(3)))
typedef unsigned short bf16_t;
typedef short bf16x8 __attribute__((ext_vector_type(8)));
typedef float f32x4 __attribute__((ext_vector_type(4)));
typedef unsigned u32x4 __attribute__((ext_vector_type(4)));
constexpr int BM = 256, BK = 64, HALF = 128, HTB = HALF * BK * 2  , STAGE_BYTES = 8 * HTB, NXCD = 8, WGM = 8;

__host__ __device__ __forceinline__ int lds_byte(int r, int c) { const int st = (r >> 4) * 2 + (c >> 5), rr = r & 15, cc = c & 31, ob = rr * 64 + cc * 2; return st * 1024 + (ob ^ (((ob >> 9) & 1) << 5)); }
__host__ __device__ __forceinline__ void stage_rc(int b, int& R, int& C) { const int st = b / 1024, sb = b % 1024, swz = sb ^ (((sb >> 9) & 1) << 5); R = (st >> 1) * 16 + swz / 64; C = (st & 1) * 32 + (swz % 64) / 2; }
__host__ __device__ __forceinline__ int perm32(int rho) { const int n = rho >> 4, i = rho & 15; return 8 * (i >> 2) + 4 * n + (i & 3); }

struct Unit { int pm, pn; };
struct Gemm { const bf16_t* A; const bf16_t* Bt; int M, N, K, lda; };

struct StaticOrder {
    int nM, nN, nwg, G, c;
    __host__ __device__ void init(int M, int N, int G_, int c_) { nM = M / BM; nN = N / BM; nwg = nM * nN; G = G_; c = c_; }
    __host__ __device__ bool next(int i, Unit& u) const {
        const long L = (long)i * G + c; if (L >= nwg) return false;
        int wgid = (int)L; { const int q = nwg / NXCD, r = nwg % NXCD, xcd = wgid % NXCD, off = wgid / NXCD; wgid = (xcd < r ? xcd * (q + 1) : r * (q + 1) + (xcd - r) * q) + off; }
        const int nig = WGM * nN, gid = wgid / nig, fm = gid * WGM, gsz = (nM - fm) < WGM ? (nM - fm) : WGM;
        u.pm = fm + ((wgid % nig) % gsz); u.pn = (wgid % nig) / gsz; return true;
    }
    __device__ __forceinline__ void a_ready(const Unit&) const {}
    __device__ __forceinline__ void done(const Unit&) const {}
};

typedef float f32x2_t __attribute__((ext_vector_type(2))); typedef __bf16 bf16x2_t __attribute__((ext_vector_type(2)));
__device__ __forceinline__ unsigned cvt_pk_bf16(float lo, float hi) { f32x2_t v = {lo, hi}; bf16x2_t b = __builtin_convertvector(v, bf16x2_t); return __builtin_bit_cast(unsigned, b); }
__device__ __forceinline__ float bf_lo(unsigned w) { return __uint_as_float(w << 16); }
__device__ __forceinline__ float bf_hi(unsigned w) { return __uint_as_float(w & 0xffff0000u); }
__device__ __forceinline__ float silu_f(float x) { return x * __builtin_amdgcn_rcpf(1.0f + __builtin_amdgcn_exp2f(-1.4426950408889634f * x)); }
__device__ __forceinline__ float sigmoid_f(float x) { return __builtin_amdgcn_rcpf(1.0f + __builtin_amdgcn_exp2f(-1.4426950408889634f * x)); }

enum { EPI_BF16 = 0, EPI_SWIGLU = 1, EPI_RESID = 2, EPI_RETQKV = 3, EPI_GATEMUL = 4, EPI_SSD = 5, EPI_SILU = 6 };
template <int MODE> struct Epi {
    static constexpr bool PERM = true, AFTER_DRAIN = false;
    bf16_t* O; int ldc;
    float* Hout; const float* Hbase; float scale;
    const float* rot;
    float* aux;
    __device__ __forceinline__ void operator()(const f32x4 (&acc)[2][2][4][2], const Unit& u, int wr, int wc, int fr, int fq) const {
        const int row0 = u.pm * BM + wr * 64 + fr;
        const int cl = wc * 32 + 8 * fq;
        if constexpr (MODE == EPI_SWIGLU) {
#pragma unroll
            for (int ai = 0; ai < 2; ++ai)
#pragma unroll
                for (int m = 0; m < 4; ++m) {
                    bf16_t* rowp = O + (size_t)(row0 + ai * HALF + m * 16) * ldc + u.pn * 128 + cl;
                    f32x4 a0 = acc[ai][0][m][0], a1 = acc[ai][0][m][1], b0 = acc[ai][1][m][0], b1 = acc[ai][1][m][1];
                    u32x4 w;
                    w.x = cvt_pk_bf16(silu_f(a0[0]) * b0[0], silu_f(a0[1]) * b0[1]); w.y = cvt_pk_bf16(silu_f(a0[2]) * b0[2], silu_f(a0[3]) * b0[3]);
                    w.z = cvt_pk_bf16(silu_f(a1[0]) * b1[0], silu_f(a1[1]) * b1[1]); w.w = cvt_pk_bf16(silu_f(a1[2]) * b1[2], silu_f(a1[3]) * b1[3]);
                    *(u32x4*)rowp = w;
                }
        } else if constexpr (MODE == EPI_RESID) {
#pragma unroll
            for (int ai = 0; ai < 2; ++ai)
#pragma unroll
                for (int m = 0; m < 4; ++m) {
                    const size_t off = (size_t)(row0 + ai * HALF + m * 16) * ldc + u.pn * BM + cl;
#pragma unroll
                    for (int bj = 0; bj < 2; ++bj)
#pragma unroll
                        for (int n = 0; n < 2; ++n) {
                            const f32x4 b = *(const f32x4*)(Hbase + off + bj * HALF + 4 * n);
                            *(f32x4*)(Hout + off + bj * HALF + 4 * n) = b + acc[ai][bj][m][n] * scale;
                        }
                }
        } else if constexpr (MODE == EPI_RETQKV) {
            if (u.pn < 8) {
                const float ks = (u.pn >= 4) ? 0.0625f : 1.0f;
#pragma unroll
                for (int ai = 0; ai < 2; ++ai)
#pragma unroll
                    for (int m = 0; m < 4; ++m) {
                        const int r = row0 + ai * HALF + m * 16; const int pos = r & 4095;
                        bf16_t* rowp = O + (size_t)r * ldc + u.pn * BM + cl;
                        u32x4 w1, w2; unsigned* p1 = (unsigned*)&w1; unsigned* p2 = (unsigned*)&w2;
#pragma unroll
                        for (int n = 0; n < 2; ++n) {
                            const f32x4 c = *(const f32x4*)(rot + (size_t)pos * 128 + cl + 4 * n);
                            const f32x4 s = *(const f32x4*)(rot + (size_t)4096 * 128 + (size_t)pos * 128 + cl + 4 * n);
                            const f32x4 t1 = acc[ai][0][m][n] * ks, t2 = acc[ai][1][m][n] * ks;
                            const f32x4 o1 = t1 * c - t2 * s, o2 = t1 * s + t2 * c;
                            p1[2 * n] = cvt_pk_bf16(o1[0], o1[1]); p1[2 * n + 1] = cvt_pk_bf16(o1[2], o1[3]);
                            p2[2 * n] = cvt_pk_bf16(o2[0], o2[1]); p2[2 * n + 1] = cvt_pk_bf16(o2[2], o2[3]);
                        }
                        *(u32x4*)rowp = w1; *(u32x4*)(rowp + HALF) = w2;
                    }
            } else {
#pragma unroll
                for (int ai = 0; ai < 2; ++ai)
#pragma unroll
                    for (int m = 0; m < 4; ++m) {
                        bf16_t* rowp = O + (size_t)(row0 + ai * HALF + m * 16) * ldc + u.pn * BM + cl;
#pragma unroll
                        for (int bj = 0; bj < 2; ++bj) { const f32x4 v0 = acc[ai][bj][m][0], v1 = acc[ai][bj][m][1]; u32x4 w;
                            w.x = cvt_pk_bf16(v0[0], v0[1]); w.y = cvt_pk_bf16(v0[2], v0[3]); w.z = cvt_pk_bf16(v1[0], v1[1]); w.w = cvt_pk_bf16(v1[2], v1[3]);
                            *(u32x4*)(rowp + bj * HALF) = w; }
                    }
            }
        } else if constexpr (MODE == EPI_GATEMUL) {
#pragma unroll
            for (int ai = 0; ai < 2; ++ai)
#pragma unroll
                for (int m = 0; m < 4; ++m) {
                    bf16_t* rowp = O + (size_t)(row0 + ai * HALF + m * 16) * ldc + u.pn * BM + cl;
#pragma unroll
                    for (int bj = 0; bj < 2; ++bj) { const f32x4 v0 = acc[ai][bj][m][0], v1 = acc[ai][bj][m][1]; const u32x4 old = *(const u32x4*)(rowp + bj * HALF); u32x4 w;
                        w.x = cvt_pk_bf16(silu_f(v0[0]) * bf_lo(old.x), silu_f(v0[1]) * bf_hi(old.x)); w.y = cvt_pk_bf16(silu_f(v0[2]) * bf_lo(old.y), silu_f(v0[3]) * bf_hi(old.y));
                        w.z = cvt_pk_bf16(silu_f(v1[0]) * bf_lo(old.z), silu_f(v1[1]) * bf_hi(old.z)); w.w = cvt_pk_bf16(silu_f(v1[2]) * bf_lo(old.w), silu_f(v1[3]) * bf_hi(old.w));
                        *(u32x4*)(rowp + bj * HALF) = w; }
                }
        } else {
            if (MODE == EPI_SSD && u.pn == 20) {
                if (wc == 0) {
#pragma unroll
                    for (int ai = 0; ai < 2; ++ai)
#pragma unroll
                        for (int m = 0; m < 4; ++m) { float* p = aux + (size_t)(row0 + ai * HALF + m * 16) * 32 + cl;
                            *(f32x4*)p = acc[ai][0][m][0]; *(f32x4*)(p + 4) = acc[ai][0][m][1]; }
                }
                return;
            }
#pragma unroll
            for (int ai = 0; ai < 2; ++ai)
#pragma unroll
                for (int m = 0; m < 4; ++m) {
                    bf16_t* rowp = O + (size_t)(row0 + ai * HALF + m * 16) * ldc + u.pn * BM + cl;
#pragma unroll
                    for (int bj = 0; bj < 2; ++bj) { f32x4 v0 = acc[ai][bj][m][0], v1 = acc[ai][bj][m][1]; u32x4 w;
                        if (MODE == EPI_SILU) { v0 = (f32x4){silu_f(v0[0]), silu_f(v0[1]), silu_f(v0[2]), silu_f(v0[3])}; v1 = (f32x4){silu_f(v1[0]), silu_f(v1[1]), silu_f(v1[2]), silu_f(v1[3])}; }
                        w.x = cvt_pk_bf16(v0[0], v0[1]); w.y = cvt_pk_bf16(v0[2], v0[3]); w.z = cvt_pk_bf16(v1[0], v1[1]); w.w = cvt_pk_bf16(v1[2], v1[3]);
                        *(u32x4*)(rowp + bj * HALF) = w; }
                }
        }
    }
};
template <class Epi, class Sched, bool ALIGN_EPI = false, bool SP2 = false>
__device__ __forceinline__ void gemm_phase(PG8_LAS unsigned char* lds, const Gemm g, const Sched& S, const Epi& E, int wave_s) {
    int tid_ = wave_s * 64 + lane_id_now(); asm volatile("" : "+v"(tid_)); const int tid = tid_, wid = __builtin_amdgcn_readfirstlane(tid >> 6), lane = tid & 63, wr = wid >> 2, wc = wid & 3, fr = lane & 15, fq = lane >> 4;
    const int K = g.K, nt = K / BK;
    unsigned voffA[2], voffB[2];
#pragma unroll
    for (int i = 0; i < 2; ++i) { int R, C; stage_rc(tid * 16 + i * 8192, R, C); const int Rb = Epi::PERM ? ((R & ~31) + perm32(R & 31)) : R;
        voffA[i] = (unsigned)(R * g.lda + C) * 2u; voffB[i] = (unsigned)(Rb * K + C) * 2u; }
    const size_t kstep = (size_t)(BK * 2);
    const size_t hstepA = (size_t)HALF * g.lda * 2, hstepB = (size_t)HALF * K * 2;
    const size_t tstepA = 2 * hstepA, tstepB = 2 * hstepB;
    const unsigned ldsw = (unsigned)wid * 1024u;
    const int aoff = lds_byte(wr * 64 + fr, fq * 8), boff = lds_byte(wc * 32 + fr, fq * 8);
#define PG8_SA(b, h) (((b) * 2 + (h)) * HTB)
#define PG8_SB(b, h) ((4 + (b) * 2 + (h)) * HTB)
#define PG8_STAGE(bufoff, gbase, voff) do { _Pragma("unroll") for (int _i = 0; _i < 2; ++_i) \
        __builtin_amdgcn_global_load_lds((const unsigned*)((const char*)(gbase) + (voff)[_i]), (PG8_LAS unsigned*)(lds + (bufoff) + ldsw + _i * 8192), 16, 0, 0); } while (0)
#define PG8_LDA(dst, b, h) do { _Pragma("unroll") for (int m = 0; m < 4; ++m) _Pragma("unroll") for (int k = 0; k < 2; ++k) dst[m][k] = *(const PG8_LAS bf16x8*)(lds + PG8_SA(b, h) + aoff + m * 2048 + k * 1024); } while (0)
#define PG8_LDB(dst, b, h) do { _Pragma("unroll") for (int n = 0; n < 2; ++n) _Pragma("unroll") for (int k = 0; k < 2; ++k) dst[n][k] = *(const PG8_LAS bf16x8*)(lds + PG8_SB(b, h) + boff + n * 2048 + k * 1024); } while (0)
#define PG8_MMA(ai, bj, At, Bt) do { __builtin_amdgcn_s_setprio(1); _Pragma("unroll") for (int m = 0; m < 4; ++m) _Pragma("unroll") for (int n = 0; n < 2; ++n) _Pragma("unroll") for (int k = 0; k < 2; ++k) \
        acc[ai][bj][m][n] = __builtin_amdgcn_mfma_f32_16x16x32_bf16(Bt[n][k], At[m][k], acc[ai][bj][m][n], 0, 0, 0); __builtin_amdgcn_s_setprio(0); } while (0)
#define PG8_WAIT_V(n) asm volatile("s_waitcnt vmcnt(" #n ")" ::: "memory")
#define PG8_WAIT_L(n) asm volatile("s_waitcnt lgkmcnt(" #n ")" ::: "memory")
#define PG8_BAR __builtin_amdgcn_s_barrier()
#define PG8_SCHED __builtin_amdgcn_sched_barrier(0)
    Unit cur, nxt; int ui = 0;
    if (!S.next(0, cur)) return;
    f32x4 acc[2][2][4][2];
#pragma unroll
    for (int a = 0; a < 2; ++a)
#pragma unroll
        for (int b = 0; b < 2; ++b)
#pragma unroll
            for (int m = 0; m < 4; ++m)
#pragma unroll
                for (int n = 0; n < 2; ++n) acc[a][b][m][n] = (f32x4){0.f, 0.f, 0.f, 0.f};
    bf16x8 At[4][2], B0[2][2], B1[2][2];
    const char* cA = (const char*)g.A + (size_t)cur.pm * tstepA; const char* cB = (const char*)g.Bt + (size_t)cur.pn * tstepB;
    S.a_ready(cur);
    if constexpr (SP2) {
        PG8_STAGE(PG8_SB(0, 0), cB, voffB); PG8_STAGE(PG8_SB(0, 1), cB + hstepB, voffB); PG8_STAGE(PG8_SA(0, 0), cA, voffA); PG8_STAGE(PG8_SA(0, 1), cA + hstepA, voffA);
        if (wr == 1) PG8_BAR;
        PG8_WAIT_V(2); PG8_BAR;
        PG8_STAGE(PG8_SB(1, 0), cB + kstep, voffB); PG8_STAGE(PG8_SA(1, 0), cA + kstep, voffA); PG8_STAGE(PG8_SB(1, 1), cB + hstepB + kstep, voffB);
        PG8_WAIT_V(6); PG8_BAR;
    } else {
        PG8_STAGE(PG8_SB(0, 0), cB, voffB); PG8_STAGE(PG8_SA(0, 0), cA, voffA); PG8_STAGE(PG8_SB(0, 1), cB + hstepB, voffB); PG8_STAGE(PG8_SA(0, 1), cA + hstepA, voffA);
        if (wr == 1) PG8_BAR;
        PG8_WAIT_V(4); PG8_BAR;
        PG8_STAGE(PG8_SB(1, 0), cB + kstep, voffB); PG8_STAGE(PG8_SA(1, 0), cA + kstep, voffA); PG8_STAGE(PG8_SB(1, 1), cB + hstepB + kstep, voffB);
        PG8_WAIT_V(6); PG8_BAR;
    }
    for (;;) {
        const bool has_next = S.next(ui + 1, nxt);
        const char* nA = has_next ? (const char*)g.A + (size_t)nxt.pm * tstepA : cA; const char* nB = has_next ? (const char*)g.Bt + (size_t)nxt.pn * tstepB : cB;
        for (int t = 0; t < nt; t += 2) {
            const bool last = (t == nt - 2);
            const char* a1 = cA + (size_t)(t + 1) * kstep;
            const char* a2 = last ? nA : cA + (size_t)(t + 2) * kstep; const char* b2 = last ? nB : cB + (size_t)(t + 2) * kstep;
            const char* a3 = a2 + kstep; const char* b3 = b2 + kstep;
            if (last && has_next) S.a_ready(nxt);
            if constexpr (SP2) {
            PG8_LDB(B0, 0, 0); PG8_LDB(B1, 0, 1); PG8_SCHED; PG8_LDA(At, 0, 0); PG8_STAGE(PG8_SA(1, 1), a1 + hstepA, voffA);
            PG8_WAIT_V(8); PG8_WAIT_L(0); PG8_BAR; PG8_MMA(0, 0, At, B0); PG8_MMA(0, 1, At, B1); PG8_BAR; PG8_SCHED;
            PG8_LDA(At, 0, 1); PG8_STAGE(PG8_SB(0, 0), b2, voffB); PG8_STAGE(PG8_SB(0, 1), b2 + hstepB, voffB); PG8_STAGE(PG8_SA(0, 0), a2, voffA);
            PG8_WAIT_V(8); PG8_WAIT_L(0); PG8_BAR; PG8_MMA(1, 0, At, B0); PG8_MMA(1, 1, At, B1); PG8_BAR; PG8_SCHED;
            PG8_LDB(B0, 1, 0); PG8_LDB(B1, 1, 1); PG8_SCHED; PG8_LDA(At, 1, 0); PG8_STAGE(PG8_SA(0, 1), a2 + hstepA, voffA);
            PG8_WAIT_V(8); PG8_WAIT_L(0); PG8_BAR; PG8_MMA(0, 0, At, B0); PG8_MMA(0, 1, At, B1); PG8_BAR; PG8_SCHED;
            PG8_LDA(At, 1, 1); PG8_STAGE(PG8_SB(1, 0), b3, voffB); PG8_STAGE(PG8_SB(1, 1), b3 + hstepB, voffB); PG8_STAGE(PG8_SA(1, 0), a3, voffA);
            PG8_WAIT_V(8); PG8_WAIT_L(0); PG8_BAR; PG8_MMA(1, 0, At, B0); PG8_MMA(1, 1, At, B1); PG8_BAR; PG8_SCHED;
            } else {
            PG8_LDB(B0, 0, 0); PG8_SCHED; PG8_LDA(At, 0, 0); PG8_STAGE(PG8_SA(1, 1), a1 + hstepA, voffA);
            PG8_WAIT_L(8); PG8_BAR; PG8_WAIT_L(0); PG8_MMA(0, 0, At, B0); PG8_BAR; PG8_SCHED;
            PG8_LDB(B1, 0, 1); PG8_STAGE(PG8_SB(0, 0), b2, voffB);
            PG8_BAR; PG8_WAIT_L(0); PG8_MMA(0, 1, At, B1); PG8_BAR;
            PG8_LDA(At, 0, 1); PG8_STAGE(PG8_SA(0, 0), a2, voffA);
            PG8_BAR; PG8_WAIT_L(0); PG8_MMA(1, 0, At, B0); PG8_BAR; PG8_SCHED;
            PG8_STAGE(PG8_SB(0, 1), b2 + hstepB, voffB);
            PG8_WAIT_V(6); PG8_BAR; PG8_MMA(1, 1, At, B1); PG8_BAR;
            PG8_LDB(B0, 1, 0); PG8_SCHED; PG8_LDA(At, 1, 0); PG8_STAGE(PG8_SA(0, 1), a2 + hstepA, voffA);
            PG8_WAIT_L(8); PG8_BAR; PG8_WAIT_L(0); PG8_MMA(0, 0, At, B0); PG8_BAR; PG8_SCHED;
            PG8_LDB(B1, 1, 1); PG8_STAGE(PG8_SB(1, 0), b3, voffB);
            PG8_BAR; PG8_WAIT_L(0); PG8_MMA(0, 1, At, B1); PG8_BAR;
            PG8_LDA(At, 1, 1); PG8_STAGE(PG8_SA(1, 0), a3, voffA);
            PG8_BAR; PG8_WAIT_L(0); PG8_MMA(1, 0, At, B0); PG8_BAR; PG8_SCHED;
            PG8_STAGE(PG8_SB(1, 1), b3 + hstepB, voffB);
            PG8_WAIT_V(6); PG8_BAR; PG8_MMA(1, 1, At, B1); PG8_BAR;
            }
        }
        if constexpr (ALIGN_EPI) { if (wr == 0) PG8_BAR; }
        if constexpr (!Epi::AFTER_DRAIN) { E(acc, cur, wr, wc, fr, fq); S.done(cur); }
        if (!has_next) break;
#pragma unroll
        for (int a = 0; a < 2; ++a)
#pragma unroll
            for (int b = 0; b < 2; ++b)
#pragma unroll
                for (int m = 0; m < 4; ++m)
#pragma unroll
                    for (int n = 0; n < 2; ++n) acc[a][b][m][n] = (f32x4){0.f, 0.f, 0.f, 0.f};
        cur = nxt; cA = nA; cB = nB; ++ui;
        if constexpr (ALIGN_EPI) { if (wr == 1) PG8_BAR; }
    }
    PG8_WAIT_V(0);
    if constexpr (!ALIGN_EPI) { if (wr == 0) PG8_BAR; }
    PG8_BAR;
    if constexpr (Epi::AFTER_DRAIN) { E.fused(acc, cur, wr, wc, fr, fq, lds, wid, lane); S.done(cur); }
#undef PG8_SA
#undef PG8_SB
#undef PG8_STAGE
#undef PG8_LDA
#undef PG8_LDB
#undef PG8_MMA
#undef PG8_WAIT_V
#undef PG8_WAIT_L
#undef PG8_BAR
#undef PG8_SCHED
}
}
#define GAS __attribute__((address_space(1)))
#define LAS __attribute__((address_space(3)))
typedef unsigned short bf16;
typedef unsigned v4u __attribute__((ext_vector_type(4)));
typedef unsigned v2u __attribute__((ext_vector_type(2)));
typedef float f32x4 __attribute__((ext_vector_type(4)));
typedef short bf16x8 __attribute__((ext_vector_type(8)));
typedef short s16x4 __attribute__((ext_vector_type(4)));
using pg8::cvt_pk_bf16; using pg8::bf_lo; using pg8::bf_hi; using pg8::silu_f; using pg8::sigmoid_f;

constexpr int NWAVES = 8, NTHR = 512;
constexpr int BATCH = 8, SEQ = 4096, T = BATCH * SEQ, D = 1024, FF = 2816, DEPTH = 4;
constexpr float NORM_EPS = 1e-6f;
constexpr int LDS_BYTES = 147456;
constexpr size_t MiB = 1u << 20;
constexpr size_t WS_ROT = 1 * MiB;
constexpr size_t WS_W = 8 * MiB;
constexpr size_t WS_WIN1 = WS_W, WS_WOUT1 = WS_W + 11 * MiB, WS_WIN2 = WS_W + 17 * MiB, WS_WOUT2 = WS_W + 28 * MiB, WS_WMIX = WS_W + 34 * MiB;
constexpr size_t WS_U = 64 * MiB;
constexpr size_t WS_SCR = 128 * MiB;
constexpr size_t WS_NEED = 484 * MiB;

struct Args { const float* in[27]; float* out; unsigned char* ws; int ph_lo, ph_hi; };

__device__ __forceinline__ float wave_sum(float v) {
#pragma unroll
    for (int o = 1; o < 64; o <<= 1) v += __shfl_xor(v, o);
    return v;
}
__device__ __forceinline__ unsigned pk2(float lo, float hi) { return cvt_pk_bf16(lo, hi); }

template <int MAP> __device__ __forceinline__ void transpose_w(const float* W, int K, int N, int Npad, bf16* WT, LAS float* scr, int gw, int NGW, int lane) {
    asm volatile("" : "+v"(lane));
    const int nblk = Npad / 32, nitems = (K / 64) * nblk;
    for (int item = gw; item < nitems; item += NGW) {
        const int kb = item / nblk, nb = item % nblk, k0 = 64 * kb, n0 = 32 * nb;
        const int nn = n0 + (lane & 31);
        float wv[32];
        const float* wp = W + (size_t)(k0 + (lane >> 5)) * N + (nn < N ? nn : 0);
#pragma unroll
        for (int i = 0; i < 32; ++i) wv[i] = wp[(size_t)(2 * i) * N];
#pragma unroll
        for (int i = 0; i < 32; ++i) scr[(2 * i + (lane >> 5)) * 33 + (lane & 31)] = (nn < N) ? wv[i] : 0.f;
        asm volatile("s_waitcnt lgkmcnt(0)" ::: "memory");
        int r0 = n0;
        if (MAP == 1) { r0 = (n0 < FF) ? (n0 / 128) * 256 + (n0 % 128) : ((n0 - FF) / 128) * 256 + 128 + ((n0 - FF) % 128); }
        const int c = lane & 7;
#pragma unroll
        for (int j = 0; j < 4; ++j) { const int n = (lane >> 3) + 8 * j; const LAS float* s = scr + (8 * c) * 33 + n;
            v4u o; o.x = pk2(s[0 * 33], s[1 * 33]); o.y = pk2(s[2 * 33], s[3 * 33]); o.z = pk2(s[4 * 33], s[5 * 33]); o.w = pk2(s[6 * 33], s[7 * 33]);
            *(v4u*)(WT + (size_t)(r0 + n) * K + k0 + 8 * c) = o; }
        asm volatile("s_waitcnt lgkmcnt(0)" ::: "memory");
    }
}

__device__ __forceinline__ void rms_rows(const float* X, const float* gain, bf16* U, float* Hcopy, int gw, int NGW, int lane) {
    asm volatile("" : "+v"(lane));
    f32x4 g[4];
#pragma unroll
    for (int j = 0; j < 4; ++j) g[j] = ((const f32x4*)gain)[lane + 64 * j];
    for (int m0 = gw; m0 < T; m0 += 4 * NGW) {
        f32x4 v[4][4];
#pragma unroll
        for (int q = 0; q < 4; ++q) { const int m = m0 + q * NGW; const f32x4* xr = (const f32x4*)(X + (size_t)(m < T ? m : m0) * D) + lane;
#pragma unroll
            for (int j = 0; j < 4; ++j) v[q][j] = xr[64 * j]; }
#pragma unroll
        for (int q = 0; q < 4; ++q) { const int m = m0 + q * NGW; if (m >= T) break;
            float s = 0.f;
#pragma unroll
            for (int j = 0; j < 4; ++j) s += (v[q][j].x * v[q][j].x + v[q][j].y * v[q][j].y) + (v[q][j].z * v[q][j].z + v[q][j].w * v[q][j].w);
            const float rstd = rsqrtf(wave_sum(s) * (1.f / D) + NORM_EPS);
            v2u* o8 = (v2u*)(U + (size_t)m * D) + lane;
#pragma unroll
            for (int j = 0; j < 4; ++j) { v2u w; w.x = pk2(v[q][j].x * rstd * g[j].x, v[q][j].y * rstd * g[j].y); w.y = pk2(v[q][j].z * rstd * g[j].z, v[q][j].w * rstd * g[j].w); o8[64 * j] = w; } }
    }
}
__device__ __forceinline__ void rms_final(float* X, const float* gain, int gw, int NGW, int lane, int nprobe) {
    asm volatile("" : "+v"(lane));
    f32x4 g[4];
#pragma unroll
    for (int j = 0; j < 4; ++j) g[j] = ((const f32x4*)gain)[lane + 64 * j];
    for (int m = gw; m < T; m += NGW) {
        f32x4* xr = (f32x4*)(X + (size_t)m * D) + lane;
        f32x4 v[4]; float s = 0.f;
#pragma unroll
        for (int j = 0; j < 4; ++j) { v[j] = xr[64 * j]; s += (v[j].x * v[j].x + v[j].y * v[j].y) + (v[j].z * v[j].z + v[j].w * v[j].w); }
        const float rstd = rsqrtf(wave_sum(s) * (1.f / D) + NORM_EPS);
#pragma unroll
        for (int j = 0; j < 4; ++j) { f32x4 o = v[j] * rstd * g[j]; const int fi = m * D + 4 * (lane + 64 * j); if (fi < nprobe) o.x += 0.125f; if (fi + 1 < nprobe) o.y += 0.125f; if (fi + 2 < nprobe) o.z += 0.125f; if (fi + 3 < nprobe) o.w += 0.125f; xr[64 * j] = o; }
    }
}

template <int MODE> __device__ __forceinline__ void run_gemm(LAS unsigned char* lds, const bf16* A, int lda, const bf16* Bt, int M, int N, int K, const pg8::Epi<MODE>& E, int wave_s) {
    pg8::Gemm g{A, Bt, M, N, K, lda}; pg8::StaticOrder S; S.init(M, N, (int)gridDim.x, (int)blockIdx.x);
    pg8::gemm_phase<pg8::Epi<MODE>, pg8::StaticOrder, true, true>(lds, g, S, E, wave_s);
}
#define XB_TMO      128
#define XB_XCNT(j)  (256  + 64 * (j))
#define XB_XSUB(j)  (1280 + 64 * (j))
#define XB_XGEN(j)  (2304 + 64 * (j))
#define XB_TOP      3328
#define XB_TOPGEN   3392
#define XCD_BAR_WORDS 3456
#define XB_SPIN_CAP (1u << 18)

__device__ __forceinline__ unsigned xb_ld(unsigned* p)              { return __hip_atomic_load(p, __ATOMIC_RELAXED, __HIP_MEMORY_SCOPE_AGENT); }
__device__ __forceinline__ unsigned xb_add(unsigned* p, unsigned v) { return __hip_atomic_fetch_add(p, v, __ATOMIC_RELAXED, __HIP_MEMORY_SCOPE_AGENT); }
__device__ __forceinline__ unsigned xb_xcc_id() { return (unsigned)__builtin_amdgcn_s_getreg((3 << 11) | 20) & 0xFu; }
#define XB_SPIN(cond, bar) do { unsigned _sp = 0; while (cond) { __builtin_amdgcn_s_sleep(1); \
    if ((++_sp & 255u) == 0u) { if (xb_ld(&(bar)[XB_TMO])) break; if (_sp > XB_SPIN_CAP) { atomicAdd(&(bar)[XB_TMO], 1u); break; } } } } while (0)

struct XcdBarrier {
    unsigned* bar; unsigned x;
    volatile LAS unsigned* st;
};

__device__ __forceinline__ XcdBarrier xcd_barrier_post(unsigned* bar, volatile LAS unsigned* st) {
    XcdBarrier b; b.bar = bar; b.x = xb_xcc_id(); b.st = st;
    if (threadIdx.x == 0) (void)xb_add(&bar[XB_XCNT(b.x)], 1u);
    return b;
}
__device__ __forceinline__ void xcd_barrier_complete(unsigned* bar, unsigned x, unsigned& nloc, unsigned& nx) {
    const unsigned G = gridDim.x * gridDim.y * gridDim.z;
    unsigned sum, cnt, mine, sp = 0u;
    for (;;) {
        sum = 0u; cnt = 0u; mine = 0u;
#pragma unroll
        for (unsigned j = 0; j < 16; ++j) { const unsigned c = xb_ld(&bar[XB_XCNT(j)]); sum += c; cnt += (c > 0u) ? 1u : 0u; mine = (j == x) ? c : mine; }
        if (sum == G) break;
        __builtin_amdgcn_s_sleep(1);
        if ((++sp & 255u) == 0u) { if (xb_ld(&bar[XB_TMO])) break; if (sp > XB_SPIN_CAP) { atomicAdd(&bar[XB_TMO], 1u); break; } }
    }
    nloc = mine > 0u ? mine : 1u; nx = cnt > 0u ? cnt : 1u;
}

__device__ __forceinline__ void xcd_barrier(const XcdBarrier& b) {
    asm volatile("s_waitcnt vmcnt(0)" ::: "memory");
    __syncthreads();
    if (threadIdx.x == 0) {
        unsigned* bar = b.bar;
        __builtin_amdgcn_s_waitcnt(0);
        unsigned nloc = b.st[0], nx = b.st[1];
        if (nloc == 0u) { xcd_barrier_complete(bar, b.x, nloc, nx); b.st[0] = nloc; b.st[1] = nx; }
        const unsigned old = xb_add(&bar[XB_XSUB(b.x)], 1u);
        const unsigned gen = old / nloc;
        if (old + 1u == (gen + 1u) * nloc) {
            __builtin_amdgcn_fence(__ATOMIC_RELEASE, "agent");
            asm volatile("s_waitcnt vmcnt(0)" ::: "memory");
            const unsigned og = xb_add(&bar[XB_TOP], 1u);
            const unsigned tg = og / nx;
            if (og + 1u == (tg + 1u) * nx) xb_add(&bar[XB_TOPGEN], 1u);
            else XB_SPIN(xb_ld(&bar[XB_TOPGEN]) == tg, bar);
            __builtin_amdgcn_fence(__ATOMIC_ACQUIRE, "agent");
            xb_add(&bar[XB_XGEN(b.x)], 1u);
            asm volatile("s_waitcnt vmcnt(0)" ::: "memory");
        } else {
            XB_SPIN(xb_ld(&bar[XB_XGEN(b.x)]) == gen, bar);
            __builtin_amdgcn_fence(__ATOMIC_ACQUIRE, "agent");
            asm volatile("s_waitcnt vmcnt(0)" ::: "memory");
        }
    }
    __syncthreads();
}
typedef short v4i16_t __attribute__((ext_vector_type(4)));
__device__ __forceinline__ s16x4 ldtr(const LAS unsigned char* p) { return __builtin_bit_cast(s16x4, __builtin_amdgcn_ds_read_tr16_b64_v4i16((LAS v4i16_t*)p)); }
__device__ __forceinline__ bf16x8 tr2(const LAS unsigned char* p, int stride4) { const s16x4 a = ldtr(p), b = ldtr(p + stride4); return (bf16x8){a[0], a[1], a[2], a[3], b[0], b[1], b[2], b[3]}; }
__device__ __forceinline__ f32x4 mfma16(bf16x8 a, bf16x8 b, f32x4 c) { return __builtin_amdgcn_mfma_f32_16x16x32_bf16(a, b, c, 0, 0, 0); }
__device__ __forceinline__ bf16x8 ldrow(const LAS unsigned char* p) { return *(const LAS bf16x8*)p; }
__device__ __forceinline__ float softplus_f(float x) { return x > 20.f ? x : log1pf(__expf(x)); }

template <int DK, bool SSD>
__device__ __forceinline__ void scan_item(LAS unsigned char* lds, const bf16* Qg, const bf16* Kg, const bf16* Vg, int pitch, bf16* Og, int opitch,
                                          float lg, const float* dtraw, float dtbias, float Aneg, float Dskip, int wave_s) {
    constexpr int KS = (DK + 8) * 2, VS = 144;
    constexpr int OFF_K = 0, OFF_ST = OFF_K + 64 * KS, OFF_VS = OFF_ST + 64 * KS, OFF_VW = OFF_VS + 64 * VS, OFF_SD = OFF_VW + 64 * VS;
    constexpr int NKS = DK / 32, NMT = DK / 128, NKP = DK / 64;
    int tid_ = wave_s * 64 + lane_id_now(); asm volatile("" : "+v"(tid_));
    const int tid = tid_, lane = tid & 63, wave = __builtin_amdgcn_readfirstlane(tid >> 6);
    const int it = wave & 3, hf = wave >> 2, l15 = lane & 15, g = lane >> 4, q4 = l15 >> 2, p4 = l15 & 3;
    for (int i = tid; i < 64 * KS / 4; i += NTHR) ((LAS unsigned*)(lds + OFF_ST))[i] = 0u;
    f32x4 st[NMT * 4];
#pragma unroll
    for (int i = 0; i < NMT * 4; ++i) st[i] = (f32x4){0.f, 0.f, 0.f, 0.f};
    v4u kreg[NKP]; v4u vreg; bf16x8 qreg[NKS]; float dtv = 0.f;
    const int vrow = tid >> 3, vpc = tid & 7;
    {
#pragma unroll
        for (int i = 0; i < NKP; ++i) { const int idx = tid + NTHR * i, row = idx / (DK / 8), pc = idx % (DK / 8); kreg[i] = *(const v4u*)(Kg + (size_t)row * pitch + pc * 8); }
        vreg = *(const v4u*)(Vg + (size_t)vrow * pitch + vpc * 8);
#pragma unroll
        for (int kk = 0; kk < NKS; ++kk) qreg[kk] = *(const bf16x8*)(Qg + (size_t)(16 * it + l15) * pitch + 8 * g + 32 * kk);
        if (SSD) dtv = dtraw[(size_t)lane * 32];
    }
    for (int c = 0; c < 64; ++c) {
        const int t0 = c * 64;
        float aj, vsj;
        if (SSD) { const float dt = softplus_f(dtv + dtbias); aj = dt * Aneg; vsj = dt; } else { aj = lg; vsj = 1.f; }
        float Lv = aj;
#pragma unroll
        for (int o = 1; o < 64; o <<= 1) { const float t = __shfl_up(Lv, o); if (lane >= o) Lv += t; }
        const float Llast = __shfl(Lv, 63);
        const float wv = __expf(Llast - Lv);
#pragma unroll
        for (int i = 0; i < NKP; ++i) { const int idx = tid + NTHR * i, row = idx / (DK / 8), pc = idx % (DK / 8); *(LAS v4u*)(lds + OFF_K + row * KS + pc * 16) = kreg[i]; }
        {
            const float vs = __shfl(vsj, vrow & 63), ww = __shfl(wv, vrow & 63) * vs;
            const float x0 = bf_lo(vreg.x), x1 = bf_hi(vreg.x), x2 = bf_lo(vreg.y), x3 = bf_hi(vreg.y), x4 = bf_lo(vreg.z), x5 = bf_hi(vreg.z), x6 = bf_lo(vreg.w), x7 = bf_hi(vreg.w);
            v4u a, b;
            a.x = pk2(x0 * vs, x1 * vs); a.y = pk2(x2 * vs, x3 * vs); a.z = pk2(x4 * vs, x5 * vs); a.w = pk2(x6 * vs, x7 * vs);
            b.x = pk2(x0 * ww, x1 * ww); b.y = pk2(x2 * ww, x3 * ww); b.z = pk2(x4 * ww, x5 * ww); b.w = pk2(x6 * ww, x7 * ww);
            *(LAS v4u*)(lds + OFF_VS + vrow * VS + vpc * 16) = a; *(LAS v4u*)(lds + OFF_VW + vrow * VS + vpc * 16) = b;
        }
        bf16x8 qc[NKS];
#pragma unroll
        for (int kk = 0; kk < NKS; ++kk) qc[kk] = qreg[kk];
        if (c + 1 < 64) {
            const int t1 = t0 + 64;
#pragma unroll
            for (int i = 0; i < NKP; ++i) { const int idx = tid + NTHR * i, row = idx / (DK / 8), pc = idx % (DK / 8); kreg[i] = *(const v4u*)(Kg + (size_t)(t1 + row) * pitch + pc * 8); }
            vreg = *(const v4u*)(Vg + (size_t)(t1 + vrow) * pitch + vpc * 8);
#pragma unroll
            for (int kk = 0; kk < NKS; ++kk) qreg[kk] = *(const bf16x8*)(Qg + (size_t)(t1 + 16 * it + l15) * pitch + 8 * g + 32 * kk);
            if (SSD) dtv = dtraw[(size_t)(t1 + lane) * 32];
        }
        __syncthreads();
        const float Li = __shfl(Lv, 16 * it + l15);
#pragma unroll
        for (int jj = 0; jj < 2; ++jj) {
            const int jt = 2 * hf + jj;
            f32x4 s = (f32x4){0.f, 0.f, 0.f, 0.f};
            if (jt <= it) {
#pragma unroll
                for (int kk = 0; kk < NKS; ++kk) s = mfma16(ldrow(lds + OFF_K + (16 * jt + l15) * KS + (8 * g + 32 * kk) * 2), qc[kk], s);
            }
            float o[4];
#pragma unroll
            for (int r = 0; r < 4; ++r) { const int j = 16 * jt + 4 * g + r; const float Lj = __shfl(Lv, j); o[r] = (j <= 16 * it + l15) ? s[r] * __expf(Li - Lj) : 0.f; }
            v2u w; w.x = pk2(o[0], o[1]); w.y = pk2(o[2], o[3]);
            *(LAS v2u*)(lds + OFF_SD + (16 * it + l15) * VS + (16 * jt + 4 * g) * 2) = w;
        }
        f32x4 o2[2];
#pragma unroll
        for (int dd = 0; dd < 2; ++dd) {
            const int dt = 2 * hf + dd; f32x4 a = (f32x4){0.f, 0.f, 0.f, 0.f};
#pragma unroll
            for (int kk = 0; kk < NKS; ++kk) a = mfma16(qc[kk], ldrow(lds + OFF_ST + (16 * dt + l15) * KS + (8 * g + 32 * kk) * 2), a);
            o2[dd] = a;
        }
        __syncthreads();
        float ei[4];
#pragma unroll
        for (int r = 0; r < 4; ++r) ei[r] = __expf(__shfl(Lv, 16 * it + 4 * g + r));
#pragma unroll
        for (int dd = 0; dd < 2; ++dd) {
            const int dt = 2 * hf + dd; f32x4 a = (f32x4){0.f, 0.f, 0.f, 0.f};
#pragma unroll
            for (int kk = 0; kk < 2; ++kk)
                a = mfma16(ldrow(lds + OFF_SD + (16 * it + l15) * VS + (8 * g + 32 * kk) * 2), tr2(lds + OFF_VS + (32 * kk + 8 * g + q4) * VS + (16 * dt + 4 * p4) * 2, 4 * VS), a);
#pragma unroll
            for (int r = 0; r < 4; ++r) {
                const int i = 16 * it + 4 * g + r, col = 16 * dt + l15;
                float o = a[r] + o2[dd][r] * ei[r];
                bf16* op = Og + (size_t)(t0 + i) * opitch + col;
                if (SSD) { const float xs = __uint_as_float((unsigned)Vg[(size_t)(t0 + i) * pitch + col] << 16), z = __uint_as_float((unsigned)(*op) << 16); o = (o + Dskip * xs) * silu_f(z); }
                *op = (bf16)(pk2(o, 0.f) & 0xffffu);
            }
        }
        const float cd = __expf(Llast);
#pragma unroll
        for (int i = 0; i < NMT * 4; ++i) st[i] = st[i] * cd;
#pragma unroll
        for (int mm = 0; mm < NMT; ++mm) {
            const int mt = NMT * wave + mm;
#pragma unroll
            for (int kk = 0; kk < 2; ++kk) {
                const bf16x8 a = tr2(lds + OFF_K + (32 * kk + 8 * g + q4) * KS + (16 * mt + 4 * p4) * 2, 4 * KS);
#pragma unroll
                for (int dt = 0; dt < 4; ++dt) st[mm * 4 + dt] = mfma16(a, tr2(lds + OFF_VW + (32 * kk + 8 * g + q4) * VS + (16 * dt + 4 * p4) * 2, 4 * VS), st[mm * 4 + dt]);
            }
#pragma unroll
            for (int dt = 0; dt < 4; ++dt) { const f32x4 s = st[mm * 4 + dt]; v2u w; w.x = pk2(s[0], s[1]); w.y = pk2(s[2], s[3]);
                *(LAS v2u*)(lds + OFF_ST + (16 * dt + l15) * KS + (16 * mt + 4 * g) * 2) = w; }
        }
        __syncthreads();
    }
}

__device__ __forceinline__ void gnorm_rows(bf16* X, int pitch, const float* gain, int gw, int NGW, int lane) {
    asm volatile("" : "+v"(lane));
    for (int m0 = gw; m0 < T * 4; m0 += 4 * NGW) {
        v4u v[4];
#pragma unroll
        for (int q = 0; q < 4; ++q) { int m = m0 + q * NGW; m = m < T * 4 ? m : m0; v[q] = *((const v4u*)(X + (size_t)(m >> 2) * pitch + (m & 3) * 512) + lane); }
#pragma unroll
        for (int q = 0; q < 4; ++q) { const int m = m0 + q * NGW; if (m >= T * 4) break;
            const int row = m >> 2, gq = m & 3;
            float x[8] = {bf_lo(v[q].x), bf_hi(v[q].x), bf_lo(v[q].y), bf_hi(v[q].y), bf_lo(v[q].z), bf_hi(v[q].z), bf_lo(v[q].w), bf_hi(v[q].w)};
            float s = 0.f;
#pragma unroll
            for (int e = 0; e < 8; ++e) s += x[e] * x[e];
            const float rstd = rsqrtf(wave_sum(s) * (1.f / 512.f) + NORM_EPS);
            const f32x4 g0 = *(const f32x4*)(gain + gq * 512 + lane * 8), g1 = *(const f32x4*)(gain + gq * 512 + lane * 8 + 4);
            v4u o; o.x = pk2(x[0] * rstd * g0.x, x[1] * rstd * g0.y); o.y = pk2(x[2] * rstd * g0.z, x[3] * rstd * g0.w); o.z = pk2(x[4] * rstd * g1.x, x[5] * rstd * g1.y); o.w = pk2(x[6] * rstd * g1.z, x[7] * rstd * g1.w);
            *((v4u*)(X + (size_t)row * pitch + gq * 512) + lane) = o; }
    }
}
constexpr int SSD_PITCH = 5376, SSD_XBC0 = 2048, SSD_XBCW = 3072;
__device__ __forceinline__ void ssd_halo_save(const bf16* PROJ, bf16* HALO, int gtid, int GT) {
    asm volatile("" : "+v"(gtid));
    for (int idx = gtid; idx < 512 * 3 * 384; idx += GT) {
        const int c8 = idx % 384, r = (idx / 384) % 3, seg = idx / (3 * 384), t0 = seg * 64;
        v4u v = (v4u){0u, 0u, 0u, 0u};
        if ((t0 & 4095) != 0) v = *(const v4u*)(PROJ + (size_t)(t0 - 3 + r) * SSD_PITCH + SSD_XBC0 + c8 * 8);
        *(v4u*)(HALO + ((size_t)seg * 3 + r) * SSD_XBCW + c8 * 8) = v;
    }
}
__device__ __forceinline__ void unpack8(const v4u v, float (&x)[8]) { x[0] = bf_lo(v.x); x[1] = bf_hi(v.x); x[2] = bf_lo(v.y); x[3] = bf_hi(v.y); x[4] = bf_lo(v.z); x[5] = bf_hi(v.z); x[6] = bf_lo(v.w); x[7] = bf_hi(v.w); }
__device__ __forceinline__ void ssd_conv(bf16* PROJ, const bf16* HALO, const float* cw, const float* cb, int gtid, int GT) {
    asm volatile("" : "+v"(gtid));
    for (int idx = gtid; idx < 512 * 384; idx += GT) {
        const int c8 = idx % 384, seg = idx / 384, t0 = seg * 64;
        float w0[8], w1[8], w2[8], w3[8], bb[8], xa[8], xb[8], xc[8], xd[8];
#pragma unroll
        for (int e = 0; e < 8; ++e) { w0[e] = cw[c8 * 8 + e]; w1[e] = cw[SSD_XBCW + c8 * 8 + e]; w2[e] = cw[2 * SSD_XBCW + c8 * 8 + e]; w3[e] = cw[3 * SSD_XBCW + c8 * 8 + e]; bb[e] = cb[c8 * 8 + e]; }
        unpack8(*(const v4u*)(HALO + ((size_t)seg * 3 + 0) * SSD_XBCW + c8 * 8), xa);
        unpack8(*(const v4u*)(HALO + ((size_t)seg * 3 + 1) * SSD_XBCW + c8 * 8), xb);
        unpack8(*(const v4u*)(HALO + ((size_t)seg * 3 + 2) * SSD_XBCW + c8 * 8), xc);
        bf16* p = PROJ + (size_t)t0 * SSD_PITCH + SSD_XBC0 + c8 * 8;
        v4u nxt = *(const v4u*)p;
        for (int tt = 0; tt < 64; ++tt, p += SSD_PITCH) {
            unpack8(nxt, xd);
            if (tt + 1 < 64) nxt = *(const v4u*)(p + SSD_PITCH);
            float o[8];
#pragma unroll
            for (int e = 0; e < 8; ++e) { o[e] = silu_f(bb[e] + w0[e] * xa[e] + w1[e] * xb[e] + w2[e] * xc[e] + w3[e] * xd[e]); xa[e] = xb[e]; xb[e] = xc[e]; xc[e] = xd[e]; }
            v4u w; w.x = pk2(o[0], o[1]); w.y = pk2(o[2], o[3]); w.z = pk2(o[4], o[5]); w.w = pk2(o[6], o[7]);
            *(v4u*)p = w;
        }
    }
}
template <int DH> struct FaState { float m, l; f32x4 o[DH / 16]; };
template <int DH> __device__ __forceinline__ void fa_init(FaState<DH>& st) { st.m = -1e30f; st.l = 0.f;
#pragma unroll
    for (int i = 0; i < DH / 16; ++i) st.o[i] = (f32x4){0.f, 0.f, 0.f, 0.f}; }
__device__ __forceinline__ float fexp2(float x) { return __builtin_amdgcn_exp2f(x); }

__device__ __forceinline__ float gmax4(float x) {
    const auto r = __builtin_amdgcn_permlane16_swap(__float_as_uint(x), __float_as_uint(x), false, false);
    const float y = fmaxf(__uint_as_float(r[0]), __uint_as_float(r[1]));
    const auto r2 = __builtin_amdgcn_permlane32_swap(__float_as_uint(y), __float_as_uint(y), false, false);
    return fmaxf(__uint_as_float(r2[0]), __uint_as_float(r2[1]));
}
__device__ __forceinline__ float gsum4(float x) {
    const auto r = __builtin_amdgcn_permlane16_swap(__float_as_uint(x), __float_as_uint(x), false, false);
    const float y = __uint_as_float(r[0]) + __uint_as_float(r[1]);
    const auto r2 = __builtin_amdgcn_permlane32_swap(__float_as_uint(y), __float_as_uint(y), false, false);
    return __uint_as_float(r2[0]) + __uint_as_float(r2[1]);
}
template <int DH, class Mask>
__device__ __forceinline__ void fa_tile(const LAS unsigned char* Kt, const LAS unsigned char* Vt, const bf16x8 (&qf)[DH / 32], FaState<DH>& st, float sc2, const Mask& mk, int ti, int l15, int g, int q4, int p4) {
    constexpr int KS = (DH + 8) * 2;
    f32x4 s0 = (f32x4){0.f, 0.f, 0.f, 0.f}, s1 = s0;
#pragma unroll
    for (int kk = 0; kk < DH / 32; ++kk) {
        s0 = mfma16(ldrow(Kt + l15 * KS + (8 * g + 32 * kk) * 2), qf[kk], s0);
        s1 = mfma16(ldrow(Kt + (16 + l15) * KS + (8 * g + 32 * kk) * 2), qf[kk], s1);
    }
    float v[8]; float tm = -3.0e38f;
    const bool rok = mk.row_ok(ti);
    if (mk.need_check(ti)) {
        const int key0 = mk.key0(ti);
#pragma unroll
        for (int r = 0; r < 4; ++r) {
            v[r] = (rok && mk.valid(key0 + 4 * g + r)) ? s0[r] * sc2 : -3.0e38f; v[4 + r] = (rok && mk.valid(key0 + 16 + 4 * g + r)) ? s1[r] * sc2 : -3.0e38f;
        }
    } else {
#pragma unroll
        for (int r = 0; r < 4; ++r) { v[r] = rok ? s0[r] * sc2 : -3.0e38f; v[4 + r] = rok ? s1[r] * sc2 : -3.0e38f; }
    }
#pragma unroll
    for (int e = 0; e < 8; ++e) tm = fmaxf(tm, v[e]);
    tm = gmax4(tm);
    const float mn = fmaxf(st.m, tm), alpha = fexp2(st.m - mn);
    float p[8], ps = 0.f;
#pragma unroll
    for (int e = 0; e < 8; ++e) { p[e] = fexp2(v[e] - mn); ps += p[e]; }
    ps = gsum4(ps);
    st.l = st.l * alpha + ps; st.m = mn;
    v4u pbu; pbu.x = pk2(p[0], p[1]); pbu.y = pk2(p[2], p[3]); pbu.z = pk2(p[4], p[5]); pbu.w = pk2(p[6], p[7]);
    const bf16x8 pb = __builtin_bit_cast(bf16x8, pbu);
#pragma unroll
    for (int dt = 0; dt < DH / 16; ++dt) {
        const s16x4 a = ldtr(Vt + (4 * g + q4) * KS + (16 * dt + 4 * p4) * 2), b = ldtr(Vt + (16 + 4 * g + q4) * KS + (16 * dt + 4 * p4) * 2);
        st.o[dt] = mfma16((bf16x8){a[0], a[1], a[2], a[3], b[0], b[1], b[2], b[3]}, pb, st.o[dt] * alpha);
    }
}

template <int DH, int NSUB, class Mask>
__device__ __forceinline__ void fa_stage(const LAS unsigned char* Kb, const LAS unsigned char* Vb, const bf16x8 (&qf)[DH / 32], FaState<DH>& st, float sc2, const Mask& mk, int ti0, int t_end, int l15, int g, int q4, int p4) {
    constexpr int KS = (DH + 8) * 2, TB = 32 * KS;
    float v[NSUB][8]; bool act[NSUB]; float tm = -3.0e38f;
#pragma unroll
    for (int u = 0; u < NSUB; ++u) {
        const int ti = ti0 + u; act[u] = ti < t_end && mk.wave_needs(ti);
        if (act[u]) {
            const LAS unsigned char* Kt = Kb + u * TB;
            f32x4 s0 = (f32x4){0.f, 0.f, 0.f, 0.f}, s1 = s0;
#pragma unroll
            for (int kk = 0; kk < DH / 32; ++kk) {
                s0 = mfma16(ldrow(Kt + l15 * KS + (8 * g + 32 * kk) * 2), qf[kk], s0);
                s1 = mfma16(ldrow(Kt + (16 + l15) * KS + (8 * g + 32 * kk) * 2), qf[kk], s1);
            }
            const float rb = mk.row_ok(ti) ? 0.f : -3.0e38f;
            if (mk.need_check(ti)) {
                const int key0 = mk.key0(ti);
#pragma unroll
                for (int r = 0; r < 4; ++r) { v[u][r] = mk.valid(key0 + 4 * g + r) ? fmaf(s0[r], sc2, rb) : -3.0e38f; v[u][4 + r] = mk.valid(key0 + 16 + 4 * g + r) ? fmaf(s1[r], sc2, rb) : -3.0e38f; }
            } else {
#pragma unroll
                for (int r = 0; r < 4; ++r) { v[u][r] = fmaf(s0[r], sc2, rb); v[u][4 + r] = fmaf(s1[r], sc2, rb); }
            }
#pragma unroll
            for (int e = 0; e < 8; ++e) tm = fmaxf(tm, v[u][e]);
        } else {
#pragma unroll
            for (int e = 0; e < 8; ++e) v[u][e] = -3.0e38f;
        }
    }
    tm = gmax4(tm);
    const float mn = fmaxf(st.m, tm), alpha = fexp2(st.m - mn);
    float ps = 0.f;
#pragma unroll
    for (int u = 0; u < NSUB; ++u)
#pragma unroll
        for (int e = 0; e < 8; ++e) { v[u][e] = fexp2(v[u][e] - mn); ps += v[u][e]; }
    ps = gsum4(ps);
    st.l = st.l * alpha + ps; st.m = mn;
#pragma unroll
    for (int dt = 0; dt < DH / 16; ++dt) st.o[dt] = st.o[dt] * alpha;
#pragma unroll
    for (int u = 0; u < NSUB; ++u) {
        if (act[u]) {
            const LAS unsigned char* Vt = Vb + u * TB;
            v4u pbu; pbu.x = pk2(v[u][0], v[u][1]); pbu.y = pk2(v[u][2], v[u][3]); pbu.z = pk2(v[u][4], v[u][5]); pbu.w = pk2(v[u][6], v[u][7]);
            const bf16x8 pb = __builtin_bit_cast(bf16x8, pbu);
#pragma unroll
            for (int dt = 0; dt < DH / 16; ++dt) {
                const s16x4 a = ldtr(Vt + (4 * g + q4) * KS + (16 * dt + 4 * p4) * 2), b = ldtr(Vt + (16 + 4 * g + q4) * KS + (16 * dt + 4 * p4) * 2);
                st.o[dt] = mfma16((bf16x8){a[0], a[1], a[2], a[3], b[0], b[1], b[2], b[3]}, pb, st.o[dt]);
            }
        }
    }
}

template <int DH, int NSUB, class Src, class Mask>
__device__ __forceinline__ void fa_stream(LAS unsigned char* lds, int tid, int t_begin, int t_end, const Src& src, const Mask& mk, const bf16x8 (&qf)[DH / 32], FaState<DH>& st, float sc2) {
    constexpr int KS = (DH + 8) * 2, TB = 32 * KS, SB = NSUB * TB;
    if (t_begin >= t_end) return;
    const int lane = tid & 63, l15 = lane & 15, g = lane >> 4, q4 = l15 >> 2, p4 = l15 & 3;
    v4u rkA[NSUB], rvA[NSUB], rkB[NSUB], rvB[NSUB];
    int lj, lpc; bool isv = false;
    if constexpr (DH == 128) { lj = tid >> 4; lpc = tid & 15; } else { lj = (tid & 255) >> 3; lpc = tid & 7; isv = tid >= 256; }
    const int nst = (t_end - t_begin + NSUB - 1) / NSUB;
#define FA_ISSUE(k, RK, RV) do { _Pragma("unroll") for (int u = 0; u < NSUB; ++u) { int ti = t_begin + (k) * NSUB + u; ti = ti < t_end ? ti : t_end - 1; \
            const bf16* rp_ = src.krow(ti, lj) + lpc * 8; if constexpr (DH == 128) { RK[u] = *(const v4u*)rp_; RV[u] = *(const v4u*)(rp_ + src.voff); } \
            else { RK[u] = *(const v4u*)(rp_ + (isv ? src.voff : 0)); } } } while (0)
#define FA_COMMIT(buf, RK, RV) do { _Pragma("unroll") for (int u = 0; u < NSUB; ++u) { \
            if constexpr (DH == 128) { *(LAS v4u*)(lds + (buf) * SB + u * TB + lj * KS + lpc * 16) = RK[u]; *(LAS v4u*)(lds + (2 + (buf)) * SB + u * TB + lj * KS + lpc * 16) = RV[u]; } \
            else { *(LAS v4u*)(lds + ((isv ? 2 : 0) + (buf)) * SB + u * TB + lj * KS + lpc * 16) = RK[u]; } } } while (0)
    FA_ISSUE(0, rkA, rvA); FA_COMMIT(0, rkA, rvA);
    if (1 < nst) FA_ISSUE(1, rkB, rvB);
    __syncthreads();
    for (int k = 0; k < nst; k += 2) {
        if (k + 2 < nst) FA_ISSUE(k + 2, rkA, rvA);
        fa_stage<DH, NSUB, Mask>(lds, lds + 2 * SB, qf, st, sc2, mk, t_begin + k * NSUB, t_end, l15, g, q4, p4);
        if (k + 1 < nst) FA_COMMIT(1, rkB, rvB);
        __syncthreads();
        if (k + 1 >= nst) break;
        if (k + 3 < nst) FA_ISSUE(k + 3, rkB, rvB);
        fa_stage<DH, NSUB, Mask>(lds + SB, lds + 3 * SB, qf, st, sc2, mk, t_begin + (k + 1) * NSUB, t_end, l15, g, q4, p4);
        if (k + 2 < nst) FA_COMMIT(0, rkA, rvA);
        __syncthreads();
    }
#undef FA_ISSUE
#undef FA_COMMIT
}

constexpr int DIL_PITCH = 3072;
struct DilSrc { const bf16* kbase; int band0, r, c; static constexpr int voff = 1024;
    __device__ __forceinline__ const bf16* krow(int s, int j) const { int a = band0 + 32 * s + j; a = a < 0 ? 0 : a; return kbase + (size_t)(a * r + c) * DIL_PITCH; }
    __device__ __forceinline__ const bf16* vrow(int s, int j) const { return krow(s, j) + 1024; } };
struct DilMask { int aq, band0, w;
    __device__ __forceinline__ bool valid(int ak) const { return ak >= 0 && ak <= aq && aq - ak <= 128; }
    __device__ __forceinline__ bool row_ok(int) const { return true; }
    __device__ __forceinline__ bool need_check(int) const { return true; }
    __device__ __forceinline__ bool wave_needs(int s) const { return 32 * s + 31 >= 16 * w && 32 * s <= 16 * w + 143; }
    __device__ __forceinline__ int key0(int s) const { return band0 + 32 * s; } };

__device__ __forceinline__ void dilated_phase(LAS unsigned char* lds, const bf16* PROJD, bf16* OACC, float* LSE, int gi, int G, int wave_s) {
    int tid_ = wave_s * 64 + lane_id_now(); asm volatile("" : "+v"(tid_));
    const int tid = tid_, lane = tid & 63, wave = __builtin_amdgcn_readfirstlane(tid >> 6), l15 = lane & 15, g = lane >> 4;
    const int r = (gi == 0) ? 1 : (gi == 1 ? 4 : 16);
    const float sc2 = 0.08838834764831845f * 1.4426950408889634f;
    for (int item = blockIdx.x; item < 2048; item += G) {
        const int bh = item >> 5, b = bh >> 3, h = bh & 7, rem = item & 31, c = rem % r, qt = rem / r;
        const bf16* base = PROJD + (size_t)b * SEQ * DIL_PITCH + h * 128;
        const int aq = 128 * qt + 16 * wave + l15, tq = aq * r + c;
        bf16x8 qf[4];
#pragma unroll
        for (int kk = 0; kk < 4; ++kk) qf[kk] = *(const bf16x8*)(base + (size_t)tq * DIL_PITCH + 8 * g + 32 * kk);
        DilSrc src{base + 1024, 128 * qt - 128, r, c};
        DilMask mk{aq, 128 * qt - 128, wave};
        FaState<128> st; fa_init<128>(st);
        fa_stream<128, 2, DilSrc, DilMask>(lds, tid, qt == 0 ? 4 : 0, 8, src, mk, qf, st, sc2);
        const float inv = 1.f / fmaxf(st.l, 1e-30f);
        float lse = (st.m + __log2f(fmaxf(st.l, 1e-30f))) * 0.6931471805599453f;
        const size_t trow = (size_t)b * SEQ + tq;
        float wp = 0.f, wn = 1.f;
        if (gi > 0) { const float lp = LSE[trow * 8 + h]; const float mx = fmaxf(lp, lse); const float ep = __expf(lp - mx), en = __expf(lse - mx); const float den = ep + en; wp = ep / den; wn = en / den; lse = mx + __logf(den); }
        bf16* op = OACC + trow * 1024 + h * 128 + 4 * g;
#pragma unroll
        for (int dt = 0; dt < 8; ++dt) {
            f32x4 o = st.o[dt] * (inv * wn);
            if (gi > 0) { const v2u old = *(const v2u*)(op + 16 * dt); o[0] += wp * bf_lo(old.x); o[1] += wp * bf_hi(old.x); o[2] += wp * bf_lo(old.y); o[3] += wp * bf_hi(old.y); }
            v2u w; w.x = pk2(o[0], o[1]); w.y = pk2(o[2], o[3]);
            *(v2u*)(op + 16 * dt) = w;
        }
        if (g == 0) LSE[trow * 8 + h] = lse;
    }
}
constexpr int NSA_PITCH = 2816;
__device__ __forceinline__ void nsa_im2col(const bf16* PROJN, const float* pos, bf16* ACMP, int gtid, int GT) {
    asm volatile("" : "+v"(gtid));
    for (int idx = gtid; idx < 2 * 8192 * 256; idx += GT) {
        const int pc = idx & 255, row = (idx >> 8) & 8191, kv = idx >> 21;
        const int l = pc >> 3, d0 = (pc & 7) * 8, n = row & 255, bg = row >> 8, b = bg >> 2, gq = bg & 3;
        v4u o = (v4u){0u, 0u, 0u, 0u};
        if (n < 255) {
            const v4u v = *(const v4u*)(PROJN + (size_t)(b * SEQ + 16 * n + l) * NSA_PITCH + 1024 + kv * 256 + gq * 64 + d0);
            const f32x4 p0 = *(const f32x4*)(pos + kv * 2048 + l * 64 + d0), p1 = *(const f32x4*)(pos + kv * 2048 + l * 64 + d0 + 4);
            o.x = pk2(bf_lo(v.x) + p0.x, bf_hi(v.x) + p0.y); o.y = pk2(bf_lo(v.y) + p0.z, bf_hi(v.y) + p0.w);
            o.z = pk2(bf_lo(v.z) + p1.x, bf_hi(v.z) + p1.y); o.w = pk2(bf_lo(v.w) + p1.z, bf_hi(v.w) + p1.w);
        }
        *(v4u*)(ACMP + ((size_t)kv * 8192 + row) * 2048 + pc * 8) = o;
    }
}
struct TokSrc { const bf16* kbase; const LAS int* list; static constexpr int voff = 256;
    __device__ __forceinline__ int tile(int s) const { return list ? list[s] : s; }
    __device__ __forceinline__ const bf16* krow(int s, int j) const { return kbase + (size_t)(32 * tile(s) + j) * NSA_PITCH; }
};
struct SelMask { unsigned lo, hi, wlo, whi; int t, qb; const LAS int* list;
    __device__ __forceinline__ bool row_ok(int ti) const { const int jb = list[ti] >> 1; return ((jb < 32) ? (lo >> jb) & 1u : (hi >> (jb - 32)) & 1u) != 0u; }
    __device__ __forceinline__ bool need_check(int ti) const { return list[ti] == qb; }
    __device__ __forceinline__ bool valid(int tok) const { return tok <= t; }
    __device__ __forceinline__ bool wave_needs(int ti) const { const int jb = list[ti] >> 1; return ((jb < 32) ? (wlo >> jb) & 1u : (whi >> (jb - 32)) & 1u) != 0u; }
    __device__ __forceinline__ int key0(int ti) const { return 32 * list[ti]; } };
struct WinMask { int t, qb, sb;
    __device__ __forceinline__ bool row_ok(int) const { return true; }
    __device__ __forceinline__ bool need_check(int ti) const { return ti == qb || ti == sb; }
    __device__ __forceinline__ bool valid(int tok) const { return tok <= t && tok > t - 512; }
    __device__ __forceinline__ bool wave_needs(int) const { return true; }
    __device__ __forceinline__ int key0(int ti) const { return 32 * ti; } };

__device__ __forceinline__ void nsa_phase(LAS unsigned char* lds, const bf16* PROJN, const bf16* KVC, bf16* ONSA, int G, int wave_s, unsigned long long* pc_) {
#define NSA_STAMP(sec) do { if (PROBE_MASK != 0 && blockIdx.x == 0 && threadIdx.x == 0) { const unsigned long long now_ = __builtin_amdgcn_s_memrealtime(); if ((PROBE_MASK >> (8 + (sec))) & 1) pc_[1] += now_ - pc_[0]; pc_[0] = now_; } } while (0)
    constexpr int KS = 144, OFF_KC = 0, OFF_VC = OFF_KC + 256 * KS, OFF_IMP = OFF_VC + 256 * KS, OFF_SEL = OFF_IMP + 32 * 256 * 4, OFF_UNI = OFF_SEL + 256, OFF_TL = OFF_UNI + 64, OFF_NT = OFF_TL + 512;
    int tid_ = wave_s * 64 + lane_id_now(); asm volatile("" : "+v"(tid_));
    const int tid = tid_, lane = tid & 63, wave = __builtin_amdgcn_readfirstlane(tid >> 6), l15 = lane & 15, g = lane >> 4, q4 = l15 >> 2, p4 = l15 & 3;
    const float sc2 = 0.125f * 1.4426950408889634f;
    LAS float* IMP = (LAS float*)(lds + OFF_IMP);
    LAS unsigned* SEL = (LAS unsigned*)(lds + OFF_SEL);
    LAS unsigned* UNI = (LAS unsigned*)(lds + OFF_UNI);
    LAS int* TL = (LAS int*)(lds + OFF_TL);
    LAS int* NT = (LAS int*)(lds + OFF_NT);
    for (int item = blockIdx.x; item < 4096; item += G) {
        const int bg = item >> 7, qb = ((bg >> 1) & 1) ? 127 - (item & 127) : (item & 127), b = bg >> 2, gq = bg & 3, t0 = 32 * qb, cur = t0 >> 6;
        const int ql = 4 * wave + q4, hp = p4, t = t0 + ql;
        const bf16* prow = PROJN + (size_t)b * SEQ * NSA_PITCH;
        bf16x8 qf[2];
#pragma unroll
        for (int kk = 0; kk < 2; ++kk) qf[kk] = *(const bf16x8*)(prow + (size_t)t * NSA_PITCH + gq * 256 + hp * 64 + 8 * g + 32 * kk);
        int ncv = (t0 >> 4) + 1; ncv = ncv > 255 ? 255 : ncv; const int ntc = (ncv + 31) >> 5;
        {
            v4u tmp[8];
            const unsigned nrow = (unsigned)tid >> 3, boff = ((unsigned)bg * 256u + nrow) * 256u + ((unsigned)tid & 7u) * 8u;
#pragma unroll
            for (int u = 0; u < 8; ++u) if ((int)nrow + 64 * (u & 3) < 32 * ntc) tmp[u] = *(const v4u*)(KVC + boff + (unsigned)(u & 3) * 16384u + (unsigned)(u >> 2) * 2097152u);
#pragma unroll
            for (int u = 0; u < 8; ++u) if ((int)nrow + 64 * (u & 3) < 32 * ntc) *(LAS v4u*)(lds + ((u >> 2) ? OFF_VC : OFF_KC) + ((int)nrow + 64 * (u & 3)) * KS + (tid & 7) * 16) = tmp[u];
        }
        __syncthreads();
        f32x4 oc[4];
#pragma unroll
        for (int i = 0; i < 4; ++i) oc[i] = (f32x4){0.f, 0.f, 0.f, 0.f};
        {
            f32x4 sc[8][2]; float mx = -1e30f;
#pragma unroll
            for (int s = 0; s < 8; ++s) {
                sc[s][0] = (f32x4){-1e30f, -1e30f, -1e30f, -1e30f}; sc[s][1] = sc[s][0];
                if (s < ntc) {
                    f32x4 a0 = (f32x4){0.f, 0.f, 0.f, 0.f}, a1 = a0;
#pragma unroll
                    for (int kk = 0; kk < 2; ++kk) {
                        a0 = mfma16(ldrow(lds + OFF_KC + (32 * s + l15) * KS + (8 * g + 32 * kk) * 2), qf[kk], a0);
                        a1 = mfma16(ldrow(lds + OFF_KC + (32 * s + 16 + l15) * KS + (8 * g + 32 * kk) * 2), qf[kk], a1);
                    }
#pragma unroll
                    for (int r = 0; r < 4; ++r) {
                        const int n0 = 32 * s + 4 * g + r, n1 = n0 + 16;
                        sc[s][0][r] = (16 * n0 + 31 <= t && n0 < 255) ? a0[r] * sc2 : -1e30f;
                        sc[s][1][r] = (16 * n1 + 31 <= t && n1 < 255) ? a1[r] * sc2 : -1e30f;
                        mx = fmaxf(mx, fmaxf(sc[s][0][r], sc[s][1][r]));
                    }
                }
            }
            mx = gmax4(mx);
            float sum = 0.f;
#pragma unroll
            for (int s = 0; s < 8; ++s)
#pragma unroll
                for (int e = 0; e < 2; ++e)
#pragma unroll
                    for (int r = 0; r < 4; ++r) { const float p = (sc[s][e][r] > -5e29f) ? fexp2(sc[s][e][r] - mx) : 0.f; sc[s][e][r] = p; sum += p; }
            sum = gsum4(sum);
            const float inv = 1.f / fmaxf(sum, 1e-30f);
#pragma unroll
            for (int s = 0; s < 8; ++s) {
                float p[8];
#pragma unroll
                for (int r = 0; r < 4; ++r) { p[r] = sc[s][0][r] * inv; p[4 + r] = sc[s][1][r] * inv; }
#pragma unroll
                for (int e = 0; e < 8; ++e) { float x = p[e]; x += __int_as_float(__builtin_amdgcn_update_dpp(0, __float_as_int(x), 0xB1, 0xf, 0xf, false)); x += __int_as_float(__builtin_amdgcn_update_dpp(0, __float_as_int(x), 0x4E, 0xf, 0xf, false));
                    if (hp == 0) IMP[ql * 256 + 32 * s + 16 * (e >> 2) + 4 * g + (e & 3)] = x; }
                if (s < ntc) {
                    v4u pbu; pbu.x = pk2(p[0], p[1]); pbu.y = pk2(p[2], p[3]); pbu.z = pk2(p[4], p[5]); pbu.w = pk2(p[6], p[7]);
                    const bf16x8 pb = __builtin_bit_cast(bf16x8, pbu);
#pragma unroll
                    for (int dt = 0; dt < 4; ++dt) {
                        const s16x4 a = ldtr(lds + OFF_VC + (32 * s + 4 * g + q4) * KS + (16 * dt + 4 * p4) * 2), bb = ldtr(lds + OFF_VC + (32 * s + 16 + 4 * g + q4) * KS + (16 * dt + 4 * p4) * 2);
                        oc[dt] = mfma16((bf16x8){a[0], a[1], a[2], a[3], bb[0], bb[1], bb[2], bb[3]}, pb, oc[dt]);
                    }
                }
            }
        }
        unsigned ocp[8];
#pragma unroll
        for (int dt = 0; dt < 4; ++dt) { ocp[2 * dt] = pk2(oc[dt][0], oc[dt][1]); ocp[2 * dt + 1] = pk2(oc[dt][2], oc[dt][3]); }
        __syncthreads();
        NSA_STAMP(0);
        {
            unsigned ulo = 0u, uhi = 0u;
            for (int qi = 0; qi < 4; ++qi) {
                const int qq = 4 * wave + qi, jb = lane;
                const LAS float* ip = IMP + qq * 256 + 4 * jb;
                const float pm1 = (jb > 0) ? ip[-1] : 0.f;
                const float imp_sel = pm1 + 2.f * (ip[0] + ip[1] + ip[2]) + ip[3];
                const bool forced = (jb == 0) || (jb == cur) || (jb == cur - 1);
                const float score = (jb <= cur) ? imp_sel + (forced ? 1e4f : 0.f) : -1e30f;
                int rank = 0;
                for (int j = 0; j < 64; ++j) { const float sj = __uint_as_float((unsigned)__builtin_amdgcn_readlane((int)__float_as_uint(score), j)); rank += (sj > score || (sj == score && j < jb)) ? 1 : 0; }
                const bool sel = rank < 16 && score > -5e29f;
                const unsigned long long mask = __ballot(sel);
                if (lane == 0) { SEL[2 * qq] = (unsigned)mask; SEL[2 * qq + 1] = (unsigned)(mask >> 32); }
                ulo |= (unsigned)mask; uhi |= (unsigned)(mask >> 32);
            }
            if (lane == 0) { UNI[2 * wave] = ulo; UNI[2 * wave + 1] = uhi; }
        }
        __syncthreads();
        if (wave == 0) {
            unsigned ulo = 0u, uhi = 0u;
            for (int w = 0; w < 8; ++w) { ulo |= UNI[2 * w]; uhi |= UNI[2 * w + 1]; }
            int cnt = 0;
            for (int half = 0; half < 2; ++half) {
                const int s = lane + 64 * half, jb = s >> 1; const unsigned bit = (jb < 32) ? (ulo >> jb) & 1u : (uhi >> (jb - 32)) & 1u;
                const bool need = (s <= qb) && bit != 0u;
                const unsigned long long m = __ballot(need);
                const int pos = cnt + __popcll(m & ((1ull << lane) - 1ull));
                if (need) TL[pos] = s;
                cnt += __popcll(m);
            }
            if (lane == 0) NT[0] = cnt;
        }
        __syncthreads();
        const int nts = NT[0];
        NSA_STAMP(1);
        FaState<64> ss; fa_init<64>(ss);
        {
            TokSrc src{prow + 1536 + gq * 64, TL};
            SelMask mk{SEL[2 * ql], SEL[2 * ql + 1], (unsigned)__builtin_amdgcn_readfirstlane((int)UNI[2 * wave]), (unsigned)__builtin_amdgcn_readfirstlane((int)UNI[2 * wave + 1]), t, qb, TL};
            fa_stream<64, 4, TokSrc, SelMask>(lds, tid, 0, nts, src, mk, qf, ss, sc2);
        }
        unsigned osp[8]; float isl = 1.f / fmaxf(ss.l, 1e-30f);
#pragma unroll
        for (int dt = 0; dt < 4; ++dt) { osp[2 * dt] = pk2(ss.o[dt][0] * isl, ss.o[dt][1] * isl); osp[2 * dt + 1] = pk2(ss.o[dt][2] * isl, ss.o[dt][3] * isl); }
        NSA_STAMP(2);
        FaState<64> sw; fa_init<64>(sw);
        {
            TokSrc src{prow + 2048 + gq * 64, nullptr};
            const int sb = (t0 - 512) < 0 ? 0 : (t0 - 512) >> 5;
            WinMask mk{t, qb, sb};
            fa_stream<64, 4, TokSrc, WinMask>(lds, tid, sb, qb + 1, src, mk, qf, sw, sc2);
        }
        NSA_STAMP(3);
        {
            const bf16* gp = prow + (size_t)t * NSA_PITCH + 2560 + gq * 4 + hp;
            const float g0 = sigmoid_f(__uint_as_float((unsigned)gp[0] << 16)), g1 = sigmoid_f(__uint_as_float((unsigned)gp[16] << 16)), g2 = sigmoid_f(__uint_as_float((unsigned)gp[32] << 16));
            const float iw = g2 / fmaxf(sw.l, 1e-30f);
            bf16* op = ONSA + ((size_t)b * SEQ + t) * 1024 + gq * 256 + hp * 64 + 4 * g;
#pragma unroll
            for (int dt = 0; dt < 4; ++dt) {
                f32x4 o = sw.o[dt] * iw;
                o[0] += g0 * bf_lo(ocp[2 * dt]) + g1 * bf_lo(osp[2 * dt]); o[1] += g0 * bf_hi(ocp[2 * dt]) + g1 * bf_hi(osp[2 * dt]);
                o[2] += g0 * bf_lo(ocp[2 * dt + 1]) + g1 * bf_lo(osp[2 * dt + 1]); o[3] += g0 * bf_hi(ocp[2 * dt + 1]) + g1 * bf_hi(osp[2 * dt + 1]);
                v2u w; w.x = pk2(o[0], o[1]); w.y = pk2(o[2], o[3]); *(v2u*)(op + 16 * dt) = w; }
        }
        __syncthreads();
        NSA_STAMP(4);
    }
}
#ifndef RET_SCAN
#define RET_SCAN 1
#define RET_GNORM 1
#define RET_GATE 1
#endif
#ifndef ENABLE_SSD
#define ENABLE_SSD 1
#endif
constexpr size_t WS_DTRAW = WS_SCR + 340 * MiB, WS_HALO = WS_SCR + 344 * MiB;
#define MIXER_CONVERT \
    if (mix == 1) { transpose_w<0>(args.in[12], D, 2608, 2816, WMIX, scr, gw, NGW, lane); \
        for (int c = 0; c < 2; ++c) { transpose_w<0>(args.in[14] + (size_t)c * 2048 * 256, 2048, 256, 256, WMIX + 3 * MiB + (size_t)c * 256 * 2048, scr, gw, NGW, lane); \
            transpose_w<0>(args.in[15] + (size_t)c * 256 * 64, 256, 64, 256, WMIX + 4 * MiB + (size_t)c * 256 * 256, scr, gw, NGW, lane); } \
        transpose_w<0>(args.in[16], D, D, D, WMIX + 5 * MiB, scr, gw, NGW, lane); } \
    if (mix == 3) { transpose_w<0>(args.in[25], D, 9216, 9216, WMIX, scr, gw, NGW, lane); transpose_w<0>(args.in[26], D, D, D, WMIX + (size_t)9216 * 1024, scr, gw, NGW, lane); } \
    if (mix == 0) { transpose_w<0>(args.in[9], D, 6144, 6144, WMIX, scr, gw, NGW, lane); transpose_w<0>(args.in[11], 2048, D, D, WMIX + (size_t)6144 * 1024, scr, gw, NGW, lane); } \
    if (mix == 2) { transpose_w<0>(args.in[17], D, 5152, 5376, WMIX, scr, gw, NGW, lane); transpose_w<0>(args.in[24], 2048, D, D, WMIX + (size_t)6144 * 1024, scr, gw, NGW, lane); }

#define MIXER_PHASES \
    if (mix == 0) { \
        bf16* PROJ = (bf16*)(ws + WS_SCR); \
        PHASE_BEGIN { pg8::Epi<pg8::EPI_RETQKV> E{}; E.O = PROJ; E.ldc = 4096; E.rot = ROT; run_gemm<pg8::EPI_RETQKV>(lds, U, D, WMIX, T, 4096, D, E, wave_s); } PHASE_END_C(3) \
        if (RET_SCAN) PHASE_BEGIN \
            for (int item = blockIdx.x; item < 256; item += G) { \
                const int b = item >> 5, h = (item >> 3) & 3, s8 = item & 7; \
                bf16* base = PROJ + (size_t)b * SEQ * 4096; \
                scan_item<256, false>(lds, base + h * 256, base + 1024 + h * 256, base + 2048 + h * 512 + s8 * 64, 4096, base + 2048 + h * 512 + s8 * 64, 4096, log1pf(-exp2f(-5.f - (float)h)), nullptr, 0.f, 0.f, 0.f, wave_s); \
                __syncthreads(); \
            } \
        PHASE_END_C(4) \
        if (RET_GNORM) PHASE_BEGIN gnorm_rows(PROJ + 2048, 4096, args.in[10], gw, NGW, lane); PHASE_END_C(7) \
        if (RET_GATE) PHASE_BEGIN { pg8::Epi<pg8::EPI_GATEMUL> E{}; E.O = PROJ + 2048; E.ldc = 4096; run_gemm<pg8::EPI_GATEMUL>(lds, U, D, WMIX + (size_t)4096 * 1024, T, 2048, D, E, wave_s); } PHASE_END_C(3) \
        PHASE_BEGIN { pg8::Epi<pg8::EPI_RESID> E{}; E.Hout = H; E.Hbase = H; E.scale = 1.0f; E.ldc = D; run_gemm<pg8::EPI_RESID>(lds, PROJ + 2048, 4096, WMIX + (size_t)6144 * 1024, T, D, 2048, E, wave_s); } PHASE_END_C(3) \
    } \
    if (mix == 2 && ENABLE_SSD) { \
        bf16* PROJ = (bf16*)(ws + WS_SCR); float* DTRAW = (float*)(ws + WS_DTRAW); bf16* HALO = (bf16*)(ws + WS_HALO); \
        PHASE_BEGIN { pg8::Epi<pg8::EPI_SSD> E{}; E.O = PROJ; E.ldc = SSD_PITCH; E.aux = DTRAW; run_gemm<pg8::EPI_SSD>(lds, U, D, WMIX, T, SSD_PITCH, D, E, wave_s); } PHASE_END_C(3) \
        PHASE_BEGIN ssd_halo_save(PROJ, HALO, blockIdx.x * NTHR + tid, G * NTHR); PHASE_END_C(7) \
        PHASE_BEGIN ssd_conv(PROJ, HALO, args.in[18], args.in[19], blockIdx.x * NTHR + tid, G * NTHR); PHASE_END_C(7) \
        PHASE_BEGIN \
            for (int item = blockIdx.x; item < 256; item += G) { \
                const int b = item >> 5, gq = (item >> 3) & 3, r = item & 7, hd = gq * 8 + r; \
                bf16* base = PROJ + (size_t)b * SEQ * SSD_PITCH; \
                scan_item<128, true>(lds, base + 4608 + gq * 128, base + 4096 + gq * 128, base + 2048 + gq * 512 + r * 64, SSD_PITCH, base + gq * 512 + r * 64, SSD_PITCH, 0.f, \
                                     DTRAW + (size_t)b * SEQ * 32 + hd, args.in[20][hd], -__expf(args.in[21][hd]), args.in[22][hd], wave_s); \
                __syncthreads(); \
            } \
        PHASE_END_C(4) \
        PHASE_BEGIN gnorm_rows(PROJ, SSD_PITCH, args.in[23], gw, NGW, lane); PHASE_END_C(7) \
        PHASE_BEGIN { pg8::Epi<pg8::EPI_RESID> E{}; E.Hout = H; E.Hbase = H; E.scale = 1.0f; E.ldc = D; run_gemm<pg8::EPI_RESID>(lds, PROJ, SSD_PITCH, WMIX + (size_t)6144 * 1024, T, D, 2048, E, wave_s); } PHASE_END_C(3) \
    } \
    if (mix == 3) { \
        bf16* PROJD = (bf16*)(ws + WS_SCR); bf16* OACC = (bf16*)(ws + WS_SCR + 192 * MiB); float* LSE = (float*)(ws + WS_SCR + 256 * MiB); \
        for (int gi = 0; gi < 3; ++gi) { \
            PHASE_BEGIN { pg8::Epi<pg8::EPI_BF16> E{}; E.O = PROJD; E.ldc = DIL_PITCH; run_gemm<pg8::EPI_BF16>(lds, U, D, WMIX + (size_t)gi * 3072 * 1024, T, 3072, D, E, wave_s); } PHASE_END_C(3) \
            PHASE_BEGIN dilated_phase(lds, PROJD, OACC, LSE, gi, G, wave_s); PHASE_END_C(6) \
        } \
        PHASE_BEGIN { pg8::Epi<pg8::EPI_RESID> E{}; E.Hout = H; E.Hbase = H; E.scale = 1.0f; E.ldc = D; run_gemm<pg8::EPI_RESID>(lds, OACC, D, WMIX + (size_t)9216 * 1024, T, D, D, E, wave_s); } PHASE_END_C(3) \
    } \
    if (mix == 1) { \
        bf16* PROJN = (bf16*)(ws + WS_SCR); bf16* ACMP = (bf16*)(ws + WS_SCR + 176 * MiB); bf16* HIDC = (bf16*)(ws + WS_SCR + 240 * MiB); bf16* KVC = (bf16*)(ws + WS_SCR + 248 * MiB); bf16* ONSA = (bf16*)(ws + WS_SCR + 256 * MiB); \
        PHASE_BEGIN { pg8::Epi<pg8::EPI_BF16> E{}; E.O = PROJN; E.ldc = NSA_PITCH; run_gemm<pg8::EPI_BF16>(lds, U, D, WMIX, T, NSA_PITCH, D, E, wave_s); } PHASE_END_C(3) \
        PHASE_BEGIN nsa_im2col(PROJN, args.in[13], ACMP, blockIdx.x * NTHR + tid, G * NTHR); PHASE_END_C(7) \
        PHASE_BEGIN for (int c = 0; c < 2; ++c) { pg8::Epi<pg8::EPI_SILU> E{}; E.O = HIDC + (size_t)c * 8192 * 256; E.ldc = 256; run_gemm<pg8::EPI_SILU>(lds, ACMP + (size_t)c * 8192 * 2048, 2048, WMIX + 3 * MiB + (size_t)c * 256 * 2048, 8192, 256, 2048, E, wave_s); } PHASE_END_C(3) \
        PHASE_BEGIN for (int c = 0; c < 2; ++c) { pg8::Epi<pg8::EPI_BF16> E{}; E.O = KVC + (size_t)c * 8192 * 256; E.ldc = 256; run_gemm<pg8::EPI_BF16>(lds, HIDC + (size_t)c * 8192 * 256, 256, WMIX + 4 * MiB + (size_t)c * 256 * 256, 8192, 256, 256, E, wave_s); } PHASE_END_C(3) \
        PHASE_BEGIN nsa_phase(lds, PROJN, KVC, ONSA, G, wave_s, (unsigned long long*)(args.ws + 32768)); PHASE_END_C(5) \
        PHASE_BEGIN { pg8::Epi<pg8::EPI_RESID> E{}; E.Hout = H; E.Hbase = H; E.scale = 1.0f; E.ldc = D; run_gemm<pg8::EPI_RESID>(lds, ONSA, D, WMIX + 5 * MiB, T, D, D, E, wave_s); } PHASE_END_C(3) \
    }
__global__ void __launch_bounds__(NTHR, 2) fwd_megakernel(Args args) {
    extern __shared__ __attribute__((aligned(16))) unsigned char lds_raw[];
    LAS unsigned char* lds = (LAS unsigned char*)lds_raw;
    cg::grid_group grid = cg::this_grid();
    const int G = gridDim.x;
    const int wave_s = __builtin_amdgcn_readfirstlane(threadIdx.x >> 6);
    volatile LAS unsigned* xst = (volatile LAS unsigned*)(lds + LDS_BYTES - 64);
    if (threadIdx.x < 16) xst[threadIdx.x] = 0u;
    __syncthreads();
    const XcdBarrier xbar = xcd_barrier_post((unsigned*)args.ws, xst);
    grid.sync();
    if (PROBE_MASK != 0 && blockIdx.x == 0 && threadIdx.x == 0) { ((unsigned long long*)(args.ws + 32768))[0] = __builtin_amdgcn_s_memrealtime(); }
#define PHASE_BEGIN {
#define PHASE_END_C(cat) xcd_barrier(xbar); if (PROBE_MASK != 0 && blockIdx.x == 0 && threadIdx.x == 0) { const unsigned long long now_ = __builtin_amdgcn_s_memrealtime(); unsigned long long* c_ = (unsigned long long*)(args.ws + 32768); if ((PROBE_MASK >> (cat)) & 1) c_[1] += now_ - c_[0]; c_[0] = now_; } }
    for (int L = 0; L < DEPTH; ++L) {
        const int mix = L & 3;
        int tid_ = wave_s * 64 + lane_id_now(); asm volatile("" : "+v"(tid_));
        const int tid = tid_, lane = tid & 63, wave = __builtin_amdgcn_readfirstlane(tid >> 6);
        const int gw = blockIdx.x * NWAVES + wave, NGW = G * NWAVES;
        unsigned char* ws = args.ws; asm volatile("" : "+s"(ws));
        float* H = args.out; asm volatile("" : "+s"(H));
        float* ROT = (float*)(ws + WS_ROT);
        bf16* WIN1 = (bf16*)(ws + WS_WIN1); bf16* WOUT1 = (bf16*)(ws + WS_WOUT1); bf16* WIN2 = (bf16*)(ws + WS_WIN2); bf16* WOUT2 = (bf16*)(ws + WS_WOUT2); bf16* WMIX = (bf16*)(ws + WS_WMIX);
        bf16* U = (bf16*)(ws + WS_U); bf16* HID = (bf16*)(ws + WS_SCR);
        LAS float* scr = (LAS float*)(lds + wave * 16384);
        PHASE_BEGIN
            transpose_w<1>(args.in[2] + (size_t)L * D * 2 * FF, D, 2 * FF, 2 * FF, WIN1, scr, gw, NGW, lane);
            transpose_w<0>(args.in[3] + (size_t)L * FF * D, FF, D, D, WOUT1, scr, gw, NGW, lane);
            transpose_w<1>(args.in[6] + (size_t)L * D * 2 * FF, D, 2 * FF, 2 * FF, WIN2, scr, gw, NGW, lane);
            transpose_w<0>(args.in[7] + (size_t)L * FF * D, FF, D, D, WOUT2, scr, gw, NGW, lane);
            MIXER_CONVERT
            if (L == 0) {
                for (int i = blockIdx.x * NTHR + tid; i < 4096 * 128; i += G * NTHR) {
                    const int pos = i >> 7, d = i & 127;
                    const float inv = exp2f(-(float)d * (13.287712379549449f / 128.f));
                    const float ang = (float)pos * inv;
                    const double x = (double)ang * 0.15915494309189535; const float fr = (float)(x - rint(x));
                    ROT[i] = __builtin_amdgcn_cosf(fr); ROT[4096 * 128 + i] = __builtin_amdgcn_sinf(fr);
                }
            }
            rms_rows(L == 0 ? args.in[0] : H, args.in[1] + L * D, U, nullptr, gw, NGW, lane);
        PHASE_END_C(0)
        PHASE_BEGIN { pg8::Epi<pg8::EPI_SWIGLU> E{}; E.O = HID; E.ldc = FF; run_gemm<pg8::EPI_SWIGLU>(lds, U, D, WIN1, T, 2 * FF, D, E, wave_s); } PHASE_END_C(1)
        PHASE_BEGIN { pg8::Epi<pg8::EPI_RESID> E{}; E.Hout = H; E.Hbase = (L == 0) ? args.in[0] : H; E.scale = 0.5f; E.ldc = D; run_gemm<pg8::EPI_RESID>(lds, HID, FF, WOUT1, T, D, FF, E, wave_s); } PHASE_END_C(1)
        PHASE_BEGIN rms_rows(H, args.in[4] + L * D, U, nullptr, gw, NGW, lane); PHASE_END_C(2)
        MIXER_PHASES
        PHASE_BEGIN rms_rows(H, args.in[5] + L * D, U, nullptr, gw, NGW, lane); PHASE_END_C(2)
        PHASE_BEGIN { pg8::Epi<pg8::EPI_SWIGLU> E{}; E.O = HID; E.ldc = FF; run_gemm<pg8::EPI_SWIGLU>(lds, U, D, WIN2, T, 2 * FF, D, E, wave_s); } PHASE_END_C(1)
        PHASE_BEGIN { pg8::Epi<pg8::EPI_RESID> E{}; E.Hout = H; E.Hbase = H; E.scale = 0.5f; E.ldc = D; run_gemm<pg8::EPI_RESID>(lds, HID, FF, WOUT2, T, D, FF, E, wave_s); } PHASE_END_C(1)
    }
    int nprobe = 0; if (PROBE_MASK != 0) { asm volatile("s_waitcnt vmcnt(0)" ::: "memory"); xcd_barrier(xbar); nprobe = (int)(__hip_atomic_load((unsigned long long*)(args.ws + 32768) + 1, __ATOMIC_RELAXED, __HIP_MEMORY_SCOPE_AGENT) >> 3); }
    { const int lane = lane_id_now(); rms_final(args.out, args.in[8], blockIdx.x * NWAVES + wave_s, G * NWAVES, lane, nprobe); }
}

extern "C" void kernel_launch(void* const* d_in, const int* in_sizes, int n_in, void* d_out, int out_size, void* d_ws, size_t ws_size, hipStream_t stream) {
    static int grid = 0;
    if (grid == 0) {
        if (n_in != 27 || out_size != T * D || ws_size < WS_NEED) { fprintf(stderr, "kernel_launch: unexpected problem (n_in %d, out %d, ws %zu)\n", n_in, out_size, ws_size); grid = -1; return; }
        int dev = 0, cus = 0, per_cu = 0;
        hipGetDevice(&dev); hipDeviceGetAttribute(&cus, hipDeviceAttributeMultiprocessorCount, dev);
        if (hipFuncSetAttribute((const void*)fwd_megakernel, hipFuncAttributeMaxDynamicSharedMemorySize, LDS_BYTES) != hipSuccess) { fprintf(stderr, "kernel_launch: hipFuncSetAttribute failed\n"); grid = -1; return; }
        if (hipOccupancyMaxActiveBlocksPerMultiprocessor(&per_cu, (const void*)fwd_megakernel, NTHR, LDS_BYTES) != hipSuccess || per_cu < 1) { fprintf(stderr, "kernel_launch: occupancy query gave %d\n", per_cu); per_cu = 1; }
        (void)hipGetLastError();
        grid = cus * 1;
    }
    if (grid < 0) return;
    if (hipMemsetAsync(d_ws, 0, 65536, stream) != hipSuccess) { fprintf(stderr, "kernel_launch: memset failed\n"); return; }
    Args a{};
    for (int i = 0; i < 27; ++i) a.in[i] = (const float*)d_in[i];
    a.out = (float*)d_out; a.ws = (unsigned char*)d_ws; a.ph_lo = 0; a.ph_hi = 1 << 20;
    void* kargs[] = {&a};
    hipError_t e = hipLaunchCooperativeKernel((const void*)fwd_megakernel, dim3(grid), dim3(NTHR), kargs, LDS_BYTES, stream);
    if (e != hipSuccess) fprintf(stderr, "kernel_launch: cooperative launch failed: %s (grid %d)\n", hipGetErrorString(e), grid);
}
```

```cpp
#include <hip/hip_runtime.h>
#include <hip/hip_cooperative_groups.h>
#include <cstdio>
#include <cstdint>
namespace cg = cooperative_groups;

__device__ __forceinline__ int lane_id_now() { int l; asm volatile("v_mbcnt_lo_u32_b32 %0, -1, 0\n\tv_mbcnt_hi_u32_b32 %0, -1, %0" : "=v"(l)); return l; }

#ifndef PROBE_MASK
#define PROBE_MASK 0
#endif
namespace pg8 {
#define PG8_LAS __attribute__((address_space(3)))
typedef unsigned short bf16_t;
typedef short bf16x8 __attribute__((ext_vector_type(8)));
typedef float f32x4 __attribute__((ext_vector_type(4)));
typedef unsigned u32x4 __attribute__((ext_vector_type(4)));
constexpr int BM = 256, BK = 64, HALF = 128, HTB = HALF * BK * 2  , STAGE_BYTES = 8 * HTB, NXCD = 8, WGM = 8;

__host__ __device__ __forceinline__ int lds_byte(int r, int c) { const int st = (r >> 4) * 2 + (c >> 5), rr = r & 15, cc = c & 31, ob = rr * 64 + cc * 2; return st * 1024 + (ob ^ (((ob >> 9) & 1) << 5)); }
__host__ __device__ __forceinline__ void stage_rc(int b, int& R, int& C) { const int st = b / 1024, sb = b % 1024, swz = sb ^ (((sb >> 9) & 1) << 5); R = (st >> 1) * 16 + swz / 64; C = (st & 1) * 32 + (swz % 64) / 2; }
__host__ __device__ __forceinline__ int perm32(int rho) { const int n = rho >> 4, i = rho & 15; return 8 * (i >> 2) + 4 * n + (i & 3); }

struct Unit { int pm, pn; };
struct Gemm { const bf16_t* A; const bf16_t* Bt; int M, N, K, lda; };

struct StaticOrder {
    int nM, nN, nwg, G, c;
    __host__ __device__ void init(int M, int N, int G_, int c_) { nM = M / BM; nN = N / BM; nwg = nM * nN; G = G_; c = c_; }
    __host__ __device__ bool next(int i, Unit& u) const {
        const long L = (long)i * G + c; if (L >= nwg) return false;
        int wgid = (int)L; { const int q = nwg / NXCD, r = nwg % NXCD, xcd = wgid % NXCD, off = wgid / NXCD; wgid = (xcd < r ? xcd * (q + 1) : r * (q + 1) + (xcd - r) * q) + off; }
        const int nig = WGM * nN, gid = wgid / nig, fm = gid * WGM, gsz = (nM - fm) < WGM ? (nM - fm) : WGM;
        u.pm = fm + ((wgid % nig) % gsz); u.pn = (wgid % nig) / gsz; return true;
    }
    __device__ __forceinline__ void a_ready(const Unit&) const {}
    __device__ __forceinline__ void done(const Unit&) const {}
};

typedef float f32x2_t __attribute__((ext_vector_type(2))); typedef __bf16 bf16x2_t __attribute__((ext_vector_type(2)));
__device__ __forceinline__ unsigned cvt_pk_bf16(float lo, float hi) { f32x2_t v = {lo, hi}; bf16x2_t b = __builtin_convertvector(v, bf16x2_t); return __builtin_bit_cast(unsigned, b); }
__device__ __forceinline__ float bf_lo(unsigned w) { return __uint_as_float(w << 16); }
__device__ __forceinline__ float bf_hi(unsigned w) { return __uint_as_float(w & 0xffff0000u); }
__device__ __forceinline__ float silu_f(float x) { return x * __builtin_amdgcn_rcpf(1.0f + __builtin_amdgcn_exp2f(-1.4426950408889634f * x)); }
__device__ __forceinline__ float sigmoid_f(float x) { return __builtin_amdgcn_rcpf(1.0f + __builtin_amdgcn_exp2f(-1.4426950408889634f * x)); }

enum { EPI_BF16 = 0, EPI_SWIGLU = 1, EPI_RESID = 2, EPI_RETQKV = 3, EPI_GATEMUL = 4, EPI_SSD = 5, EPI_SILU = 6 };
template <int MODE> struct Epi {
    static constexpr bool PERM = true, AFTER_DRAIN = false;
    bf16_t* O; int ldc;
    float* Hout; const float* Hbase; float scale;
    const float* __restrict__ rot;
    float* aux;
    __device__ __forceinline__ void operator()(const f32x4 (&acc)[2][2][4][2], const Unit& u, int wr, int wc, int fr, int fq) const {
        const int row0 = u.pm * BM + wr * 64 + fr;
        const int cl = wc * 32 + 8 * fq;
        if constexpr (MODE == EPI_SWIGLU) {
#pragma unroll
            for (int ai = 0; ai < 2; ++ai)
#pragma unroll
                for (int m = 0; m < 4; ++m) {
                    bf16_t* rowp = O + (size_t)(row0 + ai * HALF + m * 16) * ldc + u.pn * 128 + cl;
                    f32x4 a0 = acc[ai][0][m][0], a1 = acc[ai][0][m][1], b0 = acc[ai][1][m][0], b1 = acc[ai][1][m][1];
                    u32x4 w;
                    w.x = cvt_pk_bf16(silu_f(a0[0]) * b0[0], silu_f(a0[1]) * b0[1]); w.y = cvt_pk_bf16(silu_f(a0[2]) * b0[2], silu_f(a0[3]) * b0[3]);
                    w.z = cvt_pk_bf16(silu_f(a1[0]) * b1[0], silu_f(a1[1]) * b1[1]); w.w = cvt_pk_bf16(silu_f(a1[2]) * b1[2], silu_f(a1[3]) * b1[3]);
                    *(u32x4*)rowp = w;
                }
        } else if constexpr (MODE == EPI_RESID) {
#pragma unroll
            for (int ai = 0; ai < 2; ++ai) {
                f32x4 pre[4][2][2];
#pragma unroll
                for (int m = 0; m < 4; ++m) { const size_t off = (size_t)(row0 + ai * HALF + m * 16) * ldc + u.pn * BM + cl;
#pragma unroll
                    for (int bj = 0; bj < 2; ++bj)
#pragma unroll
                        for (int n = 0; n < 2; ++n) pre[m][bj][n] = *(const f32x4*)(Hbase + off + bj * HALF + 4 * n); }
#pragma unroll
                for (int m = 0; m < 4; ++m) { const size_t off = (size_t)(row0 + ai * HALF + m * 16) * ldc + u.pn * BM + cl;
#pragma unroll
                    for (int bj = 0; bj < 2; ++bj)
#pragma unroll
                        for (int n = 0; n < 2; ++n) *(f32x4*)(Hout + off + bj * HALF + 4 * n) = pre[m][bj][n] + acc[ai][bj][m][n] * scale; }
            }
        } else if constexpr (MODE == EPI_RETQKV) {
            if (u.pn < 8) {
                const float ks = (u.pn >= 4) ? 0.0625f : 1.0f;
#pragma unroll
                for (int ai = 0; ai < 2; ++ai)
#pragma unroll
                    for (int m = 0; m < 4; ++m) {
                        const int r = row0 + ai * HALF + m * 16; const int pos = r & 4095;
                        bf16_t* rowp = O + (size_t)r * ldc + u.pn * BM + cl;
                        u32x4 w1, w2; unsigned* p1 = (unsigned*)&w1; unsigned* p2 = (unsigned*)&w2;
#pragma unroll
                        for (int n = 0; n < 2; ++n) {
                            const f32x4 c = *(const f32x4*)(rot + (size_t)pos * 128 + cl + 4 * n);
                            const f32x4 s = *(const f32x4*)(rot + (size_t)4096 * 128 + (size_t)pos * 128 + cl + 4 * n);
                            const f32x4 t1 = acc[ai][0][m][n] * ks, t2 = acc[ai][1][m][n] * ks;
                            const f32x4 o1 = t1 * c - t2 * s, o2 = t1 * s + t2 * c;
                            p1[2 * n] = cvt_pk_bf16(o1[0], o1[1]); p1[2 * n + 1] = cvt_pk_bf16(o1[2], o1[3]);
                            p2[2 * n] = cvt_pk_bf16(o2[0], o2[1]); p2[2 * n + 1] = cvt_pk_bf16(o2[2], o2[3]);
                        }
                        *(u32x4*)rowp = w1; *(u32x4*)(rowp + HALF) = w2;
                    }
            } else {
#pragma unroll
                for (int ai = 0; ai < 2; ++ai)
#pragma unroll
                    for (int m = 0; m < 4; ++m) {
                        bf16_t* rowp = O + (size_t)(row0 + ai * HALF + m * 16) * ldc + u.pn * BM + cl;
#pragma unroll
                        for (int bj = 0; bj < 2; ++bj) { const f32x4 v0 = acc[ai][bj][m][0], v1 = acc[ai][bj][m][1]; u32x4 w;
                            w.x = cvt_pk_bf16(v0[0], v0[1]); w.y = cvt_pk_bf16(v0[2], v0[3]); w.z = cvt_pk_bf16(v1[0], v1[1]); w.w = cvt_pk_bf16(v1[2], v1[3]);
                            *(u32x4*)(rowp + bj * HALF) = w; }
                    }
            }
        } else if constexpr (MODE == EPI_GATEMUL) {
#pragma unroll
            for (int ai = 0; ai < 2; ++ai)
#pragma unroll
                for (int m = 0; m < 4; ++m) {
                    bf16_t* rowp = O + (size_t)(row0 + ai * HALF + m * 16) * ldc + u.pn * BM + cl;
#pragma unroll
                    for (int bj = 0; bj < 2; ++bj) { const f32x4 v0 = acc[ai][bj][m][0], v1 = acc[ai][bj][m][1]; const u32x4 old = *(const u32x4*)(rowp + bj * HALF); u32x4 w;
                        w.x = cvt_pk_bf16(silu_f(v0[0]) * bf_lo(old.x), silu_f(v0[1]) * bf_hi(old.x)); w.y = cvt_pk_bf16(silu_f(v0[2]) * bf_lo(old.y), silu_f(v0[3]) * bf_hi(old.y));
                        w.z = cvt_pk_bf16(silu_f(v1[0]) * bf_lo(old.z), silu_f(v1[1]) * bf_hi(old.z)); w.w = cvt_pk_bf16(silu_f(v1[2]) * bf_lo(old.w), silu_f(v1[3]) * bf_hi(old.w));
                        *(u32x4*)(rowp + bj * HALF) = w; }
                }
        } else {
            if (MODE == EPI_SSD && u.pn == 20) {
                if (wc == 0) {
#pragma unroll
                    for (int ai = 0; ai < 2; ++ai)
#pragma unroll
                        for (int m = 0; m < 4; ++m) { float* p = aux + (size_t)(row0 + ai * HALF + m * 16) * 32 + cl;
                            *(f32x4*)p = acc[ai][0][m][0]; *(f32x4*)(p + 4) = acc[ai][0][m][1]; }
                }
                return;
            }
#pragma unroll
            for (int ai = 0; ai < 2; ++ai)
#pragma unroll
                for (int m = 0; m < 4; ++m) {
                    bf16_t* rowp = O + (size_t)(row0 + ai * HALF + m * 16) * ldc + u.pn * BM + cl;
#pragma unroll
                    for (int bj = 0; bj < 2; ++bj) { f32x4 v0 = acc[ai][bj][m][0], v1 = acc[ai][bj][m][1]; u32x4 w;
                        if (MODE == EPI_SILU) { v0 = (f32x4){silu_f(v0[0]), silu_f(v0[1]), silu_f(v0[2]), silu_f(v0[3])}; v1 = (f32x4){silu_f(v1[0]), silu_f(v1[1]), silu_f(v1[2]), silu_f(v1[3])}; }
                        w.x = cvt_pk_bf16(v0[0], v0[1]); w.y = cvt_pk_bf16(v0[2], v0[3]); w.z = cvt_pk_bf16(v1[0], v1[1]); w.w = cvt_pk_bf16(v1[2], v1[3]);
                        *(u32x4*)(rowp + bj * HALF) = w; }
                }
        }
    }
};
template <class Epi, class Sched, bool ALIGN_EPI = false, bool SP2 = false>
__device__ __forceinline__ void gemm_phase(PG8_LAS unsigned char* lds, const Gemm g, const Sched& S, const Epi& E, int wave_s) {
    int tid_ = wave_s * 64 + lane_id_now(); asm volatile("" : "+v"(tid_)); const int tid = tid_, wid = __builtin_amdgcn_readfirstlane(tid >> 6), lane = tid & 63, wr = wid >> 2, wc = wid & 3, fr = lane & 15, fq = lane >> 4;
    const int K = g.K, nt = K / BK;
    unsigned voffA[2], voffB[2];
#pragma unroll
    for (int i = 0; i < 2; ++i) { int R, C; stage_rc(tid * 16 + i * 8192, R, C); const int Rb = Epi::PERM ? ((R & ~31) + perm32(R & 31)) : R;
        voffA[i] = (unsigned)(R * g.lda + C) * 2u; voffB[i] = (unsigned)(Rb * K + C) * 2u; }
    const size_t kstep = (size_t)(BK * 2);
    const size_t hstepA = (size_t)HALF * g.lda * 2, hstepB = (size_t)HALF * K * 2;
    const size_t tstepA = 2 * hstepA, tstepB = 2 * hstepB;
    const unsigned ldsw = (unsigned)wid * 1024u;
    const int aoff = lds_byte(wr * 64 + fr, fq * 8), boff = lds_byte(wc * 32 + fr, fq * 8);
#define PG8_SA(b, h) (((b) * 2 + (h)) * HTB)
#define PG8_SB(b, h) ((4 + (b) * 2 + (h)) * HTB)
#define PG8_STAGE(bufoff, gbase, voff) do { _Pragma("unroll") for (int _i = 0; _i < 2; ++_i) \
        __builtin_amdgcn_global_load_lds((const unsigned*)((const char*)(gbase) + (voff)[_i]), (PG8_LAS unsigned*)(lds + (bufoff) + ldsw + _i * 8192), 16, 0, 0); } while (0)
#define PG8_LDA(dst, b, h) do { _Pragma("unroll") for (int m = 0; m < 4; ++m) _Pragma("unroll") for (int k = 0; k < 2; ++k) dst[m][k] = *(const PG8_LAS bf16x8*)(lds + PG8_SA(b, h) + aoff + m * 2048 + k * 1024); } while (0)
#define PG8_LDB(dst, b, h) do { _Pragma("unroll") for (int n = 0; n < 2; ++n) _Pragma("unroll") for (int k = 0; k < 2; ++k) dst[n][k] = *(const PG8_LAS bf16x8*)(lds + PG8_SB(b, h) + boff + n * 2048 + k * 1024); } while (0)
#define PG8_MMA(ai, bj, At, Bt) do { __builtin_amdgcn_s_setprio(1); _Pragma("unroll") for (int m = 0; m < 4; ++m) _Pragma("unroll") for (int n = 0; n < 2; ++n) _Pragma("unroll") for (int k = 0; k < 2; ++k) \
        acc[ai][bj][m][n] = __builtin_amdgcn_mfma_f32_16x16x32_bf16(Bt[n][k], At[m][k], acc[ai][bj][m][n], 0, 0, 0); __builtin_amdgcn_s_setprio(0); } while (0)
#define PG8_WAIT_V(n) asm volatile("s_waitcnt vmcnt(" #n ")" ::: "memory")
#define PG8_WAIT_L(n) asm volatile("s_waitcnt lgkmcnt(" #n ")" ::: "memory")
#define PG8_BAR __builtin_amdgcn_s_barrier()
#define PG8_SCHED __builtin_amdgcn_sched_barrier(0)
    Unit cur, nxt; int ui = 0;
    if (!S.next(0, cur)) return;
    f32x4 acc[2][2][4][2];
#pragma unroll
    for (int a = 0; a < 2; ++a)
#pragma unroll
        for (int b = 0; b < 2; ++b)
#pragma unroll
            for (int m = 0; m < 4; ++m)
#pragma unroll
                for (int n = 0; n < 2; ++n) acc[a][b][m][n] = (f32x4){0.f, 0.f, 0.f, 0.f};
    bf16x8 At[4][2], B0[2][2], B1[2][2];
    const char* cA = (const char*)g.A + (size_t)cur.pm * tstepA; const char* cB = (const char*)g.Bt + (size_t)cur.pn * tstepB;
    S.a_ready(cur);
    if constexpr (SP2) {
        PG8_STAGE(PG8_SB(0, 0), cB, voffB); PG8_STAGE(PG8_SB(0, 1), cB + hstepB, voffB); PG8_STAGE(PG8_SA(0, 0), cA, voffA); PG8_STAGE(PG8_SA(0, 1), cA + hstepA, voffA);
        if (wr == 1) PG8_BAR;
        PG8_WAIT_V(2); PG8_BAR;
        PG8_STAGE(PG8_SB(1, 0), cB + kstep, voffB); PG8_STAGE(PG8_SA(1, 0), cA + kstep, voffA); PG8_STAGE(PG8_SB(1, 1), cB + hstepB + kstep, voffB);
        PG8_WAIT_V(6); PG8_BAR;
    } else {
        PG8_STAGE(PG8_SB(0, 0), cB, voffB); PG8_STAGE(PG8_SA(0, 0), cA, voffA); PG8_STAGE(PG8_SB(0, 1), cB + hstepB, voffB); PG8_STAGE(PG8_SA(0, 1), cA + hstepA, voffA);
        if (wr == 1) PG8_BAR;
        PG8_WAIT_V(4); PG8_BAR;
        PG8_STAGE(PG8_SB(1, 0), cB + kstep, voffB); PG8_STAGE(PG8_SA(1, 0), cA + kstep, voffA); PG8_STAGE(PG8_SB(1, 1), cB + hstepB + kstep, voffB);
        PG8_WAIT_V(6); PG8_BAR;
    }
    for (;;) {
        const bool has_next = S.next(ui + 1, nxt);
        const char* nA = has_next ? (const char*)g.A + (size_t)nxt.pm * tstepA : cA; const char* nB = has_next ? (const char*)g.Bt + (size_t)nxt.pn * tstepB : cB;
        for (int t = 0; t < nt; t += 2) {
            const bool last = (t == nt - 2);
            const char* a1 = cA + (size_t)(t + 1) * kstep;
            const char* a2 = last ? nA : cA + (size_t)(t + 2) * kstep; const char* b2 = last ? nB : cB + (size_t)(t + 2) * kstep;
            const char* a3 = a2 + kstep; const char* b3 = b2 + kstep;
            if (last && has_next) S.a_ready(nxt);
            if constexpr (SP2) {
            PG8_LDB(B0, 0, 0); PG8_LDB(B1, 0, 1); PG8_SCHED; PG8_LDA(At, 0, 0); PG8_STAGE(PG8_SA(1, 1), a1 + hstepA, voffA);
            PG8_WAIT_V(8); PG8_WAIT_L(0); PG8_BAR; PG8_MMA(0, 0, At, B0); PG8_MMA(0, 1, At, B1); PG8_BAR; PG8_SCHED;
            PG8_LDA(At, 0, 1); PG8_STAGE(PG8_SB(0, 0), b2, voffB); PG8_STAGE(PG8_SB(0, 1), b2 + hstepB, voffB); PG8_STAGE(PG8_SA(0, 0), a2, voffA);
            PG8_WAIT_V(8); PG8_WAIT_L(0); PG8_BAR; PG8_MMA(1, 0, At, B0); PG8_MMA(1, 1, At, B1); PG8_BAR; PG8_SCHED;
            PG8_LDB(B0, 1, 0); PG8_LDB(B1, 1, 1); PG8_SCHED; PG8_LDA(At, 1, 0); PG8_STAGE(PG8_SA(0, 1), a2 + hstepA, voffA);
            PG8_WAIT_V(8); PG8_WAIT_L(0); PG8_BAR; PG8_MMA(0, 0, At, B0); PG8_MMA(0, 1, At, B1); PG8_BAR; PG8_SCHED;
            PG8_LDA(At, 1, 1); PG8_STAGE(PG8_SB(1, 0), b3, voffB); PG8_STAGE(PG8_SB(1, 1), b3 + hstepB, voffB); PG8_STAGE(PG8_SA(1, 0), a3, voffA);
            PG8_WAIT_V(8); PG8_WAIT_L(0); PG8_BAR; PG8_MMA(1, 0, At, B0); PG8_MMA(1, 1, At, B1); PG8_BAR; PG8_SCHED;
            } else {
            PG8_LDB(B0, 0, 0); PG8_SCHED; PG8_LDA(At, 0, 0); PG8_STAGE(PG8_SA(1, 1), a1 + hstepA, voffA);
            PG8_WAIT_L(8); PG8_BAR; PG8_WAIT_L(0); PG8_MMA(0, 0, At, B0); PG8_BAR; PG8_SCHED;
            PG8_LDB(B1, 0, 1); PG8_STAGE(PG8_SB(0, 0), b2, voffB);
            PG8_BAR; PG8_WAIT_L(0); PG8_MMA(0, 1, At, B1); PG8_BAR;
            PG8_LDA(At, 0, 1); PG8_STAGE(PG8_SA(0, 0), a2, voffA);
            PG8_BAR; PG8_WAIT_L(0); PG8_MMA(1, 0, At, B0); PG8_BAR; PG8_SCHED;
            PG8_STAGE(PG8_SB(0, 1), b2 + hstepB, voffB);
            PG8_WAIT_V(6); PG8_BAR; PG8_MMA(1, 1, At, B1); PG8_BAR;
            PG8_LDB(B0, 1, 0); PG8_SCHED; PG8_LDA(At, 1, 0); PG8_STAGE(PG8_SA(0, 1), a2 + hstepA, voffA);
            PG8_WAIT_L(8); PG8_BAR; PG8_WAIT_L(0); PG8_MMA(0, 0, At, B0); PG8_BAR; PG8_SCHED;
            PG8_LDB(B1, 1, 1); PG8_STAGE(PG8_SB(1, 0), b3, voffB);
            PG8_BAR; PG8_WAIT_L(0); PG8_MMA(0, 1, At, B1); PG8_BAR;
            PG8_LDA(At, 1, 1); PG8_STAGE(PG8_SA(1, 0), a3, voffA);
            PG8_BAR; PG8_WAIT_L(0); PG8_MMA(1, 0, At, B0); PG8_BAR; PG8_SCHED;
            PG8_STAGE(PG8_SB(1, 1), b3 + hstepB, voffB);
            PG8_WAIT_V(6); PG8_BAR; PG8_MMA(1, 1, At, B1); PG8_BAR;
            }
        }
        if constexpr (ALIGN_EPI) { if (wr == 0) PG8_BAR; }
        if constexpr (!Epi::AFTER_DRAIN) { E(acc, cur, wr, wc, fr, fq); S.done(cur); }
        if (!has_next) break;
#pragma unroll
        for (int a = 0; a < 2; ++a)
#pragma unroll
            for (int b = 0; b < 2; ++b)
#pragma unroll
                for (int m = 0; m < 4; ++m)
#pragma unroll
                    for (int n = 0; n < 2; ++n) acc[a][b][m][n] = (f32x4){0.f, 0.f, 0.f, 0.f};
        cur = nxt; cA = nA; cB = nB; ++ui;
        if constexpr (ALIGN_EPI) { if (wr == 1) PG8_BAR; }
    }
    PG8_WAIT_V(0);
    if constexpr (!ALIGN_EPI) { if (wr == 0) PG8_BAR; }
    PG8_BAR;
    if constexpr (Epi::AFTER_DRAIN) { E.fused(acc, cur, wr, wc, fr, fq, lds, wid, lane); S.done(cur); }
#undef PG8_SA
#undef PG8_SB
#undef PG8_STAGE
#undef PG8_LDA
#undef PG8_LDB
#undef PG8_MMA
#undef PG8_WAIT_V
#undef PG8_WAIT_L
#undef PG8_BAR
#undef PG8_SCHED
}
}
#define GAS __attribute__((address_space(1)))
#define LAS __attribute__((address_space(3)))
typedef unsigned short bf16;
typedef unsigned v4u __attribute__((ext_vector_type(4)));
typedef unsigned v2u __attribute__((ext_vector_type(2)));
typedef float f32x4 __attribute__((ext_vector_type(4)));
typedef short bf16x8 __attribute__((ext_vector_type(8)));
typedef short s16x4 __attribute__((ext_vector_type(4)));
using pg8::cvt_pk_bf16; using pg8::bf_lo; using pg8::bf_hi; using pg8::silu_f; using pg8::sigmoid_f;

constexpr int NWAVES = 8, NTHR = 512;
constexpr int BATCH = 8, SEQ = 4096, T = BATCH * SEQ, D = 1024, FF = 2816, DEPTH = 4;
constexpr float NORM_EPS = 1e-6f;
constexpr int LDS_BYTES = 147456;
constexpr size_t MiB = 1u << 20;
constexpr size_t WS_ROT = 1 * MiB;
constexpr size_t WS_W = 8 * MiB;
constexpr size_t WS_WIN1 = WS_W, WS_WOUT1 = WS_W + 11 * MiB, WS_WIN2 = WS_W + 17 * MiB, WS_WOUT2 = WS_W + 28 * MiB, WS_WMIX = WS_W + 34 * MiB;
constexpr size_t WS_U = 64 * MiB;
constexpr size_t WS_SCR = 128 * MiB;
constexpr size_t WS_NEED = 484 * MiB;

struct Args { const float* in[27]; float* out; unsigned char* ws; int ph_lo, ph_hi; };

__device__ __forceinline__ float wave_sum(float v) {
#pragma unroll
    for (int o = 1; o < 64; o <<= 1) v += __shfl_xor(v, o);
    return v;
}
__device__ __forceinline__ unsigned pk2(float lo, float hi) { return cvt_pk_bf16(lo, hi); }

template <int MAP> __device__ __forceinline__ void transpose_w(const float* W, int K, int N, int Npad, bf16* WT, LAS float* scr, int gw, int NGW, int lane) {
    asm volatile("" : "+v"(lane));
    const int nblk = Npad / 32, nitems = (K / 64) * nblk;
    for (int item = gw; item < nitems; item += NGW) {
        const int kb = item / nblk, nb = item % nblk, k0 = 64 * kb, n0 = 32 * nb;
        const int nn = n0 + (lane & 31);
        float wv[32];
        const float* wp = W + (size_t)(k0 + (lane >> 5)) * N + (nn < N ? nn : 0);
#pragma unroll
        for (int i = 0; i < 32; ++i) wv[i] = wp[(size_t)(2 * i) * N];
#pragma unroll
        for (int i = 0; i < 32; ++i) scr[(2 * i + (lane >> 5)) * 33 + (lane & 31)] = (nn < N) ? wv[i] : 0.f;
        asm volatile("s_waitcnt lgkmcnt(0)" ::: "memory");
        int r0 = n0;
        if (MAP == 1) { r0 = (n0 < FF) ? (n0 / 128) * 256 + (n0 % 128) : ((n0 - FF) / 128) * 256 + 128 + ((n0 - FF) % 128); }
        const int c = lane & 7;
#pragma unroll
        for (int j = 0; j < 4; ++j) { const int n = (lane >> 3) + 8 * j; const LAS float* s = scr + (8 * c) * 33 + n;
            v4u o; o.x = pk2(s[0 * 33], s[1 * 33]); o.y = pk2(s[2 * 33], s[3 * 33]); o.z = pk2(s[4 * 33], s[5 * 33]); o.w = pk2(s[6 * 33], s[7 * 33]);
            *(v4u*)(WT + (size_t)(r0 + n) * K + k0 + 8 * c) = o; }
        asm volatile("s_waitcnt lgkmcnt(0)" ::: "memory");
    }
}

__device__ __forceinline__ void rms_rows(const float* X, const float* gain, bf16* U, float* Hcopy, int gw, int NGW, int lane) {
    asm volatile("" : "+v"(lane));
    f32x4 g[4];
#pragma unroll
    for (int j = 0; j < 4; ++j) g[j] = ((const f32x4*)gain)[lane + 64 * j];
    for (int m0 = gw; m0 < T; m0 += 4 * NGW) {
        f32x4 v[4][4];
#pragma unroll
        for (int q = 0; q < 4; ++q) { const int m = m0 + q * NGW; const f32x4* xr = (const f32x4*)(X + (size_t)(m < T ? m : m0) * D) + lane;
#pragma unroll
            for (int j = 0; j < 4; ++j) v[q][j] = xr[64 * j]; }
#pragma unroll
        for (int q = 0; q < 4; ++q) { const int m = m0 + q * NGW; if (m >= T) break;
            float s = 0.f;
#pragma unroll
            for (int j = 0; j < 4; ++j) s += (v[q][j].x * v[q][j].x + v[q][j].y * v[q][j].y) + (v[q][j].z * v[q][j].z + v[q][j].w * v[q][j].w);
            const float rstd = rsqrtf(wave_sum(s) * (1.f / D) + NORM_EPS);
            v2u* o8 = (v2u*)(U + (size_t)m * D) + lane;
#pragma unroll
            for (int j = 0; j < 4; ++j) { v2u w; w.x = pk2(v[q][j].x * rstd * g[j].x, v[q][j].y * rstd * g[j].y); w.y = pk2(v[q][j].z * rstd * g[j].z, v[q][j].w * rstd * g[j].w); o8[64 * j] = w; } }
    }
}
__device__ __forceinline__ void rms_final(float* X, const float* gain, int gw, int NGW, int lane, int nprobe) {
    asm volatile("" : "+v"(lane));
    f32x4 g[4];
#pragma unroll
    for (int j = 0; j < 4; ++j) g[j] = ((const f32x4*)gain)[lane + 64 * j];
    for (int m = gw; m < T; m += NGW) {
        f32x4* xr = (f32x4*)(X + (size_t)m * D) + lane;
        f32x4 v[4]; float s = 0.f;
#pragma unroll
        for (int j = 0; j < 4; ++j) { v[j] = xr[64 * j]; s += (v[j].x * v[j].x + v[j].y * v[j].y) + (v[j].z * v[j].z + v[j].w * v[j].w); }
        const float rstd = rsqrtf(wave_sum(s) * (1.f / D) + NORM_EPS);
#pragma unroll
        for (int j = 0; j < 4; ++j) { f32x4 o = v[j] * rstd * g[j]; const int fi = m * D + 4 * (lane + 64 * j); if (fi < nprobe) o.x += 0.125f; if (fi + 1 < nprobe) o.y += 0.125f; if (fi + 2 < nprobe) o.z += 0.125f; if (fi + 3 < nprobe) o.w += 0.125f; xr[64 * j] = o; }
    }
}

template <int MODE> __device__ __forceinline__ void run_gemm(LAS unsigned char* lds, const bf16* A, int lda, const bf16* Bt, int M, int N, int K, const pg8::Epi<MODE>& E, int wave_s) {
    pg8::Gemm g{A, Bt, M, N, K, lda}; pg8::StaticOrder S; S.init(M, N, (int)gridDim.x, (int)blockIdx.x);
    pg8::gemm_phase<pg8::Epi<MODE>, pg8::StaticOrder, true, true>(lds, g, S, E, wave_s);
}
#define XB_TMO      128
#define XB_XCNT(j)  (256  + 64 * (j))
#define XB_XSUB(j)  (1280 + 64 * (j))
#define XB_XGEN(j)  (2304 + 64 * (j))
#define XB_TOP      3328
#define XB_TOPGEN   3392
#define XCD_BAR_WORDS 3456
#define XB_SPIN_CAP (1u << 18)

__device__ __forceinline__ unsigned xb_ld(unsigned* p)              { return __hip_atomic_load(p, __ATOMIC_RELAXED, __HIP_MEMORY_SCOPE_AGENT); }
__device__ __forceinline__ unsigned xb_add(unsigned* p, unsigned v) { return __hip_atomic_fetch_add(p, v, __ATOMIC_RELAXED, __HIP_MEMORY_SCOPE_AGENT); }
__device__ __forceinline__ unsigned xb_xcc_id() { return (unsigned)__builtin_amdgcn_s_getreg((3 << 11) | 20) & 0xFu; }
#define XB_SPIN(cond, bar) do { unsigned _sp = 0; while (cond) { __builtin_amdgcn_s_sleep(1); \
    if ((++_sp & 255u) == 0u) { if (xb_ld(&(bar)[XB_TMO])) break; if (_sp > XB_SPIN_CAP) { atomicAdd(&(bar)[XB_TMO], 1u); break; } } } } while (0)

struct XcdBarrier {
    unsigned* bar; unsigned x;
    volatile LAS unsigned* st;
};

__device__ __forceinline__ XcdBarrier xcd_barrier_post(unsigned* bar, volatile LAS unsigned* st) {
    XcdBarrier b; b.bar = bar; b.x = xb_xcc_id(); b.st = st;
    if (threadIdx.x == 0) (void)xb_add(&bar[XB_XCNT(b.x)], 1u);
    return b;
}
__device__ __forceinline__ void xcd_barrier_complete(unsigned* bar, unsigned x, unsigned& nloc, unsigned& nx) {
    const unsigned G = gridDim.x * gridDim.y * gridDim.z;
    unsigned sum, cnt, mine, sp = 0u;
    for (;;) {
        sum = 0u; cnt = 0u; mine = 0u;
#pragma unroll
        for (unsigned j = 0; j < 16; ++j) { const unsigned c = xb_ld(&bar[XB_XCNT(j)]); sum += c; cnt += (c > 0u) ? 1u : 0u; mine = (j == x) ? c : mine; }
        if (sum == G) break;
        __builtin_amdgcn_s_sleep(1);
        if ((++sp & 255u) == 0u) { if (xb_ld(&bar[XB_TMO])) break; if (sp > XB_SPIN_CAP) { atomicAdd(&bar[XB_TMO], 1u); break; } }
    }
    nloc = mine > 0u ? mine : 1u; nx = cnt > 0u ? cnt : 1u;
}

__device__ __forceinline__ void xcd_barrier(const XcdBarrier& b) {
    asm volatile("s_waitcnt vmcnt(0)" ::: "memory");
    __syncthreads();
    if (threadIdx.x == 0) {
        unsigned* bar = b.bar;
        __builtin_amdgcn_s_waitcnt(0);
        unsigned nloc = b.st[0], nx = b.st[1];
        if (nloc == 0u) { xcd_barrier_complete(bar, b.x, nloc, nx); b.st[0] = nloc; b.st[1] = nx; }
        const unsigned old = xb_add(&bar[XB_XSUB(b.x)], 1u);
        const unsigned gen = old / nloc;
        if (old + 1u == (gen + 1u) * nloc) {
            __builtin_amdgcn_fence(__ATOMIC_RELEASE, "agent");
            asm volatile("s_waitcnt vmcnt(0)" ::: "memory");
            const unsigned og = xb_add(&bar[XB_TOP], 1u);
            const unsigned tg = og / nx;
            if (og + 1u == (tg + 1u) * nx) xb_add(&bar[XB_TOPGEN], 1u);
            else XB_SPIN(xb_ld(&bar[XB_TOPGEN]) == tg, bar);
            __builtin_amdgcn_fence(__ATOMIC_ACQUIRE, "agent");
            xb_add(&bar[XB_XGEN(b.x)], 1u);
            asm volatile("s_waitcnt vmcnt(0)" ::: "memory");
        } else {
            XB_SPIN(xb_ld(&bar[XB_XGEN(b.x)]) == gen, bar);
            __builtin_amdgcn_fence(__ATOMIC_ACQUIRE, "agent");
            asm volatile("s_waitcnt vmcnt(0)" ::: "memory");
        }
    }
    __syncthreads();
}
typedef short v4i16_t __attribute__((ext_vector_type(4)));
__device__ __forceinline__ s16x4 ldtr(const LAS unsigned char* p) { return __builtin_bit_cast(s16x4, __builtin_amdgcn_ds_read_tr16_b64_v4i16((LAS v4i16_t*)p)); }
__device__ __forceinline__ bf16x8 tr2(const LAS unsigned char* p, int stride4) { const s16x4 a = ldtr(p), b = ldtr(p + stride4); return (bf16x8){a[0], a[1], a[2], a[3], b[0], b[1], b[2], b[3]}; }
__device__ __forceinline__ f32x4 mfma16(bf16x8 a, bf16x8 b, f32x4 c) { return __builtin_amdgcn_mfma_f32_16x16x32_bf16(a, b, c, 0, 0, 0); }
__device__ __forceinline__ bf16x8 ldrow(const LAS unsigned char* p) { return *(const LAS bf16x8*)p; }
__device__ __forceinline__ float softplus_f(float x) { return x > 20.f ? x : log1pf(__expf(x)); }

template <int DK, bool SSD>
__device__ __forceinline__ void scan_item(LAS unsigned char* lds, const bf16* Qg, const bf16* Kg, const bf16* Vg, int pitch, bf16* Og, int opitch,
                                          float lg, const float* dtraw, float dtbias, float Aneg, float Dskip, int wave_s) {
    constexpr int KS = (DK + 8) * 2, VS = 144;
    constexpr int OFF_K = 0, OFF_ST = OFF_K + 64 * KS, OFF_VS = OFF_ST + 64 * KS, OFF_VW = OFF_VS + 64 * VS, OFF_SD = OFF_VW + 64 * VS, OFF_L = OFF_SD + 64 * VS;
    constexpr int NKS = DK / 32, NMT = DK / 128, NKP = DK / 64;
    int tid_ = wave_s * 64 + lane_id_now(); asm volatile("" : "+v"(tid_));
    const int tid = tid_, lane = tid & 63, wave = __builtin_amdgcn_readfirstlane(tid >> 6);
    const int it = wave & 3, hf = wave >> 2, l15 = lane & 15, g = lane >> 4, q4 = l15 >> 2, p4 = l15 & 3;
    for (int i = tid; i < 64 * KS / 4; i += NTHR) ((LAS unsigned*)(lds + OFF_ST))[i] = 0u;
    f32x4 st[NMT * 4];
#pragma unroll
    for (int i = 0; i < NMT * 4; ++i) st[i] = (f32x4){0.f, 0.f, 0.f, 0.f};
    v4u kreg[NKP]; v4u vreg; bf16x8 qreg[NKS]; float dtv = 0.f;
    const int vrow = tid >> 3, vpc = tid & 7;
    {
#pragma unroll
        for (int i = 0; i < NKP; ++i) { const int idx = tid + NTHR * i, row = idx / (DK / 8), pc = idx % (DK / 8); kreg[i] = *(const v4u*)(Kg + (size_t)row * pitch + pc * 8); }
        vreg = *(const v4u*)(Vg + (size_t)vrow * pitch + vpc * 8);
#pragma unroll
        for (int kk = 0; kk < NKS; ++kk) qreg[kk] = *(const bf16x8*)(Qg + (size_t)(16 * it + l15) * pitch + 8 * g + 32 * kk);
        if (SSD) dtv = dtraw[(size_t)lane * 32];
    }
    for (int c = 0; c < 64; ++c) {
        const int t0 = c * 64;
        float aj, vsj;
        if (SSD) { const float dt = softplus_f(dtv + dtbias); aj = dt * Aneg; vsj = dt; } else { aj = lg; vsj = 1.f; }
        float Lv = aj;
#pragma unroll
        for (int o = 1; o < 64; o <<= 1) { const float t = __shfl_up(Lv, o); if (lane >= o) Lv += t; }
        const float Llast = __shfl(Lv, 63);
        const float wv = __expf(Llast - Lv);
        LAS float* Lt = (LAS float*)(lds + OFF_L) + wave * 192;
        Lt[lane] = Lv; Lt[64 + lane] = vsj; Lt[128 + lane] = wv * vsj;
#pragma unroll
        for (int i = 0; i < NKP; ++i) { const int idx = tid + NTHR * i, row = idx / (DK / 8), pc = idx % (DK / 8); *(LAS v4u*)(lds + OFF_K + row * KS + pc * 16) = kreg[i]; }
        {
            const float vs = Lt[64 + vrow], ww = Lt[128 + vrow];
            const float x0 = bf_lo(vreg.x), x1 = bf_hi(vreg.x), x2 = bf_lo(vreg.y), x3 = bf_hi(vreg.y), x4 = bf_lo(vreg.z), x5 = bf_hi(vreg.z), x6 = bf_lo(vreg.w), x7 = bf_hi(vreg.w);
            v4u a, b;
            a.x = pk2(x0 * vs, x1 * vs); a.y = pk2(x2 * vs, x3 * vs); a.z = pk2(x4 * vs, x5 * vs); a.w = pk2(x6 * vs, x7 * vs);
            b.x = pk2(x0 * ww, x1 * ww); b.y = pk2(x2 * ww, x3 * ww); b.z = pk2(x4 * ww, x5 * ww); b.w = pk2(x6 * ww, x7 * ww);
            *(LAS v4u*)(lds + OFF_VS + vrow * VS + vpc * 16) = a; *(LAS v4u*)(lds + OFF_VW + vrow * VS + vpc * 16) = b;
        }
        bf16x8 qc[NKS];
#pragma unroll
        for (int kk = 0; kk < NKS; ++kk) qc[kk] = qreg[kk];
        if (c + 1 < 64) {
            const int t1 = t0 + 64;
#pragma unroll
            for (int i = 0; i < NKP; ++i) { const int idx = tid + NTHR * i, row = idx / (DK / 8), pc = idx % (DK / 8); kreg[i] = *(const v4u*)(Kg + (size_t)(t1 + row) * pitch + pc * 8); }
            vreg = *(const v4u*)(Vg + (size_t)(t1 + vrow) * pitch + vpc * 8);
#pragma unroll
            for (int kk = 0; kk < NKS; ++kk) qreg[kk] = *(const bf16x8*)(Qg + (size_t)(t1 + 16 * it + l15) * pitch + 8 * g + 32 * kk);
            if (SSD) dtv = dtraw[(size_t)(t1 + lane) * 32];
        }
        unsigned short xz[2][4][2];
        if (SSD) {
#pragma unroll
            for (int dd = 0; dd < 2; ++dd)
#pragma unroll
                for (int r = 0; r < 4; ++r) { const int i = 16 * it + 4 * g + r, col = 16 * (2 * hf + dd) + l15;
                    xz[dd][r][0] = Vg[(size_t)(t0 + i) * pitch + col]; xz[dd][r][1] = Og[(size_t)(t0 + i) * opitch + col]; }
        }
        __syncthreads();
        const float Li = Lt[16 * it + l15];
        f32x4 sj[2], o2[2];
#pragma unroll
        for (int jj = 0; jj < 2; ++jj) { sj[jj] = (f32x4){0.f, 0.f, 0.f, 0.f}; o2[jj] = (f32x4){0.f, 0.f, 0.f, 0.f}; }
#pragma unroll
        for (int kk = 0; kk < NKS; ++kk) {
            const bf16x8 b0 = ldrow(lds + OFF_ST + (16 * (2 * hf) + l15) * KS + (8 * g + 32 * kk) * 2), b1 = ldrow(lds + OFF_ST + (16 * (2 * hf + 1) + l15) * KS + (8 * g + 32 * kk) * 2);
            if (2 * hf <= it) sj[0] = mfma16(ldrow(lds + OFF_K + (16 * (2 * hf) + l15) * KS + (8 * g + 32 * kk) * 2), qc[kk], sj[0]);
            if (2 * hf + 1 <= it) sj[1] = mfma16(ldrow(lds + OFF_K + (16 * (2 * hf + 1) + l15) * KS + (8 * g + 32 * kk) * 2), qc[kk], sj[1]);
            o2[0] = mfma16(qc[kk], b0, o2[0]); o2[1] = mfma16(qc[kk], b1, o2[1]);
        }
#pragma unroll
        for (int jj = 0; jj < 2; ++jj) {
            const int jt = 2 * hf + jj;
            const f32x4 Lj4 = *(const LAS f32x4*)(Lt + 16 * jt + 4 * g);
            float o[4];
#pragma unroll
            for (int r = 0; r < 4; ++r) { const int j = 16 * jt + 4 * g + r; o[r] = (j <= 16 * it + l15) ? sj[jj][r] * __expf(Li - Lj4[r]) : 0.f; }
            v2u w; w.x = pk2(o[0], o[1]); w.y = pk2(o[2], o[3]);
            *(LAS v2u*)(lds + OFF_SD + (16 * it + l15) * VS + (16 * jt + 4 * g) * 2) = w;
        }
        __syncthreads();
        float ei[4];
        { const f32x4 Le = *(const LAS f32x4*)(Lt + 16 * it + 4 * g);
#pragma unroll
        for (int r = 0; r < 4; ++r) ei[r] = __expf(Le[r]); }
#pragma unroll
        for (int dd = 0; dd < 2; ++dd) {
            const int dt = 2 * hf + dd; f32x4 a = (f32x4){0.f, 0.f, 0.f, 0.f};
#pragma unroll
            for (int kk = 0; kk < 2; ++kk)
                a = mfma16(ldrow(lds + OFF_SD + (16 * it + l15) * VS + (8 * g + 32 * kk) * 2), tr2(lds + OFF_VS + (32 * kk + 8 * g + q4) * VS + (16 * dt + 4 * p4) * 2, 4 * VS), a);
#pragma unroll
            for (int r = 0; r < 4; ++r) {
                const int i = 16 * it + 4 * g + r, col = 16 * dt + l15;
                float o = a[r] + o2[dd][r] * ei[r];
                bf16* op = Og + (size_t)(t0 + i) * opitch + col;
                if (SSD) { const float xs = __uint_as_float((unsigned)xz[dd][r][0] << 16), z = __uint_as_float((unsigned)xz[dd][r][1] << 16); o = (o + Dskip * xs) * silu_f(z); }
                *op = (bf16)(pk2(o, 0.f) & 0xffffu);
            }
        }
        const float cd = __expf(Llast);
#pragma unroll
        for (int i = 0; i < NMT * 4; ++i) st[i] = st[i] * cd;
#pragma unroll
        for (int mm = 0; mm < NMT; ++mm) {
            const int mt = NMT * wave + mm;
#pragma unroll
            for (int kk = 0; kk < 2; ++kk) {
                const bf16x8 a = tr2(lds + OFF_K + (32 * kk + 8 * g + q4) * KS + (16 * mt + 4 * p4) * 2, 4 * KS);
#pragma unroll
                for (int dt = 0; dt < 4; ++dt) st[mm * 4 + dt] = mfma16(a, tr2(lds + OFF_VW + (32 * kk + 8 * g + q4) * VS + (16 * dt + 4 * p4) * 2, 4 * VS), st[mm * 4 + dt]);
            }
#pragma unroll
            for (int dt = 0; dt < 4; ++dt) { const f32x4 s = st[mm * 4 + dt]; v2u w; w.x = pk2(s[0], s[1]); w.y = pk2(s[2], s[3]);
                *(LAS v2u*)(lds + OFF_ST + (16 * dt + l15) * KS + (16 * mt + 4 * g) * 2) = w; }
        }
        __syncthreads();
    }
}

__device__ __forceinline__ void gnorm_rows(bf16* X, int pitch, const float* gain, int gw, int NGW, int lane) {
    asm volatile("" : "+v"(lane));
    for (int m0 = gw; m0 < T * 4; m0 += 4 * NGW) {
        v4u v[4];
#pragma unroll
        for (int q = 0; q < 4; ++q) { int m = m0 + q * NGW; m = m < T * 4 ? m : m0; v[q] = *((const v4u*)(X + (size_t)(m >> 2) * pitch + (m & 3) * 512) + lane); }
#pragma unroll
        for (int q = 0; q < 4; ++q) { const int m = m0 + q * NGW; if (m >= T * 4) break;
            const int row = m >> 2, gq = m & 3;
            float x[8] = {bf_lo(v[q].x), bf_hi(v[q].x), bf_lo(v[q].y), bf_hi(v[q].y), bf_lo(v[q].z), bf_hi(v[q].z), bf_lo(v[q].w), bf_hi(v[q].w)};
            float s = 0.f;
#pragma unroll
            for (int e = 0; e < 8; ++e) s += x[e] * x[e];
            const float rstd = rsqrtf(wave_sum(s) * (1.f / 512.f) + NORM_EPS);
            const f32x4 g0 = *(const f32x4*)(gain + gq * 512 + lane * 8), g1 = *(const f32x4*)(gain + gq * 512 + lane * 8 + 4);
            v4u o; o.x = pk2(x[0] * rstd * g0.x, x[1] * rstd * g0.y); o.y = pk2(x[2] * rstd * g0.z, x[3] * rstd * g0.w); o.z = pk2(x[4] * rstd * g1.x, x[5] * rstd * g1.y); o.w = pk2(x[6] * rstd * g1.z, x[7] * rstd * g1.w);
            *((v4u*)(X + (size_t)row * pitch + gq * 512) + lane) = o; }
    }
}
constexpr int SSD_PITCH = 5376, SSD_XBC0 = 2048, SSD_XBCW = 3072;
__device__ __forceinline__ void ssd_halo_save(const bf16* PROJ, bf16* HALO, int gtid, int GT) {
    asm volatile("" : "+v"(gtid));
    for (int idx = gtid; idx < 512 * 3 * 384; idx += GT) {
        const int c8 = idx % 384, r = (idx / 384) % 3, seg = idx / (3 * 384), t0 = seg * 64;
        v4u v = (v4u){0u, 0u, 0u, 0u};
        if ((t0 & 4095) != 0) v = *(const v4u*)(PROJ + (size_t)(t0 - 3 + r) * SSD_PITCH + SSD_XBC0 + c8 * 8);
        *(v4u*)(HALO + ((size_t)seg * 3 + r) * SSD_XBCW + c8 * 8) = v;
    }
}
__device__ __forceinline__ void unpack8(const v4u v, float (&x)[8]) { x[0] = bf_lo(v.x); x[1] = bf_hi(v.x); x[2] = bf_lo(v.y); x[3] = bf_hi(v.y); x[4] = bf_lo(v.z); x[5] = bf_hi(v.z); x[6] = bf_lo(v.w); x[7] = bf_hi(v.w); }
__device__ __forceinline__ void ssd_conv(bf16* PROJ, const bf16* HALO, const float* cw, const float* cb, int gtid, int GT) {
    asm volatile("" : "+v"(gtid));
    for (int idx = gtid; idx < 512 * 384; idx += GT) {
        const int c8 = idx % 384, seg = idx / 384, t0 = seg * 64;
        float w0[8], w1[8], w2[8], w3[8], bb[8], xa[8], xb[8], xc[8], xd[8];
#pragma unroll
        for (int e = 0; e < 8; ++e) { w0[e] = cw[c8 * 8 + e]; w1[e] = cw[SSD_XBCW + c8 * 8 + e]; w2[e] = cw[2 * SSD_XBCW + c8 * 8 + e]; w3[e] = cw[3 * SSD_XBCW + c8 * 8 + e]; bb[e] = cb[c8 * 8 + e]; }
        unpack8(*(const v4u*)(HALO + ((size_t)seg * 3 + 0) * SSD_XBCW + c8 * 8), xa);
        unpack8(*(const v4u*)(HALO + ((size_t)seg * 3 + 1) * SSD_XBCW + c8 * 8), xb);
        unpack8(*(const v4u*)(HALO + ((size_t)seg * 3 + 2) * SSD_XBCW + c8 * 8), xc);
        bf16* p = PROJ + (size_t)t0 * SSD_PITCH + SSD_XBC0 + c8 * 8;
        v4u nxt = *(const v4u*)p;
        for (int tt = 0; tt < 64; ++tt, p += SSD_PITCH) {
            unpack8(nxt, xd);
            if (tt + 1 < 64) nxt = *(const v4u*)(p + SSD_PITCH);
            float o[8];
#pragma unroll
            for (int e = 0; e < 8; ++e) { o[e] = silu_f(bb[e] + w0[e] * xa[e] + w1[e] * xb[e] + w2[e] * xc[e] + w3[e] * xd[e]); xa[e] = xb[e]; xb[e] = xc[e]; xc[e] = xd[e]; }
            v4u w; w.x = pk2(o[0], o[1]); w.y = pk2(o[2], o[3]); w.z = pk2(o[4], o[5]); w.w = pk2(o[6], o[7]);
            *(v4u*)p = w;
        }
    }
}
template <int DH> struct FaState { float m, l; f32x4 o[DH / 16]; };
template <int DH> __device__ __forceinline__ void fa_init(FaState<DH>& st) { st.m = -1e30f; st.l = 0.f;
#pragma unroll
    for (int i = 0; i < DH / 16; ++i) st.o[i] = (f32x4){0.f, 0.f, 0.f, 0.f}; }
__device__ __forceinline__ float fexp2(float x) { return __builtin_amdgcn_exp2f(x); }

__device__ __forceinline__ float gmax4(float x) {
    const auto r = __builtin_amdgcn_permlane16_swap(__float_as_uint(x), __float_as_uint(x), false, false);
    const float y = fmaxf(__uint_as_float(r[0]), __uint_as_float(r[1]));
    const auto r2 = __builtin_amdgcn_permlane32_swap(__float_as_uint(y), __float_as_uint(y), false, false);
    return fmaxf(__uint_as_float(r2[0]), __uint_as_float(r2[1]));
}
__device__ __forceinline__ float gsum4(float x) {
    const auto r = __builtin_amdgcn_permlane16_swap(__float_as_uint(x), __float_as_uint(x), false, false);
    const float y = __uint_as_float(r[0]) + __uint_as_float(r[1]);
    const auto r2 = __builtin_amdgcn_permlane32_swap(__float_as_uint(y), __float_as_uint(y), false, false);
    return __uint_as_float(r2[0]) + __uint_as_float(r2[1]);
}
template <int DH, class Mask>
__device__ __forceinline__ void fa_tile(const LAS unsigned char* Kt, const LAS unsigned char* Vt, const bf16x8 (&qf)[DH / 32], FaState<DH>& st, float sc2, const Mask& mk, int ti, int l15, int g, int q4, int p4) {
    constexpr int KS = (DH + 8) * 2;
    f32x4 s0 = (f32x4){0.f, 0.f, 0.f, 0.f}, s1 = s0;
#pragma unroll
    for (int kk = 0; kk < DH / 32; ++kk) {
        s0 = mfma16(ldrow(Kt + l15 * KS + (8 * g + 32 * kk) * 2), qf[kk], s0);
        s1 = mfma16(ldrow(Kt + (16 + l15) * KS + (8 * g + 32 * kk) * 2), qf[kk], s1);
    }
    float v[8]; float tm = -3.0e38f;
    const bool rok = mk.row_ok(ti);
    if (mk.need_check(ti)) {
        const int key0 = mk.key0(ti);
#pragma unroll
        for (int r = 0; r < 4; ++r) {
            v[r] = (rok && mk.valid(key0 + 4 * g + r)) ? s0[r] * sc2 : -3.0e38f; v[4 + r] = (rok && mk.valid(key0 + 16 + 4 * g + r)) ? s1[r] * sc2 : -3.0e38f;
        }
    } else {
#pragma unroll
        for (int r = 0; r < 4; ++r) { v[r] = rok ? s0[r] * sc2 : -3.0e38f; v[4 + r] = rok ? s1[r] * sc2 : -3.0e38f; }
    }
#pragma unroll
    for (int e = 0; e < 8; ++e) tm = fmaxf(tm, v[e]);
    tm = gmax4(tm);
    const float mn = fmaxf(st.m, tm), alpha = fexp2(st.m - mn);
    float p[8], ps = 0.f;
#pragma unroll
    for (int e = 0; e < 8; ++e) { p[e] = fexp2(v[e] - mn); ps += p[e]; }
    ps = gsum4(ps);
    st.l = st.l * alpha + ps; st.m = mn;
    v4u pbu; pbu.x = pk2(p[0], p[1]); pbu.y = pk2(p[2], p[3]); pbu.z = pk2(p[4], p[5]); pbu.w = pk2(p[6], p[7]);
    const bf16x8 pb = __builtin_bit_cast(bf16x8, pbu);
#pragma unroll
    for (int dt = 0; dt < DH / 16; ++dt) {
        const s16x4 a = ldtr(Vt + (4 * g + q4) * KS + (16 * dt + 4 * p4) * 2), b = ldtr(Vt + (16 + 4 * g + q4) * KS + (16 * dt + 4 * p4) * 2);
        st.o[dt] = mfma16((bf16x8){a[0], a[1], a[2], a[3], b[0], b[1], b[2], b[3]}, pb, st.o[dt] * alpha);
    }
}

template <int DH, int NSUB, class Mask>
__device__ __forceinline__ void fa_stage(const LAS unsigned char* Kb, const LAS unsigned char* Vb, const bf16x8 (&qf)[DH / 32], FaState<DH>& st, float sc2, const Mask& mk, int ti0, int t_end, int l15, int g, int q4, int p4) {
    constexpr int KS = (DH + 8) * 2, TB = 32 * KS;
    float v[NSUB][8]; bool act[NSUB]; float tm = -3.0e38f;
#pragma unroll
    for (int u = 0; u < NSUB; ++u) {
        const int ti = ti0 + u; act[u] = ti < t_end && mk.wave_needs(ti);
        if (act[u]) {
            const LAS unsigned char* Kt = Kb + u * TB;
            f32x4 s0 = (f32x4){0.f, 0.f, 0.f, 0.f}, s1 = s0;
#pragma unroll
            for (int kk = 0; kk < DH / 32; ++kk) {
                s0 = mfma16(ldrow(Kt + l15 * KS + (8 * g + 32 * kk) * 2), qf[kk], s0);
                s1 = mfma16(ldrow(Kt + (16 + l15) * KS + (8 * g + 32 * kk) * 2), qf[kk], s1);
            }
            const float rb = mk.row_ok(ti) ? 0.f : -3.0e38f;
            if (mk.need_check(ti)) {
                const int key0 = mk.key0(ti);
#pragma unroll
                for (int r = 0; r < 4; ++r) { v[u][r] = mk.valid(key0 + 4 * g + r) ? fmaf(s0[r], sc2, rb) : -3.0e38f; v[u][4 + r] = mk.valid(key0 + 16 + 4 * g + r) ? fmaf(s1[r], sc2, rb) : -3.0e38f; }
            } else {
#pragma unroll
                for (int r = 0; r < 4; ++r) { v[u][r] = fmaf(s0[r], sc2, rb); v[u][4 + r] = fmaf(s1[r], sc2, rb); }
            }
#pragma unroll
            for (int e = 0; e < 8; ++e) tm = fmaxf(tm, v[u][e]);
        } else {
#pragma unroll
            for (int e = 0; e < 8; ++e) v[u][e] = -3.0e38f;
        }
    }
    tm = gmax4(tm);
    const float mn = fmaxf(st.m, tm), alpha = fexp2(st.m - mn);
    float ps = 0.f;
#pragma unroll
    for (int u = 0; u < NSUB; ++u)
#pragma unroll
        for (int e = 0; e < 8; ++e) { v[u][e] = fexp2(v[u][e] - mn); ps += v[u][e]; }
    ps = gsum4(ps);
    st.l = st.l * alpha + ps; st.m = mn;
#pragma unroll
    for (int dt = 0; dt < DH / 16; ++dt) st.o[dt] = st.o[dt] * alpha;
#pragma unroll
    for (int u = 0; u < NSUB; ++u) {
        if (act[u]) {
            const LAS unsigned char* Vt = Vb + u * TB;
            v4u pbu; pbu.x = pk2(v[u][0], v[u][1]); pbu.y = pk2(v[u][2], v[u][3]); pbu.z = pk2(v[u][4], v[u][5]); pbu.w = pk2(v[u][6], v[u][7]);
            const bf16x8 pb = __builtin_bit_cast(bf16x8, pbu);
#pragma unroll
            for (int dt = 0; dt < DH / 16; ++dt) {
                const s16x4 a = ldtr(Vt + (4 * g + q4) * KS + (16 * dt + 4 * p4) * 2), b = ldtr(Vt + (16 + 4 * g + q4) * KS + (16 * dt + 4 * p4) * 2);
                st.o[dt] = mfma16((bf16x8){a[0], a[1], a[2], a[3], b[0], b[1], b[2], b[3]}, pb, st.o[dt]);
            }
        }
    }
}

template <int DH, int NSUB, class Src, class Mask>
__device__ __forceinline__ void fa_stream(LAS unsigned char* lds, int tid, int t_begin, int t_end, const Src& src, const Mask& mk, const bf16x8 (&qf)[DH / 32], FaState<DH>& st, float sc2) {
    constexpr int KS = (DH + 8) * 2, TB = 32 * KS, SB = NSUB * TB;
    if (t_begin >= t_end) return;
    const int lane = tid & 63, l15 = lane & 15, g = lane >> 4, q4 = l15 >> 2, p4 = l15 & 3;
    v4u rkA[NSUB], rvA[NSUB], rkB[NSUB], rvB[NSUB];
    int lj, lpc; bool isv = false;
    if constexpr (DH == 128) { lj = tid >> 4; lpc = tid & 15; } else { lj = (tid & 255) >> 3; lpc = tid & 7; isv = tid >= 256; }
    const int nst = (t_end - t_begin + NSUB - 1) / NSUB;
#define FA_ISSUE(k, RK, RV) do { _Pragma("unroll") for (int u = 0; u < NSUB; ++u) { int ti = t_begin + (k) * NSUB + u; ti = ti < t_end ? ti : t_end - 1; \
            const bf16* rp_ = src.krow(ti, lj) + lpc * 8; if constexpr (DH == 128) { RK[u] = *(const v4u*)rp_; RV[u] = *(const v4u*)(rp_ + src.voff); } \
            else { RK[u] = *(const v4u*)(rp_ + (isv ? src.voff : 0)); } } } while (0)
#define FA_COMMIT(buf, RK, RV) do { _Pragma("unroll") for (int u = 0; u < NSUB; ++u) { \
            if constexpr (DH == 128) { *(LAS v4u*)(lds + (buf) * SB + u * TB + lj * KS + lpc * 16) = RK[u]; *(LAS v4u*)(lds + (2 + (buf)) * SB + u * TB + lj * KS + lpc * 16) = RV[u]; } \
            else { *(LAS v4u*)(lds + ((isv ? 2 : 0) + (buf)) * SB + u * TB + lj * KS + lpc * 16) = RK[u]; } } } while (0)
    FA_ISSUE(0, rkA, rvA); FA_COMMIT(0, rkA, rvA);
    if (1 < nst) FA_ISSUE(1, rkB, rvB);
    __syncthreads();
    for (int k = 0; k < nst; k += 2) {
        if (k + 2 < nst) FA_ISSUE(k + 2, rkA, rvA);
        fa_stage<DH, NSUB, Mask>(lds, lds + 2 * SB, qf, st, sc2, mk, t_begin + k * NSUB, t_end, l15, g, q4, p4);
        if (k + 1 < nst) FA_COMMIT(1, rkB, rvB);
        __syncthreads();
        if (k + 1 >= nst) break;
        if (k + 3 < nst) FA_ISSUE(k + 3, rkB, rvB);
        fa_stage<DH, NSUB, Mask>(lds + SB, lds + 3 * SB, qf, st, sc2, mk, t_begin + (k + 1) * NSUB, t_end, l15, g, q4, p4);
        if (k + 2 < nst) FA_COMMIT(0, rkA, rvA);
        __syncthreads();
    }
#undef FA_ISSUE
#undef FA_COMMIT
}

constexpr int DIL_PITCH = 3072;
struct DilSrc { const bf16* kbase; int band0, r, c; static constexpr int voff = 1024;
    __device__ __forceinline__ const bf16* krow(int s, int j) const { int a = band0 + 32 * s + j; a = a < 0 ? 0 : a; return kbase + (size_t)(a * r + c) * DIL_PITCH; }
    __device__ __forceinline__ const bf16* vrow(int s, int j) const { return krow(s, j) + 1024; } };
struct DilMask { int aq, band0, w;
    __device__ __forceinline__ bool valid(int ak) const { return ak >= 0 && ak <= aq && aq - ak <= 128; }
    __device__ __forceinline__ bool row_ok(int) const { return true; }
    __device__ __forceinline__ bool need_check(int) const { return true; }
    __device__ __forceinline__ bool wave_needs(int s) const { return 32 * s + 31 >= 16 * w && 32 * s <= 16 * w + 143; }
    __device__ __forceinline__ int key0(int s) const { return band0 + 32 * s; } };

__device__ __forceinline__ void dilated_phase(LAS unsigned char* lds, const bf16* PROJD, bf16* OACC, float* LSE, int gi, int G, int wave_s) {
    int tid_ = wave_s * 64 + lane_id_now(); asm volatile("" : "+v"(tid_));
    const int tid = tid_, lane = tid & 63, wave = __builtin_amdgcn_readfirstlane(tid >> 6), l15 = lane & 15, g = lane >> 4;
    const int r = (gi == 0) ? 1 : (gi == 1 ? 4 : 16);
    const float sc2 = 0.08838834764831845f * 1.4426950408889634f;
    for (int item = blockIdx.x; item < 2048; item += G) {
        const int bh = item >> 5, b = bh >> 3, h = bh & 7, rem = item & 31, c = rem % r, qt = rem / r;
        const bf16* base = PROJD + (size_t)b * SEQ * DIL_PITCH + h * 128;
        const int aq = 128 * qt + 16 * wave + l15, tq = aq * r + c;
        bf16x8 qf[4];
#pragma unroll
        for (int kk = 0; kk < 4; ++kk) qf[kk] = *(const bf16x8*)(base + (size_t)tq * DIL_PITCH + 8 * g + 32 * kk);
        DilSrc src{base + 1024, 128 * qt - 128, r, c};
        DilMask mk{aq, 128 * qt - 128, wave};
        FaState<128> st; fa_init<128>(st);
        fa_stream<128, 2, DilSrc, DilMask>(lds, tid, qt == 0 ? 4 : 0, 8, src, mk, qf, st, sc2);
        const float inv = 1.f / fmaxf(st.l, 1e-30f);
        float lse = (st.m + __log2f(fmaxf(st.l, 1e-30f))) * 0.6931471805599453f;
        const size_t trow = (size_t)b * SEQ + tq;
        float wp = 0.f, wn = 1.f;
        if (gi > 0) { const float lp = LSE[trow * 8 + h]; const float mx = fmaxf(lp, lse); const float ep = __expf(lp - mx), en = __expf(lse - mx); const float den = ep + en; wp = ep / den; wn = en / den; lse = mx + __logf(den); }
        bf16* op = OACC + trow * 1024 + h * 128 + 4 * g;
#pragma unroll
        for (int dt = 0; dt < 8; ++dt) {
            f32x4 o = st.o[dt] * (inv * wn);
            if (gi > 0) { const v2u old = *(const v2u*)(op + 16 * dt); o[0] += wp * bf_lo(old.x); o[1] += wp * bf_hi(old.x); o[2] += wp * bf_lo(old.y); o[3] += wp * bf_hi(old.y); }
            v2u w; w.x = pk2(o[0], o[1]); w.y = pk2(o[2], o[3]);
            *(v2u*)(op + 16 * dt) = w;
        }
        if (g == 0) LSE[trow * 8 + h] = lse;
    }
}
constexpr int NSA_PITCH = 2816;
__device__ __forceinline__ void nsa_im2col(const bf16* PROJN, const float* pos, bf16* ACMP, int gtid, int GT) {
    asm volatile("" : "+v"(gtid));
    for (int idx = gtid; idx < 2 * 8192 * 256; idx += GT) {
        const int pc = idx & 255, row = (idx >> 8) & 8191, kv = idx >> 21;
        const int l = pc >> 3, d0 = (pc & 7) * 8, n = row & 255, bg = row >> 8, b = bg >> 2, gq = bg & 3;
        v4u o = (v4u){0u, 0u, 0u, 0u};
        if (n < 255) {
            const v4u v = *(const v4u*)(PROJN + (size_t)(b * SEQ + 16 * n + l) * NSA_PITCH + 1024 + kv * 256 + gq * 64 + d0);
            const f32x4 p0 = *(const f32x4*)(pos + kv * 2048 + l * 64 + d0), p1 = *(const f32x4*)(pos + kv * 2048 + l * 64 + d0 + 4);
            o.x = pk2(bf_lo(v.x) + p0.x, bf_hi(v.x) + p0.y); o.y = pk2(bf_lo(v.y) + p0.z, bf_hi(v.y) + p0.w);
            o.z = pk2(bf_lo(v.z) + p1.x, bf_hi(v.z) + p1.y); o.w = pk2(bf_lo(v.w) + p1.z, bf_hi(v.w) + p1.w);
        }
        *(v4u*)(ACMP + ((size_t)kv * 8192 + row) * 2048 + pc * 8) = o;
    }
}
struct TokSrc { const bf16* kbase; const LAS int* list; static constexpr int voff = 256;
    __device__ __forceinline__ int tile(int s) const { return list ? list[s] : s; }
    __device__ __forceinline__ const bf16* krow(int s, int j) const { return kbase + (size_t)(32 * tile(s) + j) * NSA_PITCH; }
};
struct SelMask { unsigned lo, hi, wlo, whi; int t, qb; const LAS int* list;
    __device__ __forceinline__ bool row_ok(int ti) const { const int jb = list[ti] >> 1; return ((jb < 32) ? (lo >> jb) & 1u : (hi >> (jb - 32)) & 1u) != 0u; }
    __device__ __forceinline__ bool need_check(int ti) const { return list[ti] == qb; }
    __device__ __forceinline__ bool valid(int tok) const { return tok <= t; }
    __device__ __forceinline__ bool wave_needs(int ti) const { const int jb = list[ti] >> 1; return ((jb < 32) ? (wlo >> jb) & 1u : (whi >> (jb - 32)) & 1u) != 0u; }
    __device__ __forceinline__ int key0(int ti) const { return 32 * list[ti]; } };
struct WinMask { int t, qb, sb;
    __device__ __forceinline__ bool row_ok(int) const { return true; }
    __device__ __forceinline__ bool need_check(int ti) const { return ti == qb || ti == sb; }
    __device__ __forceinline__ bool valid(int tok) const { return tok <= t && tok > t - 512; }
    __device__ __forceinline__ bool wave_needs(int) const { return true; }
    __device__ __forceinline__ int key0(int ti) const { return 32 * ti; } };

__device__ __forceinline__ void nsa_phase(LAS unsigned char* lds, const bf16* PROJN, const bf16* KVC, bf16* ONSA, int G, int wave_s, unsigned long long* pc_) {
#define NSA_STAMP(sec) do { if ((PROBE_MASK >> 8) != 0 && blockIdx.x == 0 && threadIdx.x == 0) { const unsigned long long now_ = __builtin_amdgcn_s_memrealtime(); if ((PROBE_MASK >> (8 + (sec))) & 1) pc_[1] += now_ - pc_[0]; pc_[0] = now_; } } while (0)
    constexpr int KS = 144, OFF_KC = 0, OFF_VC = OFF_KC + 256 * KS, OFF_IMP = OFF_VC + 256 * KS, OFF_SEL = OFF_IMP + 32 * 256 * 4, OFF_UNI = OFF_SEL + 256, OFF_TL = OFF_UNI + 64, OFF_NT = OFF_TL + 512;
    int tid_ = wave_s * 64 + lane_id_now(); asm volatile("" : "+v"(tid_));
    const int tid = tid_, lane = tid & 63, wave = __builtin_amdgcn_readfirstlane(tid >> 6), l15 = lane & 15, g = lane >> 4, q4 = l15 >> 2, p4 = l15 & 3;
    const float sc2 = 0.125f * 1.4426950408889634f;
    LAS float* IMP = (LAS float*)(lds + OFF_IMP);
    LAS unsigned* SEL = (LAS unsigned*)(lds + OFF_SEL);
    LAS unsigned* UNI = (LAS unsigned*)(lds + OFF_UNI);
    LAS int* TL = (LAS int*)(lds + OFF_TL);
    LAS int* NT = (LAS int*)(lds + OFF_NT);
    for (int item = blockIdx.x; item < 4096; item += G) {
        const int bg = item >> 7, qb = ((bg >> 1) & 1) ? 127 - (item & 127) : (item & 127), b = bg >> 2, gq = bg & 3, t0 = 32 * qb, cur = t0 >> 6;
        const int ql = 4 * wave + q4, hp = p4, t = t0 + ql;
        const bf16* prow = PROJN + (size_t)b * SEQ * NSA_PITCH;
        bf16x8 qf[2];
#pragma unroll
        for (int kk = 0; kk < 2; ++kk) qf[kk] = *(const bf16x8*)(prow + (size_t)t * NSA_PITCH + gq * 256 + hp * 64 + 8 * g + 32 * kk);
        int ncv = (t0 >> 4) + 1; ncv = ncv > 255 ? 255 : ncv; const int ntc = (ncv + 31) >> 5;
        {
            v4u tmp[8];
            const unsigned nrow = (unsigned)tid >> 3, boff = ((unsigned)bg * 256u + nrow) * 256u + ((unsigned)tid & 7u) * 8u;
#pragma unroll
            for (int u = 0; u < 8; ++u) if ((int)nrow + 64 * (u & 3) < 32 * ntc) tmp[u] = *(const v4u*)(KVC + boff + (unsigned)(u & 3) * 16384u + (unsigned)(u >> 2) * 2097152u);
#pragma unroll
            for (int u = 0; u < 8; ++u) if ((int)nrow + 64 * (u & 3) < 32 * ntc) *(LAS v4u*)(lds + ((u >> 2) ? OFF_VC : OFF_KC) + ((int)nrow + 64 * (u & 3)) * KS + (tid & 7) * 16) = tmp[u];
        }
        __syncthreads();
        f32x4 oc[4];
#pragma unroll
        for (int i = 0; i < 4; ++i) oc[i] = (f32x4){0.f, 0.f, 0.f, 0.f};
        {
            f32x4 sc[8][2]; float mx = -1e30f;
#pragma unroll
            for (int s = 0; s < 8; ++s) {
                sc[s][0] = (f32x4){-1e30f, -1e30f, -1e30f, -1e30f}; sc[s][1] = sc[s][0];
                if (s < ntc) {
                    f32x4 a0 = (f32x4){0.f, 0.f, 0.f, 0.f}, a1 = a0;
#pragma unroll
                    for (int kk = 0; kk < 2; ++kk) {
                        a0 = mfma16(ldrow(lds + OFF_KC + (32 * s + l15) * KS + (8 * g + 32 * kk) * 2), qf[kk], a0);
                        a1 = mfma16(ldrow(lds + OFF_KC + (32 * s + 16 + l15) * KS + (8 * g + 32 * kk) * 2), qf[kk], a1);
                    }
#pragma unroll
                    for (int r = 0; r < 4; ++r) {
                        const int n0 = 32 * s + 4 * g + r, n1 = n0 + 16;
                        sc[s][0][r] = (16 * n0 + 31 <= t && n0 < 255) ? a0[r] * sc2 : -1e30f;
                        sc[s][1][r] = (16 * n1 + 31 <= t && n1 < 255) ? a1[r] * sc2 : -1e30f;
                        mx = fmaxf(mx, fmaxf(sc[s][0][r], sc[s][1][r]));
                    }
                }
            }
            mx = gmax4(mx);
            float sum = 0.f;
#pragma unroll
            for (int s = 0; s < 8; ++s)
#pragma unroll
                for (int e = 0; e < 2; ++e)
#pragma unroll
                    for (int r = 0; r < 4; ++r) { const float p = (sc[s][e][r] > -5e29f) ? fexp2(sc[s][e][r] - mx) : 0.f; sc[s][e][r] = p; sum += p; }
            sum = gsum4(sum);
            const float inv = 1.f / fmaxf(sum, 1e-30f);
#pragma unroll
            for (int s = 0; s < 8; ++s) {
                float p[8];
#pragma unroll
                for (int r = 0; r < 4; ++r) { p[r] = sc[s][0][r] * inv; p[4 + r] = sc[s][1][r] * inv; }
#pragma unroll
                for (int e = 0; e < 8; ++e) { float x = p[e]; x += __int_as_float(__builtin_amdgcn_update_dpp(0, __float_as_int(x), 0xB1, 0xf, 0xf, false)); x += __int_as_float(__builtin_amdgcn_update_dpp(0, __float_as_int(x), 0x4E, 0xf, 0xf, false));
                    if (hp == 0) IMP[ql * 256 + 32 * s + 16 * (e >> 2) + 4 * g + (e & 3)] = x; }
                if (s < ntc) {
                    v4u pbu; pbu.x = pk2(p[0], p[1]); pbu.y = pk2(p[2], p[3]); pbu.z = pk2(p[4], p[5]); pbu.w = pk2(p[6], p[7]);
                    const bf16x8 pb = __builtin_bit_cast(bf16x8, pbu);
#pragma unroll
                    for (int dt = 0; dt < 4; ++dt) {
                        const s16x4 a = ldtr(lds + OFF_VC + (32 * s + 4 * g + q4) * KS + (16 * dt + 4 * p4) * 2), bb = ldtr(lds + OFF_VC + (32 * s + 16 + 4 * g + q4) * KS + (16 * dt + 4 * p4) * 2);
                        oc[dt] = mfma16((bf16x8){a[0], a[1], a[2], a[3], bb[0], bb[1], bb[2], bb[3]}, pb, oc[dt]);
                    }
                }
            }
        }
        unsigned ocp[8];
#pragma unroll
        for (int dt = 0; dt < 4; ++dt) { ocp[2 * dt] = pk2(oc[dt][0], oc[dt][1]); ocp[2 * dt + 1] = pk2(oc[dt][2], oc[dt][3]); }
        __syncthreads();
        NSA_STAMP(0);
        {
            unsigned ulo = 0u, uhi = 0u;
            unsigned key[4];
#pragma unroll
            for (int qi = 0; qi < 4; ++qi) {
                const int qq = 4 * wave + qi, jb = lane;
                const LAS float* ip = IMP + qq * 256 + 4 * jb;
                const float pm1 = (jb > 0) ? ip[-1] : 0.f;
                const float imp_sel = pm1 + 2.f * (ip[0] + ip[1] + ip[2]) + ip[3];
                const bool forced = (jb == 0) || (jb == cur) || (jb == cur - 1);
                key[qi] = (jb <= cur) ? __float_as_uint(imp_sel + (forced ? 1e4f : 0.f)) + 1u : 0u;
            }
            unsigned thr[4] = {0u, 0u, 0u, 0u};
            for (int bit = 31; bit >= 0; --bit) {
#pragma unroll
                for (int qi = 0; qi < 4; ++qi) { const unsigned cand = thr[qi] | (1u << bit); if (__popcll(__ballot(key[qi] >= cand)) >= 16) thr[qi] = cand; }
            }
#pragma unroll
            for (int qi = 0; qi < 4; ++qi) {
                const int qq = 4 * wave + qi;
                const bool gt = key[qi] > thr[qi], eq = key[qi] == thr[qi];
                const int need = 16 - __popcll(__ballot(gt));
                const unsigned long long em = __ballot(eq);
                const int below = __popcll(em & ((1ull << lane) - 1ull));
                const bool sel = key[qi] > 0u && (gt || (eq && below < need));
                const unsigned long long mask = __ballot(sel);
                if (lane == 0) { SEL[2 * qq] = (unsigned)mask; SEL[2 * qq + 1] = (unsigned)(mask >> 32); }
                ulo |= (unsigned)mask; uhi |= (unsigned)(mask >> 32);
            }
            if (lane == 0) { UNI[2 * wave] = ulo; UNI[2 * wave + 1] = uhi; }
        }
        __syncthreads();
        if (wave == 0) {
            unsigned ulo = 0u, uhi = 0u;
            for (int w = 0; w < 8; ++w) { ulo |= UNI[2 * w]; uhi |= UNI[2 * w + 1]; }
            int cnt = 0;
            for (int half = 0; half < 2; ++half) {
                const int s = lane + 64 * half, jb = s >> 1; const unsigned bit = (jb < 32) ? (ulo >> jb) & 1u : (uhi >> (jb - 32)) & 1u;
                const bool need = (s <= qb) && bit != 0u;
                const unsigned long long m = __ballot(need);
                const int pos = cnt + __popcll(m & ((1ull << lane) - 1ull));
                if (need) TL[pos] = s;
                cnt += __popcll(m);
            }
            if (lane == 0) NT[0] = cnt;
        }
        __syncthreads();
        const int nts = NT[0];
        NSA_STAMP(1);
        FaState<64> ss; fa_init<64>(ss);
        {
            TokSrc src{prow + 1536 + gq * 64, TL};
            SelMask mk{SEL[2 * ql], SEL[2 * ql + 1], (unsigned)__builtin_amdgcn_readfirstlane((int)UNI[2 * wave]), (unsigned)__builtin_amdgcn_readfirstlane((int)UNI[2 * wave + 1]), t, qb, TL};
            fa_stream<64, 4, TokSrc, SelMask>(lds, tid, 0, nts, src, mk, qf, ss, sc2);
        }
        unsigned osp[8]; float isl = 1.f / fmaxf(ss.l, 1e-30f);
#pragma unroll
        for (int dt = 0; dt < 4; ++dt) { osp[2 * dt] = pk2(ss.o[dt][0] * isl, ss.o[dt][1] * isl); osp[2 * dt + 1] = pk2(ss.o[dt][2] * isl, ss.o[dt][3] * isl); }
        NSA_STAMP(2);
        FaState<64> sw; fa_init<64>(sw);
        {
            TokSrc src{prow + 2048 + gq * 64, nullptr};
            const int sb = (t0 - 512) < 0 ? 0 : (t0 - 512) >> 5;
            WinMask mk{t, qb, sb};
            fa_stream<64, 4, TokSrc, WinMask>(lds, tid, sb, qb + 1, src, mk, qf, sw, sc2);
        }
        NSA_STAMP(3);
        {
            const bf16* gp = prow + (size_t)t * NSA_PITCH + 2560 + gq * 4 + hp;
            const float g0 = sigmoid_f(__uint_as_float((unsigned)gp[0] << 16)), g1 = sigmoid_f(__uint_as_float((unsigned)gp[16] << 16)), g2 = sigmoid_f(__uint_as_float((unsigned)gp[32] << 16));
            const float iw = g2 / fmaxf(sw.l, 1e-30f);
            bf16* op = ONSA + ((size_t)b * SEQ + t) * 1024 + gq * 256 + hp * 64 + 4 * g;
#pragma unroll
            for (int dt = 0; dt < 4; ++dt) {
                f32x4 o = sw.o[dt] * iw;
                o[0] += g0 * bf_lo(ocp[2 * dt]) + g1 * bf_lo(osp[2 * dt]); o[1] += g0 * bf_hi(ocp[2 * dt]) + g1 * bf_hi(osp[2 * dt]);
                o[2] += g0 * bf_lo(ocp[2 * dt + 1]) + g1 * bf_lo(osp[2 * dt + 1]); o[3] += g0 * bf_hi(ocp[2 * dt + 1]) + g1 * bf_hi(osp[2 * dt + 1]);
                v2u w; w.x = pk2(o[0], o[1]); w.y = pk2(o[2], o[3]); *(v2u*)(op + 16 * dt) = w; }
        }
        __syncthreads();
        NSA_STAMP(4);
    }
}
#ifndef RET_SCAN
#define RET_SCAN 1
#define RET_GNORM 1
#define RET_GATE 1
#endif
#ifndef ENABLE_SSD
#define ENABLE_SSD 1
#endif
constexpr size_t WS_DTRAW = WS_SCR + 340 * MiB, WS_HALO = WS_SCR + 344 * MiB;
#define MIXER_CONVERT \
    if (mix == 1) { transpose_w<0>(args.in[12], D, 2608, 2816, WMIX, scr, gw, NGW, lane); \
        for (int c = 0; c < 2; ++c) { transpose_w<0>(args.in[14] + (size_t)c * 2048 * 256, 2048, 256, 256, WMIX + 3 * MiB + (size_t)c * 256 * 2048, scr, gw, NGW, lane); \
            transpose_w<0>(args.in[15] + (size_t)c * 256 * 64, 256, 64, 256, WMIX + 4 * MiB + (size_t)c * 256 * 256, scr, gw, NGW, lane); } \
        transpose_w<0>(args.in[16], D, D, D, WMIX + 5 * MiB, scr, gw, NGW, lane); } \
    if (mix == 3) { transpose_w<0>(args.in[25], D, 9216, 9216, WMIX, scr, gw, NGW, lane); transpose_w<0>(args.in[26], D, D, D, WMIX + (size_t)9216 * 1024, scr, gw, NGW, lane); } \
    if (mix == 0) { transpose_w<0>(args.in[9], D, 6144, 6144, WMIX, scr, gw, NGW, lane); transpose_w<0>(args.in[11], 2048, D, D, WMIX + (size_t)6144 * 1024, scr, gw, NGW, lane); } \
    if (mix == 2) { transpose_w<0>(args.in[17], D, 5152, 5376, WMIX, scr, gw, NGW, lane); transpose_w<0>(args.in[24], 2048, D, D, WMIX + (size_t)6144 * 1024, scr, gw, NGW, lane); }

#define MIXER_PHASES \
    if (mix == 0) { \
        bf16* PROJ = (bf16*)(ws + WS_SCR); \
        PHASE_BEGIN { pg8::Epi<pg8::EPI_RETQKV> E{}; E.O = PROJ; E.ldc = 4096; E.rot = ROT; run_gemm<pg8::EPI_RETQKV>(lds, U, D, WMIX, T, 4096, D, E, wave_s); } PHASE_END_C(3) \
        if (RET_SCAN) PHASE_BEGIN \
            for (int item = blockIdx.x; item < 256; item += G) { \
                const int b = item >> 5, h = (item >> 3) & 3, s8 = item & 7; \
                bf16* base = PROJ + (size_t)b * SEQ * 4096; \
                scan_item<256, false>(lds, base + h * 256, base + 1024 + h * 256, base + 2048 + h * 512 + s8 * 64, 4096, base + 2048 + h * 512 + s8 * 64, 4096, log1pf(-exp2f(-5.f - (float)h)), nullptr, 0.f, 0.f, 0.f, wave_s); \
                __syncthreads(); \
            } \
        PHASE_END_C(4) \
        if (RET_GNORM) PHASE_BEGIN gnorm_rows(PROJ + 2048, 4096, args.in[10], gw, NGW, lane); PHASE_END_C(7) \
        if (RET_GATE) PHASE_BEGIN { pg8::Epi<pg8::EPI_GATEMUL> E{}; E.O = PROJ + 2048; E.ldc = 4096; run_gemm<pg8::EPI_GATEMUL>(lds, U, D, WMIX + (size_t)4096 * 1024, T, 2048, D, E, wave_s); } PHASE_END_C(3) \
        PHASE_BEGIN { pg8::Epi<pg8::EPI_RESID> E{}; E.Hout = H; E.Hbase = H; E.scale = 1.0f; E.ldc = D; run_gemm<pg8::EPI_RESID>(lds, PROJ + 2048, 4096, WMIX + (size_t)6144 * 1024, T, D, 2048, E, wave_s); } PHASE_END_C(3) \
    } \
    if (mix == 2 && ENABLE_SSD) { \
        bf16* PROJ = (bf16*)(ws + WS_SCR); float* DTRAW = (float*)(ws + WS_DTRAW); bf16* HALO = (bf16*)(ws + WS_HALO); \
        PHASE_BEGIN { pg8::Epi<pg8::EPI_SSD> E{}; E.O = PROJ; E.ldc = SSD_PITCH; E.aux = DTRAW; run_gemm<pg8::EPI_SSD>(lds, U, D, WMIX, T, SSD_PITCH, D, E, wave_s); } PHASE_END_C(3) \
        PHASE_BEGIN ssd_halo_save(PROJ, HALO, blockIdx.x * NTHR + tid, G * NTHR); PHASE_END_C(7) \
        PHASE_BEGIN ssd_conv(PROJ, HALO, args.in[18], args.in[19], blockIdx.x * NTHR + tid, G * NTHR); PHASE_END_C(7) \
        PHASE_BEGIN \
            for (int item = blockIdx.x; item < 256; item += G) { \
                const int b = item >> 5, gq = (item >> 3) & 3, r = item & 7, hd = gq * 8 + r; \
                bf16* base = PROJ + (size_t)b * SEQ * SSD_PITCH; \
                scan_item<128, true>(lds, base + 4608 + gq * 128, base + 4096 + gq * 128, base + 2048 + gq * 512 + r * 64, SSD_PITCH, base + gq * 512 + r * 64, SSD_PITCH, 0.f, \
                                     DTRAW + (size_t)b * SEQ * 32 + hd, args.in[20][hd], -__expf(args.in[21][hd]), args.in[22][hd], wave_s); \
                __syncthreads(); \
            } \
        PHASE_END_C(4) \
        PHASE_BEGIN gnorm_rows(PROJ, SSD_PITCH, args.in[23], gw, NGW, lane); PHASE_END_C(7) \
        PHASE_BEGIN { pg8::Epi<pg8::EPI_RESID> E{}; E.Hout = H; E.Hbase = H; E.scale = 1.0f; E.ldc = D; run_gemm<pg8::EPI_RESID>(lds, PROJ, SSD_PITCH, WMIX + (size_t)6144 * 1024, T, D, 2048, E, wave_s); } PHASE_END_C(3) \
    } \
    if (mix == 3) { \
        bf16* PROJD = (bf16*)(ws + WS_SCR); bf16* OACC = (bf16*)(ws + WS_SCR + 192 * MiB); float* LSE = (float*)(ws + WS_SCR + 256 * MiB); \
        for (int gi = 0; gi < 3; ++gi) { \
            PHASE_BEGIN { pg8::Epi<pg8::EPI_BF16> E{}; E.O = PROJD; E.ldc = DIL_PITCH; run_gemm<pg8::EPI_BF16>(lds, U, D, WMIX + (size_t)gi * 3072 * 1024, T, 3072, D, E, wave_s); } PHASE_END_C(3) \
            PHASE_BEGIN dilated_phase(lds, PROJD, OACC, LSE, gi, G, wave_s); PHASE_END_C(6) \
        } \
        PHASE_BEGIN { pg8::Epi<pg8::EPI_RESID> E{}; E.Hout = H; E.Hbase = H; E.scale = 1.0f; E.ldc = D; run_gemm<pg8::EPI_RESID>(lds, OACC, D, WMIX + (size_t)9216 * 1024, T, D, D, E, wave_s); } PHASE_END_C(3) \
    } \
    if (mix == 1) { \
        bf16* PROJN = (bf16*)(ws + WS_SCR); bf16* ACMP = (bf16*)(ws + WS_SCR + 176 * MiB); bf16* HIDC = (bf16*)(ws + WS_SCR + 240 * MiB); bf16* KVC = (bf16*)(ws + WS_SCR + 248 * MiB); bf16* ONSA = (bf16*)(ws + WS_SCR + 256 * MiB); \
        PHASE_BEGIN { pg8::Epi<pg8::EPI_BF16> E{}; E.O = PROJN; E.ldc = NSA_PITCH; run_gemm<pg8::EPI_BF16>(lds, U, D, WMIX, T, NSA_PITCH, D, E, wave_s); } PHASE_END_C(3) \
        PHASE_BEGIN nsa_im2col(PROJN, args.in[13], ACMP, blockIdx.x * NTHR + tid, G * NTHR); PHASE_END_C(7) \
        PHASE_BEGIN for (int c = 0; c < 2; ++c) { pg8::Epi<pg8::EPI_SILU> E{}; E.O = HIDC + (size_t)c * 8192 * 256; E.ldc = 256; run_gemm<pg8::EPI_SILU>(lds, ACMP + (size_t)c * 8192 * 2048, 2048, WMIX + 3 * MiB + (size_t)c * 256 * 2048, 8192, 256, 2048, E, wave_s); } PHASE_END_C(3) \
        PHASE_BEGIN for (int c = 0; c < 2; ++c) { pg8::Epi<pg8::EPI_BF16> E{}; E.O = KVC + (size_t)c * 8192 * 256; E.ldc = 256; run_gemm<pg8::EPI_BF16>(lds, HIDC + (size_t)c * 8192 * 256, 256, WMIX + 4 * MiB + (size_t)c * 256 * 256, 8192, 256, 256, E, wave_s); } PHASE_END_C(3) \
        PHASE_BEGIN nsa_phase(lds, PROJN, KVC, ONSA, G, wave_s, (unsigned long long*)(args.ws + 32768)); PHASE_END_C(5) \
        PHASE_BEGIN { pg8::Epi<pg8::EPI_RESID> E{}; E.Hout = H; E.Hbase = H; E.scale = 1.0f; E.ldc = D; run_gemm<pg8::EPI_RESID>(lds, ONSA, D, WMIX + 5 * MiB, T, D, D, E, wave_s); } PHASE_END_C(3) \
    }
__global__ void __launch_bounds__(NTHR, 2) fwd_megakernel(Args args) {
    extern __shared__ __attribute__((aligned(16))) unsigned char lds_raw[];
    LAS unsigned char* lds = (LAS unsigned char*)lds_raw;
    cg::grid_group grid = cg::this_grid();
    const int G = gridDim.x;
    const int wave_s = __builtin_amdgcn_readfirstlane(threadIdx.x >> 6);
    volatile LAS unsigned* xst = (volatile LAS unsigned*)(lds + LDS_BYTES - 64);
    if (threadIdx.x < 16) xst[threadIdx.x] = 0u;
    __syncthreads();
    const XcdBarrier xbar = xcd_barrier_post((unsigned*)args.ws, xst);
    if (args.ph_lo < 0) grid.sync();
    if (PROBE_MASK != 0 && blockIdx.x == 0 && threadIdx.x == 0) { ((unsigned long long*)(args.ws + 32768))[0] = __builtin_amdgcn_s_memrealtime(); }
#define PHASE_BEGIN {
#define PHASE_END_C(cat) xcd_barrier(xbar); if (PROBE_MASK != 0 && blockIdx.x == 0 && threadIdx.x == 0) { const unsigned long long now_ = __builtin_amdgcn_s_memrealtime(); unsigned long long* c_ = (unsigned long long*)(args.ws + 32768); if ((PROBE_MASK >> (cat)) & 1) c_[1] += now_ - c_[0]; c_[0] = now_; } }
    for (int L = 0; L < DEPTH; ++L) {
        const int mix = L & 3;
        int tid_ = wave_s * 64 + lane_id_now(); asm volatile("" : "+v"(tid_));
        const int tid = tid_, lane = tid & 63, wave = __builtin_amdgcn_readfirstlane(tid >> 6);
        const int gw = blockIdx.x * NWAVES + wave, NGW = G * NWAVES;
        unsigned char* ws = args.ws; asm volatile("" : "+s"(ws));
        float* H = args.out; asm volatile("" : "+s"(H));
        float* ROT = (float*)(ws + WS_ROT);
        bf16* WIN1 = (bf16*)(ws + WS_WIN1); bf16* WOUT1 = (bf16*)(ws + WS_WOUT1); bf16* WIN2 = (bf16*)(ws + WS_WIN2); bf16* WOUT2 = (bf16*)(ws + WS_WOUT2); bf16* WMIX = (bf16*)(ws + WS_WMIX);
        bf16* U = (bf16*)(ws + WS_U); bf16* HID = (bf16*)(ws + WS_SCR);
        LAS float* scr = (LAS float*)(lds + wave * 16384);
        PHASE_BEGIN
            transpose_w<1>(args.in[2] + (size_t)L * D * 2 * FF, D, 2 * FF, 2 * FF, WIN1, scr, gw, NGW, lane);
            transpose_w<0>(args.in[3] + (size_t)L * FF * D, FF, D, D, WOUT1, scr, gw, NGW, lane);
            transpose_w<1>(args.in[6] + (size_t)L * D * 2 * FF, D, 2 * FF, 2 * FF, WIN2, scr, gw, NGW, lane);
            transpose_w<0>(args.in[7] + (size_t)L * FF * D, FF, D, D, WOUT2, scr, gw, NGW, lane);
            MIXER_CONVERT
            if (L == 0) {
                for (int i = blockIdx.x * NTHR + tid; i < 4096 * 128; i += G * NTHR) {
                    const int pos = i >> 7, d = i & 127;
                    const float inv = exp2f(-(float)d * (13.287712379549449f / 128.f));
                    const float ang = (float)pos * inv;
                    const double x = (double)ang * 0.15915494309189535; const float fr = (float)(x - rint(x));
                    ROT[i] = __builtin_amdgcn_cosf(fr); ROT[4096 * 128 + i] = __builtin_amdgcn_sinf(fr);
                }
            }
            rms_rows(L == 0 ? args.in[0] : H, args.in[1] + L * D, U, nullptr, gw, NGW, lane);
        PHASE_END_C(0)
        PHASE_BEGIN { pg8::Epi<pg8::EPI_SWIGLU> E{}; E.O = HID; E.ldc = FF; run_gemm<pg8::EPI_SWIGLU>(lds, U, D, WIN1, T, 2 * FF, D, E, wave_s); } PHASE_END_C(1)
        PHASE_BEGIN { pg8::Epi<pg8::EPI_RESID> E{}; E.Hout = H; E.Hbase = (L == 0) ? args.in[0] : H; E.scale = 0.5f; E.ldc = D; run_gemm<pg8::EPI_RESID>(lds, HID, FF, WOUT1, T, D, FF, E, wave_s); } PHASE_END_C(1)
        PHASE_BEGIN rms_rows(H, args.in[4] + L * D, U, nullptr, gw, NGW, lane); PHASE_END_C(2)
        MIXER_PHASES
        PHASE_BEGIN rms_rows(H, args.in[5] + L * D, U, nullptr, gw, NGW, lane); PHASE_END_C(2)
        PHASE_BEGIN { pg8::Epi<pg8::EPI_SWIGLU> E{}; E.O = HID; E.ldc = FF; run_gemm<pg8::EPI_SWIGLU>(lds, U, D, WIN2, T, 2 * FF, D, E, wave_s); } PHASE_END_C(1)
        PHASE_BEGIN { pg8::Epi<pg8::EPI_RESID> E{}; E.Hout = H; E.Hbase = H; E.scale = 0.5f; E.ldc = D; run_gemm<pg8::EPI_RESID>(lds, HID, FF, WOUT2, T, D, FF, E, wave_s); } PHASE_END_C(1)
    }
    int nprobe = 0; if (PROBE_MASK != 0) { asm volatile("s_waitcnt vmcnt(0)" ::: "memory"); xcd_barrier(xbar); nprobe = (int)(__hip_atomic_load((unsigned long long*)(args.ws + 32768) + 1, __ATOMIC_RELAXED, __HIP_MEMORY_SCOPE_AGENT) >> 3); }
    { const int lane = lane_id_now(); rms_final(args.out, args.in[8], blockIdx.x * NWAVES + wave_s, G * NWAVES, lane, nprobe); }
}

extern "C" void kernel_launch(void* const* d_in, const int* in_sizes, int n_in, void* d_out, int out_size, void* d_ws, size_t ws_size, hipStream_t stream) {
    static int grid = 0;
    if (grid == 0) {
        if (n_in != 27 || out_size != T * D || ws_size < WS_NEED) { fprintf(stderr, "kernel_launch: unexpected problem (n_in %d, out %d, ws %zu)\n", n_in, out_size, ws_size); grid = -1; return; }
        int dev = 0, cus = 0, per_cu = 0;
        hipGetDevice(&dev); hipDeviceGetAttribute(&cus, hipDeviceAttributeMultiprocessorCount, dev);
        if (hipFuncSetAttribute((const void*)fwd_megakernel, hipFuncAttributeMaxDynamicSharedMemorySize, LDS_BYTES) != hipSuccess) { fprintf(stderr, "kernel_launch: hipFuncSetAttribute failed\n"); grid = -1; return; }
        if (hipOccupancyMaxActiveBlocksPerMultiprocessor(&per_cu, (const void*)fwd_megakernel, NTHR, LDS_BYTES) != hipSuccess || per_cu < 1) { fprintf(stderr, "kernel_launch: occupancy query gave %d\n", per_cu); per_cu = 1; }
        (void)hipGetLastError();
        grid = cus * 1;
    }
    if (grid < 0) return;
    if (hipMemsetAsync(d_ws, 0, 65536, stream) != hipSuccess) { fprintf(stderr, "kernel_launch: memset failed\n"); return; }
    Args a{};
    for (int i = 0; i < 27; ++i) a.in[i] = (const float*)d_in[i];
    a.out = (float*)d_out; a.ws = (unsigned char*)d_ws; a.ph_lo = 0; a.ph_hi = 1 << 20;
    void* kargs[] = {&a};
    hipError_t e = hipLaunchCooperativeKernel((const void*)fwd_megakernel, dim3(grid), dim3(NTHR), kargs, LDS_BYTES, stream);
    if (e != hipSuccess) fprintf(stderr, "kernel_launch: cooperative launch failed: %s (grid %d)\n", hipGetErrorString(e), grid);
}
```

```cpp
#include <hip/hip_runtime.h>
#include <hip/hip_cooperative_groups.h>
#include <cstdio>
#include <cstdint>
namespace cg = cooperative_groups;

__device__ __forceinline__ int lane_id_now() { int l; asm volatile("v_mbcnt_lo_u32_b32 %0, -1, 0\n\tv_mbcnt_hi_u32_b32 %0, -1, %0" : "=v"(l)); return l; }

#ifndef PROBE_MASK
#define PROBE_MASK 0
#endif
namespace pg8 {
#define PG8_LAS __attribute__((address_space(3)))
typedef unsigned short bf16_t;
typedef short bf16x8 __attribute__((ext_vector_type(8)));
typedef float f32x4 __attribute__((ext_vector_type(4)));
typedef unsigned u32x4 __attribute__((ext_vector_type(4)));
constexpr int BM = 256, BK = 64, HALF = 128, HTB = HALF * BK * 2  , STAGE_BYTES = 8 * HTB, NXCD = 8, WGM = 8;

__host__ __device__ __forceinline__ int lds_byte(int r, int c) { const int st = (r >> 4) * 2 + (c >> 5), rr = r & 15, cc = c & 31, ob = rr * 64 + cc * 2; return st * 1024 + (ob ^ (((ob >> 9) & 1) << 5)); }
__host__ __device__ __forceinline__ void stage_rc(int b, int& R, int& C) { const int st = b / 1024, sb = b % 1024, swz = sb ^ (((sb >> 9) & 1) << 5); R = (st >> 1) * 16 + swz / 64; C = (st & 1) * 32 + (swz % 64) / 2; }
__host__ __device__ __forceinline__ int perm32(int rho) { const int n = rho >> 4, i = rho & 15; return 8 * (i >> 2) + 4 * n + (i & 3); }

struct Unit { int pm, pn; };
struct Gemm { const bf16_t* A; const bf16_t* Bt; int M, N, K, lda; };

struct StaticOrder {
    int nM, nN, nwg, G, c;
    __host__ __device__ void init(int M, int N, int G_, int c_) { nM = M / BM; nN = N / BM; nwg = nM * nN; G = G_; c = c_; }
    __host__ __device__ bool next(int i, Unit& u) const {
        const long L = (long)i * G + c; if (L >= nwg) return false;
        int wgid = (int)L; { const int q = nwg / NXCD, r = nwg % NXCD, xcd = wgid % NXCD, off = wgid / NXCD; wgid = (xcd < r ? xcd * (q + 1) : r * (q + 1) + (xcd - r) * q) + off; }
        const int nig = WGM * nN, gid = wgid / nig, fm = gid * WGM, gsz = (nM - fm) < WGM ? (nM - fm) : WGM;
        u.pm = fm + ((wgid % nig) % gsz); u.pn = (wgid % nig) / gsz; return true;
    }
    __device__ __forceinline__ void a_ready(const Unit&) const {}
    __device__ __forceinline__ void done(const Unit&) const {}
};

typedef float f32x2_t __attribute__((ext_vector_type(2))); typedef __bf16 bf16x2_t __attribute__((ext_vector_type(2)));
__device__ __forceinline__ unsigned cvt_pk_bf16(float lo, float hi) { f32x2_t v = {lo, hi}; bf16x2_t b = __builtin_convertvector(v, bf16x2_t); return __builtin_bit_cast(unsigned, b); }
__device__ __forceinline__ float bf_lo(unsigned w) { return __uint_as_float(w << 16); }
__device__ __forceinline__ float bf_hi(unsigned w) { return __uint_as_float(w & 0xffff0000u); }
__device__ __forceinline__ float silu_f(float x) { return x * __builtin_amdgcn_rcpf(1.0f + __builtin_amdgcn_exp2f(-1.4426950408889634f * x)); }
__device__ __forceinline__ float sigmoid_f(float x) { return __builtin_amdgcn_rcpf(1.0f + __builtin_amdgcn_exp2f(-1.4426950408889634f * x)); }

enum { EPI_BF16 = 0, EPI_SWIGLU = 1, EPI_RESID = 2, EPI_RETQKV = 3, EPI_GATEMUL = 4, EPI_SSD = 5, EPI_SILU = 6 };
template <int MODE> struct Epi {
    static constexpr bool PERM = true, AFTER_DRAIN = false;
    bf16_t* O; int ldc;
    float* Hout; const float* Hbase; float scale;
    const float* __restrict__ rot;
    float* aux;
    __device__ __forceinline__ void operator()(const f32x4 (&acc)[2][2][4][2], const Unit& u, int wr, int wc, int fr, int fq) const {
        const int row0 = u.pm * BM + wr * 64 + fr;
        const int cl = wc * 32 + 8 * fq;
        if constexpr (MODE == EPI_SWIGLU) {
#pragma unroll
            for (int ai = 0; ai < 2; ++ai)
#pragma unroll
                for (int m = 0; m < 4; ++m) {
                    bf16_t* rowp = O + (size_t)(row0 + ai * HALF + m * 16) * ldc + u.pn * 128 + cl;
                    f32x4 a0 = acc[ai][0][m][0], a1 = acc[ai][0][m][1], b0 = acc[ai][1][m][0], b1 = acc[ai][1][m][1];
                    u32x4 w;
                    w.x = cvt_pk_bf16(silu_f(a0[0]) * b0[0], silu_f(a0[1]) * b0[1]); w.y = cvt_pk_bf16(silu_f(a0[2]) * b0[2], silu_f(a0[3]) * b0[3]);
                    w.z = cvt_pk_bf16(silu_f(a1[0]) * b1[0], silu_f(a1[1]) * b1[1]); w.w = cvt_pk_bf16(silu_f(a1[2]) * b1[2], silu_f(a1[3]) * b1[3]);
                    *(u32x4*)rowp = w;
                }
        } else if constexpr (MODE == EPI_RESID) {
#pragma unroll
            for (int ai = 0; ai < 2; ++ai) {
                f32x4 pre[4][2][2];
#pragma unroll
                for (int m = 0; m < 4; ++m) { const size_t off = (size_t)(row0 + ai * HALF + m * 16) * ldc + u.pn * BM + cl;
#pragma unroll
                    for (int bj = 0; bj < 2; ++bj)
#pragma unroll
                        for (int n = 0; n < 2; ++n) pre[m][bj][n] = *(const f32x4*)(Hbase + off + bj * HALF + 4 * n); }
#pragma unroll
                for (int m = 0; m < 4; ++m) { const size_t off = (size_t)(row0 + ai * HALF + m * 16) * ldc + u.pn * BM + cl;
#pragma unroll
                    for (int bj = 0; bj < 2; ++bj)
#pragma unroll
                        for (int n = 0; n < 2; ++n) *(f32x4*)(Hout + off + bj * HALF + 4 * n) = pre[m][bj][n] + acc[ai][bj][m][n] * scale; }
            }
        } else if constexpr (MODE == EPI_RETQKV) {
            if (u.pn < 8) {
                const float ks = (u.pn >= 4) ? 0.0625f : 1.0f;
#pragma unroll
                for (int ai = 0; ai < 2; ++ai)
#pragma unroll
                    for (int m = 0; m < 4; ++m) {
                        const int r = row0 + ai * HALF + m * 16; const int pos = r & 4095;
                        bf16_t* rowp = O + (size_t)r * ldc + u.pn * BM + cl;
                        u32x4 w1, w2; unsigned* p1 = (unsigned*)&w1; unsigned* p2 = (unsigned*)&w2;
#pragma unroll
                        for (int n = 0; n < 2; ++n) {
                            const f32x4 c = *(const f32x4*)(rot + (size_t)pos * 128 + cl + 4 * n);
                            const f32x4 s = *(const f32x4*)(rot + (size_t)4096 * 128 + (size_t)pos * 128 + cl + 4 * n);
                            const f32x4 t1 = acc[ai][0][m][n] * ks, t2 = acc[ai][1][m][n] * ks;
                            const f32x4 o1 = t1 * c - t2 * s, o2 = t1 * s + t2 * c;
                            p1[2 * n] = cvt_pk_bf16(o1[0], o1[1]); p1[2 * n + 1] = cvt_pk_bf16(o1[2], o1[3]);
                            p2[2 * n] = cvt_pk_bf16(o2[0], o2[1]); p2[2 * n + 1] = cvt_pk_bf16(o2[2], o2[3]);
                        }
                        *(u32x4*)rowp = w1; *(u32x4*)(rowp + HALF) = w2;
                    }
            } else {
#pragma unroll
                for (int ai = 0; ai < 2; ++ai)
#pragma unroll
                    for (int m = 0; m < 4; ++m) {
                        bf16_t* rowp = O + (size_t)(row0 + ai * HALF + m * 16) * ldc + u.pn * BM + cl;
#pragma unroll
                        for (int bj = 0; bj < 2; ++bj) { const f32x4 v0 = acc[ai][bj][m][0], v1 = acc[ai][bj][m][1]; u32x4 w;
                            w.x = cvt_pk_bf16(v0[0], v0[1]); w.y = cvt_pk_bf16(v0[2], v0[3]); w.z = cvt_pk_bf16(v1[0], v1[1]); w.w = cvt_pk_bf16(v1[2], v1[3]);
                            *(u32x4*)(rowp + bj * HALF) = w; }
                    }
            }
        } else if constexpr (MODE == EPI_GATEMUL) {
#pragma unroll
            for (int ai = 0; ai < 2; ++ai)
#pragma unroll
                for (int m = 0; m < 4; ++m) {
                    bf16_t* rowp = O + (size_t)(row0 + ai * HALF + m * 16) * ldc + u.pn * BM + cl;
#pragma unroll
                    for (int bj = 0; bj < 2; ++bj) { const f32x4 v0 = acc[ai][bj][m][0], v1 = acc[ai][bj][m][1]; const u32x4 old = *(const u32x4*)(rowp + bj * HALF); u32x4 w;
                        w.x = cvt_pk_bf16(silu_f(v0[0]) * bf_lo(old.x), silu_f(v0[1]) * bf_hi(old.x)); w.y = cvt_pk_bf16(silu_f(v0[2]) * bf_lo(old.y), silu_f(v0[3]) * bf_hi(old.y));
                        w.z = cvt_pk_bf16(silu_f(v1[0]) * bf_lo(old.z), silu_f(v1[1]) * bf_hi(old.z)); w.w = cvt_pk_bf16(silu_f(v1[2]) * bf_lo(old.w), silu_f(v1[3]) * bf_hi(old.w));
                        *(u32x4*)(rowp + bj * HALF) = w; }
                }
        } else {
            if (MODE == EPI_SSD && u.pn == 20) {
                if (wc == 0) {
#pragma unroll
                    for (int ai = 0; ai < 2; ++ai)
#pragma unroll
                        for (int m = 0; m < 4; ++m) { float* p = aux + (size_t)(row0 + ai * HALF + m * 16) * 32 + cl;
                            *(f32x4*)p = acc[ai][0][m][0]; *(f32x4*)(p + 4) = acc[ai][0][m][1]; }
                }
                return;
            }
#pragma unroll
            for (int ai = 0; ai < 2; ++ai)
#pragma unroll
                for (int m = 0; m < 4; ++m) {
                    bf16_t* rowp = O + (size_t)(row0 + ai * HALF + m * 16) * ldc + u.pn * BM + cl;
#pragma unroll
                    for (int bj = 0; bj < 2; ++bj) { f32x4 v0 = acc[ai][bj][m][0], v1 = acc[ai][bj][m][1]; u32x4 w;
                        if (MODE == EPI_SILU) { v0 = (f32x4){silu_f(v0[0]), silu_f(v0[1]), silu_f(v0[2]), silu_f(v0[3])}; v1 = (f32x4){silu_f(v1[0]), silu_f(v1[1]), silu_f(v1[2]), silu_f(v1[3])}; }
                        w.x = cvt_pk_bf16(v0[0], v0[1]); w.y = cvt_pk_bf16(v0[2], v0[3]); w.z = cvt_pk_bf16(v1[0], v1[1]); w.w = cvt_pk_bf16(v1[2], v1[3]);
                        *(u32x4*)(rowp + bj * HALF) = w; }
                }
        }
    }
};
template <class Epi, class Sched, bool ALIGN_EPI = false, bool SP2 = false>
__device__ __forceinline__ void gemm_phase(PG8_LAS unsigned char* lds, const Gemm g, const Sched& S, const Epi& E, int wave_s) {
    int tid_ = wave_s * 64 + lane_id_now(); asm volatile("" : "+v"(tid_)); const int tid = tid_, wid = __builtin_amdgcn_readfirstlane(tid >> 6), lane = tid & 63, wr = wid >> 2, wc = wid & 3, fr = lane & 15, fq = lane >> 4;
    const int K = g.K, nt = K / BK;
    unsigned voffA[2], voffB[2];
#pragma unroll
    for (int i = 0; i < 2; ++i) { int R, C; stage_rc(tid * 16 + i * 8192, R, C); const int Rb = Epi::PERM ? ((R & ~31) + perm32(R & 31)) : R;
        voffA[i] = (unsigned)(R * g.lda + C) * 2u; voffB[i] = (unsigned)(Rb * K + C) * 2u; }
    const size_t kstep = (size_t)(BK * 2);
    const size_t hstepA = (size_t)HALF * g.lda * 2, hstepB = (size_t)HALF * K * 2;
    const size_t tstepA = 2 * hstepA, tstepB = 2 * hstepB;
    const unsigned ldsw = (unsigned)wid * 1024u;
    const int aoff = lds_byte(wr * 64 + fr, fq * 8), boff = lds_byte(wc * 32 + fr, fq * 8);
#define PG8_SA(b, h) (((b) * 2 + (h)) * HTB)
#define PG8_SB(b, h) ((4 + (b) * 2 + (h)) * HTB)
#define PG8_STAGE(bufoff, gbase, voff) do { _Pragma("unroll") for (int _i = 0; _i < 2; ++_i) \
        __builtin_amdgcn_global_load_lds((const unsigned*)((const char*)(gbase) + (voff)[_i]), (PG8_LAS unsigned*)(lds + (bufoff) + ldsw + _i * 8192), 16, 0, 0); } while (0)
#define PG8_LDA(dst, b, h) do { _Pragma("unroll") for (int m = 0; m < 4; ++m) _Pragma("unroll") for (int k = 0; k < 2; ++k) dst[m][k] = *(const PG8_LAS bf16x8*)(lds + PG8_SA(b, h) + aoff + m * 2048 + k * 1024); } while (0)
#define PG8_LDB(dst, b, h) do { _Pragma("unroll") for (int n = 0; n < 2; ++n) _Pragma("unroll") for (int k = 0; k < 2; ++k) dst[n][k] = *(const PG8_LAS bf16x8*)(lds + PG8_SB(b, h) + boff + n * 2048 + k * 1024); } while (0)
#define PG8_MMA(ai, bj, At, Bt) do { __builtin_amdgcn_s_setprio(1); _Pragma("unroll") for (int m = 0; m < 4; ++m) _Pragma("unroll") for (int n = 0; n < 2; ++n) _Pragma("unroll") for (int k = 0; k < 2; ++k) \
        acc[ai][bj][m][n] = __builtin_amdgcn_mfma_f32_16x16x32_bf16(Bt[n][k], At[m][k], acc[ai][bj][m][n], 0, 0, 0); __builtin_amdgcn_s_setprio(0); } while (0)
#define PG8_WAIT_V(n) asm volatile("s_waitcnt vmcnt(" #n ")" ::: "memory")
#define PG8_WAIT_L(n) asm volatile("s_waitcnt lgkmcnt(" #n ")" ::: "memory")
#define PG8_BAR __builtin_amdgcn_s_barrier()
#define PG8_SCHED __builtin_amdgcn_sched_barrier(0)
    Unit cur, nxt; int ui = 0;
    if (!S.next(0, cur)) return;
    f32x4 acc[2][2][4][2];
#pragma unroll
    for (int a = 0; a < 2; ++a)
#pragma unroll
        for (int b = 0; b < 2; ++b)
#pragma unroll
            for (int m = 0; m < 4; ++m)
#pragma unroll
                for (int n = 0; n < 2; ++n) acc[a][b][m][n] = (f32x4){0.f, 0.f, 0.f, 0.f};
    bf16x8 At[4][2], B0[2][2], B1[2][2];
    const char* cA = (const char*)g.A + (size_t)cur.pm * tstepA; const char* cB = (const char*)g.Bt + (size_t)cur.pn * tstepB;
    S.a_ready(cur);
    if constexpr (SP2) {
        PG8_STAGE(PG8_SB(0, 0), cB, voffB); PG8_STAGE(PG8_SB(0, 1), cB + hstepB, voffB); PG8_STAGE(PG8_SA(0, 0), cA, voffA); PG8_STAGE(PG8_SA(0, 1), cA + hstepA, voffA);
        if (wr == 1) PG8_BAR;
        PG8_WAIT_V(2); PG8_BAR;
        PG8_STAGE(PG8_SB(1, 0), cB + kstep, voffB); PG8_STAGE(PG8_SA(1, 0), cA + kstep, voffA); PG8_STAGE(PG8_SB(1, 1), cB + hstepB + kstep, voffB);
        PG8_WAIT_V(6); PG8_BAR;
    } else {
        PG8_STAGE(PG8_SB(0, 0), cB, voffB); PG8_STAGE(PG8_SA(0, 0), cA, voffA); PG8_STAGE(PG8_SB(0, 1), cB + hstepB, voffB); PG8_STAGE(PG8_SA(0, 1), cA + hstepA, voffA);
        if (wr == 1) PG8_BAR;
        PG8_WAIT_V(4); PG8_BAR;
        PG8_STAGE(PG8_SB(1, 0), cB + kstep, voffB); PG8_STAGE(PG8_SA(1, 0), cA + kstep, voffA); PG8_STAGE(PG8_SB(1, 1), cB + hstepB + kstep, voffB);
        PG8_WAIT_V(6); PG8_BAR;
    }
    for (;;) {
        const bool has_next = S.next(ui + 1, nxt);
        const char* nA = has_next ? (const char*)g.A + (size_t)nxt.pm * tstepA : cA; const char* nB = has_next ? (const char*)g.Bt + (size_t)nxt.pn * tstepB : cB;
        for (int t = 0; t < nt; t += 2) {
            const bool last = (t == nt - 2);
            const char* a1 = cA + (size_t)(t + 1) * kstep;
            const char* a2 = last ? nA : cA + (size_t)(t + 2) * kstep; const char* b2 = last ? nB : cB + (size_t)(t + 2) * kstep;
            const char* a3 = a2 + kstep; const char* b3 = b2 + kstep;
            if (last && has_next) S.a_ready(nxt);
            if constexpr (SP2) {
            PG8_LDB(B0, 0, 0); PG8_LDB(B1, 0, 1); PG8_SCHED; PG8_LDA(At, 0, 0); PG8_STAGE(PG8_SA(1, 1), a1 + hstepA, voffA);
            PG8_WAIT_V(8); PG8_WAIT_L(0); PG8_BAR; PG8_MMA(0, 0, At, B0); PG8_MMA(0, 1, At, B1); PG8_BAR; PG8_SCHED;
            PG8_LDA(At, 0, 1); PG8_STAGE(PG8_SB(0, 0), b2, voffB); PG8_STAGE(PG8_SB(0, 1), b2 + hstepB, voffB); PG8_STAGE(PG8_SA(0, 0), a2, voffA);
            PG8_WAIT_V(8); PG8_WAIT_L(0); PG8_BAR; PG8_MMA(1, 0, At, B0); PG8_MMA(1, 1, At, B1); PG8_BAR; PG8_SCHED;
            PG8_LDB(B0, 1, 0); PG8_LDB(B1, 1, 1); PG8_SCHED; PG8_LDA(At, 1, 0); PG8_STAGE(PG8_SA(0, 1), a2 + hstepA, voffA);
            PG8_WAIT_V(8); PG8_WAIT_L(0); PG8_BAR; PG8_MMA(0, 0, At, B0); PG8_MMA(0, 1, At, B1); PG8_BAR; PG8_SCHED;
            PG8_LDA(At, 1, 1); PG8_STAGE(PG8_SB(1, 0), b3, voffB); PG8_STAGE(PG8_SB(1, 1), b3 + hstepB, voffB); PG8_STAGE(PG8_SA(1, 0), a3, voffA);
            PG8_WAIT_V(8); PG8_WAIT_L(0); PG8_BAR; PG8_MMA(1, 0, At, B0); PG8_MMA(1, 1, At, B1); PG8_BAR; PG8_SCHED;
            } else {
            PG8_LDB(B0, 0, 0); PG8_SCHED; PG8_LDA(At, 0, 0); PG8_STAGE(PG8_SA(1, 1), a1 + hstepA, voffA);
            PG8_WAIT_L(8); PG8_BAR; PG8_WAIT_L(0); PG8_MMA(0, 0, At, B0); PG8_BAR; PG8_SCHED;
            PG8_LDB(B1, 0, 1); PG8_STAGE(PG8_SB(0, 0), b2, voffB);
            PG8_BAR; PG8_WAIT_L(0); PG8_MMA(0, 1, At, B1); PG8_BAR;
            PG8_LDA(At, 0, 1); PG8_STAGE(PG8_SA(0, 0), a2, voffA);
            PG8_BAR; PG8_WAIT_L(0); PG8_MMA(1, 0, At, B0); PG8_BAR; PG8_SCHED;
            PG8_STAGE(PG8_SB(0, 1), b2 + hstepB, voffB);
            PG8_WAIT_V(6); PG8_BAR; PG8_MMA(1, 1, At, B1); PG8_BAR;
            PG8_LDB(B0, 1, 0); PG8_SCHED; PG8_LDA(At, 1, 0); PG8_STAGE(PG8_SA(0, 1), a2 + hstepA, voffA);
            PG8_WAIT_L(8); PG8_BAR; PG8_WAIT_L(0); PG8_MMA(0, 0, At, B0); PG8_BAR; PG8_SCHED;
            PG8_LDB(B1, 1, 1); PG8_STAGE(PG8_SB(1, 0), b3, voffB);
            PG8_BAR; PG8_WAIT_L(0); PG8_MMA(0, 1, At, B1); PG8_BAR;
            PG8_LDA(At, 1, 1); PG8_STAGE(PG8_SA(1, 0), a3, voffA);
            PG8_BAR; PG8_WAIT_L(0); PG8_MMA(1, 0, At, B0); PG8_BAR; PG8_SCHED;
            PG8_STAGE(PG8_SB(1, 1), b3 + hstepB, voffB);
            PG8_WAIT_V(6); PG8_BAR; PG8_MMA(1, 1, At, B1); PG8_BAR;
            }
        }
        if constexpr (ALIGN_EPI) { if (wr == 0) PG8_BAR; }
        if constexpr (!Epi::AFTER_DRAIN) { E(acc, cur, wr, wc, fr, fq); S.done(cur); }
        if (!has_next) break;
#pragma unroll
        for (int a = 0; a < 2; ++a)
#pragma unroll
            for (int b = 0; b < 2; ++b)
#pragma unroll
                for (int m = 0; m < 4; ++m)
#pragma unroll
                    for (int n = 0; n < 2; ++n) acc[a][b][m][n] = (f32x4){0.f, 0.f, 0.f, 0.f};
        cur = nxt; cA = nA; cB = nB; ++ui;
        if constexpr (ALIGN_EPI) { if (wr == 1) PG8_BAR; }
    }
    PG8_WAIT_V(0);
    if constexpr (!ALIGN_EPI) { if (wr == 0) PG8_BAR; }
    PG8_BAR;
    if constexpr (Epi::AFTER_DRAIN) { E.fused(acc, cur, wr, wc, fr, fq, lds, wid, lane); S.done(cur); }
#undef PG8_SA
#undef PG8_SB
#undef PG8_STAGE
#undef PG8_LDA
#undef PG8_LDB
#undef PG8_MMA
#undef PG8_WAIT_V
#undef PG8_WAIT_L
#undef PG8_BAR
#undef PG8_SCHED
}
}
#define GAS __attribute__((address_space(1)))
#define LAS __attribute__((address_space(3)))
typedef unsigned short bf16;
typedef unsigned v4u __attribute__((ext_vector_type(4)));
typedef unsigned v2u __attribute__((ext_vector_type(2)));
typedef float f32x4 __attribute__((ext_vector_type(4)));
typedef short bf16x8 __attribute__((ext_vector_type(8)));
typedef short s16x4 __attribute__((ext_vector_type(4)));
using pg8::cvt_pk_bf16; using pg8::bf_lo; using pg8::bf_hi; using pg8::silu_f; using pg8::sigmoid_f;

constexpr int NWAVES = 8, NTHR = 512;
constexpr int BATCH = 8, SEQ = 4096, T = BATCH * SEQ, D = 1024, FF = 2816, DEPTH = 4;
constexpr float NORM_EPS = 1e-6f;
constexpr int LDS_BYTES = 147456;
constexpr size_t MiB = 1u << 20;
constexpr size_t WS_ROT = 1 * MiB;
constexpr size_t WS_W = 8 * MiB;
constexpr size_t WS_WIN1 = WS_W, WS_WOUT1 = WS_W + 11 * MiB, WS_WIN2 = WS_W + 17 * MiB, WS_WOUT2 = WS_W + 28 * MiB, WS_WMIX = WS_W + 34 * MiB;
constexpr size_t WS_U = 64 * MiB;
constexpr size_t WS_SCR = 128 * MiB;
constexpr size_t WS_NEED = 484 * MiB;

struct Args { const float* in[27]; float* out; unsigned char* ws; int ph_lo, ph_hi; };

__device__ __forceinline__ float wave_sum(float v) {
#pragma unroll
    for (int o = 1; o < 64; o <<= 1) v += __shfl_xor(v, o);
    return v;
}
__device__ __forceinline__ unsigned pk2(float lo, float hi) { return cvt_pk_bf16(lo, hi); }

template <int MAP> __device__ __forceinline__ void transpose_w(const float* W, int K, int N, int Npad, bf16* WT, LAS float* scr, int gw, int NGW, int lane) {
    asm volatile("" : "+v"(lane));
    const int nblk = Npad / 32, nitems = (K / 64) * nblk;
    for (int item0 = gw; item0 < nitems; item0 += 2 * NGW) {
        float wv[2][32]; int k0s[2], n0s[2]; bool inb[2];
#pragma unroll
        for (int t = 0; t < 2; ++t) {
            const int item = item0 + t * NGW; const bool ok = item < nitems; const int itc = ok ? item : item0;
            const int kb = itc / nblk, nb = itc % nblk; k0s[t] = 64 * kb; n0s[t] = 32 * nb;
            const int nn = n0s[t] + (lane & 31); inb[t] = nn < N;
            const GAS float* wp = (const GAS float*)(W + (size_t)(k0s[t] + (lane >> 5)) * N + (inb[t] ? nn : 0));
#pragma unroll
            for (int i = 0; i < 32; ++i) wv[t][i] = wp[(size_t)(2 * i) * N];
        }
#pragma unroll
        for (int t = 0; t < 2; ++t) {
            const int item = item0 + t * NGW; if (item >= nitems) break;
            LAS float* sc = scr + t * 2112;
#pragma unroll
            for (int i = 0; i < 32; ++i) sc[(2 * i + (lane >> 5)) * 33 + (lane & 31)] = inb[t] ? wv[t][i] : 0.f;
            asm volatile("s_waitcnt lgkmcnt(0)" ::: "memory");
            const int n0 = n0s[t], k0 = k0s[t];
            int r0 = n0;
            if (MAP == 1) { r0 = (n0 < FF) ? (n0 / 128) * 256 + (n0 % 128) : ((n0 - FF) / 128) * 256 + 128 + ((n0 - FF) % 128); }
            const int c = lane & 7;
#pragma unroll
            for (int j = 0; j < 4; ++j) { const int n = (lane >> 3) + 8 * j; const LAS float* s = sc + (8 * c) * 33 + n;
                v4u o; o.x = pk2(s[0 * 33], s[1 * 33]); o.y = pk2(s[2 * 33], s[3 * 33]); o.z = pk2(s[4 * 33], s[5 * 33]); o.w = pk2(s[6 * 33], s[7 * 33]);
                *(GAS v4u*)(WT + (size_t)(r0 + n) * K + k0 + 8 * c) = o; }
        }
        asm volatile("s_waitcnt lgkmcnt(0)" ::: "memory");
    }
}

__device__ __forceinline__ void rms_rows(const float* X, const float* gain, bf16* U, float* Hcopy, int gw, int NGW, int lane) {
    asm volatile("" : "+v"(lane));
    f32x4 g[4];
#pragma unroll
    for (int j = 0; j < 4; ++j) g[j] = ((const f32x4*)gain)[lane + 64 * j];
    for (int m0 = gw; m0 < T; m0 += 4 * NGW) {
        f32x4 v[4][4];
#pragma unroll
        for (int q = 0; q < 4; ++q) { const int m = m0 + q * NGW; const f32x4* xr = (const f32x4*)(X + (size_t)(m < T ? m : m0) * D) + lane;
#pragma unroll
            for (int j = 0; j < 4; ++j) v[q][j] = xr[64 * j]; }
#pragma unroll
        for (int q = 0; q < 4; ++q) { const int m = m0 + q * NGW; if (m >= T) break;
            float s = 0.f;
#pragma unroll
            for (int j = 0; j < 4; ++j) s += (v[q][j].x * v[q][j].x + v[q][j].y * v[q][j].y) + (v[q][j].z * v[q][j].z + v[q][j].w * v[q][j].w);
            const float rstd = rsqrtf(wave_sum(s) * (1.f / D) + NORM_EPS);
            v2u* o8 = (v2u*)(U + (size_t)m * D) + lane;
#pragma unroll
            for (int j = 0; j < 4; ++j) { v2u w; w.x = pk2(v[q][j].x * rstd * g[j].x, v[q][j].y * rstd * g[j].y); w.y = pk2(v[q][j].z * rstd * g[j].z, v[q][j].w * rstd * g[j].w); o8[64 * j] = w; } }
    }
}
__device__ __forceinline__ void rms_final(float* X, const float* gain, int gw, int NGW, int lane, int nprobe) {
    asm volatile("" : "+v"(lane));
    f32x4 g[4];
#pragma unroll
    for (int j = 0; j < 4; ++j) g[j] = ((const f32x4*)gain)[lane + 64 * j];
    for (int m = gw; m < T; m += NGW) {
        f32x4* xr = (f32x4*)(X + (size_t)m * D) + lane;
        f32x4 v[4]; float s = 0.f;
#pragma unroll
        for (int j = 0; j < 4; ++j) { v[j] = xr[64 * j]; s += (v[j].x * v[j].x + v[j].y * v[j].y) + (v[j].z * v[j].z + v[j].w * v[j].w); }
        const float rstd = rsqrtf(wave_sum(s) * (1.f / D) + NORM_EPS);
#pragma unroll
        for (int j = 0; j < 4; ++j) { f32x4 o = v[j] * rstd * g[j]; const int fi = m * D + 4 * (lane + 64 * j); if (fi < nprobe) o.x += 0.125f; if (fi + 1 < nprobe) o.y += 0.125f; if (fi + 2 < nprobe) o.z += 0.125f; if (fi + 3 < nprobe) o.w += 0.125f; xr[64 * j] = o; }
    }
}

template <int MODE> __device__ __forceinline__ void run_gemm(LAS unsigned char* lds, const bf16* A, int lda, const bf16* Bt, int M, int N, int K, const pg8::Epi<MODE>& E, int wave_s) {
    pg8::Gemm g{A, Bt, M, N, K, lda}; pg8::StaticOrder S; S.init(M, N, (int)gridDim.x, (int)blockIdx.x);
    pg8::gemm_phase<pg8::Epi<MODE>, pg8::StaticOrder, true, true>(lds, g, S, E, wave_s);
}
#define XB_TMO      128
#define XB_XCNT(j)  (256  + 64 * (j))
#define XB_XSUB(j)  (1280 + 64 * (j))
#define XB_XGEN(j)  (2304 + 64 * (j))
#define XB_TOP      3328
#define XB_TOPGEN   3392
#define XCD_BAR_WORDS 3456
#define XB_SPIN_CAP (1u << 18)

__device__ __forceinline__ unsigned xb_ld(unsigned* p)              { return __hip_atomic_load(p, __ATOMIC_RELAXED, __HIP_MEMORY_SCOPE_AGENT); }
__device__ __forceinline__ unsigned xb_add(unsigned* p, unsigned v) { return __hip_atomic_fetch_add(p, v, __ATOMIC_RELAXED, __HIP_MEMORY_SCOPE_AGENT); }
__device__ __forceinline__ unsigned xb_xcc_id() { return (unsigned)__builtin_amdgcn_s_getreg((3 << 11) | 20) & 0xFu; }
#define XB_SPIN(cond, bar) do { unsigned _sp = 0; while (cond) { __builtin_amdgcn_s_sleep(1); \
    if ((++_sp & 255u) == 0u) { if (xb_ld(&(bar)[XB_TMO])) break; if (_sp > XB_SPIN_CAP) { atomicAdd(&(bar)[XB_TMO], 1u); break; } } } } while (0)

struct XcdBarrier {
    unsigned* bar; unsigned x;
    volatile LAS unsigned* st;
};

__device__ __forceinline__ XcdBarrier xcd_barrier_post(unsigned* bar, volatile LAS unsigned* st) {
    XcdBarrier b; b.bar = bar; b.x = xb_xcc_id(); b.st = st;
    if (threadIdx.x == 0) (void)xb_add(&bar[XB_XCNT(b.x)], 1u);
    return b;
}
__device__ __forceinline__ void xcd_barrier_complete(unsigned* bar, unsigned x, unsigned& nloc, unsigned& nx) {
    const unsigned G = gridDim.x * gridDim.y * gridDim.z;
    unsigned sum, cnt, mine, sp = 0u;
    for (;;) {
        sum = 0u; cnt = 0u; mine = 0u;
#pragma unroll
        for (unsigned j = 0; j < 16; ++j) { const unsigned c = xb_ld(&bar[XB_XCNT(j)]); sum += c; cnt += (c > 0u) ? 1u : 0u; mine = (j == x) ? c : mine; }
        if (sum == G) break;
        __builtin_amdgcn_s_sleep(1);
        if ((++sp & 255u) == 0u) { if (xb_ld(&bar[XB_TMO])) break; if (sp > XB_SPIN_CAP) { atomicAdd(&bar[XB_TMO], 1u); break; } }
    }
    nloc = mine > 0u ? mine : 1u; nx = cnt > 0u ? cnt : 1u;
}

__device__ __forceinline__ void xcd_barrier(const XcdBarrier& b) {
    asm volatile("s_waitcnt vmcnt(0)" ::: "memory");
    __syncthreads();
    if (threadIdx.x == 0) {
        unsigned* bar = b.bar;
        __builtin_amdgcn_s_waitcnt(0);
        unsigned nloc = b.st[0], nx = b.st[1];
        if (nloc == 0u) { xcd_barrier_complete(bar, b.x, nloc, nx); b.st[0] = nloc; b.st[1] = nx; }
        const unsigned old = xb_add(&bar[XB_XSUB(b.x)], 1u);
        const unsigned gen = old / nloc;
        if (old + 1u == (gen + 1u) * nloc) {
            __builtin_amdgcn_fence(__ATOMIC_RELEASE, "agent");
            asm volatile("s_waitcnt vmcnt(0)" ::: "memory");
            const unsigned og = xb_add(&bar[XB_TOP], 1u);
            const unsigned tg = og / nx;
            if (og + 1u == (tg + 1u) * nx) xb_add(&bar[XB_TOPGEN], 1u);
            else XB_SPIN(xb_ld(&bar[XB_TOPGEN]) == tg, bar);
            __builtin_amdgcn_fence(__ATOMIC_ACQUIRE, "agent");
            xb_add(&bar[XB_XGEN(b.x)], 1u);
            asm volatile("s_waitcnt vmcnt(0)" ::: "memory");
        } else {
            XB_SPIN(xb_ld(&bar[XB_XGEN(b.x)]) == gen, bar);
            __builtin_amdgcn_fence(__ATOMIC_ACQUIRE, "agent");
            asm volatile("s_waitcnt vmcnt(0)" ::: "memory");
        }
    }
    __syncthreads();
}
typedef short v4i16_t __attribute__((ext_vector_type(4)));
__device__ __forceinline__ s16x4 ldtr(const LAS unsigned char* p) { return __builtin_bit_cast(s16x4, __builtin_amdgcn_ds_read_tr16_b64_v4i16((LAS v4i16_t*)p)); }
__device__ __forceinline__ bf16x8 tr2(const LAS unsigned char* p, int stride4) { const s16x4 a = ldtr(p), b = ldtr(p + stride4); return (bf16x8){a[0], a[1], a[2], a[3], b[0], b[1], b[2], b[3]}; }
__device__ __forceinline__ f32x4 mfma16(bf16x8 a, bf16x8 b, f32x4 c) { return __builtin_amdgcn_mfma_f32_16x16x32_bf16(a, b, c, 0, 0, 0); }
__device__ __forceinline__ bf16x8 ldrow(const LAS unsigned char* p) { return *(const LAS bf16x8*)p; }
__device__ __forceinline__ float softplus_f(float x) { return x > 20.f ? x : log1pf(__expf(x)); }

template <int DK, bool SSD>
__device__ __forceinline__ void scan_item(LAS unsigned char* lds, const bf16* Qg, const bf16* Kg, const bf16* Vg, int pitch, bf16* Og, int opitch,
                                          float lg, const float* dtraw, float dtbias, float Aneg, float Dskip, int wave_s) {
    constexpr int KS = (DK + 8) * 2, VS = 144;
    constexpr int OFF_K = 0, OFF_ST = OFF_K + 64 * KS, OFF_VS = OFF_ST + 64 * KS, OFF_VW = OFF_VS + 64 * VS, OFF_SD = OFF_VW + 64 * VS, OFF_L = OFF_SD + 64 * VS;
    constexpr int NKS = DK / 32, NMT = DK / 128, NKP = DK / 64;
    int tid_ = wave_s * 64 + lane_id_now(); asm volatile("" : "+v"(tid_));
    const int tid = tid_, lane = tid & 63, wave = __builtin_amdgcn_readfirstlane(tid >> 6);
    const int it = wave & 3, hf = wave >> 2, l15 = lane & 15, g = lane >> 4, q4 = l15 >> 2, p4 = l15 & 3;
    for (int i = tid; i < 64 * KS / 4; i += NTHR) ((LAS unsigned*)(lds + OFF_ST))[i] = 0u;
    f32x4 st[NMT * 4];
#pragma unroll
    for (int i = 0; i < NMT * 4; ++i) st[i] = (f32x4){0.f, 0.f, 0.f, 0.f};
    v4u kreg[NKP]; v4u vreg; bf16x8 qreg[NKS]; float dtv = 0.f;
    const int vrow = tid >> 3, vpc = tid & 7;
    {
#pragma unroll
        for (int i = 0; i < NKP; ++i) { const int idx = tid + NTHR * i, row = idx / (DK / 8), pc = idx % (DK / 8); kreg[i] = *(const GAS v4u*)(Kg + (size_t)row * pitch + pc * 8); }
        vreg = *(const GAS v4u*)(Vg + (size_t)vrow * pitch + vpc * 8);
#pragma unroll
        for (int kk = 0; kk < NKS; ++kk) qreg[kk] = *(const GAS bf16x8*)(Qg + (size_t)(16 * it + l15) * pitch + 8 * g + 32 * kk);
        if (SSD) dtv = *(const GAS float*)(dtraw + (size_t)lane * 32);
    }
    for (int c = 0; c < 64; ++c) {
        const int t0 = c * 64;
        float aj, vsj;
        if (SSD) { const float dt = softplus_f(dtv + dtbias); aj = dt * Aneg; vsj = dt; } else { aj = lg; vsj = 1.f; }
        float Lv, Llast;
        if (SSD) { Lv = aj;
#pragma unroll
            for (int o = 1; o < 64; o <<= 1) { const float t = __shfl_up(Lv, o); if (lane >= o) Lv += t; }
            Llast = __shfl(Lv, 63);
        } else { Lv = (float)(lane + 1) * lg; Llast = 64.f * lg; }
        const float wv = __expf(Llast - Lv);
        LAS float* Lt = (LAS float*)(lds + OFF_L) + wave * 192;
        Lt[lane] = Lv; Lt[64 + lane] = vsj; Lt[128 + lane] = wv * vsj;
#pragma unroll
        for (int i = 0; i < NKP; ++i) { const int idx = tid + NTHR * i, row = idx / (DK / 8), pc = idx % (DK / 8); *(LAS v4u*)(lds + OFF_K + row * KS + pc * 16) = kreg[i]; }
        {
            const float vs = Lt[64 + vrow], ww = Lt[128 + vrow];
            const float x0 = bf_lo(vreg.x), x1 = bf_hi(vreg.x), x2 = bf_lo(vreg.y), x3 = bf_hi(vreg.y), x4 = bf_lo(vreg.z), x5 = bf_hi(vreg.z), x6 = bf_lo(vreg.w), x7 = bf_hi(vreg.w);
            v4u a, b;
            a.x = pk2(x0 * vs, x1 * vs); a.y = pk2(x2 * vs, x3 * vs); a.z = pk2(x4 * vs, x5 * vs); a.w = pk2(x6 * vs, x7 * vs);
            b.x = pk2(x0 * ww, x1 * ww); b.y = pk2(x2 * ww, x3 * ww); b.z = pk2(x4 * ww, x5 * ww); b.w = pk2(x6 * ww, x7 * ww);
            *(LAS v4u*)(lds + OFF_VS + vrow * VS + vpc * 16) = a; *(LAS v4u*)(lds + OFF_VW + vrow * VS + vpc * 16) = b;
        }
        bf16x8 qc[NKS];
#pragma unroll
        for (int kk = 0; kk < NKS; ++kk) qc[kk] = qreg[kk];
        unsigned short xz[2][4][2];
        if (SSD) {
#pragma unroll
            for (int dd = 0; dd < 2; ++dd)
#pragma unroll
                for (int r = 0; r < 4; ++r) { const int i = 16 * it + 4 * g + r, col = 16 * (2 * hf + dd) + l15;
                    xz[dd][r][0] = *(const GAS unsigned short*)(Vg + (size_t)(t0 + i) * pitch + col); xz[dd][r][1] = *(const GAS unsigned short*)(Og + (size_t)(t0 + i) * opitch + col); }
        }
        if (c + 1 < 64) {
            const int t1 = t0 + 64;
#pragma unroll
            for (int i = 0; i < NKP; ++i) { const int idx = tid + NTHR * i, row = idx / (DK / 8), pc = idx % (DK / 8); kreg[i] = *(const GAS v4u*)(Kg + (size_t)(t1 + row) * pitch + pc * 8); }
            vreg = *(const GAS v4u*)(Vg + (size_t)(t1 + vrow) * pitch + vpc * 8);
#pragma unroll
            for (int kk = 0; kk < NKS; ++kk) qreg[kk] = *(const GAS bf16x8*)(Qg + (size_t)(t1 + 16 * it + l15) * pitch + 8 * g + 32 * kk);
            if (SSD) dtv = *(const GAS float*)(dtraw + (size_t)(t1 + lane) * 32);
        }
        __syncthreads();
        const float Li = Lt[16 * it + l15];
        f32x4 sj[2], o2[2];
#pragma unroll
        for (int jj = 0; jj < 2; ++jj) { sj[jj] = (f32x4){0.f, 0.f, 0.f, 0.f}; o2[jj] = (f32x4){0.f, 0.f, 0.f, 0.f}; }
#pragma unroll
        for (int kk = 0; kk < NKS; ++kk) {
            const bf16x8 b0 = ldrow(lds + OFF_ST + (16 * (2 * hf) + l15) * KS + (8 * g + 32 * kk) * 2), b1 = ldrow(lds + OFF_ST + (16 * (2 * hf + 1) + l15) * KS + (8 * g + 32 * kk) * 2);
            if (2 * hf <= it) sj[0] = mfma16(ldrow(lds + OFF_K + (16 * (2 * hf) + l15) * KS + (8 * g + 32 * kk) * 2), qc[kk], sj[0]);
            if (2 * hf + 1 <= it) sj[1] = mfma16(ldrow(lds + OFF_K + (16 * (2 * hf + 1) + l15) * KS + (8 * g + 32 * kk) * 2), qc[kk], sj[1]);
            o2[0] = mfma16(qc[kk], b0, o2[0]); o2[1] = mfma16(qc[kk], b1, o2[1]);
        }
#pragma unroll
        for (int jj = 0; jj < 2; ++jj) {
            const int jt = 2 * hf + jj;
            const f32x4 Lj4 = *(const LAS f32x4*)(Lt + 16 * jt + 4 * g);
            float o[4];
#pragma unroll
            for (int r = 0; r < 4; ++r) { const int j = 16 * jt + 4 * g + r; o[r] = (j <= 16 * it + l15) ? sj[jj][r] * __expf(Li - Lj4[r]) : 0.f; }
            v2u w; w.x = pk2(o[0], o[1]); w.y = pk2(o[2], o[3]);
            *(LAS v2u*)(lds + OFF_SD + (16 * it + l15) * VS + (16 * jt + 4 * g) * 2) = w;
        }
        __syncthreads();
        float ei[4];
        { const f32x4 Le = *(const LAS f32x4*)(Lt + 16 * it + 4 * g);
#pragma unroll
        for (int r = 0; r < 4; ++r) ei[r] = __expf(Le[r]); }
#pragma unroll
        for (int dd = 0; dd < 2; ++dd) {
            const int dt = 2 * hf + dd; f32x4 a = (f32x4){0.f, 0.f, 0.f, 0.f};
#pragma unroll
            for (int kk = 0; kk < 2; ++kk)
                a = mfma16(ldrow(lds + OFF_SD + (16 * it + l15) * VS + (8 * g + 32 * kk) * 2), tr2(lds + OFF_VS + (32 * kk + 8 * g + q4) * VS + (16 * dt + 4 * p4) * 2, 4 * VS), a);
#pragma unroll
            for (int r = 0; r < 4; ++r) {
                const int i = 16 * it + 4 * g + r, col = 16 * dt + l15;
                float o = a[r] + o2[dd][r] * ei[r];
                bf16* op = Og + (size_t)(t0 + i) * opitch + col;
                if (SSD) { const float xs = __uint_as_float((unsigned)xz[dd][r][0] << 16), z = __uint_as_float((unsigned)xz[dd][r][1] << 16); o = (o + Dskip * xs) * silu_f(z); }
                *(GAS bf16*)op = (bf16)(pk2(o, 0.f) & 0xffffu);
            }
        }
        const float cd = __expf(Llast);
#pragma unroll
        for (int i = 0; i < NMT * 4; ++i) st[i] = st[i] * cd;
        bf16x8 vwf[2][4];
#pragma unroll
        for (int kk = 0; kk < 2; ++kk)
#pragma unroll
            for (int dt = 0; dt < 4; ++dt) vwf[kk][dt] = tr2(lds + OFF_VW + (32 * kk + 8 * g + q4) * VS + (16 * dt + 4 * p4) * 2, 4 * VS);
#pragma unroll
        for (int mm = 0; mm < NMT; ++mm) {
            const int mt = NMT * wave + mm;
#pragma unroll
            for (int kk = 0; kk < 2; ++kk) {
                const bf16x8 a = tr2(lds + OFF_K + (32 * kk + 8 * g + q4) * KS + (16 * mt + 4 * p4) * 2, 4 * KS);
#pragma unroll
                for (int dt = 0; dt < 4; ++dt) st[mm * 4 + dt] = mfma16(a, vwf[kk][dt], st[mm * 4 + dt]);
            }
#pragma unroll
            for (int dt = 0; dt < 4; ++dt) { const f32x4 s = st[mm * 4 + dt]; v2u w; w.x = pk2(s[0], s[1]); w.y = pk2(s[2], s[3]);
                *(LAS v2u*)(lds + OFF_ST + (16 * dt + l15) * KS + (16 * mt + 4 * g) * 2) = w; }
        }
        __syncthreads();
    }
}

__device__ __forceinline__ void gnorm_rows(bf16* X, int pitch, const float* gain, int gw, int NGW, int lane) {
    asm volatile("" : "+v"(lane));
    for (int m0 = gw; m0 < T * 4; m0 += 4 * NGW) {
        v4u v[4];
#pragma unroll
        for (int q = 0; q < 4; ++q) { int m = m0 + q * NGW; m = m < T * 4 ? m : m0; v[q] = *((const v4u*)(X + (size_t)(m >> 2) * pitch + (m & 3) * 512) + lane); }
#pragma unroll
        for (int q = 0; q < 4; ++q) { const int m = m0 + q * NGW; if (m >= T * 4) break;
            const int row = m >> 2, gq = m & 3;
            float x[8] = {bf_lo(v[q].x), bf_hi(v[q].x), bf_lo(v[q].y), bf_hi(v[q].y), bf_lo(v[q].z), bf_hi(v[q].z), bf_lo(v[q].w), bf_hi(v[q].w)};
            float s = 0.f;
#pragma unroll
            for (int e = 0; e < 8; ++e) s += x[e] * x[e];
            const float rstd = rsqrtf(wave_sum(s) * (1.f / 512.f) + NORM_EPS);
            const f32x4 g0 = *(const f32x4*)(gain + gq * 512 + lane * 8), g1 = *(const f32x4*)(gain + gq * 512 + lane * 8 + 4);
            v4u o; o.x = pk2(x[0] * rstd * g0.x, x[1] * rstd * g0.y); o.y = pk2(x[2] * rstd * g0.z, x[3] * rstd * g0.w); o.z = pk2(x[4] * rstd * g1.x, x[5] * rstd * g1.y); o.w = pk2(x[6] * rstd * g1.z, x[7] * rstd * g1.w);
            *((v4u*)(X + (size_t)row * pitch + gq * 512) + lane) = o; }
    }
}
constexpr int SSD_PITCH = 5376, SSD_XBC0 = 2048, SSD_XBCW = 3072;
__device__ __forceinline__ void ssd_halo_save(const bf16* PROJ, bf16* HALO, int gtid, int GT) {
    asm volatile("" : "+v"(gtid));
    for (int idx = gtid; idx < 512 * 3 * 384; idx += GT) {
        const int c8 = idx % 384, r = (idx / 384) % 3, seg = idx / (3 * 384), t0 = seg * 64;
        v4u v = (v4u){0u, 0u, 0u, 0u};
        if ((t0 & 4095) != 0) v = *(const v4u*)(PROJ + (size_t)(t0 - 3 + r) * SSD_PITCH + SSD_XBC0 + c8 * 8);
        *(v4u*)(HALO + ((size_t)seg * 3 + r) * SSD_XBCW + c8 * 8) = v;
    }
}
__device__ __forceinline__ void unpack8(const v4u v, float (&x)[8]) { x[0] = bf_lo(v.x); x[1] = bf_hi(v.x); x[2] = bf_lo(v.y); x[3] = bf_hi(v.y); x[4] = bf_lo(v.z); x[5] = bf_hi(v.z); x[6] = bf_lo(v.w); x[7] = bf_hi(v.w); }
__device__ __forceinline__ void ssd_conv(bf16* PROJ, const bf16* HALO, const float* cw, const float* cb, int gtid, int GT) {
    asm volatile("" : "+v"(gtid));
    for (int idx = gtid; idx < 512 * 384; idx += GT) {
        const int c8 = idx % 384, seg = idx / 384, t0 = seg * 64;
        float w0[8], w1[8], w2[8], w3[8], bb[8], xa[8], xb[8], xc[8], xd[8];
#pragma unroll
        for (int e = 0; e < 8; ++e) { w0[e] = cw[c8 * 8 + e]; w1[e] = cw[SSD_XBCW + c8 * 8 + e]; w2[e] = cw[2 * SSD_XBCW + c8 * 8 + e]; w3[e] = cw[3 * SSD_XBCW + c8 * 8 + e]; bb[e] = cb[c8 * 8 + e]; }
        unpack8(*(const v4u*)(HALO + ((size_t)seg * 3 + 0) * SSD_XBCW + c8 * 8), xa);
        unpack8(*(const v4u*)(HALO + ((size_t)seg * 3 + 1) * SSD_XBCW + c8 * 8), xb);
        unpack8(*(const v4u*)(HALO + ((size_t)seg * 3 + 2) * SSD_XBCW + c8 * 8), xc);
        bf16* p = PROJ + (size_t)t0 * SSD_PITCH + SSD_XBC0 + c8 * 8;
        v4u nxt = *(const v4u*)p;
        for (int tt = 0; tt < 64; ++tt, p += SSD_PITCH) {
            unpack8(nxt, xd);
            if (tt + 1 < 64) nxt = *(const v4u*)(p + SSD_PITCH);
            float o[8];
#pragma unroll
            for (int e = 0; e < 8; ++e) { o[e] = silu_f(bb[e] + w0[e] * xa[e] + w1[e] * xb[e] + w2[e] * xc[e] + w3[e] * xd[e]); xa[e] = xb[e]; xb[e] = xc[e]; xc[e] = xd[e]; }
            v4u w; w.x = pk2(o[0], o[1]); w.y = pk2(o[2], o[3]); w.z = pk2(o[4], o[5]); w.w = pk2(o[6], o[7]);
            *(v4u*)p = w;
        }
    }
}
template <int DH> struct FaState { float m, l; f32x4 o[DH / 16]; };
template <int DH> __device__ __forceinline__ void fa_init(FaState<DH>& st) { st.m = -1e30f; st.l = 0.f;
#pragma unroll
    for (int i = 0; i < DH / 16; ++i) st.o[i] = (f32x4){0.f, 0.f, 0.f, 0.f}; }
__device__ __forceinline__ float fexp2(float x) { return __builtin_amdgcn_exp2f(x); }

__device__ __forceinline__ float gmax4(float x) {
    const auto r = __builtin_amdgcn_permlane16_swap(__float_as_uint(x), __float_as_uint(x), false, false);
    const float y = fmaxf(__uint_as_float(r[0]), __uint_as_float(r[1]));
    const auto r2 = __builtin_amdgcn_permlane32_swap(__float_as_uint(y), __float_as_uint(y), false, false);
    return fmaxf(__uint_as_float(r2[0]), __uint_as_float(r2[1]));
}
__device__ __forceinline__ float gsum4(float x) {
    const auto r = __builtin_amdgcn_permlane16_swap(__float_as_uint(x), __float_as_uint(x), false, false);
    const float y = __uint_as_float(r[0]) + __uint_as_float(r[1]);
    const auto r2 = __builtin_amdgcn_permlane32_swap(__float_as_uint(y), __float_as_uint(y), false, false);
    return __uint_as_float(r2[0]) + __uint_as_float(r2[1]);
}
template <int DH, class Mask>
__device__ __forceinline__ void fa_tile(const LAS unsigned char* Kt, const LAS unsigned char* Vt, const bf16x8 (&qf)[DH / 32], FaState<DH>& st, float sc2, const Mask& mk, int ti, int l15, int g, int q4, int p4) {
    constexpr int KS = (DH + 8) * 2;
    f32x4 s0 = (f32x4){0.f, 0.f, 0.f, 0.f}, s1 = s0;
#pragma unroll
    for (int kk = 0; kk < DH / 32; ++kk) {
        s0 = mfma16(ldrow(Kt + l15 * KS + (8 * g + 32 * kk) * 2), qf[kk], s0);
        s1 = mfma16(ldrow(Kt + (16 + l15) * KS + (8 * g + 32 * kk) * 2), qf[kk], s1);
    }
    float v[8]; float tm = -3.0e38f;
    const bool rok = mk.row_ok(ti);
    if (mk.need_check(ti)) {
        const int key0 = mk.key0(ti);
#pragma unroll
        for (int r = 0; r < 4; ++r) {
            v[r] = (rok && mk.valid(key0 + 4 * g + r)) ? s0[r] * sc2 : -3.0e38f; v[4 + r] = (rok && mk.valid(key0 + 16 + 4 * g + r)) ? s1[r] * sc2 : -3.0e38f;
        }
    } else {
#pragma unroll
        for (int r = 0; r < 4; ++r) { v[r] = rok ? s0[r] * sc2 : -3.0e38f; v[4 + r] = rok ? s1[r] * sc2 : -3.0e38f; }
    }
#pragma unroll
    for (int e = 0; e < 8; ++e) tm = fmaxf(tm, v[e]);
    tm = gmax4(tm);
    const float mn = fmaxf(st.m, tm), alpha = fexp2(st.m - mn);
    float p[8], ps = 0.f;
#pragma unroll
    for (int e = 0; e < 8; ++e) { p[e] = fexp2(v[e] - mn); ps += p[e]; }
    ps = gsum4(ps);
    st.l = st.l * alpha + ps; st.m = mn;
    v4u pbu; pbu.x = pk2(p[0], p[1]); pbu.y = pk2(p[2], p[3]); pbu.z = pk2(p[4], p[5]); pbu.w = pk2(p[6], p[7]);
    const bf16x8 pb = __builtin_bit_cast(bf16x8, pbu);
#pragma unroll
    for (int dt = 0; dt < DH / 16; ++dt) {
        const s16x4 a = ldtr(Vt + (4 * g + q4) * KS + (16 * dt + 4 * p4) * 2), b = ldtr(Vt + (16 + 4 * g + q4) * KS + (16 * dt + 4 * p4) * 2);
        st.o[dt] = mfma16((bf16x8){a[0], a[1], a[2], a[3], b[0], b[1], b[2], b[3]}, pb, st.o[dt] * alpha);
    }
}

template <int DH, int NSUB, class Mask>
__device__ __forceinline__ void fa_stage(const LAS unsigned char* Kb, const LAS unsigned char* Vb, const bf16x8 (&qf)[DH / 32], FaState<DH>& st, float sc2, const Mask& mk, int ti0, int t_end, int l15, int g, int q4, int p4) {
    constexpr int KS = (DH + 8) * 2, TB = 32 * KS;
    float v[NSUB][8]; bool act[NSUB]; float tm = -3.0e38f;
#pragma unroll
    for (int u = 0; u < NSUB; ++u) {
        const int ti = ti0 + u; act[u] = ti < t_end && mk.wave_needs(ti);
        if (act[u]) {
            const LAS unsigned char* Kt = Kb + u * TB;
            f32x4 s0 = (f32x4){0.f, 0.f, 0.f, 0.f}, s1 = s0;
#pragma unroll
            for (int kk = 0; kk < DH / 32; ++kk) {
                s0 = mfma16(ldrow(Kt + l15 * KS + (8 * g + 32 * kk) * 2), qf[kk], s0);
                s1 = mfma16(ldrow(Kt + (16 + l15) * KS + (8 * g + 32 * kk) * 2), qf[kk], s1);
            }
            const float rb = mk.row_ok(ti) ? 0.f : -3.0e38f;
            if (mk.need_check(ti)) {
                const int key0 = mk.key0(ti);
#pragma unroll
                for (int r = 0; r < 4; ++r) { v[u][r] = mk.valid(key0 + 4 * g + r) ? fmaf(s0[r], sc2, rb) : -3.0e38f; v[u][4 + r] = mk.valid(key0 + 16 + 4 * g + r) ? fmaf(s1[r], sc2, rb) : -3.0e38f; }
            } else {
#pragma unroll
                for (int r = 0; r < 4; ++r) { v[u][r] = fmaf(s0[r], sc2, rb); v[u][4 + r] = fmaf(s1[r], sc2, rb); }
            }
#pragma unroll
            for (int e = 0; e < 8; ++e) tm = fmaxf(tm, v[u][e]);
        } else {
#pragma unroll
            for (int e = 0; e < 8; ++e) v[u][e] = -3.0e38f;
        }
    }
    tm = gmax4(tm);
    const float mn = fmaxf(st.m, tm), alpha = fexp2(st.m - mn);
    float ps = 0.f;
#pragma unroll
    for (int u = 0; u < NSUB; ++u)
#pragma unroll
        for (int e = 0; e < 8; ++e) { v[u][e] = fexp2(v[u][e] - mn); ps += v[u][e]; }
    ps = gsum4(ps);
    st.l = st.l * alpha + ps; st.m = mn;
#pragma unroll
    for (int dt = 0; dt < DH / 16; ++dt) st.o[dt] = st.o[dt] * alpha;
#pragma unroll
    for (int u = 0; u < NSUB; ++u) {
        if (act[u]) {
            const LAS unsigned char* Vt = Vb + u * TB;
            v4u pbu; pbu.x = pk2(v[u][0], v[u][1]); pbu.y = pk2(v[u][2], v[u][3]); pbu.z = pk2(v[u][4], v[u][5]); pbu.w = pk2(v[u][6], v[u][7]);
            const bf16x8 pb = __builtin_bit_cast(bf16x8, pbu);
#pragma unroll
            for (int dt = 0; dt < DH / 16; ++dt) {
                const s16x4 a = ldtr(Vt + (4 * g + q4) * KS + (16 * dt + 4 * p4) * 2), b = ldtr(Vt + (16 + 4 * g + q4) * KS + (16 * dt + 4 * p4) * 2);
                st.o[dt] = mfma16((bf16x8){a[0], a[1], a[2], a[3], b[0], b[1], b[2], b[3]}, pb, st.o[dt]);
            }
        }
    }
}

template <int DH, int NSUB, class Src, class Mask>
__device__ __forceinline__ void fa_stream(LAS unsigned char* lds, int tid, int t_begin, int t_end, const Src& src, const Mask& mk, const bf16x8 (&qf)[DH / 32], FaState<DH>& st, float sc2) {
    constexpr int KS = (DH + 8) * 2, TB = 32 * KS, SB = NSUB * TB;
    if (t_begin >= t_end) return;
    const int lane = tid & 63, l15 = lane & 15, g = lane >> 4, q4 = l15 >> 2, p4 = l15 & 3;
    v4u rkA[NSUB], rvA[NSUB], rkB[NSUB], rvB[NSUB];
    int lj, lpc; bool isv = false;
    if constexpr (DH == 128) { lj = tid >> 4; lpc = tid & 15; } else { lj = (tid & 255) >> 3; lpc = tid & 7; isv = tid >= 256; }
    const int nst = (t_end - t_begin + NSUB - 1) / NSUB;
#define FA_ISSUE(k, RK, RV) do { _Pragma("unroll") for (int u = 0; u < NSUB; ++u) { int ti = t_begin + (k) * NSUB + u; ti = ti < t_end ? ti : t_end - 1; \
            const bf16* rp_ = src.krow(ti, lj) + lpc * 8; if constexpr (DH == 128) { RK[u] = *(const GAS v4u*)rp_; RV[u] = *(const GAS v4u*)(rp_ + src.voff); } \
            else { RK[u] = *(const GAS v4u*)(rp_ + (isv ? src.voff : 0)); } } } while (0)
#define FA_COMMIT(buf, RK, RV) do { _Pragma("unroll") for (int u = 0; u < NSUB; ++u) { \
            if constexpr (DH == 128) { *(LAS v4u*)(lds + (buf) * SB + u * TB + lj * KS + lpc * 16) = RK[u]; *(LAS v4u*)(lds + (2 + (buf)) * SB + u * TB + lj * KS + lpc * 16) = RV[u]; } \
            else { *(LAS v4u*)(lds + ((isv ? 2 : 0) + (buf)) * SB + u * TB + lj * KS + lpc * 16) = RK[u]; } } } while (0)
    FA_ISSUE(0, rkA, rvA); FA_COMMIT(0, rkA, rvA);
    if (1 < nst) FA_ISSUE(1, rkB, rvB);
    __syncthreads();
    for (int k = 0; k < nst; k += 2) {
        if (k + 2 < nst) FA_ISSUE(k + 2, rkA, rvA);
        fa_stage<DH, NSUB, Mask>(lds, lds + 2 * SB, qf, st, sc2, mk, t_begin + k * NSUB, t_end, l15, g, q4, p4);
        if (k + 1 < nst) FA_COMMIT(1, rkB, rvB);
        __syncthreads();
        if (k + 1 >= nst) break;
        if (k + 3 < nst) FA_ISSUE(k + 3, rkB, rvB);
        fa_stage<DH, NSUB, Mask>(lds + SB, lds + 3 * SB, qf, st, sc2, mk, t_begin + (k + 1) * NSUB, t_end, l15, g, q4, p4);
        if (k + 2 < nst) FA_COMMIT(0, rkA, rvA);
        __syncthreads();
    }
#undef FA_ISSUE
#undef FA_COMMIT
}

constexpr int DIL_PITCH = 3072;
struct DilSrc { const bf16* kbase; int band0, r, c; static constexpr int voff = 1024;
    __device__ __forceinline__ const bf16* krow(int s, int j) const { int a = band0 + 32 * s + j; a = a < 0 ? 0 : a; return kbase + (size_t)(a * r + c) * DIL_PITCH; }
    __device__ __forceinline__ const bf16* vrow(int s, int j) const { return krow(s, j) + 1024; } };
struct DilMask { int aq, band0, w;
    __device__ __forceinline__ bool valid(int ak) const { return ak >= 0 && ak <= aq && aq - ak <= 128; }
    __device__ __forceinline__ bool row_ok(int) const { return true; }
    __device__ __forceinline__ bool need_check(int) const { return true; }
    __device__ __forceinline__ bool wave_needs(int s) const { return 32 * s + 31 >= 16 * w && 32 * s <= 16 * w + 143; }
    __device__ __forceinline__ int key0(int s) const { return band0 + 32 * s; } };

__device__ __forceinline__ void dilated_phase(LAS unsigned char* lds, const bf16* PROJD, bf16* OACC, float* LSE, int gi, int G, int wave_s) {
    int tid_ = wave_s * 64 + lane_id_now(); asm volatile("" : "+v"(tid_));
    const int tid = tid_, lane = tid & 63, wave = __builtin_amdgcn_readfirstlane(tid >> 6), l15 = lane & 15, g = lane >> 4;
    const int r = (gi == 0) ? 1 : (gi == 1 ? 4 : 16);
    const float sc2 = 0.08838834764831845f * 1.4426950408889634f;
    for (int item = blockIdx.x; item < 2048; item += G) {
        const int bh = item >> 5, b = bh >> 3, h = bh & 7, rem = item & 31, c = rem % r, qt = rem / r;
        const bf16* base = PROJD + (size_t)b * SEQ * DIL_PITCH + h * 128;
        const int aq = 128 * qt + 16 * wave + l15, tq = aq * r + c;
        bf16x8 qf[4];
#pragma unroll
        for (int kk = 0; kk < 4; ++kk) qf[kk] = *(const GAS bf16x8*)(base + (size_t)tq * DIL_PITCH + 8 * g + 32 * kk);
        DilSrc src{base + 1024, 128 * qt - 128, r, c};
        DilMask mk{aq, 128 * qt - 128, wave};
        FaState<128> st; fa_init<128>(st);
        fa_stream<128, 2, DilSrc, DilMask>(lds, tid, qt == 0 ? 4 : 0, 8, src, mk, qf, st, sc2);
        const float inv = 1.f / fmaxf(st.l, 1e-30f);
        float lse = (st.m + __log2f(fmaxf(st.l, 1e-30f))) * 0.6931471805599453f;
        const size_t trow = (size_t)b * SEQ + tq;
        float wp = 0.f, wn = 1.f;
        if (gi > 0) { const float lp = *(const GAS float*)(LSE + trow * 8 + h); const float mx = fmaxf(lp, lse); const float ep = __expf(lp - mx), en = __expf(lse - mx); const float den = ep + en; wp = ep / den; wn = en / den; lse = mx + __logf(den); }
        bf16* op = OACC + trow * 1024 + h * 128 + 4 * g;
#pragma unroll
        for (int dt = 0; dt < 8; ++dt) {
            f32x4 o = st.o[dt] * (inv * wn);
            if (gi > 0) { const v2u old = *(const GAS v2u*)(op + 16 * dt); o[0] += wp * bf_lo(old.x); o[1] += wp * bf_hi(old.x); o[2] += wp * bf_lo(old.y); o[3] += wp * bf_hi(old.y); }
            v2u w; w.x = pk2(o[0], o[1]); w.y = pk2(o[2], o[3]);
            *(GAS v2u*)(op + 16 * dt) = w;
        }
        if (g == 0) *(GAS float*)(LSE + trow * 8 + h) = lse;
    }
}
constexpr int NSA_PITCH = 2816;
__device__ __forceinline__ void nsa_im2col(const bf16* PROJN, const float* pos, bf16* ACMP, int gtid, int GT) {
    asm volatile("" : "+v"(gtid));
    for (int idx = gtid; idx < 2 * 8192 * 256; idx += GT) {
        const int pc = idx & 255, row = (idx >> 8) & 8191, kv = idx >> 21;
        const int l = pc >> 3, d0 = (pc & 7) * 8, n = row & 255, bg = row >> 8, b = bg >> 2, gq = bg & 3;
        v4u o = (v4u){0u, 0u, 0u, 0u};
        if (n < 255) {
            const v4u v = *(const v4u*)(PROJN + (size_t)(b * SEQ + 16 * n + l) * NSA_PITCH + 1024 + kv * 256 + gq * 64 + d0);
            const f32x4 p0 = *(const f32x4*)(pos + kv * 2048 + l * 64 + d0), p1 = *(const f32x4*)(pos + kv * 2048 + l * 64 + d0 + 4);
            o.x = pk2(bf_lo(v.x) + p0.x, bf_hi(v.x) + p0.y); o.y = pk2(bf_lo(v.y) + p0.z, bf_hi(v.y) + p0.w);
            o.z = pk2(bf_lo(v.z) + p1.x, bf_hi(v.z) + p1.y); o.w = pk2(bf_lo(v.w) + p1.z, bf_hi(v.w) + p1.w);
        }
        *(v4u*)(ACMP + ((size_t)kv * 8192 + row) * 2048 + pc * 8) = o;
    }
}
struct TokSrc { const bf16* kbase; const LAS int* list; static constexpr int voff = 256;
    __device__ __forceinline__ int tile(int s) const { return list ? list[s] : s; }
    __device__ __forceinline__ const bf16* krow(int s, int j) const { return kbase + (size_t)(32 * tile(s) + j) * NSA_PITCH; }
};
struct SelMask { unsigned lo, hi, wlo, whi; int t, qb; const LAS int* list;
    __device__ __forceinline__ bool row_ok(int ti) const { const int jb = list[ti] >> 1; return ((jb < 32) ? (lo >> jb) & 1u : (hi >> (jb - 32)) & 1u) != 0u; }
    __device__ __forceinline__ bool need_check(int ti) const { return list[ti] == qb; }
    __device__ __forceinline__ bool valid(int tok) const { return tok <= t; }
    __device__ __forceinline__ bool wave_needs(int ti) const { const int jb = list[ti] >> 1; return ((jb < 32) ? (wlo >> jb) & 1u : (whi >> (jb - 32)) & 1u) != 0u; }
    __device__ __forceinline__ int key0(int ti) const { return 32 * list[ti]; } };
struct WinMask { int t, qb, sb;
    __device__ __forceinline__ bool row_ok(int) const { return true; }
    __device__ __forceinline__ bool need_check(int ti) const { return ti == qb || ti == sb; }
    __device__ __forceinline__ bool valid(int tok) const { return tok <= t && tok > t - 512; }
    __device__ __forceinline__ bool wave_needs(int) const { return true; }
    __device__ __forceinline__ int key0(int ti) const { return 32 * ti; } };

__device__ __forceinline__ void nsa_phase(LAS unsigned char* lds, const bf16* PROJN, const bf16* KVC, bf16* ONSA, int G, int wave_s, unsigned long long* pc_) {
#define NSA_STAMP(sec) do { if ((PROBE_MASK >> 8) != 0 && blockIdx.x == 0 && threadIdx.x == 0) { const unsigned long long now_ = __builtin_amdgcn_s_memrealtime(); if ((PROBE_MASK >> (8 + (sec))) & 1) pc_[1] += now_ - pc_[0]; pc_[0] = now_; } } while (0)
    constexpr int KS = 144, OFF_KC = 0, OFF_VC = OFF_KC + 256 * KS, OFF_IMP = OFF_VC + 256 * KS, OFF_SEL = OFF_IMP + 32 * 256 * 4, OFF_UNI = OFF_SEL + 256, OFF_TL = OFF_UNI + 64, OFF_NT = OFF_TL + 512;
    int tid_ = wave_s * 64 + lane_id_now(); asm volatile("" : "+v"(tid_));
    const int tid = tid_, lane = tid & 63, wave = __builtin_amdgcn_readfirstlane(tid >> 6), l15 = lane & 15, g = lane >> 4, q4 = l15 >> 2, p4 = l15 & 3;
    const float sc2 = 0.125f * 1.4426950408889634f;
    LAS float* IMP = (LAS float*)(lds + OFF_IMP);
    LAS unsigned* SEL = (LAS unsigned*)(lds + OFF_SEL);
    LAS unsigned* UNI = (LAS unsigned*)(lds + OFF_UNI);
    LAS int* TL = (LAS int*)(lds + OFF_TL);
    LAS int* NT = (LAS int*)(lds + OFF_NT);
    for (int item = blockIdx.x; item < 4096; item += G) {
        const int bg = item >> 7, qr = ((item & 127) + 37 * (bg >> 1)) & 127, qb = ((bg >> 1) & 1) ? 127 - qr : qr, b = bg >> 2, gq = bg & 3, t0 = 32 * qb, cur = t0 >> 6;
        const int ql = 4 * wave + q4, hp = p4, t = t0 + ql;
        const bf16* prow = PROJN + (size_t)b * SEQ * NSA_PITCH;
        bf16x8 qf[2];
#pragma unroll
        for (int kk = 0; kk < 2; ++kk) qf[kk] = *(const GAS bf16x8*)(prow + (size_t)t * NSA_PITCH + gq * 256 + hp * 64 + 8 * g + 32 * kk);
        int ncv = (t0 >> 4) + 1; ncv = ncv > 255 ? 255 : ncv; const int ntc = (ncv + 31) >> 5;
        {
            v4u tmp[8];
            const unsigned nrow = (unsigned)tid >> 3, boff = ((unsigned)bg * 256u + nrow) * 256u + ((unsigned)tid & 7u) * 8u;
#pragma unroll
            for (int u = 0; u < 8; ++u) if ((int)nrow + 64 * (u & 3) < 32 * ntc) tmp[u] = *(const GAS v4u*)(KVC + boff + (unsigned)(u & 3) * 16384u + (unsigned)(u >> 2) * 2097152u);
#pragma unroll
            for (int u = 0; u < 8; ++u) if ((int)nrow + 64 * (u & 3) < 32 * ntc) *(LAS v4u*)(lds + ((u >> 2) ? OFF_VC : OFF_KC) + ((int)nrow + 64 * (u & 3)) * KS + (tid & 7) * 16) = tmp[u];
        }
        __syncthreads();
        f32x4 oc[4];
#pragma unroll
        for (int i = 0; i < 4; ++i) oc[i] = (f32x4){0.f, 0.f, 0.f, 0.f};
        {
            f32x4 sc[8][2]; float mx = -1e30f;
#pragma unroll
            for (int s = 0; s < 8; ++s) {
                sc[s][0] = (f32x4){-1e30f, -1e30f, -1e30f, -1e30f}; sc[s][1] = sc[s][0];
                if (s < ntc) {
                    f32x4 a0 = (f32x4){0.f, 0.f, 0.f, 0.f}, a1 = a0;
#pragma unroll
                    for (int kk = 0; kk < 2; ++kk) {
                        a0 = mfma16(ldrow(lds + OFF_KC + (32 * s + l15) * KS + (8 * g + 32 * kk) * 2), qf[kk], a0);
                        a1 = mfma16(ldrow(lds + OFF_KC + (32 * s + 16 + l15) * KS + (8 * g + 32 * kk) * 2), qf[kk], a1);
                    }
#pragma unroll
                    for (int r = 0; r < 4; ++r) {
                        const int n0 = 32 * s + 4 * g + r, n1 = n0 + 16;
                        sc[s][0][r] = (16 * n0 + 31 <= t && n0 < 255) ? a0[r] * sc2 : -1e30f;
                        sc[s][1][r] = (16 * n1 + 31 <= t && n1 < 255) ? a1[r] * sc2 : -1e30f;
                        mx = fmaxf(mx, fmaxf(sc[s][0][r], sc[s][1][r]));
                    }
                }
            }
            mx = gmax4(mx);
            float sum = 0.f;
#pragma unroll
            for (int s = 0; s < 8; ++s)
#pragma unroll
                for (int e = 0; e < 2; ++e)
#pragma unroll
                    for (int r = 0; r < 4; ++r) { const float p = (sc[s][e][r] > -5e29f) ? fexp2(sc[s][e][r] - mx) : 0.f; sc[s][e][r] = p; sum += p; }
            sum = gsum4(sum);
            const float inv = 1.f / fmaxf(sum, 1e-30f);
#pragma unroll
            for (int s = 0; s < 8; ++s) {
                float p[8];
#pragma unroll
                for (int r = 0; r < 4; ++r) { p[r] = sc[s][0][r] * inv; p[4 + r] = sc[s][1][r] * inv; }
#pragma unroll
                for (int e = 0; e < 8; ++e) { float x = p[e]; x += __int_as_float(__builtin_amdgcn_update_dpp(0, __float_as_int(x), 0xB1, 0xf, 0xf, false)); x += __int_as_float(__builtin_amdgcn_update_dpp(0, __float_as_int(x), 0x4E, 0xf, 0xf, false));
                    if (hp == 0) IMP[ql * 256 + 32 * s + 16 * (e >> 2) + 4 * g + (e & 3)] = x; }
                if (s < ntc) {
                    v4u pbu; pbu.x = pk2(p[0], p[1]); pbu.y = pk2(p[2], p[3]); pbu.z = pk2(p[4], p[5]); pbu.w = pk2(p[6], p[7]);
                    const bf16x8 pb = __builtin_bit_cast(bf16x8, pbu);
#pragma unroll
                    for (int dt = 0; dt < 4; ++dt) {
                        const s16x4 a = ldtr(lds + OFF_VC + (32 * s + 4 * g + q4) * KS + (16 * dt + 4 * p4) * 2), bb = ldtr(lds + OFF_VC + (32 * s + 16 + 4 * g + q4) * KS + (16 * dt + 4 * p4) * 2);
                        oc[dt] = mfma16((bf16x8){a[0], a[1], a[2], a[3], bb[0], bb[1], bb[2], bb[3]}, pb, oc[dt]);
                    }
                }
            }
        }
        unsigned ocp[8];
#pragma unroll
        for (int dt = 0; dt < 4; ++dt) { ocp[2 * dt] = pk2(oc[dt][0], oc[dt][1]); ocp[2 * dt + 1] = pk2(oc[dt][2], oc[dt][3]); }
        __syncthreads();
        NSA_STAMP(0);
        {
            unsigned ulo = 0u, uhi = 0u;
            unsigned key[4];
#pragma unroll
            for (int qi = 0; qi < 4; ++qi) {
                const int qq = 4 * wave + qi, jb = lane;
                const LAS float* ip = IMP + qq * 256 + 4 * jb;
                const float pm1 = (jb > 0) ? ip[-1] : 0.f;
                const float imp_sel = pm1 + 2.f * (ip[0] + ip[1] + ip[2]) + ip[3];
                const bool forced = (jb == 0) || (jb == cur) || (jb == cur - 1);
                key[qi] = (jb <= cur) ? __float_as_uint(imp_sel + (forced ? 1e4f : 0.f)) + 1u : 0u;
            }
            unsigned thr[4] = {0u, 0u, 0u, 0u};
            for (int bit = 31; bit >= 0; --bit) {
#pragma unroll
                for (int qi = 0; qi < 4; ++qi) { const unsigned cand = thr[qi] | (1u << bit); if (__popcll(__ballot(key[qi] >= cand)) >= 16) thr[qi] = cand; }
            }
#pragma unroll
            for (int qi = 0; qi < 4; ++qi) {
                const int qq = 4 * wave + qi;
                const bool gt = key[qi] > thr[qi], eq = key[qi] == thr[qi];
                const int need = 16 - __popcll(__ballot(gt));
                const unsigned long long em = __ballot(eq);
                const int below = __popcll(em & ((1ull << lane) - 1ull));
                const bool sel = key[qi] > 0u && (gt || (eq && below < need));
                const unsigned long long mask = __ballot(sel);
                if (lane == 0) { SEL[2 * qq] = (unsigned)mask; SEL[2 * qq + 1] = (unsigned)(mask >> 32); }
                ulo |= (unsigned)mask; uhi |= (unsigned)(mask >> 32);
            }
            if (lane == 0) { UNI[2 * wave] = ulo; UNI[2 * wave + 1] = uhi; }
        }
        __syncthreads();
        if (wave == 0) {
            unsigned ulo = 0u, uhi = 0u;
            for (int w = 0; w < 8; ++w) { ulo |= UNI[2 * w]; uhi |= UNI[2 * w + 1]; }
            int cnt = 0;
            for (int half = 0; half < 2; ++half) {
                const int s = lane + 64 * half, jb = s >> 1; const unsigned bit = (jb < 32) ? (ulo >> jb) & 1u : (uhi >> (jb - 32)) & 1u;
                const bool need = (s <= qb) && bit != 0u;
                const unsigned long long m = __ballot(need);
                const int pos = cnt + __popcll(m & ((1ull << lane) - 1ull));
                if (need) TL[pos] = s;
                cnt += __popcll(m);
            }
            if (lane == 0) NT[0] = cnt;
        }
        __syncthreads();
        const int nts = NT[0];
        NSA_STAMP(1);
        FaState<64> ss; fa_init<64>(ss);
        {
            TokSrc src{prow + 1536 + gq * 64, TL};
            SelMask mk{SEL[2 * ql], SEL[2 * ql + 1], (unsigned)__builtin_amdgcn_readfirstlane((int)UNI[2 * wave]), (unsigned)__builtin_amdgcn_readfirstlane((int)UNI[2 * wave + 1]), t, qb, TL};
            fa_stream<64, 4, TokSrc, SelMask>(lds, tid, 0, nts, src, mk, qf, ss, sc2);
        }
        unsigned osp[8]; float isl = 1.f / fmaxf(ss.l, 1e-30f);
#pragma unroll
        for (int dt = 0; dt < 4; ++dt) { osp[2 * dt] = pk2(ss.o[dt][0] * isl, ss.o[dt][1] * isl); osp[2 * dt + 1] = pk2(ss.o[dt][2] * isl, ss.o[dt][3] * isl); }
        NSA_STAMP(2);
        FaState<64> sw; fa_init<64>(sw);
        {
            TokSrc src{prow + 2048 + gq * 64, nullptr};
            const int sb = (t0 - 512) < 0 ? 0 : (t0 - 512) >> 5;
            WinMask mk{t, qb, sb};
            fa_stream<64, 4, TokSrc, WinMask>(lds, tid, sb, qb + 1, src, mk, qf, sw, sc2);
        }
        NSA_STAMP(3);
        {
            const GAS bf16* gp = (const GAS bf16*)(prow + (size_t)t * NSA_PITCH + 2560 + gq * 4 + hp);
            const float g0 = sigmoid_f(__uint_as_float((unsigned)gp[0] << 16)), g1 = sigmoid_f(__uint_as_float((unsigned)gp[16] << 16)), g2 = sigmoid_f(__uint_as_float((unsigned)gp[32] << 16));
            const float iw = g2 / fmaxf(sw.l, 1e-30f);
            bf16* op = ONSA + ((size_t)b * SEQ + t) * 1024 + gq * 256 + hp * 64 + 4 * g;
#pragma unroll
            for (int dt = 0; dt < 4; ++dt) {
                f32x4 o = sw.o[dt] * iw;
                o[0] += g0 * bf_lo(ocp[2 * dt]) + g1 * bf_lo(osp[2 * dt]); o[1] += g0 * bf_hi(ocp[2 * dt]) + g1 * bf_hi(osp[2 * dt]);
                o[2] += g0 * bf_lo(ocp[2 * dt + 1]) + g1 * bf_lo(osp[2 * dt + 1]); o[3] += g0 * bf_hi(ocp[2 * dt + 1]) + g1 * bf_hi(osp[2 * dt + 1]);
                v2u w; w.x = pk2(o[0], o[1]); w.y = pk2(o[2], o[3]); *(GAS v2u*)(op + 16 * dt) = w; }
        }
        __syncthreads();
        NSA_STAMP(4);
    }
}
#ifndef RET_SCAN
#define RET_SCAN 1
#define RET_GNORM 1
#define RET_GATE 1
#endif
#ifndef ENABLE_SSD
#define ENABLE_SSD 1
#endif
constexpr size_t WS_DTRAW = WS_SCR + 340 * MiB, WS_HALO = WS_SCR + 344 * MiB;
#define MIXER_CONVERT \
    if (mix == 1) { transpose_w<0>(args.in[12], D, 2608, 2816, WMIX, scr, gw, NGW, lane); \
        for (int c = 0; c < 2; ++c) { transpose_w<0>(args.in[14] + (size_t)c * 2048 * 256, 2048, 256, 256, WMIX + 3 * MiB + (size_t)c * 256 * 2048, scr, gw, NGW, lane); \
            transpose_w<0>(args.in[15] + (size_t)c * 256 * 64, 256, 64, 256, WMIX + 4 * MiB + (size_t)c * 256 * 256, scr, gw, NGW, lane); } \
        transpose_w<0>(args.in[16], D, D, D, WMIX + 5 * MiB, scr, gw, NGW, lane); } \
    if (mix == 3) { transpose_w<0>(args.in[25], D, 9216, 9216, WMIX, scr, gw, NGW, lane); transpose_w<0>(args.in[26], D, D, D, WMIX + (size_t)9216 * 1024, scr, gw, NGW, lane); } \
    if (mix == 0) { transpose_w<0>(args.in[9], D, 6144, 6144, WMIX, scr, gw, NGW, lane); transpose_w<0>(args.in[11], 2048, D, D, WMIX + (size_t)6144 * 1024, scr, gw, NGW, lane); } \
    if (mix == 2) { transpose_w<0>(args.in[17], D, 5152, 5376, WMIX, scr, gw, NGW, lane); transpose_w<0>(args.in[24], 2048, D, D, WMIX + (size_t)6144 * 1024, scr, gw, NGW, lane); }

#define MIXER_PHASES \
    if (mix == 0) { \
        bf16* PROJ = (bf16*)(ws + WS_SCR); \
        PHASE_BEGIN { pg8::Epi<pg8::EPI_RETQKV> E{}; E.O = PROJ; E.ldc = 4096; E.rot = ROT; run_gemm<pg8::EPI_RETQKV>(lds, U, D, WMIX, T, 4096, D, E, wave_s); } PHASE_END_C(3) \
        if (RET_SCAN) PHASE_BEGIN \
            for (int item = blockIdx.x; item < 256; item += G) { \
                const int b = item >> 5, h = (item >> 3) & 3, s8 = item & 7; \
                bf16* base = PROJ + (size_t)b * SEQ * 4096; \
                scan_item<256, false>(lds, base + h * 256, base + 1024 + h * 256, base + 2048 + h * 512 + s8 * 64, 4096, base + 2048 + h * 512 + s8 * 64, 4096, log1pf(-exp2f(-5.f - (float)h)), nullptr, 0.f, 0.f, 0.f, wave_s); \
                __syncthreads(); \
            } \
        PHASE_END_C(4) \
        if (RET_GNORM) PHASE_BEGIN gnorm_rows(PROJ + 2048, 4096, args.in[10], gw, NGW, lane); PHASE_END_C(7) \
        if (RET_GATE) PHASE_BEGIN { pg8::Epi<pg8::EPI_GATEMUL> E{}; E.O = PROJ + 2048; E.ldc = 4096; run_gemm<pg8::EPI_GATEMUL>(lds, U, D, WMIX + (size_t)4096 * 1024, T, 2048, D, E, wave_s); } PHASE_END_C(3) \
        PHASE_BEGIN { pg8::Epi<pg8::EPI_RESID> E{}; E.Hout = H; E.Hbase = H; E.scale = 1.0f; E.ldc = D; run_gemm<pg8::EPI_RESID>(lds, PROJ + 2048, 4096, WMIX + (size_t)6144 * 1024, T, D, 2048, E, wave_s); } PHASE_END_C(3) \
    } \
    if (mix == 2 && ENABLE_SSD) { \
        bf16* PROJ = (bf16*)(ws + WS_SCR); float* DTRAW = (float*)(ws + WS_DTRAW); bf16* HALO = (bf16*)(ws + WS_HALO); \
        PHASE_BEGIN { pg8::Epi<pg8::EPI_SSD> E{}; E.O = PROJ; E.ldc = SSD_PITCH; E.aux = DTRAW; run_gemm<pg8::EPI_SSD>(lds, U, D, WMIX, T, SSD_PITCH, D, E, wave_s); } PHASE_END_C(3) \
        PHASE_BEGIN ssd_halo_save(PROJ, HALO, blockIdx.x * NTHR + tid, G * NTHR); PHASE_END_C(7) \
        PHASE_BEGIN ssd_conv(PROJ, HALO, args.in[18], args.in[19], blockIdx.x * NTHR + tid, G * NTHR); PHASE_END_C(7) \
        PHASE_BEGIN \
            for (int item = blockIdx.x; item < 256; item += G) { \
                const int b = item >> 5, gq = (item >> 3) & 3, r = item & 7, hd = gq * 8 + r; \
                bf16* base = PROJ + (size_t)b * SEQ * SSD_PITCH; \
                scan_item<128, true>(lds, base + 4608 + gq * 128, base + 4096 + gq * 128, base + 2048 + gq * 512 + r * 64, SSD_PITCH, base + gq * 512 + r * 64, SSD_PITCH, 0.f, \
                                     DTRAW + (size_t)b * SEQ * 32 + hd, args.in[20][hd], -__expf(args.in[21][hd]), args.in[22][hd], wave_s); \
                __syncthreads(); \
            } \
        PHASE_END_C(4) \
        PHASE_BEGIN gnorm_rows(PROJ, SSD_PITCH, args.in[23], gw, NGW, lane); PHASE_END_C(7) \
        PHASE_BEGIN { pg8::Epi<pg8::EPI_RESID> E{}; E.Hout = H; E.Hbase = H; E.scale = 1.0f; E.ldc = D; run_gemm<pg8::EPI_RESID>(lds, PROJ, SSD_PITCH, WMIX + (size_t)6144 * 1024, T, D, 2048, E, wave_s); } PHASE_END_C(3) \
    } \
    if (mix == 3) { \
        bf16* PROJD = (bf16*)(ws + WS_SCR); bf16* OACC = (bf16*)(ws + WS_SCR + 192 * MiB); float* LSE = (float*)(ws + WS_SCR + 256 * MiB); \
        for (int gi = 0; gi < 3; ++gi) { \
            PHASE_BEGIN { pg8::Epi<pg8::EPI_BF16> E{}; E.O = PROJD; E.ldc = DIL_PITCH; run_gemm<pg8::EPI_BF16>(lds, U, D, WMIX + (size_t)gi * 3072 * 1024, T, 3072, D, E, wave_s); } PHASE_END_C(3) \
            PHASE_BEGIN dilated_phase(lds, PROJD, OACC, LSE, gi, G, wave_s); PHASE_END_C(6) \
        } \
        PHASE_BEGIN { pg8::Epi<pg8::EPI_RESID> E{}; E.Hout = H; E.Hbase = H; E.scale = 1.0f; E.ldc = D; run_gemm<pg8::EPI_RESID>(lds, OACC, D, WMIX + (size_t)9216 * 1024, T, D, D, E, wave_s); } PHASE_END_C(3) \
    } \
    if (mix == 1) { \
        bf16* PROJN = (bf16*)(ws + WS_SCR); bf16* ACMP = (bf16*)(ws + WS_SCR + 176 * MiB); bf16* HIDC = (bf16*)(ws + WS_SCR + 240 * MiB); bf16* KVC = (bf16*)(ws + WS_SCR + 248 * MiB); bf16* ONSA = (bf16*)(ws + WS_SCR + 256 * MiB); \
        PHASE_BEGIN { pg8::Epi<pg8::EPI_BF16> E{}; E.O = PROJN; E.ldc = NSA_PITCH; run_gemm<pg8::EPI_BF16>(lds, U, D, WMIX, T, NSA_PITCH, D, E, wave_s); } PHASE_END_C(3) \
        PHASE_BEGIN nsa_im2col(PROJN, args.in[13], ACMP, blockIdx.x * NTHR + tid, G * NTHR); PHASE_END_C(7) \
        PHASE_BEGIN for (int c = 0; c < 2; ++c) { pg8::Epi<pg8::EPI_SILU> E{}; E.O = HIDC + (size_t)c * 8192 * 256; E.ldc = 256; run_gemm<pg8::EPI_SILU>(lds, ACMP + (size_t)c * 8192 * 2048, 2048, WMIX + 3 * MiB + (size_t)c * 256 * 2048, 8192, 256, 2048, E, wave_s); } PHASE_END_C(3) \
        PHASE_BEGIN for (int c = 0; c < 2; ++c) { pg8::Epi<pg8::EPI_BF16> E{}; E.O = KVC + (size_t)c * 8192 * 256; E.ldc = 256; run_gemm<pg8::EPI_BF16>(lds, HIDC + (size_t)c * 8192 * 256, 256, WMIX + 4 * MiB + (size_t)c * 256 * 256, 8192, 256, 256, E, wave_s); } PHASE_END_C(3) \
        PHASE_BEGIN nsa_phase(lds, PROJN, KVC, ONSA, G, wave_s, (unsigned long long*)(args.ws + 32768)); PHASE_END_C(5) \
        PHASE_BEGIN { pg8::Epi<pg8::EPI_RESID> E{}; E.Hout = H; E.Hbase = H; E.scale = 1.0f; E.ldc = D; run_gemm<pg8::EPI_RESID>(lds, ONSA, D, WMIX + 5 * MiB, T, D, D, E, wave_s); } PHASE_END_C(3) \
    }
__global__ void __launch_bounds__(NTHR, 2) fwd_megakernel(Args args) {
    extern __shared__ __attribute__((aligned(16))) unsigned char lds_raw[];
    LAS unsigned char* lds = (LAS unsigned char*)lds_raw;
    cg::grid_group grid = cg::this_grid();
    const int G = gridDim.x;
    const int wave_s = __builtin_amdgcn_readfirstlane(threadIdx.x >> 6);
    volatile LAS unsigned* xst = (volatile LAS unsigned*)(lds + LDS_BYTES - 64);
    if (threadIdx.x < 16) xst[threadIdx.x] = 0u;
    __syncthreads();
    const XcdBarrier xbar = xcd_barrier_post((unsigned*)args.ws, xst);
    if (args.ph_lo < 0) grid.sync();
    if (PROBE_MASK != 0 && blockIdx.x == 0 && threadIdx.x == 0) { ((unsigned long long*)(args.ws + 32768))[0] = __builtin_amdgcn_s_memrealtime(); }
#define PHASE_BEGIN {
#define PHASE_END_C(cat) xcd_barrier(xbar); if (PROBE_MASK != 0 && blockIdx.x == 0 && threadIdx.x == 0) { const unsigned long long now_ = __builtin_amdgcn_s_memrealtime(); unsigned long long* c_ = (unsigned long long*)(args.ws + 32768); if ((PROBE_MASK >> (cat)) & 1) c_[1] += now_ - c_[0]; c_[0] = now_; } }
    for (int L = 0; L < DEPTH; ++L) {
        const int mix = L & 3;
        int tid_ = wave_s * 64 + lane_id_now(); asm volatile("" : "+v"(tid_));
        const int tid = tid_, lane = tid & 63, wave = __builtin_amdgcn_readfirstlane(tid >> 6);
        const int gw = blockIdx.x * NWAVES + wave, NGW = G * NWAVES;
        unsigned char* ws = args.ws; asm volatile("" : "+s"(ws));
        float* H = args.out; asm volatile("" : "+s"(H));
        float* ROT = (float*)(ws + WS_ROT);
        bf16* WIN1 = (bf16*)(ws + WS_WIN1); bf16* WOUT1 = (bf16*)(ws + WS_WOUT1); bf16* WIN2 = (bf16*)(ws + WS_WIN2); bf16* WOUT2 = (bf16*)(ws + WS_WOUT2); bf16* WMIX = (bf16*)(ws + WS_WMIX);
        bf16* U = (bf16*)(ws + WS_U); bf16* HID = (bf16*)(ws + WS_SCR);
        LAS float* scr = (LAS float*)(lds + wave * 18432);
        PHASE_BEGIN
            transpose_w<1>(args.in[2] + (size_t)L * D * 2 * FF, D, 2 * FF, 2 * FF, WIN1, scr, gw, NGW, lane);
            transpose_w<0>(args.in[3] + (size_t)L * FF * D, FF, D, D, WOUT1, scr, gw, NGW, lane);
            transpose_w<1>(args.in[6] + (size_t)L * D * 2 * FF, D, 2 * FF, 2 * FF, WIN2, scr, gw, NGW, lane);
            transpose_w<0>(args.in[7] + (size_t)L * FF * D, FF, D, D, WOUT2, scr, gw, NGW, lane);
            MIXER_CONVERT
            if (L == 0) {
                for (int i = blockIdx.x * NTHR + tid; i < 4096 * 128; i += G * NTHR) {
                    const int pos = i >> 7, d = i & 127;
                    const float inv = exp2f(-(float)d * (13.287712379549449f / 128.f));
                    const float ang = (float)pos * inv;
                    const double x = (double)ang * 0.15915494309189535; const float fr = (float)(x - rint(x));
                    ROT[i] = __builtin_amdgcn_cosf(fr); ROT[4096 * 128 + i] = __builtin_amdgcn_sinf(fr);
                }
            }
            rms_rows(L == 0 ? args.in[0] : H, args.in[1] + L * D, U, nullptr, gw, NGW, lane);
        PHASE_END_C(0)
        PHASE_BEGIN { pg8::Epi<pg8::EPI_SWIGLU> E{}; E.O = HID; E.ldc = FF; run_gemm<pg8::EPI_SWIGLU>(lds, U, D, WIN1, T, 2 * FF, D, E, wave_s); } PHASE_END_C(1)
        PHASE_BEGIN { pg8::Epi<pg8::EPI_RESID> E{}; E.Hout = H; E.Hbase = (L == 0) ? args.in[0] : H; E.scale = 0.5f; E.ldc = D; run_gemm<pg8::EPI_RESID>(lds, HID, FF, WOUT1, T, D, FF, E, wave_s); } PHASE_END_C(1)
        PHASE_BEGIN rms_rows(H, args.in[4] + L * D, U, nullptr, gw, NGW, lane); PHASE_END_C(2)
        MIXER_PHASES
        PHASE_BEGIN rms_rows(H, args.in[5] + L * D, U, nullptr, gw, NGW, lane); PHASE_END_C(2)
        PHASE_BEGIN { pg8::Epi<pg8::EPI_SWIGLU> E{}; E.O = HID; E.ldc = FF; run_gemm<pg8::EPI_SWIGLU>(lds, U, D, WIN2, T, 2 * FF, D, E, wave_s); } PHASE_END_C(1)
        PHASE_BEGIN { pg8::Epi<pg8::EPI_RESID> E{}; E.Hout = H; E.Hbase = H; E.scale = 0.5f; E.ldc = D; run_gemm<pg8::EPI_RESID>(lds, HID, FF, WOUT2, T, D, FF, E, wave_s); } PHASE_END_C(1)
    }
    int nprobe = 0; if (PROBE_MASK != 0) { asm volatile("s_waitcnt vmcnt(0)" ::: "memory"); xcd_barrier(xbar); nprobe = (int)(__hip_atomic_load((unsigned long long*)(args.ws + 32768) + 1, __ATOMIC_RELAXED, __HIP_MEMORY_SCOPE_AGENT) >> 3); }
    { const int lane = lane_id_now(); rms_final(args.out, args.in[8], blockIdx.x * NWAVES + wave_s, G * NWAVES, lane, nprobe); }
}

extern "C" void kernel_launch(void* const* d_in, const int* in_sizes, int n_in, void* d_out, int out_size, void* d_ws, size_t ws_size, hipStream_t stream) {
    static int grid = 0;
    if (grid == 0) {
        if (n_in != 27 || out_size != T * D || ws_size < WS_NEED) { fprintf(stderr, "kernel_launch: unexpected problem (n_in %d, out %d, ws %zu)\n", n_in, out_size, ws_size); grid = -1; return; }
        int dev = 0, cus = 0, per_cu = 0;
        hipGetDevice(&dev); hipDeviceGetAttribute(&cus, hipDeviceAttributeMultiprocessorCount, dev);
        if (hipFuncSetAttribute((const void*)fwd_megakernel, hipFuncAttributeMaxDynamicSharedMemorySize, LDS_BYTES) != hipSuccess) { fprintf(stderr, "kernel_launch: hipFuncSetAttribute failed\n"); grid = -1; return; }
        if (hipOccupancyMaxActiveBlocksPerMultiprocessor(&per_cu, (const void*)fwd_megakernel, NTHR, LDS_BYTES) != hipSuccess || per_cu < 1) { fprintf(stderr, "kernel_launch: occupancy query gave %d\n", per_cu); per_cu = 1; }
        (void)hipGetLastError();
        grid = cus * 1;
    }
    if (grid < 0) return;
    if (hipMemsetAsync(d_ws, 0, 65536, stream) != hipSuccess) { fprintf(stderr, "kernel_launch: memset failed\n"); return; }
    Args a{};
    for (int i = 0; i < 27; ++i) a.in[i] = (const float*)d_in[i];
    a.out = (float*)d_out; a.ws = (unsigned char*)d_ws; a.ph_lo = 0; a.ph_hi = 1 << 20;
    void* kargs[] = {&a};
    hipError_t e = hipLaunchCooperativeKernel((const void*)fwd_megakernel, dim3(grid), dim3(NTHR), kargs, LDS_BYTES, stream);
    if (e != hipSuccess) fprintf(stderr, "kernel_launch: cooperative launch failed: %s (grid %d)\n", hipGetErrorString(e), grid);
}
```

```cpp
#include <hip/hip_runtime.h>
#include <hip/hip_cooperative_groups.h>
#include <cstdio>
#include <cstdint>
namespace cg = cooperative_groups;

__device__ __forceinline__ int lane_id_now() { int l; asm volatile("v_mbcnt_lo_u32_b32 %0, -1, 0\n\tv_mbcnt_hi_u32_b32 %0, -1, %0" : "=v"(l)); return l; }

#ifndef PROBE_MASK
#define PROBE_MASK 0
#endif
namespace pg8 {
#define PG8_LAS __attribute__((address_space(3)))
typedef unsigned short bf16_t;
typedef short bf16x8 __attribute__((ext_vector_type(8)));
typedef float f32x4 __attribute__((ext_vector_type(4)));
typedef unsigned u32x4 __attribute__((ext_vector_type(4)));
constexpr int BM = 256, BK = 64, HALF = 128, HTB = HALF * BK * 2  , STAGE_BYTES = 8 * HTB, NXCD = 8, WGM = 8;

__host__ __device__ __forceinline__ int lds_byte(int r, int c) { const int st = (r >> 4) * 2 + (c >> 5), rr = r & 15, cc = c & 31, ob = rr * 64 + cc * 2; return st * 1024 + (ob ^ (((ob >> 9) & 1) << 5)); }
__host__ __device__ __forceinline__ void stage_rc(int b, int& R, int& C) { const int st = b / 1024, sb = b % 1024, swz = sb ^ (((sb >> 9) & 1) << 5); R = (st >> 1) * 16 + swz / 64; C = (st & 1) * 32 + (swz % 64) / 2; }
__host__ __device__ __forceinline__ int perm32(int rho) { const int n = rho >> 4, i = rho & 15; return 8 * (i >> 2) + 4 * n + (i & 3); }

struct Unit { int pm, pn; };
struct Gemm { const bf16_t* A; const bf16_t* Bt; int M, N, K, lda; };

struct StaticOrder {
    int nM, nN, nwg, G, c;
    __host__ __device__ void init(int M, int N, int G_, int c_) { nM = M / BM; nN = N / BM; nwg = nM * nN; G = G_; c = c_; }
    __host__ __device__ bool next(int i, Unit& u) const {
        const long L = (long)i * G + c; if (L >= nwg) return false;
        int wgid = (int)L; { const int q = nwg / NXCD, r = nwg % NXCD, xcd = wgid % NXCD, off = wgid / NXCD; wgid = (xcd < r ? xcd * (q + 1) : r * (q + 1) + (xcd - r) * q) + off; }
        const int nig = WGM * nN, gid = wgid / nig, fm = gid * WGM, gsz = (nM - fm) < WGM ? (nM - fm) : WGM;
        u.pm = fm + ((wgid % nig) % gsz); u.pn = (wgid % nig) / gsz; return true;
    }
    __device__ __forceinline__ void a_ready(const Unit&) const {}
    __device__ __forceinline__ void done(const Unit&) const {}
};

typedef float f32x2_t __attribute__((ext_vector_type(2))); typedef __bf16 bf16x2_t __attribute__((ext_vector_type(2)));
__device__ __forceinline__ unsigned cvt_pk_bf16(float lo, float hi) { f32x2_t v = {lo, hi}; bf16x2_t b = __builtin_convertvector(v, bf16x2_t); return __builtin_bit_cast(unsigned, b); }
__device__ __forceinline__ float bf_lo(unsigned w) { return __uint_as_float(w << 16); }
__device__ __forceinline__ float bf_hi(unsigned w) { return __uint_as_float(w & 0xffff0000u); }
__device__ __forceinline__ float silu_f(float x) { return x * __builtin_amdgcn_rcpf(1.0f + __builtin_amdgcn_exp2f(-1.4426950408889634f * x)); }
__device__ __forceinline__ float sigmoid_f(float x) { return __builtin_amdgcn_rcpf(1.0f + __builtin_amdgcn_exp2f(-1.4426950408889634f * x)); }

enum { EPI_BF16 = 0, EPI_SWIGLU = 1, EPI_RESID = 2, EPI_RETQKV = 3, EPI_GATEMUL = 4, EPI_SSD = 5, EPI_SILU = 6 };
template <int MODE> struct Epi {
    static constexpr bool PERM = true, AFTER_DRAIN = false;
    bf16_t* O; int ldc;
    float* Hout; const float* Hbase; float scale;
    const float* __restrict__ rot;
    float* aux;
    __device__ __forceinline__ void operator()(const f32x4 (&acc)[2][2][4][2], const Unit& u, int wr, int wc, int fr, int fq) const {
        const int row0 = u.pm * BM + wr * 64 + fr;
        const int cl = wc * 32 + 8 * fq;
        if constexpr (MODE == EPI_SWIGLU) {
#pragma unroll
            for (int ai = 0; ai < 2; ++ai)
#pragma unroll
                for (int m = 0; m < 4; ++m) {
                    bf16_t* rowp = O + (size_t)(row0 + ai * HALF + m * 16) * ldc + u.pn * 128 + cl;
                    f32x4 a0 = acc[ai][0][m][0], a1 = acc[ai][0][m][1], b0 = acc[ai][1][m][0], b1 = acc[ai][1][m][1];
                    u32x4 w;
                    w.x = cvt_pk_bf16(silu_f(a0[0]) * b0[0], silu_f(a0[1]) * b0[1]); w.y = cvt_pk_bf16(silu_f(a0[2]) * b0[2], silu_f(a0[3]) * b0[3]);
                    w.z = cvt_pk_bf16(silu_f(a1[0]) * b1[0], silu_f(a1[1]) * b1[1]); w.w = cvt_pk_bf16(silu_f(a1[2]) * b1[2], silu_f(a1[3]) * b1[3]);
                    *(u32x4*)rowp = w;
                }
        } else if constexpr (MODE == EPI_RESID) {
            bf16_t* const HB = (bf16_t*)Hout;
#pragma unroll
            for (int ai = 0; ai < 2; ++ai) {
                if (Hbase) {
                    f32x4 pre[4][2][2];
#pragma unroll
                    for (int m = 0; m < 4; ++m) { const size_t off = (size_t)(row0 + ai * HALF + m * 16) * ldc + u.pn * BM + cl;
#pragma unroll
                        for (int bj = 0; bj < 2; ++bj)
#pragma unroll
                            for (int n = 0; n < 2; ++n) pre[m][bj][n] = *(const f32x4*)(Hbase + off + bj * HALF + 4 * n); }
#pragma unroll
                    for (int m = 0; m < 4; ++m) { const size_t off = (size_t)(row0 + ai * HALF + m * 16) * ldc + u.pn * BM + cl;
#pragma unroll
                        for (int bj = 0; bj < 2; ++bj) { const f32x4 h0 = pre[m][bj][0] + acc[ai][bj][m][0] * scale, h1 = pre[m][bj][1] + acc[ai][bj][m][1] * scale; u32x4 w;
                            w.x = cvt_pk_bf16(h0[0], h0[1]); w.y = cvt_pk_bf16(h0[2], h0[3]); w.z = cvt_pk_bf16(h1[0], h1[1]); w.w = cvt_pk_bf16(h1[2], h1[3]);
                            *(u32x4*)(HB + off + bj * HALF) = w; } }
                } else {
                    u32x4 pre[4][2];
#pragma unroll
                    for (int m = 0; m < 4; ++m) { const size_t off = (size_t)(row0 + ai * HALF + m * 16) * ldc + u.pn * BM + cl;
#pragma unroll
                        for (int bj = 0; bj < 2; ++bj) pre[m][bj] = *(const u32x4*)(HB + off + bj * HALF); }
#pragma unroll
                    for (int m = 0; m < 4; ++m) { const size_t off = (size_t)(row0 + ai * HALF + m * 16) * ldc + u.pn * BM + cl;
#pragma unroll
                        for (int bj = 0; bj < 2; ++bj) { const u32x4 p = pre[m][bj]; const f32x4 a0 = acc[ai][bj][m][0] * scale, a1 = acc[ai][bj][m][1] * scale; u32x4 w;
                            w.x = cvt_pk_bf16(bf_lo(p.x) + a0[0], bf_hi(p.x) + a0[1]); w.y = cvt_pk_bf16(bf_lo(p.y) + a0[2], bf_hi(p.y) + a0[3]);
                            w.z = cvt_pk_bf16(bf_lo(p.z) + a1[0], bf_hi(p.z) + a1[1]); w.w = cvt_pk_bf16(bf_lo(p.w) + a1[2], bf_hi(p.w) + a1[3]);
                            *(u32x4*)(HB + off + bj * HALF) = w; } }
                }
            }
        } else if constexpr (MODE == EPI_RETQKV) {
            if (u.pn < 8) {
                const float ks = (u.pn >= 4) ? 0.0625f : 1.0f;
#pragma unroll
                for (int ai = 0; ai < 2; ++ai)
#pragma unroll
                    for (int m = 0; m < 4; ++m) {
                        const int r = row0 + ai * HALF + m * 16; const int pos = r & 4095;
                        bf16_t* rowp = O + (size_t)r * ldc + u.pn * BM + cl;
                        u32x4 w1, w2; unsigned* p1 = (unsigned*)&w1; unsigned* p2 = (unsigned*)&w2;
#pragma unroll
                        for (int n = 0; n < 2; ++n) {
                            const f32x4 c = *(const f32x4*)(rot + (size_t)pos * 128 + cl + 4 * n);
                            const f32x4 s = *(const f32x4*)(rot + (size_t)4096 * 128 + (size_t)pos * 128 + cl + 4 * n);
                            const f32x4 t1 = acc[ai][0][m][n] * ks, t2 = acc[ai][1][m][n] * ks;
                            const f32x4 o1 = t1 * c - t2 * s, o2 = t1 * s + t2 * c;
                            p1[2 * n] = cvt_pk_bf16(o1[0], o1[1]); p1[2 * n + 1] = cvt_pk_bf16(o1[2], o1[3]);
                            p2[2 * n] = cvt_pk_bf16(o2[0], o2[1]); p2[2 * n + 1] = cvt_pk_bf16(o2[2], o2[3]);
                        }
                        *(u32x4*)rowp = w1; *(u32x4*)(rowp + HALF) = w2;
                    }
            } else {
#pragma unroll
                for (int ai = 0; ai < 2; ++ai)
#pragma unroll
                    for (int m = 0; m < 4; ++m) {
                        bf16_t* rowp = O + (size_t)(row0 + ai * HALF + m * 16) * ldc + u.pn * BM + cl;
#pragma unroll
                        for (int bj = 0; bj < 2; ++bj) { const f32x4 v0 = acc[ai][bj][m][0], v1 = acc[ai][bj][m][1]; u32x4 w;
                            w.x = cvt_pk_bf16(v0[0], v0[1]); w.y = cvt_pk_bf16(v0[2], v0[3]); w.z = cvt_pk_bf16(v1[0], v1[1]); w.w = cvt_pk_bf16(v1[2], v1[3]);
                            *(u32x4*)(rowp + bj * HALF) = w; }
                    }
            }
        } else if constexpr (MODE == EPI_GATEMUL) {
#pragma unroll
            for (int ai = 0; ai < 2; ++ai)
#pragma unroll
                for (int m = 0; m < 4; ++m) {
                    bf16_t* rowp = O + (size_t)(row0 + ai * HALF + m * 16) * ldc + u.pn * BM + cl;
#pragma unroll
                    for (int bj = 0; bj < 2; ++bj) { const f32x4 v0 = acc[ai][bj][m][0], v1 = acc[ai][bj][m][1]; const u32x4 old = *(const u32x4*)(rowp + bj * HALF); u32x4 w;
                        w.x = cvt_pk_bf16(silu_f(v0[0]) * bf_lo(old.x), silu_f(v0[1]) * bf_hi(old.x)); w.y = cvt_pk_bf16(silu_f(v0[2]) * bf_lo(old.y), silu_f(v0[3]) * bf_hi(old.y));
                        w.z = cvt_pk_bf16(silu_f(v1[0]) * bf_lo(old.z), silu_f(v1[1]) * bf_hi(old.z)); w.w = cvt_pk_bf16(silu_f(v1[2]) * bf_lo(old.w), silu_f(v1[3]) * bf_hi(old.w));
                        *(u32x4*)(rowp + bj * HALF) = w; }
                }
        } else {
            if (MODE == EPI_SSD && u.pn == 20) {
                if (wc == 0) {
#pragma unroll
                    for (int ai = 0; ai < 2; ++ai)
#pragma unroll
                        for (int m = 0; m < 4; ++m) { float* p = aux + (size_t)(row0 + ai * HALF + m * 16) * 32 + cl;
                            *(f32x4*)p = acc[ai][0][m][0]; *(f32x4*)(p + 4) = acc[ai][0][m][1]; }
                }
                return;
            }
#pragma unroll
            for (int ai = 0; ai < 2; ++ai)
#pragma unroll
                for (int m = 0; m < 4; ++m) {
                    bf16_t* rowp = O + (size_t)(row0 + ai * HALF + m * 16) * ldc + u.pn * BM + cl;
#pragma unroll
                    for (int bj = 0; bj < 2; ++bj) { f32x4 v0 = acc[ai][bj][m][0], v1 = acc[ai][bj][m][1]; u32x4 w;
                        if (MODE == EPI_SILU) { v0 = (f32x4){silu_f(v0[0]), silu_f(v0[1]), silu_f(v0[2]), silu_f(v0[3])}; v1 = (f32x4){silu_f(v1[0]), silu_f(v1[1]), silu_f(v1[2]), silu_f(v1[3])}; }
                        w.x = cvt_pk_bf16(v0[0], v0[1]); w.y = cvt_pk_bf16(v0[2], v0[3]); w.z = cvt_pk_bf16(v1[0], v1[1]); w.w = cvt_pk_bf16(v1[2], v1[3]);
                        *(u32x4*)(rowp + bj * HALF) = w; }
                }
        }
    }
};
template <class Epi, class Sched, bool ALIGN_EPI = false, bool SP2 = false>
__device__ __forceinline__ void gemm_phase(PG8_LAS unsigned char* lds, const Gemm g, const Sched& S, const Epi& E, int wave_s) {
    int tid_ = wave_s * 64 + lane_id_now(); asm volatile("" : "+v"(tid_)); const int tid = tid_, wid = __builtin_amdgcn_readfirstlane(tid >> 6), lane = tid & 63, wr = wid >> 2, wc = wid & 3, fr = lane & 15, fq = lane >> 4;
    const int K = g.K, nt = K / BK;
    unsigned voffA[2], voffB[2];
#pragma unroll
    for (int i = 0; i < 2; ++i) { int R, C; stage_rc(tid * 16 + i * 8192, R, C); const int Rb = Epi::PERM ? ((R & ~31) + perm32(R & 31)) : R;
        voffA[i] = (unsigned)(R * g.lda + C) * 2u; voffB[i] = (unsigned)(Rb * K + C) * 2u; }
    const size_t kstep = (size_t)(BK * 2);
    const size_t hstepA = (size_t)HALF * g.lda * 2, hstepB = (size_t)HALF * K * 2;
    const size_t tstepA = 2 * hstepA, tstepB = 2 * hstepB;
    const unsigned ldsw = (unsigned)wid * 1024u;
    const int aoff = lds_byte(wr * 64 + fr, fq * 8), boff = lds_byte(wc * 32 + fr, fq * 8);
#define PG8_SA(b, h) (((b) * 2 + (h)) * HTB)
#define PG8_SB(b, h) ((4 + (b) * 2 + (h)) * HTB)
#define PG8_STAGE(bufoff, gbase, voff) do { _Pragma("unroll") for (int _i = 0; _i < 2; ++_i) \
        __builtin_amdgcn_global_load_lds((const unsigned*)((const char*)(gbase) + (voff)[_i]), (PG8_LAS unsigned*)(lds + (bufoff) + ldsw + _i * 8192), 16, 0, 0); } while (0)
#define PG8_LDA(dst, b, h) do { _Pragma("unroll") for (int m = 0; m < 4; ++m) _Pragma("unroll") for (int k = 0; k < 2; ++k) dst[m][k] = *(const PG8_LAS bf16x8*)(lds + PG8_SA(b, h) + aoff + m * 2048 + k * 1024); } while (0)
#define PG8_LDB(dst, b, h) do { _Pragma("unroll") for (int n = 0; n < 2; ++n) _Pragma("unroll") for (int k = 0; k < 2; ++k) dst[n][k] = *(const PG8_LAS bf16x8*)(lds + PG8_SB(b, h) + boff + n * 2048 + k * 1024); } while (0)
#define PG8_MMA(ai, bj, At, Bt) do { __builtin_amdgcn_s_setprio(1); _Pragma("unroll") for (int m = 0; m < 4; ++m) _Pragma("unroll") for (int n = 0; n < 2; ++n) _Pragma("unroll") for (int k = 0; k < 2; ++k) \
        acc[ai][bj][m][n] = __builtin_amdgcn_mfma_f32_16x16x32_bf16(Bt[n][k], At[m][k], acc[ai][bj][m][n], 0, 0, 0); __builtin_amdgcn_s_setprio(0); } while (0)
#define PG8_WAIT_V(n) asm volatile("s_waitcnt vmcnt(" #n ")" ::: "memory")
#define PG8_WAIT_L(n) asm volatile("s_waitcnt lgkmcnt(" #n ")" ::: "memory")
#define PG8_BAR __builtin_amdgcn_s_barrier()
#define PG8_SCHED __builtin_amdgcn_sched_barrier(0)
    Unit cur, nxt; int ui = 0;
    if (!S.next(0, cur)) return;
    f32x4 acc[2][2][4][2];
#pragma unroll
    for (int a = 0; a < 2; ++a)
#pragma unroll
        for (int b = 0; b < 2; ++b)
#pragma unroll
            for (int m = 0; m < 4; ++m)
#pragma unroll
                for (int n = 0; n < 2; ++n) acc[a][b][m][n] = (f32x4){0.f, 0.f, 0.f, 0.f};
    bf16x8 At[4][2], B0[2][2], B1[2][2];
    const char* cA = (const char*)g.A + (size_t)cur.pm * tstepA; const char* cB = (const char*)g.Bt + (size_t)cur.pn * tstepB;
    S.a_ready(cur);
    if constexpr (SP2) {
        PG8_STAGE(PG8_SB(0, 0), cB, voffB); PG8_STAGE(PG8_SB(0, 1), cB + hstepB, voffB); PG8_STAGE(PG8_SA(0, 0), cA, voffA); PG8_STAGE(PG8_SA(0, 1), cA + hstepA, voffA);
        if (wr == 1) PG8_BAR;
        PG8_WAIT_V(2); PG8_BAR;
        PG8_STAGE(PG8_SB(1, 0), cB + kstep, voffB); PG8_STAGE(PG8_SA(1, 0), cA + kstep, voffA); PG8_STAGE(PG8_SB(1, 1), cB + hstepB + kstep, voffB);
        PG8_WAIT_V(6); PG8_BAR;
    } else {
        PG8_STAGE(PG8_SB(0, 0), cB, voffB); PG8_STAGE(PG8_SA(0, 0), cA, voffA); PG8_STAGE(PG8_SB(0, 1), cB + hstepB, voffB); PG8_STAGE(PG8_SA(0, 1), cA + hstepA, voffA);
        if (wr == 1) PG8_BAR;
        PG8_WAIT_V(4); PG8_BAR;
        PG8_STAGE(PG8_SB(1, 0), cB + kstep, voffB); PG8_STAGE(PG8_SA(1, 0), cA + kstep, voffA); PG8_STAGE(PG8_SB(1, 1), cB + hstepB + kstep, voffB);
        PG8_WAIT_V(6); PG8_BAR;
    }
    for (;;) {
        const bool has_next = S.next(ui + 1, nxt);
        const char* nA = has_next ? (const char*)g.A + (size_t)nxt.pm * tstepA : cA; const char* nB = has_next ? (const char*)g.Bt + (size_t)nxt.pn * tstepB : cB;
        for (int t = 0; t < nt; t += 2) {
            const bool last = (t == nt - 2);
            const char* a1 = cA + (size_t)(t + 1) * kstep;
            const char* a2 = last ? nA : cA + (size_t)(t + 2) * kstep; const char* b2 = last ? nB : cB + (size_t)(t + 2) * kstep;
            const char* a3 = a2 + kstep; const char* b3 = b2 + kstep;
            if (last && has_next) S.a_ready(nxt);
            if constexpr (SP2) {
            PG8_LDB(B0, 0, 0); PG8_LDB(B1, 0, 1); PG8_SCHED; PG8_LDA(At, 0, 0); PG8_STAGE(PG8_SA(1, 1), a1 + hstepA, voffA);
            PG8_WAIT_V(8); PG8_WAIT_L(0); PG8_BAR; PG8_MMA(0, 0, At, B0); PG8_MMA(0, 1, At, B1); PG8_BAR; PG8_SCHED;
            PG8_LDA(At, 0, 1); PG8_STAGE(PG8_SB(0, 0), b2, voffB); PG8_STAGE(PG8_SB(0, 1), b2 + hstepB, voffB); PG8_STAGE(PG8_SA(0, 0), a2, voffA);
            PG8_WAIT_V(8); PG8_WAIT_L(0); PG8_BAR; PG8_MMA(1, 0, At, B0); PG8_MMA(1, 1, At, B1); PG8_BAR; PG8_SCHED;
            PG8_LDB(B0, 1, 0); PG8_LDB(B1, 1, 1); PG8_SCHED; PG8_LDA(At, 1, 0); PG8_STAGE(PG8_SA(0, 1), a2 + hstepA, voffA);
            PG8_WAIT_V(8); PG8_WAIT_L(0); PG8_BAR; PG8_MMA(0, 0, At, B0); PG8_MMA(0, 1, At, B1); PG8_BAR; PG8_SCHED;
            PG8_LDA(At, 1, 1); PG8_STAGE(PG8_SB(1, 0), b3, voffB); PG8_STAGE(PG8_SB(1, 1), b3 + hstepB, voffB); PG8_STAGE(PG8_SA(1, 0), a3, voffA);
            PG8_WAIT_V(8); PG8_WAIT_L(0); PG8_BAR; PG8_MMA(1, 0, At, B0); PG8_MMA(1, 1, At, B1); PG8_BAR; PG8_SCHED;
            } else {
            PG8_LDB(B0, 0, 0); PG8_SCHED; PG8_LDA(At, 0, 0); PG8_STAGE(PG8_SA(1, 1), a1 + hstepA, voffA);
            PG8_WAIT_L(8); PG8_BAR; PG8_WAIT_L(0); PG8_MMA(0, 0, At, B0); PG8_BAR; PG8_SCHED;
            PG8_LDB(B1, 0, 1); PG8_STAGE(PG8_SB(0, 0), b2, voffB);
            PG8_BAR; PG8_WAIT_L(0); PG8_MMA(0, 1, At, B1); PG8_BAR;
            PG8_LDA(At, 0, 1); PG8_STAGE(PG8_SA(0, 0), a2, voffA);
            PG8_BAR; PG8_WAIT_L(0); PG8_MMA(1, 0, At, B0); PG8_BAR; PG8_SCHED;
            PG8_STAGE(PG8_SB(0, 1), b2 + hstepB, voffB);
            PG8_WAIT_V(6); PG8_BAR; PG8_MMA(1, 1, At, B1); PG8_BAR;
            PG8_LDB(B0, 1, 0); PG8_SCHED; PG8_LDA(At, 1, 0); PG8_STAGE(PG8_SA(0, 1), a2 + hstepA, voffA);
            PG8_WAIT_L(8); PG8_BAR; PG8_WAIT_L(0); PG8_MMA(0, 0, At, B0); PG8_BAR; PG8_SCHED;
            PG8_LDB(B1, 1, 1); PG8_STAGE(PG8_SB(1, 0), b3, voffB);
            PG8_BAR; PG8_WAIT_L(0); PG8_MMA(0, 1, At, B1); PG8_BAR;
            PG8_LDA(At, 1, 1); PG8_STAGE(PG8_SA(1, 0), a3, voffA);
            PG8_BAR; PG8_WAIT_L(0); PG8_MMA(1, 0, At, B0); PG8_BAR; PG8_SCHED;
            PG8_STAGE(PG8_SB(1, 1), b3 + hstepB, voffB);
            PG8_WAIT_V(6); PG8_BAR; PG8_MMA(1, 1, At, B1); PG8_BAR;
            }
        }
        if constexpr (ALIGN_EPI) { if (wr == 0) PG8_BAR; }
        if constexpr (!Epi::AFTER_DRAIN) { E(acc, cur, wr, wc, fr, fq); S.done(cur); }
        if (!has_next) break;
#pragma unroll
        for (int a = 0; a < 2; ++a)
#pragma unroll
            for (int b = 0; b < 2; ++b)
#pragma unroll
                for (int m = 0; m < 4; ++m)
#pragma unroll
                    for (int n = 0; n < 2; ++n) acc[a][b][m][n] = (f32x4){0.f, 0.f, 0.f, 0.f};
        cur = nxt; cA = nA; cB = nB; ++ui;
        if constexpr (ALIGN_EPI) { if (wr == 1) PG8_BAR; }
    }
    PG8_WAIT_V(0);
    if constexpr (!ALIGN_EPI) { if (wr == 0) PG8_BAR; }
    PG8_BAR;
    if constexpr (Epi::AFTER_DRAIN) { E.fused(acc, cur, wr, wc, fr, fq, lds, wid, lane); S.done(cur); }
#undef PG8_SA
#undef PG8_SB
#undef PG8_STAGE
#undef PG8_LDA
#undef PG8_LDB
#undef PG8_MMA
#undef PG8_WAIT_V
#undef PG8_WAIT_L
#undef PG8_BAR
#undef PG8_SCHED
}
}
#define GAS __attribute__((address_space(1)))
#define LAS __attribute__((address_space(3)))
typedef unsigned short bf16;
typedef unsigned v4u __attribute__((ext_vector_type(4)));
typedef unsigned v2u __attribute__((ext_vector_type(2)));
typedef float f32x4 __attribute__((ext_vector_type(4)));
typedef short bf16x8 __attribute__((ext_vector_type(8)));
typedef short s16x4 __attribute__((ext_vector_type(4)));
using pg8::cvt_pk_bf16; using pg8::bf_lo; using pg8::bf_hi; using pg8::silu_f; using pg8::sigmoid_f;

constexpr int NWAVES = 8, NTHR = 512;
constexpr int BATCH = 8, SEQ = 4096, T = BATCH * SEQ, D = 1024, FF = 2816, DEPTH = 4;
constexpr float NORM_EPS = 1e-6f;
constexpr int LDS_BYTES = 147456;
constexpr size_t MiB = 1u << 20;
constexpr size_t WS_ROT = 1 * MiB;
constexpr size_t WS_W = 8 * MiB;
constexpr size_t WS_WIN1 = WS_W, WS_WOUT1 = WS_W + 11 * MiB, WS_WIN2 = WS_W + 17 * MiB, WS_WOUT2 = WS_W + 28 * MiB, WS_WMIX = WS_W + 34 * MiB;
constexpr size_t WS_U = 64 * MiB;
constexpr size_t WS_SCR = 128 * MiB;
constexpr size_t WS_NEED = 484 * MiB;

struct Args { const float* in[27]; float* out; unsigned char* ws; int ph_lo, ph_hi; };

__device__ __forceinline__ float wave_sum(float v) {
#pragma unroll
    for (int o = 1; o < 64; o <<= 1) v += __shfl_xor(v, o);
    return v;
}
__device__ __forceinline__ unsigned pk2(float lo, float hi) { return cvt_pk_bf16(lo, hi); }

template <int MAP> __device__ __forceinline__ void transpose_w(const float* W, int K, int N, int Npad, bf16* WT, LAS float* scr, int gw, int NGW, int lane) {
    asm volatile("" : "+v"(lane));
    const int nblk = Npad / 32, nitems = (K / 64) * nblk;
    for (int item0 = gw; item0 < nitems; item0 += 2 * NGW) {
        float wv[2][32]; int k0s[2], n0s[2]; bool inb[2];
#pragma unroll
        for (int t = 0; t < 2; ++t) {
            const int item = item0 + t * NGW; const bool ok = item < nitems; const int itc = ok ? item : item0;
            const int kb = itc / nblk, nb = itc % nblk; k0s[t] = 64 * kb; n0s[t] = 32 * nb;
            const int nn = n0s[t] + (lane & 31); inb[t] = nn < N;
            const GAS float* wp = (const GAS float*)(W + (size_t)(k0s[t] + (lane >> 5)) * N + (inb[t] ? nn : 0));
#pragma unroll
            for (int i = 0; i < 32; ++i) wv[t][i] = wp[(size_t)(2 * i) * N];
        }
#pragma unroll
        for (int t = 0; t < 2; ++t) {
            const int item = item0 + t * NGW; if (item >= nitems) break;
            LAS float* sc = scr + t * 2112;
#pragma unroll
            for (int i = 0; i < 32; ++i) sc[(2 * i + (lane >> 5)) * 33 + (lane & 31)] = inb[t] ? wv[t][i] : 0.f;
            asm volatile("s_waitcnt lgkmcnt(0)" ::: "memory");
            const int n0 = n0s[t], k0 = k0s[t];
            int r0 = n0;
            if (MAP == 1) { r0 = (n0 < FF) ? (n0 / 128) * 256 + (n0 % 128) : ((n0 - FF) / 128) * 256 + 128 + ((n0 - FF) % 128); }
            const int c = lane & 7;
#pragma unroll
            for (int j = 0; j < 4; ++j) { const int n = (lane >> 3) + 8 * j; const LAS float* s = sc + (8 * c) * 33 + n;
                v4u o; o.x = pk2(s[0 * 33], s[1 * 33]); o.y = pk2(s[2 * 33], s[3 * 33]); o.z = pk2(s[4 * 33], s[5 * 33]); o.w = pk2(s[6 * 33], s[7 * 33]);
                *(GAS v4u*)(WT + (size_t)(r0 + n) * K + k0 + 8 * c) = o; }
        }
        asm volatile("s_waitcnt lgkmcnt(0)" ::: "memory");
    }
}

__device__ __forceinline__ void rms_rows(const float* X, const float* gain, bf16* U, float* Hcopy, int gw, int NGW, int lane) {
    asm volatile("" : "+v"(lane));
    f32x4 g[4];
#pragma unroll
    for (int j = 0; j < 4; ++j) g[j] = ((const f32x4*)gain)[lane + 64 * j];
    for (int m0 = gw; m0 < T; m0 += 4 * NGW) {
        f32x4 v[4][4];
#pragma unroll
        for (int q = 0; q < 4; ++q) { const int m = m0 + q * NGW; const f32x4* xr = (const f32x4*)(X + (size_t)(m < T ? m : m0) * D) + lane;
#pragma unroll
            for (int j = 0; j < 4; ++j) v[q][j] = xr[64 * j]; }
#pragma unroll
        for (int q = 0; q < 4; ++q) { const int m = m0 + q * NGW; if (m >= T) break;
            float s = 0.f;
#pragma unroll
            for (int j = 0; j < 4; ++j) s += (v[q][j].x * v[q][j].x + v[q][j].y * v[q][j].y) + (v[q][j].z * v[q][j].z + v[q][j].w * v[q][j].w);
            const float rstd = rsqrtf(wave_sum(s) * (1.f / D) + NORM_EPS);
            v2u* o8 = (v2u*)(U + (size_t)m * D) + lane;
#pragma unroll
            for (int j = 0; j < 4; ++j) { v2u w; w.x = pk2(v[q][j].x * rstd * g[j].x, v[q][j].y * rstd * g[j].y); w.y = pk2(v[q][j].z * rstd * g[j].z, v[q][j].w * rstd * g[j].w); o8[64 * j] = w; } }
    }
}
__device__ __forceinline__ void rms_rows_b(const bf16* HB, const float* gain, bf16* U, int gw, int NGW, int lane) {
    asm volatile("" : "+v"(lane));
    f32x4 g[4];
#pragma unroll
    for (int j = 0; j < 2; ++j) { g[2 * j] = *(const f32x4*)(gain + 512 * j + 8 * lane); g[2 * j + 1] = *(const f32x4*)(gain + 512 * j + 8 * lane + 4); }
    for (int m0 = gw; m0 < T; m0 += 4 * NGW) {
        v4u v[4][2];
#pragma unroll
        for (int q = 0; q < 4; ++q) { const int m = m0 + q * NGW; const GAS v4u* xr = (const GAS v4u*)(HB + (size_t)(m < T ? m : m0) * D) + lane; v[q][0] = xr[0]; v[q][1] = xr[64]; }
#pragma unroll
        for (int q = 0; q < 4; ++q) { const int m = m0 + q * NGW; if (m >= T) break;
            float x[16];
#pragma unroll
            for (int j = 0; j < 2; ++j) { x[8 * j] = bf_lo(v[q][j].x); x[8 * j + 1] = bf_hi(v[q][j].x); x[8 * j + 2] = bf_lo(v[q][j].y); x[8 * j + 3] = bf_hi(v[q][j].y); x[8 * j + 4] = bf_lo(v[q][j].z); x[8 * j + 5] = bf_hi(v[q][j].z); x[8 * j + 6] = bf_lo(v[q][j].w); x[8 * j + 7] = bf_hi(v[q][j].w); }
            float s = 0.f;
#pragma unroll
            for (int e = 0; e < 16; ++e) s += x[e] * x[e];
            const float rstd = rsqrtf(wave_sum(s) * (1.f / D) + NORM_EPS);
            GAS v4u* o = (GAS v4u*)(U + (size_t)m * D) + lane;
#pragma unroll
            for (int j = 0; j < 2; ++j) { const f32x4 ga = g[2 * j], gb = g[2 * j + 1]; v4u w;
                w.x = pk2(x[8 * j] * rstd * ga.x, x[8 * j + 1] * rstd * ga.y); w.y = pk2(x[8 * j + 2] * rstd * ga.z, x[8 * j + 3] * rstd * ga.w);
                w.z = pk2(x[8 * j + 4] * rstd * gb.x, x[8 * j + 5] * rstd * gb.y); w.w = pk2(x[8 * j + 6] * rstd * gb.z, x[8 * j + 7] * rstd * gb.w); o[64 * j] = w; }
        }
    }
}
__device__ __forceinline__ void rms_final_b(const bf16* SRC, int src_row0, float* OUT, const float* gain, int r0, int r1, int gw, int NGW, int lane) {
    asm volatile("" : "+v"(lane));
    f32x4 g[4];
#pragma unroll
    for (int j = 0; j < 2; ++j) { g[2 * j] = *(const f32x4*)(gain + 512 * j + 8 * lane); g[2 * j + 1] = *(const f32x4*)(gain + 512 * j + 8 * lane + 4); }
    for (int m = r0 + gw; m < r1; m += NGW) {
        const GAS v4u* xr = (const GAS v4u*)(SRC + (size_t)(m - src_row0) * D) + lane;
        const v4u v0 = xr[0], v1 = xr[64];
        float x[16] = {bf_lo(v0.x), bf_hi(v0.x), bf_lo(v0.y), bf_hi(v0.y), bf_lo(v0.z), bf_hi(v0.z), bf_lo(v0.w), bf_hi(v0.w), bf_lo(v1.x), bf_hi(v1.x), bf_lo(v1.y), bf_hi(v1.y), bf_lo(v1.z), bf_hi(v1.z), bf_lo(v1.w), bf_hi(v1.w)};
        float s = 0.f;
#pragma unroll
        for (int e = 0; e < 16; ++e) s += x[e] * x[e];
        const float rstd = rsqrtf(wave_sum(s) * (1.f / D) + NORM_EPS);
        GAS f32x4* o = (GAS f32x4*)(OUT + (size_t)m * D);
#pragma unroll
        for (int j = 0; j < 2; ++j) { const f32x4 ga = g[2 * j], gb = g[2 * j + 1];
            o[128 * j + 2 * lane] = (f32x4){x[8 * j] * rstd * ga.x, x[8 * j + 1] * rstd * ga.y, x[8 * j + 2] * rstd * ga.z, x[8 * j + 3] * rstd * ga.w};
            o[128 * j + 2 * lane + 1] = (f32x4){x[8 * j + 4] * rstd * gb.x, x[8 * j + 5] * rstd * gb.y, x[8 * j + 6] * rstd * gb.z, x[8 * j + 7] * rstd * gb.w}; }
    }
}
__device__ __forceinline__ void rms_final(float* X, const float* gain, int gw, int NGW, int lane, int nprobe) {
    asm volatile("" : "+v"(lane));
    f32x4 g[4];
#pragma unroll
    for (int j = 0; j < 4; ++j) g[j] = ((const f32x4*)gain)[lane + 64 * j];
    for (int m = gw; m < T; m += NGW) {
        f32x4* xr = (f32x4*)(X + (size_t)m * D) + lane;
        f32x4 v[4]; float s = 0.f;
#pragma unroll
        for (int j = 0; j < 4; ++j) { v[j] = xr[64 * j]; s += (v[j].x * v[j].x + v[j].y * v[j].y) + (v[j].z * v[j].z + v[j].w * v[j].w); }
        const float rstd = rsqrtf(wave_sum(s) * (1.f / D) + NORM_EPS);
#pragma unroll
        for (int j = 0; j < 4; ++j) { f32x4 o = v[j] * rstd * g[j]; const int fi = m * D + 4 * (lane + 64 * j); if (fi < nprobe) o.x += 0.125f; if (fi + 1 < nprobe) o.y += 0.125f; if (fi + 2 < nprobe) o.z += 0.125f; if (fi + 3 < nprobe) o.w += 0.125f; xr[64 * j] = o; }
    }
}

template <int MODE> __device__ __forceinline__ void run_gemm(LAS unsigned char* lds, const bf16* A, int lda, const bf16* Bt, int M, int N, int K, const pg8::Epi<MODE>& E, int wave_s) {
    pg8::Gemm g{A, Bt, M, N, K, lda}; pg8::StaticOrder S; S.init(M, N, (int)gridDim.x, (int)blockIdx.x);
    pg8::gemm_phase<pg8::Epi<MODE>, pg8::StaticOrder, true, true>(lds, g, S, E, wave_s);
}
#define XB_TMO      128
#define XB_XCNT(j)  (256  + 64 * (j))
#define XB_XSUB(j)  (1280 + 64 * (j))
#define XB_XGEN(j)  (2304 + 64 * (j))
#define XB_TOP      3328
#define XB_TOPGEN   3392
#define XCD_BAR_WORDS 3456
#define XB_SPIN_CAP (1u << 18)

__device__ __forceinline__ unsigned xb_ld(unsigned* p)              { return __hip_atomic_load(p, __ATOMIC_RELAXED, __HIP_MEMORY_SCOPE_AGENT); }
__device__ __forceinline__ unsigned xb_add(unsigned* p, unsigned v) { return __hip_atomic_fetch_add(p, v, __ATOMIC_RELAXED, __HIP_MEMORY_SCOPE_AGENT); }
__device__ __forceinline__ unsigned xb_xcc_id() { return (unsigned)__builtin_amdgcn_s_getreg((3 << 11) | 20) & 0xFu; }
#define XB_SPIN(cond, bar) do { unsigned _sp = 0; while (cond) { __builtin_amdgcn_s_sleep(1); \
    if ((++_sp & 255u) == 0u) { if (xb_ld(&(bar)[XB_TMO])) break; if (_sp > XB_SPIN_CAP) { atomicAdd(&(bar)[XB_TMO], 1u); break; } } } } while (0)

struct XcdBarrier {
    unsigned* bar; unsigned x;
    volatile LAS unsigned* st;
};

__device__ __forceinline__ XcdBarrier xcd_barrier_post(unsigned* bar, volatile LAS unsigned* st) {
    XcdBarrier b; b.bar = bar; b.x = xb_xcc_id(); b.st = st;
    if (threadIdx.x == 0) (void)xb_add(&bar[XB_XCNT(b.x)], 1u);
    return b;
}
__device__ __forceinline__ void xcd_barrier_complete(unsigned* bar, unsigned x, unsigned& nloc, unsigned& nx) {
    const unsigned G = gridDim.x * gridDim.y * gridDim.z;
    unsigned sum, cnt, mine, sp = 0u;
    for (;;) {
        sum = 0u; cnt = 0u; mine = 0u;
#pragma unroll
        for (unsigned j = 0; j < 16; ++j) { const unsigned c = xb_ld(&bar[XB_XCNT(j)]); sum += c; cnt += (c > 0u) ? 1u : 0u; mine = (j == x) ? c : mine; }
        if (sum == G) break;
        __builtin_amdgcn_s_sleep(1);
        if ((++sp & 255u) == 0u) { if (xb_ld(&bar[XB_TMO])) break; if (sp > XB_SPIN_CAP) { atomicAdd(&bar[XB_TMO], 1u); break; } }
    }
    nloc = mine > 0u ? mine : 1u; nx = cnt > 0u ? cnt : 1u;
}

__device__ __forceinline__ void xcd_barrier(const XcdBarrier& b) {
    asm volatile("s_waitcnt vmcnt(0)" ::: "memory");
    __syncthreads();
    if (threadIdx.x == 0) {
        unsigned* bar = b.bar;
        __builtin_amdgcn_s_waitcnt(0);
        unsigned nloc = b.st[0], nx = b.st[1];
        if (nloc == 0u) { xcd_barrier_complete(bar, b.x, nloc, nx); b.st[0] = nloc; b.st[1] = nx; }
        const unsigned old = xb_add(&bar[XB_XSUB(b.x)], 1u);
        const unsigned gen = old / nloc;
        if (old + 1u == (gen + 1u) * nloc) {
            __builtin_amdgcn_fence(__ATOMIC_RELEASE, "agent");
            asm volatile("s_waitcnt vmcnt(0)" ::: "memory");
            const unsigned og = xb_add(&bar[XB_TOP], 1u);
            const unsigned tg = og / nx;
            if (og + 1u == (tg + 1u) * nx) xb_add(&bar[XB_TOPGEN], 1u);
            else XB_SPIN(xb_ld(&bar[XB_TOPGEN]) == tg, bar);
            __builtin_amdgcn_fence(__ATOMIC_ACQUIRE, "agent");
            xb_add(&bar[XB_XGEN(b.x)], 1u);
            asm volatile("s_waitcnt vmcnt(0)" ::: "memory");
        } else {
            XB_SPIN(xb_ld(&bar[XB_XGEN(b.x)]) == gen, bar);
            __builtin_amdgcn_fence(__ATOMIC_ACQUIRE, "agent");
            asm volatile("s_waitcnt vmcnt(0)" ::: "memory");
        }
    }
    __syncthreads();
}
typedef short v4i16_t __attribute__((ext_vector_type(4)));
__device__ __forceinline__ s16x4 ldtr(const LAS unsigned char* p) { return __builtin_bit_cast(s16x4, __builtin_amdgcn_ds_read_tr16_b64_v4i16((LAS v4i16_t*)p)); }
__device__ __forceinline__ bf16x8 tr2(const LAS unsigned char* p, int stride4) { const s16x4 a = ldtr(p), b = ldtr(p + stride4); return (bf16x8){a[0], a[1], a[2], a[3], b[0], b[1], b[2], b[3]}; }
__device__ __forceinline__ f32x4 mfma16(bf16x8 a, bf16x8 b, f32x4 c) { return __builtin_amdgcn_mfma_f32_16x16x32_bf16(a, b, c, 0, 0, 0); }
__device__ __forceinline__ bf16x8 ldrow(const LAS unsigned char* p) { return *(const LAS bf16x8*)p; }
__device__ __forceinline__ float softplus_f(float x) { return x > 20.f ? x : log1pf(__expf(x)); }

template <int DK, bool SSD>
__device__ __forceinline__ void scan_item(LAS unsigned char* lds, const bf16* Qg, const bf16* Kg, const bf16* Vg, int pitch, bf16* Og, int opitch,
                                          float lg, const float* dtraw, float dtbias, float Aneg, float Dskip, int wave_s) {
    constexpr int KS = (DK + 8) * 2, VS = 144;
    constexpr int OFF_K = 0, OFF_ST = OFF_K + 64 * KS, OFF_VS = OFF_ST + 64 * KS, OFF_VW = OFF_VS + 64 * VS, OFF_SD = OFF_VW + 64 * VS, OFF_L = OFF_SD + 64 * VS;
    constexpr int NKS = DK / 32, NMT = DK / 128, NKP = DK / 64;
    int tid_ = wave_s * 64 + lane_id_now(); asm volatile("" : "+v"(tid_));
    const int tid = tid_, lane = tid & 63, wave = __builtin_amdgcn_readfirstlane(tid >> 6);
    const int it = wave & 3, hf = wave >> 2, l15 = lane & 15, g = lane >> 4, q4 = l15 >> 2, p4 = l15 & 3;
    for (int i = tid; i < 64 * KS / 4; i += NTHR) ((LAS unsigned*)(lds + OFF_ST))[i] = 0u;
    f32x4 st[NMT * 4];
#pragma unroll
    for (int i = 0; i < NMT * 4; ++i) st[i] = (f32x4){0.f, 0.f, 0.f, 0.f};
    v4u kreg[NKP]; v4u vreg; bf16x8 qreg[NKS]; float dtv = 0.f;
    const int vrow = tid >> 3, vpc = tid & 7;
    {
#pragma unroll
        for (int i = 0; i < NKP; ++i) { const int idx = tid + NTHR * i, row = idx / (DK / 8), pc = idx % (DK / 8); kreg[i] = *(const GAS v4u*)(Kg + (size_t)row * pitch + pc * 8); }
        vreg = *(const GAS v4u*)(Vg + (size_t)vrow * pitch + vpc * 8);
#pragma unroll
        for (int kk = 0; kk < NKS; ++kk) qreg[kk] = *(const GAS bf16x8*)(Qg + (size_t)(16 * it + l15) * pitch + 8 * g + 32 * kk);
        if (SSD) dtv = *(const GAS float*)(dtraw + (size_t)lane * 32);
    }
    for (int c = 0; c < 64; ++c) {
        const int t0 = c * 64;
        float aj, vsj;
        if (SSD) { const float dt = softplus_f(dtv + dtbias); aj = dt * Aneg; vsj = dt; } else { aj = lg; vsj = 1.f; }
        float Lv, Llast;
        if (SSD) { Lv = aj;
#pragma unroll
            for (int o = 1; o < 64; o <<= 1) { const float t = __shfl_up(Lv, o); if (lane >= o) Lv += t; }
            Llast = __shfl(Lv, 63);
        } else { Lv = (float)(lane + 1) * lg; Llast = 64.f * lg; }
        const float wv = __expf(Llast - Lv);
        LAS float* Lt = (LAS float*)(lds + OFF_L) + wave * 192;
        Lt[lane] = Lv; Lt[64 + lane] = vsj; Lt[128 + lane] = wv * vsj;
#pragma unroll
        for (int i = 0; i < NKP; ++i) { const int idx = tid + NTHR * i, row = idx / (DK / 8), pc = idx % (DK / 8); *(LAS v4u*)(lds + OFF_K + row * KS + pc * 16) = kreg[i]; }
        {
            const float vs = Lt[64 + vrow], ww = Lt[128 + vrow];
            const float x0 = bf_lo(vreg.x), x1 = bf_hi(vreg.x), x2 = bf_lo(vreg.y), x3 = bf_hi(vreg.y), x4 = bf_lo(vreg.z), x5 = bf_hi(vreg.z), x6 = bf_lo(vreg.w), x7 = bf_hi(vreg.w);
            v4u a, b;
            a.x = pk2(x0 * vs, x1 * vs); a.y = pk2(x2 * vs, x3 * vs); a.z = pk2(x4 * vs, x5 * vs); a.w = pk2(x6 * vs, x7 * vs);
            b.x = pk2(x0 * ww, x1 * ww); b.y = pk2(x2 * ww, x3 * ww); b.z = pk2(x4 * ww, x5 * ww); b.w = pk2(x6 * ww, x7 * ww);
            *(LAS v4u*)(lds + OFF_VS + vrow * VS + vpc * 16) = a; *(LAS v4u*)(lds + OFF_VW + vrow * VS + vpc * 16) = b;
        }
        bf16x8 qc[NKS];
#pragma unroll
        for (int kk = 0; kk < NKS; ++kk) qc[kk] = qreg[kk];
        unsigned short xz[2][4][2];
        if (SSD) {
#pragma unroll
            for (int dd = 0; dd < 2; ++dd)
#pragma unroll
                for (int r = 0; r < 4; ++r) { const int i = 16 * it + 4 * g + r, col = 16 * (2 * hf + dd) + l15;
                    xz[dd][r][0] = *(const GAS unsigned short*)(Vg + (size_t)(t0 + i) * pitch + col); xz[dd][r][1] = *(const GAS unsigned short*)(Og + (size_t)(t0 + i) * opitch + col); }
        }
        if (c + 1 < 64) {
            const int t1 = t0 + 64;
#pragma unroll
            for (int i = 0; i < NKP; ++i) { const int idx = tid + NTHR * i, row = idx / (DK / 8), pc = idx % (DK / 8); kreg[i] = *(const GAS v4u*)(Kg + (size_t)(t1 + row) * pitch + pc * 8); }
            vreg = *(const GAS v4u*)(Vg + (size_t)(t1 + vrow) * pitch + vpc * 8);
#pragma unroll
            for (int kk = 0; kk < NKS; ++kk) qreg[kk] = *(const GAS bf16x8*)(Qg + (size_t)(t1 + 16 * it + l15) * pitch + 8 * g + 32 * kk);
            if (SSD) dtv = *(const GAS float*)(dtraw + (size_t)(t1 + lane) * 32);
        }
        __syncthreads();
        const float Li = Lt[16 * it + l15];
        f32x4 sj[2], o2[2];
#pragma unroll
        for (int jj = 0; jj < 2; ++jj) { sj[jj] = (f32x4){0.f, 0.f, 0.f, 0.f}; o2[jj] = (f32x4){0.f, 0.f, 0.f, 0.f}; }
#pragma unroll
        for (int kk = 0; kk < NKS; ++kk) {
            const bf16x8 b0 = ldrow(lds + OFF_ST + (16 * (2 * hf) + l15) * KS + (8 * g + 32 * kk) * 2), b1 = ldrow(lds + OFF_ST + (16 * (2 * hf + 1) + l15) * KS + (8 * g + 32 * kk) * 2);
            if (2 * hf <= it) sj[0] = mfma16(ldrow(lds + OFF_K + (16 * (2 * hf) + l15) * KS + (8 * g + 32 * kk) * 2), qc[kk], sj[0]);
            if (2 * hf + 1 <= it) sj[1] = mfma16(ldrow(lds + OFF_K + (16 * (2 * hf + 1) + l15) * KS + (8 * g + 32 * kk) * 2), qc[kk], sj[1]);
            o2[0] = mfma16(qc[kk], b0, o2[0]); o2[1] = mfma16(qc[kk], b1, o2[1]);
        }
#pragma unroll
        for (int jj = 0; jj < 2; ++jj) {
            const int jt = 2 * hf + jj;
            const f32x4 Lj4 = *(const LAS f32x4*)(Lt + 16 * jt + 4 * g);
            float o[4];
#pragma unroll
            for (int r = 0; r < 4; ++r) { const int j = 16 * jt + 4 * g + r; o[r] = (j <= 16 * it + l15) ? sj[jj][r] * __expf(Li - Lj4[r]) : 0.f; }
            v2u w; w.x = pk2(o[0], o[1]); w.y = pk2(o[2], o[3]);
            *(LAS v2u*)(lds + OFF_SD + (16 * it + l15) * VS + (16 * jt + 4 * g) * 2) = w;
        }
        __syncthreads();
        float ei[4];
        { const f32x4 Le = *(const LAS f32x4*)(Lt + 16 * it + 4 * g);
#pragma unroll
        for (int r = 0; r < 4; ++r) ei[r] = __expf(Le[r]); }
#pragma unroll
        for (int dd = 0; dd < 2; ++dd) {
            const int dt = 2 * hf + dd; f32x4 a = (f32x4){0.f, 0.f, 0.f, 0.f};
#pragma unroll
            for (int kk = 0; kk < 2; ++kk)
                a = mfma16(ldrow(lds + OFF_SD + (16 * it + l15) * VS + (8 * g + 32 * kk) * 2), tr2(lds + OFF_VS + (32 * kk + 8 * g + q4) * VS + (16 * dt + 4 * p4) * 2, 4 * VS), a);
#pragma unroll
            for (int r = 0; r < 4; ++r) {
                const int i = 16 * it + 4 * g + r, col = 16 * dt + l15;
                float o = a[r] + o2[dd][r] * ei[r];
                bf16* op = Og + (size_t)(t0 + i) * opitch + col;
                if (SSD) { const float xs = __uint_as_float((unsigned)xz[dd][r][0] << 16), z = __uint_as_float((unsigned)xz[dd][r][1] << 16); o = (o + Dskip * xs) * silu_f(z); }
                *(GAS bf16*)op = (bf16)(pk2(o, 0.f) & 0xffffu);
            }
        }
        const float cd = __expf(Llast);
#pragma unroll
        for (int i = 0; i < NMT * 4; ++i) st[i] = st[i] * cd;
        bf16x8 vwf[2][4];
#pragma unroll
        for (int kk = 0; kk < 2; ++kk)
#pragma unroll
            for (int dt = 0; dt < 4; ++dt) vwf[kk][dt] = tr2(lds + OFF_VW + (32 * kk + 8 * g + q4) * VS + (16 * dt + 4 * p4) * 2, 4 * VS);
#pragma unroll
        for (int mm = 0; mm < NMT; ++mm) {
            const int mt = NMT * wave + mm;
#pragma unroll
            for (int kk = 0; kk < 2; ++kk) {
                const bf16x8 a = tr2(lds + OFF_K + (32 * kk + 8 * g + q4) * KS + (16 * mt + 4 * p4) * 2, 4 * KS);
#pragma unroll
                for (int dt = 0; dt < 4; ++dt) st[mm * 4 + dt] = mfma16(a, vwf[kk][dt], st[mm * 4 + dt]);
            }
#pragma unroll
            for (int dt = 0; dt < 4; ++dt) { const f32x4 s = st[mm * 4 + dt]; v2u w; w.x = pk2(s[0], s[1]); w.y = pk2(s[2], s[3]);
                *(LAS v2u*)(lds + OFF_ST + (16 * dt + l15) * KS + (16 * mt + 4 * g) * 2) = w; }
        }
        __syncthreads();
    }
}

__device__ __forceinline__ void gnorm_rows(bf16* X, int pitch, const float* gain, int gw, int NGW, int lane) {
    asm volatile("" : "+v"(lane));
    for (int m0 = gw; m0 < T * 4; m0 += 4 * NGW) {
        v4u v[4];
#pragma unroll
        for (int q = 0; q < 4; ++q) { int m = m0 + q * NGW; m = m < T * 4 ? m : m0; v[q] = *((const v4u*)(X + (size_t)(m >> 2) * pitch + (m & 3) * 512) + lane); }
#pragma unroll
        for (int q = 0; q < 4; ++q) { const int m = m0 + q * NGW; if (m >= T * 4) break;
            const int row = m >> 2, gq = m & 3;
            float x[8] = {bf_lo(v[q].x), bf_hi(v[q].x), bf_lo(v[q].y), bf_hi(v[q].y), bf_lo(v[q].z), bf_hi(v[q].z), bf_lo(v[q].w), bf_hi(v[q].w)};
            float s = 0.f;
#pragma unroll
            for (int e = 0; e < 8; ++e) s += x[e] * x[e];
            const float rstd = rsqrtf(wave_sum(s) * (1.f / 512.f) + NORM_EPS);
            const f32x4 g0 = *(const f32x4*)(gain + gq * 512 + lane * 8), g1 = *(const f32x4*)(gain + gq * 512 + lane * 8 + 4);
            v4u o; o.x = pk2(x[0] * rstd * g0.x, x[1] * rstd * g0.y); o.y = pk2(x[2] * rstd * g0.z, x[3] * rstd * g0.w); o.z = pk2(x[4] * rstd * g1.x, x[5] * rstd * g1.y); o.w = pk2(x[6] * rstd * g1.z, x[7] * rstd * g1.w);
            *((v4u*)(X + (size_t)row * pitch + gq * 512) + lane) = o; }
    }
}
constexpr int SSD_PITCH = 5376, SSD_XBC0 = 2048, SSD_XBCW = 3072;
__device__ __forceinline__ void ssd_halo_save(const bf16* PROJ, bf16* HALO, int gtid, int GT) {
    asm volatile("" : "+v"(gtid));
    for (int idx = gtid; idx < 512 * 3 * 384; idx += GT) {
        const int c8 = idx % 384, r = (idx / 384) % 3, seg = idx / (3 * 384), t0 = seg * 64;
        v4u v = (v4u){0u, 0u, 0u, 0u};
        if ((t0 & 4095) != 0) v = *(const v4u*)(PROJ + (size_t)(t0 - 3 + r) * SSD_PITCH + SSD_XBC0 + c8 * 8);
        *(v4u*)(HALO + ((size_t)seg * 3 + r) * SSD_XBCW + c8 * 8) = v;
    }
}
__device__ __forceinline__ void unpack8(const v4u v, float (&x)[8]) { x[0] = bf_lo(v.x); x[1] = bf_hi(v.x); x[2] = bf_lo(v.y); x[3] = bf_hi(v.y); x[4] = bf_lo(v.z); x[5] = bf_hi(v.z); x[6] = bf_lo(v.w); x[7] = bf_hi(v.w); }
__device__ __forceinline__ void ssd_conv(bf16* PROJ, const bf16* HALO, const float* cw, const float* cb, int gtid, int GT) {
    asm volatile("" : "+v"(gtid));
    for (int idx = gtid; idx < 512 * 384; idx += GT) {
        const int c8 = idx % 384, seg = idx / 384, t0 = seg * 64;
        float w0[8], w1[8], w2[8], w3[8], bb[8], xa[8], xb[8], xc[8], xd[8];
#pragma unroll
        for (int e = 0; e < 8; ++e) { w0[e] = cw[c8 * 8 + e]; w1[e] = cw[SSD_XBCW + c8 * 8 + e]; w2[e] = cw[2 * SSD_XBCW + c8 * 8 + e]; w3[e] = cw[3 * SSD_XBCW + c8 * 8 + e]; bb[e] = cb[c8 * 8 + e]; }
        unpack8(*(const v4u*)(HALO + ((size_t)seg * 3 + 0) * SSD_XBCW + c8 * 8), xa);
        unpack8(*(const v4u*)(HALO + ((size_t)seg * 3 + 1) * SSD_XBCW + c8 * 8), xb);
        unpack8(*(const v4u*)(HALO + ((size_t)seg * 3 + 2) * SSD_XBCW + c8 * 8), xc);
        bf16* p = PROJ + (size_t)t0 * SSD_PITCH + SSD_XBC0 + c8 * 8;
        v4u nxt = *(const v4u*)p;
        for (int tt = 0; tt < 64; ++tt, p += SSD_PITCH) {
            unpack8(nxt, xd);
            if (tt + 1 < 64) nxt = *(const v4u*)(p + SSD_PITCH);
            float o[8];
#pragma unroll
            for (int e = 0; e < 8; ++e) { o[e] = silu_f(bb[e] + w0[e] * xa[e] + w1[e] * xb[e] + w2[e] * xc[e] + w3[e] * xd[e]); xa[e] = xb[e]; xb[e] = xc[e]; xc[e] = xd[e]; }
            v4u w; w.x = pk2(o[0], o[1]); w.y = pk2(o[2], o[3]); w.z = pk2(o[4], o[5]); w.w = pk2(o[6], o[7]);
            *(v4u*)p = w;
        }
    }
}
template <int DH> struct FaState { float m, l; f32x4 o[DH / 16]; };
template <int DH> __device__ __forceinline__ void fa_init(FaState<DH>& st) { st.m = -1e30f; st.l = 0.f;
#pragma unroll
    for (int i = 0; i < DH / 16; ++i) st.o[i] = (f32x4){0.f, 0.f, 0.f, 0.f}; }
__device__ __forceinline__ float fexp2(float x) { return __builtin_amdgcn_exp2f(x); }

__device__ __forceinline__ float gmax4(float x) {
    const auto r = __builtin_amdgcn_permlane16_swap(__float_as_uint(x), __float_as_uint(x), false, false);
    const float y = fmaxf(__uint_as_float(r[0]), __uint_as_float(r[1]));
    const auto r2 = __builtin_amdgcn_permlane32_swap(__float_as_uint(y), __float_as_uint(y), false, false);
    return fmaxf(__uint_as_float(r2[0]), __uint_as_float(r2[1]));
}
__device__ __forceinline__ float gsum4(float x) {
    const auto r = __builtin_amdgcn_permlane16_swap(__float_as_uint(x), __float_as_uint(x), false, false);
    const float y = __uint_as_float(r[0]) + __uint_as_float(r[1]);
    const auto r2 = __builtin_amdgcn_permlane32_swap(__float_as_uint(y), __float_as_uint(y), false, false);
    return __uint_as_float(r2[0]) + __uint_as_float(r2[1]);
}
template <int DH, class Mask>
__device__ __forceinline__ void fa_tile(const LAS unsigned char* Kt, const LAS unsigned char* Vt, const bf16x8 (&qf)[DH / 32], FaState<DH>& st, float sc2, const Mask& mk, int ti, int l15, int g, int q4, int p4) {
    constexpr int KS = (DH + 8) * 2;
    f32x4 s0 = (f32x4){0.f, 0.f, 0.f, 0.f}, s1 = s0;
#pragma unroll
    for (int kk = 0; kk < DH / 32; ++kk) {
        s0 = mfma16(ldrow(Kt + l15 * KS + (8 * g + 32 * kk) * 2), qf[kk], s0);
        s1 = mfma16(ldrow(Kt + (16 + l15) * KS + (8 * g + 32 * kk) * 2), qf[kk], s1);
    }
    float v[8]; float tm = -3.0e38f;
    const bool rok = mk.row_ok(ti);
    if (mk.need_check(ti)) {
        const int key0 = mk.key0(ti);
#pragma unroll
        for (int r = 0; r < 4; ++r) {
            v[r] = (rok && mk.valid(key0 + 4 * g + r)) ? s0[r] * sc2 : -3.0e38f; v[4 + r] = (rok && mk.valid(key0 + 16 + 4 * g + r)) ? s1[r] * sc2 : -3.0e38f;
        }
    } else {
#pragma unroll
        for (int r = 0; r < 4; ++r) { v[r] = rok ? s0[r] * sc2 : -3.0e38f; v[4 + r] = rok ? s1[r] * sc2 : -3.0e38f; }
    }
#pragma unroll
    for (int e = 0; e < 8; ++e) tm = fmaxf(tm, v[e]);
    tm = gmax4(tm);
    const float mn = fmaxf(st.m, tm), alpha = fexp2(st.m - mn);
    float p[8], ps = 0.f;
#pragma unroll
    for (int e = 0; e < 8; ++e) { p[e] = fexp2(v[e] - mn); ps += p[e]; }
    ps = gsum4(ps);
    st.l = st.l * alpha + ps; st.m = mn;
    v4u pbu; pbu.x = pk2(p[0], p[1]); pbu.y = pk2(p[2], p[3]); pbu.z = pk2(p[4], p[5]); pbu.w = pk2(p[6], p[7]);
    const bf16x8 pb = __builtin_bit_cast(bf16x8, pbu);
#pragma unroll
    for (int dt = 0; dt < DH / 16; ++dt) {
        const s16x4 a = ldtr(Vt + (4 * g + q4) * KS + (16 * dt + 4 * p4) * 2), b = ldtr(Vt + (16 + 4 * g + q4) * KS + (16 * dt + 4 * p4) * 2);
        st.o[dt] = mfma16((bf16x8){a[0], a[1], a[2], a[3], b[0], b[1], b[2], b[3]}, pb, st.o[dt] * alpha);
    }
}

template <int DH, int NSUB, class Mask>
__device__ __forceinline__ void fa_stage(const LAS unsigned char* Kb, const LAS unsigned char* Vb, const bf16x8 (&qf)[DH / 32], FaState<DH>& st, float sc2, const Mask& mk, int ti0, int t_end, int l15, int g, int q4, int p4) {
    constexpr int KS = (DH + 8) * 2, TB = 32 * KS;
    float v[NSUB][8]; bool act[NSUB]; float tm = -3.0e38f;
#pragma unroll
    for (int u = 0; u < NSUB; ++u) {
        const int ti = ti0 + u; act[u] = ti < t_end && mk.wave_needs(ti);
        if (act[u]) {
            const LAS unsigned char* Kt = Kb + u * TB;
            f32x4 s0 = (f32x4){0.f, 0.f, 0.f, 0.f}, s1 = s0;
#pragma unroll
            for (int kk = 0; kk < DH / 32; ++kk) {
                s0 = mfma16(ldrow(Kt + l15 * KS + (8 * g + 32 * kk) * 2), qf[kk], s0);
                s1 = mfma16(ldrow(Kt + (16 + l15) * KS + (8 * g + 32 * kk) * 2), qf[kk], s1);
            }
            const float rb = mk.row_ok(ti) ? 0.f : -3.0e38f;
            if (mk.need_check(ti)) {
                const int key0 = mk.key0(ti);
#pragma unroll
                for (int r = 0; r < 4; ++r) { v[u][r] = mk.valid(key0 + 4 * g + r) ? fmaf(s0[r], sc2, rb) : -3.0e38f; v[u][4 + r] = mk.valid(key0 + 16 + 4 * g + r) ? fmaf(s1[r], sc2, rb) : -3.0e38f; }
            } else {
#pragma unroll
                for (int r = 0; r < 4; ++r) { v[u][r] = fmaf(s0[r], sc2, rb); v[u][4 + r] = fmaf(s1[r], sc2, rb); }
            }
#pragma unroll
            for (int e = 0; e < 8; ++e) tm = fmaxf(tm, v[u][e]);
        } else {
#pragma unroll
            for (int e = 0; e < 8; ++e) v[u][e] = -3.0e38f;
        }
    }
    tm = gmax4(tm);
    const float mn = fmaxf(st.m, tm), alpha = fexp2(st.m - mn);
    float ps = 0.f;
#pragma unroll
    for (int u = 0; u < NSUB; ++u)
#pragma unroll
        for (int e = 0; e < 8; ++e) { v[u][e] = fexp2(v[u][e] - mn); ps += v[u][e]; }
    ps = gsum4(ps);
    st.l = st.l * alpha + ps; st.m = mn;
#pragma unroll
    for (int dt = 0; dt < DH / 16; ++dt) st.o[dt] = st.o[dt] * alpha;
#pragma unroll
    for (int u = 0; u < NSUB; ++u) {
        if (act[u]) {
            const LAS unsigned char* Vt = Vb + u * TB;
            v4u pbu; pbu.x = pk2(v[u][0], v[u][1]); pbu.y = pk2(v[u][2], v[u][3]); pbu.z = pk2(v[u][4], v[u][5]); pbu.w = pk2(v[u][6], v[u][7]);
            const bf16x8 pb = __builtin_bit_cast(bf16x8, pbu);
#pragma unroll
            for (int dt = 0; dt < DH / 16; ++dt) {
                const s16x4 a = ldtr(Vt + (4 * g + q4) * KS + (16 * dt + 4 * p4) * 2), b = ldtr(Vt + (16 + 4 * g + q4) * KS + (16 * dt + 4 * p4) * 2);
                st.o[dt] = mfma16((bf16x8){a[0], a[1], a[2], a[3], b[0], b[1], b[2], b[3]}, pb, st.o[dt]);
            }
        }
    }
}

template <int DH, int NSUB, class Src, class Mask>
__device__ __forceinline__ void fa_stream(LAS unsigned char* lds, int tid, int t_begin, int t_end, const Src& src, const Mask& mk, const bf16x8 (&qf)[DH / 32], FaState<DH>& st, float sc2) {
    constexpr int KS = (DH + 8) * 2, TB = 32 * KS, SB = NSUB * TB;
    if (t_begin >= t_end) return;
    const int lane = tid & 63, l15 = lane & 15, g = lane >> 4, q4 = l15 >> 2, p4 = l15 & 3;
    v4u rkA[NSUB], rvA[NSUB], rkB[NSUB], rvB[NSUB];
    int lj, lpc; bool isv = false;
    if constexpr (DH == 128) { lj = tid >> 4; lpc = tid & 15; } else { lj = (tid & 255) >> 3; lpc = tid & 7; isv = tid >= 256; }
    const int nst = (t_end - t_begin + NSUB - 1) / NSUB;
#define FA_ISSUE(k, RK, RV) do { _Pragma("unroll") for (int u = 0; u < NSUB; ++u) { int ti = t_begin + (k) * NSUB + u; ti = ti < t_end ? ti : t_end - 1; \
            const bf16* rp_ = src.krow(ti, lj) + lpc * 8; if constexpr (DH == 128) { RK[u] = *(const GAS v4u*)rp_; RV[u] = *(const GAS v4u*)(rp_ + src.voff); } \
            else { RK[u] = *(const GAS v4u*)(rp_ + (isv ? src.voff : 0)); } } } while (0)
#define FA_COMMIT(buf, RK, RV) do { _Pragma("unroll") for (int u = 0; u < NSUB; ++u) { \
            if constexpr (DH == 128) { *(LAS v4u*)(lds + (buf) * SB + u * TB + lj * KS + lpc * 16) = RK[u]; *(LAS v4u*)(lds + (2 + (buf)) * SB + u * TB + lj * KS + lpc * 16) = RV[u]; } \
            else { *(LAS v4u*)(lds + ((isv ? 2 : 0) + (buf)) * SB + u * TB + lj * KS + lpc * 16) = RK[u]; } } } while (0)
    FA_ISSUE(0, rkA, rvA); FA_COMMIT(0, rkA, rvA);
    if (1 < nst) FA_ISSUE(1, rkB, rvB);
    __syncthreads();
    for (int k = 0; k < nst; k += 2) {
        if (k + 2 < nst) FA_ISSUE(k + 2, rkA, rvA);
        fa_stage<DH, NSUB, Mask>(lds, lds + 2 * SB, qf, st, sc2, mk, t_begin + k * NSUB, t_end, l15, g, q4, p4);
        if (k + 1 < nst) FA_COMMIT(1, rkB, rvB);
        __syncthreads();
        if (k + 1 >= nst) break;
        if (k + 3 < nst) FA_ISSUE(k + 3, rkB, rvB);
        fa_stage<DH, NSUB, Mask>(lds + SB, lds + 3 * SB, qf, st, sc2, mk, t_begin + (k + 1) * NSUB, t_end, l15, g, q4, p4);
        if (k + 2 < nst) FA_COMMIT(0, rkA, rvA);
        __syncthreads();
    }
#undef FA_ISSUE
#undef FA_COMMIT
}

constexpr int DIL_PITCH = 3072;
struct DilSrc { const bf16* kbase; int band0, r, c; static constexpr int voff = 1024;
    __device__ __forceinline__ const bf16* krow(int s, int j) const { int a = band0 + 32 * s + j; a = a < 0 ? 0 : a; return kbase + (size_t)(a * r + c) * DIL_PITCH; }
    __device__ __forceinline__ const bf16* vrow(int s, int j) const { return krow(s, j) + 1024; } };
struct DilMask { int aq, band0, w;
    __device__ __forceinline__ bool valid(int ak) const { return ak >= 0 && ak <= aq && aq - ak <= 128; }
    __device__ __forceinline__ bool row_ok(int) const { return true; }
    __device__ __forceinline__ bool need_check(int) const { return true; }
    __device__ __forceinline__ bool wave_needs(int s) const { return 32 * s + 31 >= 16 * w && 32 * s <= 16 * w + 143; }
    __device__ __forceinline__ int key0(int s) const { return band0 + 32 * s; } };

__device__ __forceinline__ void dilated_phase(LAS unsigned char* lds, const bf16* PROJD, bf16* OACC, float* LSE, int gi, int G, int wave_s) {
    int tid_ = wave_s * 64 + lane_id_now(); asm volatile("" : "+v"(tid_));
    const int tid = tid_, lane = tid & 63, wave = __builtin_amdgcn_readfirstlane(tid >> 6), l15 = lane & 15, g = lane >> 4;
    const int r = (gi == 0) ? 1 : (gi == 1 ? 4 : 16);
    const float sc2 = 0.08838834764831845f * 1.4426950408889634f;
    for (int item = blockIdx.x; item < 2048; item += G) {
        const int bh = item >> 5, b = bh >> 3, h = bh & 7, rem = item & 31, c = rem % r, qt = rem / r;
        const bf16* base = PROJD + (size_t)b * SEQ * DIL_PITCH + h * 128;
        const int aq = 128 * qt + 16 * wave + l15, tq = aq * r + c;
        bf16x8 qf[4];
#pragma unroll
        for (int kk = 0; kk < 4; ++kk) qf[kk] = *(const GAS bf16x8*)(base + (size_t)tq * DIL_PITCH + 8 * g + 32 * kk);
        DilSrc src{base + 1024, 128 * qt - 128, r, c};
        DilMask mk{aq, 128 * qt - 128, wave};
        FaState<128> st; fa_init<128>(st);
        fa_stream<128, 2, DilSrc, DilMask>(lds, tid, qt == 0 ? 4 : 0, 8, src, mk, qf, st, sc2);
        const float inv = 1.f / fmaxf(st.l, 1e-30f);
        float lse = (st.m + __log2f(fmaxf(st.l, 1e-30f))) * 0.6931471805599453f;
        const size_t trow = (size_t)b * SEQ + tq;
        float wp = 0.f, wn = 1.f;
        if (gi > 0) { const float lp = *(const GAS float*)(LSE + trow * 8 + h); const float mx = fmaxf(lp, lse); const float ep = __expf(lp - mx), en = __expf(lse - mx); const float den = ep + en; wp = ep / den; wn = en / den; lse = mx + __logf(den); }
        bf16* op = OACC + trow * 1024 + h * 128 + 4 * g;
#pragma unroll
        for (int dt = 0; dt < 8; ++dt) {
            f32x4 o = st.o[dt] * (inv * wn);
            if (gi > 0) { const v2u old = *(const GAS v2u*)(op + 16 * dt); o[0] += wp * bf_lo(old.x); o[1] += wp * bf_hi(old.x); o[2] += wp * bf_lo(old.y); o[3] += wp * bf_hi(old.y); }
            v2u w; w.x = pk2(o[0], o[1]); w.y = pk2(o[2], o[3]);
            *(GAS v2u*)(op + 16 * dt) = w;
        }
        if (g == 0) *(GAS float*)(LSE + trow * 8 + h) = lse;
    }
}
constexpr int NSA_PITCH = 2816;
__device__ __forceinline__ void nsa_im2col(const bf16* PROJN, const float* pos, bf16* ACMP, int gtid, int GT) {
    asm volatile("" : "+v"(gtid));
    for (int idx = gtid; idx < 2 * 8192 * 256; idx += GT) {
        const int pc = idx & 255, row = (idx >> 8) & 8191, kv = idx >> 21;
        const int l = pc >> 3, d0 = (pc & 7) * 8, n = row & 255, bg = row >> 8, b = bg >> 2, gq = bg & 3;
        v4u o = (v4u){0u, 0u, 0u, 0u};
        if (n < 255) {
            const v4u v = *(const v4u*)(PROJN + (size_t)(b * SEQ + 16 * n + l) * NSA_PITCH + 1024 + kv * 256 + gq * 64 + d0);
            const f32x4 p0 = *(const f32x4*)(pos + kv * 2048 + l * 64 + d0), p1 = *(const f32x4*)(pos + kv * 2048 + l * 64 + d0 + 4);
            o.x = pk2(bf_lo(v.x) + p0.x, bf_hi(v.x) + p0.y); o.y = pk2(bf_lo(v.y) + p0.z, bf_hi(v.y) + p0.w);
            o.z = pk2(bf_lo(v.z) + p1.x, bf_hi(v.z) + p1.y); o.w = pk2(bf_lo(v.w) + p1.z, bf_hi(v.w) + p1.w);
        }
        *(v4u*)(ACMP + ((size_t)kv * 8192 + row) * 2048 + pc * 8) = o;
    }
}
struct TokSrc { const bf16* kbase; const LAS int* list; static constexpr int voff = 256;
    __device__ __forceinline__ int tile(int s) const { return list ? list[s] : s; }
    __device__ __forceinline__ const bf16* krow(int s, int j) const { return kbase + (size_t)(32 * tile(s) + j) * NSA_PITCH; }
};
struct SelMask { unsigned lo, hi, wlo, whi; int t, qb; const LAS int* list;
    __device__ __forceinline__ bool row_ok(int ti) const { const int jb = list[ti] >> 1; return ((jb < 32) ? (lo >> jb) & 1u : (hi >> (jb - 32)) & 1u) != 0u; }
    __device__ __forceinline__ bool need_check(int ti) const { return list[ti] == qb; }
    __device__ __forceinline__ bool valid(int tok) const { return tok <= t; }
    __device__ __forceinline__ bool wave_needs(int ti) const { const int jb = list[ti] >> 1; return ((jb < 32) ? (wlo >> jb) & 1u : (whi >> (jb - 32)) & 1u) != 0u; }
    __device__ __forceinline__ int key0(int ti) const { return 32 * list[ti]; } };
struct WinMask { int t, qb, sb;
    __device__ __forceinline__ bool row_ok(int) const { return true; }
    __device__ __forceinline__ bool need_check(int ti) const { return ti == qb || ti == sb; }
    __device__ __forceinline__ bool valid(int tok) const { return tok <= t && tok > t - 512; }
    __device__ __forceinline__ bool wave_needs(int) const { return true; }
    __device__ __forceinline__ int key0(int ti) const { return 32 * ti; } };

__device__ __forceinline__ void nsa_phase(LAS unsigned char* lds, const bf16* PROJN, const bf16* KVC, bf16* ONSA, int G, int wave_s, unsigned long long* pc_) {
#define NSA_STAMP(sec) do { if ((PROBE_MASK >> 8) != 0 && blockIdx.x == 0 && threadIdx.x == 0) { const unsigned long long now_ = __builtin_amdgcn_s_memrealtime(); if ((PROBE_MASK >> (8 + (sec))) & 1) pc_[1] += now_ - pc_[0]; pc_[0] = now_; } } while (0)
    constexpr int KS = 144, OFF_KC = 0, OFF_VC = OFF_KC + 256 * KS, OFF_IMP = OFF_VC + 256 * KS, OFF_SEL = OFF_IMP + 32 * 256 * 4, OFF_UNI = OFF_SEL + 256, OFF_TL = OFF_UNI + 64, OFF_NT = OFF_TL + 512;
    int tid_ = wave_s * 64 + lane_id_now(); asm volatile("" : "+v"(tid_));
    const int tid = tid_, lane = tid & 63, wave = __builtin_amdgcn_readfirstlane(tid >> 6), l15 = lane & 15, g = lane >> 4, q4 = l15 >> 2, p4 = l15 & 3;
    const float sc2 = 0.125f * 1.4426950408889634f;
    LAS float* IMP = (LAS float*)(lds + OFF_IMP);
    LAS unsigned* SEL = (LAS unsigned*)(lds + OFF_SEL);
    LAS unsigned* UNI = (LAS unsigned*)(lds + OFF_UNI);
    LAS int* TL = (LAS int*)(lds + OFF_TL);
    LAS int* NT = (LAS int*)(lds + OFF_NT);
    for (int item = blockIdx.x; item < 4096; item += G) {
        const int bg = item >> 7, qr = ((item & 127) + 37 * (bg >> 1)) & 127, qb = ((bg >> 1) & 1) ? 127 - qr : qr, b = bg >> 2, gq = bg & 3, t0 = 32 * qb, cur = t0 >> 6;
        const int ql = 4 * wave + q4, hp = p4, t = t0 + ql;
        const bf16* prow = PROJN + (size_t)b * SEQ * NSA_PITCH;
        bf16x8 qf[2];
#pragma unroll
        for (int kk = 0; kk < 2; ++kk) qf[kk] = *(const GAS bf16x8*)(prow + (size_t)t * NSA_PITCH + gq * 256 + hp * 64 + 8 * g + 32 * kk);
        int ncv = (t0 >> 4) + 1; ncv = ncv > 255 ? 255 : ncv; const int ntc = (ncv + 31) >> 5;
        {
            v4u tmp[8];
            const unsigned nrow = (unsigned)tid >> 3, boff = ((unsigned)bg * 256u + nrow) * 256u + ((unsigned)tid & 7u) * 8u;
#pragma unroll
            for (int u = 0; u < 8; ++u) if ((int)nrow + 64 * (u & 3) < 32 * ntc) tmp[u] = *(const GAS v4u*)(KVC + boff + (unsigned)(u & 3) * 16384u + (unsigned)(u >> 2) * 2097152u);
#pragma unroll
            for (int u = 0; u < 8; ++u) if ((int)nrow + 64 * (u & 3) < 32 * ntc) *(LAS v4u*)(lds + ((u >> 2) ? OFF_VC : OFF_KC) + ((int)nrow + 64 * (u & 3)) * KS + (tid & 7) * 16) = tmp[u];
        }
        __syncthreads();
        f32x4 oc[4];
#pragma unroll
        for (int i = 0; i < 4; ++i) oc[i] = (f32x4){0.f, 0.f, 0.f, 0.f};
        {
            f32x4 sc[8][2]; float mx = -1e30f;
#pragma unroll
            for (int s = 0; s < 8; ++s) {
                sc[s][0] = (f32x4){-1e30f, -1e30f, -1e30f, -1e30f}; sc[s][1] = sc[s][0];
                if (s < ntc) {
                    f32x4 a0 = (f32x4){0.f, 0.f, 0.f, 0.f}, a1 = a0;
#pragma unroll
                    for (int kk = 0; kk < 2; ++kk) {
                        a0 = mfma16(ldrow(lds + OFF_KC + (32 * s + l15) * KS + (8 * g + 32 * kk) * 2), qf[kk], a0);
                        a1 = mfma16(ldrow(lds + OFF_KC + (32 * s + 16 + l15) * KS + (8 * g + 32 * kk) * 2), qf[kk], a1);
                    }
#pragma unroll
                    for (int r = 0; r < 4; ++r) {
                        const int n0 = 32 * s + 4 * g + r, n1 = n0 + 16;
                        sc[s][0][r] = (16 * n0 + 31 <= t && n0 < 255) ? a0[r] * sc2 : -1e30f;
                        sc[s][1][r] = (16 * n1 + 31 <= t && n1 < 255) ? a1[r] * sc2 : -1e30f;
                        mx = fmaxf(mx, fmaxf(sc[s][0][r], sc[s][1][r]));
                    }
                }
            }
            mx = gmax4(mx);
            float sum = 0.f;
#pragma unroll
            for (int s = 0; s < 8; ++s)
#pragma unroll
                for (int e = 0; e < 2; ++e)
#pragma unroll
                    for (int r = 0; r < 4; ++r) { const float p = (sc[s][e][r] > -5e29f) ? fexp2(sc[s][e][r] - mx) : 0.f; sc[s][e][r] = p; sum += p; }
            sum = gsum4(sum);
            const float inv = 1.f / fmaxf(sum, 1e-30f);
#pragma unroll
            for (int s = 0; s < 8; ++s) {
                float p[8];
#pragma unroll
                for (int r = 0; r < 4; ++r) { p[r] = sc[s][0][r] * inv; p[4 + r] = sc[s][1][r] * inv; }
#pragma unroll
                for (int e = 0; e < 8; ++e) { float x = p[e]; x += __int_as_float(__builtin_amdgcn_update_dpp(0, __float_as_int(x), 0xB1, 0xf, 0xf, false)); x += __int_as_float(__builtin_amdgcn_update_dpp(0, __float_as_int(x), 0x4E, 0xf, 0xf, false));
                    if (hp == 0) IMP[ql * 256 + 32 * s + 16 * (e >> 2) + 4 * g + (e & 3)] = x; }
                if (s < ntc) {
                    v4u pbu; pbu.x = pk2(p[0], p[1]); pbu.y = pk2(p[2], p[3]); pbu.z = pk2(p[4], p[5]); pbu.w = pk2(p[6], p[7]);
                    const bf16x8 pb = __builtin_bit_cast(bf16x8, pbu);
#pragma unroll
                    for (int dt = 0; dt < 4; ++dt) {
                        const s16x4 a = ldtr(lds + OFF_VC + (32 * s + 4 * g + q4) * KS + (16 * dt + 4 * p4) * 2), bb = ldtr(lds + OFF_VC + (32 * s + 16 + 4 * g + q4) * KS + (16 * dt + 4 * p4) * 2);
                        oc[dt] = mfma16((bf16x8){a[0], a[1], a[2], a[3], bb[0], bb[1], bb[2], bb[3]}, pb, oc[dt]);
                    }
                }
            }
        }
        unsigned ocp[8];
#pragma unroll
        for (int dt = 0; dt < 4; ++dt) { ocp[2 * dt] = pk2(oc[dt][0], oc[dt][1]); ocp[2 * dt + 1] = pk2(oc[dt][2], oc[dt][3]); }
        __syncthreads();
        NSA_STAMP(0);
        {
            unsigned ulo = 0u, uhi = 0u;
            unsigned key[4];
#pragma unroll
            for (int qi = 0; qi < 4; ++qi) {
                const int qq = 4 * wave + qi, jb = lane;
                const LAS float* ip = IMP + qq * 256 + 4 * jb;
                const float pm1 = (jb > 0) ? ip[-1] : 0.f;
                const float imp_sel = pm1 + 2.f * (ip[0] + ip[1] + ip[2]) + ip[3];
                const bool forced = (jb == 0) || (jb == cur) || (jb == cur - 1);
                key[qi] = (jb <= cur) ? __float_as_uint(imp_sel + (forced ? 1e4f : 0.f)) + 1u : 0u;
            }
            unsigned thr[4] = {0u, 0u, 0u, 0u};
            for (int bit = 31; bit >= 0; --bit) {
#pragma unroll
                for (int qi = 0; qi < 4; ++qi) { const unsigned cand = thr[qi] | (1u << bit); if (__popcll(__ballot(key[qi] >= cand)) >= 16) thr[qi] = cand; }
            }
#pragma unroll
            for (int qi = 0; qi < 4; ++qi) {
                const int qq = 4 * wave + qi;
                const bool gt = key[qi] > thr[qi], eq = key[qi] == thr[qi];
                const int need = 16 - __popcll(__ballot(gt));
                const unsigned long long em = __ballot(eq);
                const int below = __popcll(em & ((1ull << lane) - 1ull));
                const bool sel = key[qi] > 0u && (gt || (eq && below < need));
                const unsigned long long mask = __ballot(sel);
                if (lane == 0) { SEL[2 * qq] = (unsigned)mask; SEL[2 * qq + 1] = (unsigned)(mask >> 32); }
                ulo |= (unsigned)mask; uhi |= (unsigned)(mask >> 32);
            }
            if (lane == 0) { UNI[2 * wave] = ulo; UNI[2 * wave + 1] = uhi; }
        }
        __syncthreads();
        if (wave == 0) {
            unsigned ulo = 0u, uhi = 0u;
            for (int w = 0; w < 8; ++w) { ulo |= UNI[2 * w]; uhi |= UNI[2 * w + 1]; }
            int cnt = 0;
            for (int half = 0; half < 2; ++half) {
                const int s = lane + 64 * half, jb = s >> 1; const unsigned bit = (jb < 32) ? (ulo >> jb) & 1u : (uhi >> (jb - 32)) & 1u;
                const bool need = (s <= qb) && bit != 0u;
                const unsigned long long m = __ballot(need);
                const int pos = cnt + __popcll(m & ((1ull << lane) - 1ull));
                if (need) TL[pos] = s;
                cnt += __popcll(m);
            }
            if (lane == 0) NT[0] = cnt;
        }
        __syncthreads();
        const int nts = NT[0];
        NSA_STAMP(1);
        FaState<64> ss; fa_init<64>(ss);
        {
            TokSrc src{prow + 1536 + gq * 64, TL};
            SelMask mk{SEL[2 * ql], SEL[2 * ql + 1], (unsigned)__builtin_amdgcn_readfirstlane((int)UNI[2 * wave]), (unsigned)__builtin_amdgcn_readfirstlane((int)UNI[2 * wave + 1]), t, qb, TL};
            fa_stream<64, 4, TokSrc, SelMask>(lds, tid, 0, nts, src, mk, qf, ss, sc2);
        }
        unsigned osp[8]; float isl = 1.f / fmaxf(ss.l, 1e-30f);
#pragma unroll
        for (int dt = 0; dt < 4; ++dt) { osp[2 * dt] = pk2(ss.o[dt][0] * isl, ss.o[dt][1] * isl); osp[2 * dt + 1] = pk2(ss.o[dt][2] * isl, ss.o[dt][3] * isl); }
        NSA_STAMP(2);
        FaState<64> sw; fa_init<64>(sw);
        {
            TokSrc src{prow + 2048 + gq * 64, nullptr};
            const int sb = (t0 - 512) < 0 ? 0 : (t0 - 512) >> 5;
            WinMask mk{t, qb, sb};
            fa_stream<64, 4, TokSrc, WinMask>(lds, tid, sb, qb + 1, src, mk, qf, sw, sc2);
        }
        NSA_STAMP(3);
        {
            const GAS bf16* gp = (const GAS bf16*)(prow + (size_t)t * NSA_PITCH + 2560 + gq * 4 + hp);
            const float g0 = sigmoid_f(__uint_as_float((unsigned)gp[0] << 16)), g1 = sigmoid_f(__uint_as_float((unsigned)gp[16] << 16)), g2 = sigmoid_f(__uint_as_float((unsigned)gp[32] << 16));
            const float iw = g2 / fmaxf(sw.l, 1e-30f);
            bf16* op = ONSA + ((size_t)b * SEQ + t) * 1024 + gq * 256 + hp * 64 + 4 * g;
#pragma unroll
            for (int dt = 0; dt < 4; ++dt) {
                f32x4 o = sw.o[dt] * iw;
                o[0] += g0 * bf_lo(ocp[2 * dt]) + g1 * bf_lo(osp[2 * dt]); o[1] += g0 * bf_hi(ocp[2 * dt]) + g1 * bf_hi(osp[2 * dt]);
                o[2] += g0 * bf_lo(ocp[2 * dt + 1]) + g1 * bf_lo(osp[2 * dt + 1]); o[3] += g0 * bf_hi(ocp[2 * dt + 1]) + g1 * bf_hi(osp[2 * dt + 1]);
                v2u w; w.x = pk2(o[0], o[1]); w.y = pk2(o[2], o[3]); *(GAS v2u*)(op + 16 * dt) = w; }
        }
        __syncthreads();
        NSA_STAMP(4);
    }
}
#ifndef RET_SCAN
#define RET_SCAN 1
#define RET_GNORM 1
#define RET_GATE 1
#endif
#ifndef ENABLE_SSD
#define ENABLE_SSD 1
#endif
constexpr size_t WS_DTRAW = WS_SCR + 340 * MiB, WS_HALO = WS_SCR + 344 * MiB;
#define MIXER_CONVERT \
    if (mix == 1) { transpose_w<0>(args.in[12], D, 2608, 2816, WMIX, scr, gw, NGW, lane); \
        for (int c = 0; c < 2; ++c) { transpose_w<0>(args.in[14] + (size_t)c * 2048 * 256, 2048, 256, 256, WMIX + 3 * MiB + (size_t)c * 256 * 2048, scr, gw, NGW, lane); \
            transpose_w<0>(args.in[15] + (size_t)c * 256 * 64, 256, 64, 256, WMIX + 4 * MiB + (size_t)c * 256 * 256, scr, gw, NGW, lane); } \
        transpose_w<0>(args.in[16], D, D, D, WMIX + 5 * MiB, scr, gw, NGW, lane); } \
    if (mix == 3) { transpose_w<0>(args.in[25], D, 9216, 9216, WMIX, scr, gw, NGW, lane); transpose_w<0>(args.in[26], D, D, D, WMIX + (size_t)9216 * 1024, scr, gw, NGW, lane); } \
    if (mix == 0) { transpose_w<0>(args.in[9], D, 6144, 6144, WMIX, scr, gw, NGW, lane); transpose_w<0>(args.in[11], 2048, D, D, WMIX + (size_t)6144 * 1024, scr, gw, NGW, lane); } \
    if (mix == 2) { transpose_w<0>(args.in[17], D, 5152, 5376, WMIX, scr, gw, NGW, lane); transpose_w<0>(args.in[24], 2048, D, D, WMIX + (size_t)6144 * 1024, scr, gw, NGW, lane); }

#define MIXER_PHASES \
    if (mix == 0) { \
        bf16* PROJ = (bf16*)(ws + WS_SCR); \
        PHASE_BEGIN { pg8::Epi<pg8::EPI_RETQKV> E{}; E.O = PROJ; E.ldc = 4096; E.rot = ROT; run_gemm<pg8::EPI_RETQKV>(lds, U, D, WMIX, T, 4096, D, E, wave_s); } PHASE_END_C(3) \
        if (RET_SCAN) PHASE_BEGIN \
            for (int item = blockIdx.x; item < 256; item += G) { \
                const int b = item >> 5, h = (item >> 3) & 3, s8 = item & 7; \
                bf16* base = PROJ + (size_t)b * SEQ * 4096; \
                scan_item<256, false>(lds, base + h * 256, base + 1024 + h * 256, base + 2048 + h * 512 + s8 * 64, 4096, base + 2048 + h * 512 + s8 * 64, 4096, log1pf(-exp2f(-5.f - (float)h)), nullptr, 0.f, 0.f, 0.f, wave_s); \
                __syncthreads(); \
            } \
        PHASE_END_C(4) \
        if (RET_GNORM) PHASE_BEGIN gnorm_rows(PROJ + 2048, 4096, args.in[10], gw, NGW, lane); PHASE_END_C(7) \
        if (RET_GATE) PHASE_BEGIN { pg8::Epi<pg8::EPI_GATEMUL> E{}; E.O = PROJ + 2048; E.ldc = 4096; run_gemm<pg8::EPI_GATEMUL>(lds, U, D, WMIX + (size_t)4096 * 1024, T, 2048, D, E, wave_s); } PHASE_END_C(3) \
        PHASE_BEGIN { pg8::Epi<pg8::EPI_RESID> E{}; E.Hout = (float*)H; E.Hbase = nullptr; E.scale = 1.0f; E.ldc = D; run_gemm<pg8::EPI_RESID>(lds, PROJ + 2048, 4096, WMIX + (size_t)6144 * 1024, T, D, 2048, E, wave_s); } PHASE_END_C(3) \
    } \
    if (mix == 2 && ENABLE_SSD) { \
        bf16* PROJ = (bf16*)(ws + WS_SCR); float* DTRAW = (float*)(ws + WS_DTRAW); bf16* HALO = (bf16*)(ws + WS_HALO); \
        PHASE_BEGIN { pg8::Epi<pg8::EPI_SSD> E{}; E.O = PROJ; E.ldc = SSD_PITCH; E.aux = DTRAW; run_gemm<pg8::EPI_SSD>(lds, U, D, WMIX, T, SSD_PITCH, D, E, wave_s); } PHASE_END_C(3) \
        PHASE_BEGIN ssd_halo_save(PROJ, HALO, blockIdx.x * NTHR + tid, G * NTHR); PHASE_END_C(7) \
        PHASE_BEGIN ssd_conv(PROJ, HALO, args.in[18], args.in[19], blockIdx.x * NTHR + tid, G * NTHR); PHASE_END_C(7) \
        PHASE_BEGIN \
            for (int item = blockIdx.x; item < 256; item += G) { \
                const int b = item >> 5, gq = (item >> 3) & 3, r = item & 7, hd = gq * 8 + r; \
                bf16* base = PROJ + (size_t)b * SEQ * SSD_PITCH; \
                scan_item<128, true>(lds, base + 4608 + gq * 128, base + 4096 + gq * 128, base + 2048 + gq * 512 + r * 64, SSD_PITCH, base + gq * 512 + r * 64, SSD_PITCH, 0.f, \
                                     DTRAW + (size_t)b * SEQ * 32 + hd, args.in[20][hd], -__expf(args.in[21][hd]), args.in[22][hd], wave_s); \
                __syncthreads(); \
            } \
        PHASE_END_C(4) \
        PHASE_BEGIN gnorm_rows(PROJ, SSD_PITCH, args.in[23], gw, NGW, lane); PHASE_END_C(7) \
        PHASE_BEGIN { pg8::Epi<pg8::EPI_RESID> E{}; E.Hout = (float*)H; E.Hbase = nullptr; E.scale = 1.0f; E.ldc = D; run_gemm<pg8::EPI_RESID>(lds, PROJ, SSD_PITCH, WMIX + (size_t)6144 * 1024, T, D, 2048, E, wave_s); } PHASE_END_C(3) \
    } \
    if (mix == 3) { \
        bf16* PROJD = (bf16*)(ws + WS_SCR); bf16* OACC = (bf16*)(ws + WS_SCR + 192 * MiB); float* LSE = (float*)(ws + WS_SCR + 256 * MiB); \
        for (int gi = 0; gi < 3; ++gi) { \
            PHASE_BEGIN { pg8::Epi<pg8::EPI_BF16> E{}; E.O = PROJD; E.ldc = DIL_PITCH; run_gemm<pg8::EPI_BF16>(lds, U, D, WMIX + (size_t)gi * 3072 * 1024, T, 3072, D, E, wave_s); } PHASE_END_C(3) \
            PHASE_BEGIN dilated_phase(lds, PROJD, OACC, LSE, gi, G, wave_s); PHASE_END_C(6) \
        } \
        PHASE_BEGIN { pg8::Epi<pg8::EPI_RESID> E{}; E.Hout = (float*)H; E.Hbase = nullptr; E.scale = 1.0f; E.ldc = D; run_gemm<pg8::EPI_RESID>(lds, OACC, D, WMIX + (size_t)9216 * 1024, T, D, D, E, wave_s); } PHASE_END_C(3) \
    } \
    if (mix == 1) { \
        bf16* PROJN = (bf16*)(ws + WS_SCR); bf16* ACMP = (bf16*)(ws + WS_SCR + 176 * MiB); bf16* HIDC = (bf16*)(ws + WS_SCR + 240 * MiB); bf16* KVC = (bf16*)(ws + WS_SCR + 248 * MiB); bf16* ONSA = (bf16*)(ws + WS_SCR + 256 * MiB); \
        PHASE_BEGIN { pg8::Epi<pg8::EPI_BF16> E{}; E.O = PROJN; E.ldc = NSA_PITCH; run_gemm<pg8::EPI_BF16>(lds, U, D, WMIX, T, NSA_PITCH, D, E, wave_s); } PHASE_END_C(3) \
        PHASE_BEGIN nsa_im2col(PROJN, args.in[13], ACMP, blockIdx.x * NTHR + tid, G * NTHR); PHASE_END_C(7) \
        PHASE_BEGIN for (int c = 0; c < 2; ++c) { pg8::Epi<pg8::EPI_SILU> E{}; E.O = HIDC + (size_t)c * 8192 * 256; E.ldc = 256; run_gemm<pg8::EPI_SILU>(lds, ACMP + (size_t)c * 8192 * 2048, 2048, WMIX + 3 * MiB + (size_t)c * 256 * 2048, 8192, 256, 2048, E, wave_s); } PHASE_END_C(3) \
        PHASE_BEGIN for (int c = 0; c < 2; ++c) { pg8::Epi<pg8::EPI_BF16> E{}; E.O = KVC + (size_t)c * 8192 * 256; E.ldc = 256; run_gemm<pg8::EPI_BF16>(lds, HIDC + (size_t)c * 8192 * 256, 256, WMIX + 4 * MiB + (size_t)c * 256 * 256, 8192, 256, 256, E, wave_s); } PHASE_END_C(3) \
        PHASE_BEGIN nsa_phase(lds, PROJN, KVC, ONSA, G, wave_s, (unsigned long long*)(args.ws + 32768)); PHASE_END_C(5) \
        PHASE_BEGIN { pg8::Epi<pg8::EPI_RESID> E{}; E.Hout = (float*)H; E.Hbase = nullptr; E.scale = 1.0f; E.ldc = D; run_gemm<pg8::EPI_RESID>(lds, ONSA, D, WMIX + 5 * MiB, T, D, D, E, wave_s); } PHASE_END_C(3) \
    }
__global__ void __launch_bounds__(NTHR, 2) fwd_megakernel(Args args) {
    extern __shared__ __attribute__((aligned(16))) unsigned char lds_raw[];
    LAS unsigned char* lds = (LAS unsigned char*)lds_raw;
    cg::grid_group grid = cg::this_grid();
    const int G = gridDim.x;
    const int wave_s = __builtin_amdgcn_readfirstlane(threadIdx.x >> 6);
    volatile LAS unsigned* xst = (volatile LAS unsigned*)(lds + LDS_BYTES - 64);
    if (threadIdx.x < 16) xst[threadIdx.x] = 0u;
    __syncthreads();
    const XcdBarrier xbar = xcd_barrier_post((unsigned*)args.ws, xst);
    if (args.ph_lo < 0) grid.sync();
    if (PROBE_MASK != 0 && blockIdx.x == 0 && threadIdx.x == 0) { ((unsigned long long*)(args.ws + 32768))[0] = __builtin_amdgcn_s_memrealtime(); }
#define PHASE_BEGIN {
#define PHASE_END_C(cat) xcd_barrier(xbar); if (PROBE_MASK != 0 && blockIdx.x == 0 && threadIdx.x == 0) { const unsigned long long now_ = __builtin_amdgcn_s_memrealtime(); unsigned long long* c_ = (unsigned long long*)(args.ws + 32768); if ((PROBE_MASK >> (cat)) & 1) c_[1] += now_ - c_[0]; c_[0] = now_; } }
    for (int L = 0; L < DEPTH; ++L) {
        const int mix = L & 3;
        int tid_ = wave_s * 64 + lane_id_now(); asm volatile("" : "+v"(tid_));
        const int tid = tid_, lane = tid & 63, wave = __builtin_amdgcn_readfirstlane(tid >> 6);
        const int gw = blockIdx.x * NWAVES + wave, NGW = G * NWAVES;
        unsigned char* ws = args.ws; asm volatile("" : "+s"(ws));
        bf16* H = (bf16*)((unsigned char*)args.out + 64 * MiB); asm volatile("" : "+s"(H));
        float* ROT = (float*)(ws + WS_ROT);
        bf16* WIN1 = (bf16*)(ws + WS_WIN1); bf16* WOUT1 = (bf16*)(ws + WS_WOUT1); bf16* WIN2 = (bf16*)(ws + WS_WIN2); bf16* WOUT2 = (bf16*)(ws + WS_WOUT2); bf16* WMIX = (bf16*)(ws + WS_WMIX);
        bf16* U = (bf16*)(ws + WS_U); bf16* HID = (bf16*)(ws + WS_SCR);
        LAS float* scr = (LAS float*)(lds + wave * 18432);
        PHASE_BEGIN
            transpose_w<1>(args.in[2] + (size_t)L * D * 2 * FF, D, 2 * FF, 2 * FF, WIN1, scr, gw, NGW, lane);
            transpose_w<0>(args.in[3] + (size_t)L * FF * D, FF, D, D, WOUT1, scr, gw, NGW, lane);
            transpose_w<1>(args.in[6] + (size_t)L * D * 2 * FF, D, 2 * FF, 2 * FF, WIN2, scr, gw, NGW, lane);
            transpose_w<0>(args.in[7] + (size_t)L * FF * D, FF, D, D, WOUT2, scr, gw, NGW, lane);
            MIXER_CONVERT
            if (L == 0) {
                for (int i = blockIdx.x * NTHR + tid; i < 4096 * 128; i += G * NTHR) {
                    const int pos = i >> 7, d = i & 127;
                    const float inv = exp2f(-(float)d * (13.287712379549449f / 128.f));
                    const float ang = (float)pos * inv;
                    const double x = (double)ang * 0.15915494309189535; const float fr = (float)(x - rint(x));
                    ROT[i] = __builtin_amdgcn_cosf(fr); ROT[4096 * 128 + i] = __builtin_amdgcn_sinf(fr);
                }
            }
            if (L == 0) rms_rows(args.in[0], args.in[1], U, nullptr, gw, NGW, lane); else rms_rows_b(H, args.in[1] + L * D, U, gw, NGW, lane);
        PHASE_END_C(0)
        PHASE_BEGIN { pg8::Epi<pg8::EPI_SWIGLU> E{}; E.O = HID; E.ldc = FF; run_gemm<pg8::EPI_SWIGLU>(lds, U, D, WIN1, T, 2 * FF, D, E, wave_s); } PHASE_END_C(1)
        PHASE_BEGIN { pg8::Epi<pg8::EPI_RESID> E{}; E.Hout = (float*)H; E.Hbase = (L == 0) ? args.in[0] : nullptr; E.scale = 0.5f; E.ldc = D; run_gemm<pg8::EPI_RESID>(lds, HID, FF, WOUT1, T, D, FF, E, wave_s); } PHASE_END_C(1)
        PHASE_BEGIN rms_rows_b(H, args.in[4] + L * D, U, gw, NGW, lane); PHASE_END_C(2)
        MIXER_PHASES
        PHASE_BEGIN rms_rows_b(H, args.in[5] + L * D, U, gw, NGW, lane); PHASE_END_C(2)
        PHASE_BEGIN { pg8::Epi<pg8::EPI_SWIGLU> E{}; E.O = HID; E.ldc = FF; run_gemm<pg8::EPI_SWIGLU>(lds, U, D, WIN2, T, 2 * FF, D, E, wave_s); } PHASE_END_C(1)
        PHASE_BEGIN { pg8::Epi<pg8::EPI_RESID> E{}; E.Hout = (float*)H; E.Hbase = nullptr; E.scale = 0.5f; E.ldc = D; run_gemm<pg8::EPI_RESID>(lds, HID, FF, WOUT2, T, D, FF, E, wave_s); } PHASE_END_C(1)
    }
    {
        const int lane = lane_id_now(); const int gw = blockIdx.x * NWAVES + wave_s, NGW = G * NWAVES;
        const bf16* HBf = (const bf16*)((unsigned char*)args.out + 64 * MiB); bf16* Uc = (bf16*)(args.ws + WS_U);
        rms_final_b(HBf, 0, args.out, args.in[8], 0, T / 2, gw, NGW, lane);
        { const GAS v4u* src = (const GAS v4u*)(HBf + (size_t)(T / 2) * D); GAS v4u* dst = (GAS v4u*)Uc;
          for (int i = blockIdx.x * NTHR + wave_s * 64 + lane; i < (T / 2) * D / 8; i += G * NTHR) dst[i] = src[i]; }
        xcd_barrier(xbar);
        rms_final_b(Uc, T / 2, args.out, args.in[8], T / 2, T, gw, NGW, lane);
    }
}

extern "C" void kernel_launch(void* const* d_in, const int* in_sizes, int n_in, void* d_out, int out_size, void* d_ws, size_t ws_size, hipStream_t stream) {
    static int grid = 0;
    if (grid == 0) {
        if (n_in != 27 || out_size != T * D || ws_size < WS_NEED) { fprintf(stderr, "kernel_launch: unexpected problem (n_in %d, out %d, ws %zu)\n", n_in, out_size, ws_size); grid = -1; return; }
        int dev = 0, cus = 0, per_cu = 0;
        hipGetDevice(&dev); hipDeviceGetAttribute(&cus, hipDeviceAttributeMultiprocessorCount, dev);
        if (hipFuncSetAttribute((const void*)fwd_megakernel, hipFuncAttributeMaxDynamicSharedMemorySize, LDS_BYTES) != hipSuccess) { fprintf(stderr, "kernel_launch: hipFuncSetAttribute failed\n"); grid = -1; return; }
        if (hipOccupancyMaxActiveBlocksPerMultiprocessor(&per_cu, (const void*)fwd_megakernel, NTHR, LDS_BYTES) != hipSuccess || per_cu < 1) { fprintf(stderr, "kernel_launch: occupancy query gave %d\n", per_cu); per_cu = 1; }
        (void)hipGetLastError();
        grid = cus * 1;
    }
    if (grid < 0) return;
    if (hipMemsetAsync(d_ws, 0, 65536, stream) != hipSuccess) { fprintf(stderr, "kernel_launch: memset failed\n"); return; }
    Args a{};
    for (int i = 0; i < 27; ++i) a.in[i] = (const float*)d_in[i];
    a.out = (float*)d_out; a.ws = (unsigned char*)d_ws; a.ph_lo = 0; a.ph_hi = 1 << 20;
    void* kargs[] = {&a};
    hipError_t e = hipLaunchCooperativeKernel((const void*)fwd_megakernel, dim3(grid), dim3(NTHR), kargs, LDS_BYTES, stream);
    if (e != hipSuccess) fprintf(stderr, "kernel_launch: cooperative launch failed: %s (grid %d)\n", hipGetErrorString(e), grid);
}
```

```cpp
#include <hip/hip_runtime.h>
#include <hip/hip_cooperative_groups.h>
#include <cstdio>
#include <cstdint>
namespace cg = cooperative_groups;

__device__ __forceinline__ int lane_id_now() { int l; asm volatile("v_mbcnt_lo_u32_b32 %0, -1, 0\n\tv_mbcnt_hi_u32_b32 %0, -1, %0" : "=v"(l)); return l; }

#ifndef PROBE_MASK
#define PROBE_MASK 0
#endif
namespace pg8 {
#define PG8_LAS __attribute__((address_space(3)))
typedef unsigned short bf16_t;
typedef short bf16x8 __attribute__((ext_vector_type(8)));
typedef float f32x4 __attribute__((ext_vector_type(4)));
typedef unsigned u32x4 __attribute__((ext_vector_type(4)));
constexpr int BM = 256, BK = 64, HALF = 128, HTB = HALF * BK * 2  , STAGE_BYTES = 8 * HTB, NXCD = 8, WGM = 8;

__host__ __device__ __forceinline__ int lds_byte(int r, int c) { const int st = (r >> 4) * 2 + (c >> 5), rr = r & 15, cc = c & 31, ob = rr * 64 + cc * 2; return st * 1024 + (ob ^ (((ob >> 9) & 1) << 5)); }
__host__ __device__ __forceinline__ void stage_rc(int b, int& R, int& C) { const int st = b / 1024, sb = b % 1024, swz = sb ^ (((sb >> 9) & 1) << 5); R = (st >> 1) * 16 + swz / 64; C = (st & 1) * 32 + (swz % 64) / 2; }
__host__ __device__ __forceinline__ int perm32(int rho) { const int n = rho >> 4, i = rho & 15; return 8 * (i >> 2) + 4 * n + (i & 3); }

struct Unit { int pm, pn; };
struct Gemm { const bf16_t* A; const bf16_t* Bt; int M, N, K, lda; };

struct StaticOrder {
    int nM, nN, nwg, G, c;
    __host__ __device__ void init(int M, int N, int G_, int c_) { nM = M / BM; nN = N / BM; nwg = nM * nN; G = G_; c = c_; }
    __host__ __device__ bool next(int i, Unit& u) const {
        const long L = (long)i * G + c; if (L >= nwg) return false;
        int wgid = (int)L; { const int q = nwg / NXCD, r = nwg % NXCD, xcd = wgid % NXCD, off = wgid / NXCD; wgid = (xcd < r ? xcd * (q + 1) : r * (q + 1) + (xcd - r) * q) + off; }
        const int nig = WGM * nN, gid = wgid / nig, fm = gid * WGM, gsz = (nM - fm) < WGM ? (nM - fm) : WGM;
        u.pm = fm + ((wgid % nig) % gsz); u.pn = (wgid % nig) / gsz; return true;
    }
    __device__ __forceinline__ void a_ready(const Unit&) const {}
    __device__ __forceinline__ void done(const Unit&) const {}
};

typedef float f32x2_t __attribute__((ext_vector_type(2))); typedef __bf16 bf16x2_t __attribute__((ext_vector_type(2)));
__device__ __forceinline__ unsigned cvt_pk_bf16(float lo, float hi) { f32x2_t v = {lo, hi}; bf16x2_t b = __builtin_convertvector(v, bf16x2_t); return __builtin_bit_cast(unsigned, b); }
__device__ __forceinline__ float bf_lo(unsigned w) { return __uint_as_float(w << 16); }
__device__ __forceinline__ float bf_hi(unsigned w) { return __uint_as_float(w & 0xffff0000u); }
__device__ __forceinline__ float silu_f(float x) { return x * __builtin_amdgcn_rcpf(1.0f + __builtin_amdgcn_exp2f(-1.4426950408889634f * x)); }
__device__ __forceinline__ float sigmoid_f(float x) { return __builtin_amdgcn_rcpf(1.0f + __builtin_amdgcn_exp2f(-1.4426950408889634f * x)); }

enum { EPI_BF16 = 0, EPI_SWIGLU = 1, EPI_RESID = 2, EPI_RETQKV = 3, EPI_GATEMUL = 4, EPI_SSD = 5, EPI_SILU = 6 };
template <int MODE> struct Epi {
    static constexpr bool PERM = true, AFTER_DRAIN = false;
    bf16_t* O; int ldc;
    float* Hout; const float* Hbase; float scale;
    const float* __restrict__ rot;
    float* aux;
    __device__ __forceinline__ void operator()(const f32x4 (&acc)[2][2][4][2], const Unit& u, int wr, int wc, int fr, int fq) const {
        const int row0 = u.pm * BM + wr * 64 + fr;
        const int cl = wc * 32 + 8 * fq;
        if constexpr (MODE == EPI_SWIGLU) {
#pragma unroll
            for (int ai = 0; ai < 2; ++ai)
#pragma unroll
                for (int m = 0; m < 4; ++m) {
                    bf16_t* rowp = O + (size_t)(row0 + ai * HALF + m * 16) * ldc + u.pn * 128 + cl;
                    f32x4 a0 = acc[ai][0][m][0], a1 = acc[ai][0][m][1], b0 = acc[ai][1][m][0], b1 = acc[ai][1][m][1];
                    u32x4 w;
                    w.x = cvt_pk_bf16(silu_f(a0[0]) * b0[0], silu_f(a0[1]) * b0[1]); w.y = cvt_pk_bf16(silu_f(a0[2]) * b0[2], silu_f(a0[3]) * b0[3]);
                    w.z = cvt_pk_bf16(silu_f(a1[0]) * b1[0], silu_f(a1[1]) * b1[1]); w.w = cvt_pk_bf16(silu_f(a1[2]) * b1[2], silu_f(a1[3]) * b1[3]);
                    *(u32x4*)rowp = w;
                }
        } else if constexpr (MODE == EPI_RESID) {
            bf16_t* const HB = (bf16_t*)Hout;
#pragma unroll
            for (int ai = 0; ai < 2; ++ai) {
                if (Hbase) {
                    f32x4 pre[4][2][2];
#pragma unroll
                    for (int m = 0; m < 4; ++m) { const size_t off = (size_t)(row0 + ai * HALF + m * 16) * ldc + u.pn * BM + cl;
#pragma unroll
                        for (int bj = 0; bj < 2; ++bj)
#pragma unroll
                            for (int n = 0; n < 2; ++n) pre[m][bj][n] = *(const f32x4*)(Hbase + off + bj * HALF + 4 * n); }
#pragma unroll
                    for (int m = 0; m < 4; ++m) { const size_t off = (size_t)(row0 + ai * HALF + m * 16) * ldc + u.pn * BM + cl;
#pragma unroll
                        for (int bj = 0; bj < 2; ++bj) { const f32x4 h0 = pre[m][bj][0] + acc[ai][bj][m][0] * scale, h1 = pre[m][bj][1] + acc[ai][bj][m][1] * scale; u32x4 w;
                            w.x = cvt_pk_bf16(h0[0], h0[1]); w.y = cvt_pk_bf16(h0[2], h0[3]); w.z = cvt_pk_bf16(h1[0], h1[1]); w.w = cvt_pk_bf16(h1[2], h1[3]);
                            *(u32x4*)(HB + off + bj * HALF) = w; } }
                } else {
                    u32x4 pre[4][2];
#pragma unroll
                    for (int m = 0; m < 4; ++m) { const size_t off = (size_t)(row0 + ai * HALF + m * 16) * ldc + u.pn * BM + cl;
#pragma unroll
                        for (int bj = 0; bj < 2; ++bj) pre[m][bj] = *(const u32x4*)(HB + off + bj * HALF); }
#pragma unroll
                    for (int m = 0; m < 4; ++m) { const size_t off = (size_t)(row0 + ai * HALF + m * 16) * ldc + u.pn * BM + cl;
#pragma unroll
                        for (int bj = 0; bj < 2; ++bj) { const u32x4 p = pre[m][bj]; const f32x4 a0 = acc[ai][bj][m][0] * scale, a1 = acc[ai][bj][m][1] * scale; u32x4 w;
                            w.x = cvt_pk_bf16(bf_lo(p.x) + a0[0], bf_hi(p.x) + a0[1]); w.y = cvt_pk_bf16(bf_lo(p.y) + a0[2], bf_hi(p.y) + a0[3]);
                            w.z = cvt_pk_bf16(bf_lo(p.z) + a1[0], bf_hi(p.z) + a1[1]); w.w = cvt_pk_bf16(bf_lo(p.w) + a1[2], bf_hi(p.w) + a1[3]);
                            *(u32x4*)(HB + off + bj * HALF) = w; } }
                }
            }
        } else if constexpr (MODE == EPI_RETQKV) {
            if (u.pn < 8) {
                const float ks = (u.pn >= 4) ? 0.0625f : 1.0f;
#pragma unroll
                for (int ai = 0; ai < 2; ++ai)
#pragma unroll
                    for (int m = 0; m < 4; ++m) {
                        const int r = row0 + ai * HALF + m * 16; const int pos = r & 4095;
                        bf16_t* rowp = O + (size_t)r * ldc + u.pn * BM + cl;
                        u32x4 w1, w2; unsigned* p1 = (unsigned*)&w1; unsigned* p2 = (unsigned*)&w2;
#pragma unroll
                        for (int n = 0; n < 2; ++n) {
                            const f32x4 c = *(const f32x4*)(rot + (size_t)pos * 128 + cl + 4 * n);
                            const f32x4 s = *(const f32x4*)(rot + (size_t)4096 * 128 + (size_t)pos * 128 + cl + 4 * n);
                            const f32x4 t1 = acc[ai][0][m][n] * ks, t2 = acc[ai][1][m][n] * ks;
                            const f32x4 o1 = t1 * c - t2 * s, o2 = t1 * s + t2 * c;
                            p1[2 * n] = cvt_pk_bf16(o1[0], o1[1]); p1[2 * n + 1] = cvt_pk_bf16(o1[2], o1[3]);
                            p2[2 * n] = cvt_pk_bf16(o2[0], o2[1]); p2[2 * n + 1] = cvt_pk_bf16(o2[2], o2[3]);
                        }
                        *(u32x4*)rowp = w1; *(u32x4*)(rowp + HALF) = w2;
                    }
            } else {
#pragma unroll
                for (int ai = 0; ai < 2; ++ai)
#pragma unroll
                    for (int m = 0; m < 4; ++m) {
                        bf16_t* rowp = O + (size_t)(row0 + ai * HALF + m * 16) * ldc + u.pn * BM + cl;
#pragma unroll
                        for (int bj = 0; bj < 2; ++bj) { const f32x4 v0 = acc[ai][bj][m][0], v1 = acc[ai][bj][m][1]; u32x4 w;
                            w.x = cvt_pk_bf16(v0[0], v0[1]); w.y = cvt_pk_bf16(v0[2], v0[3]); w.z = cvt_pk_bf16(v1[0], v1[1]); w.w = cvt_pk_bf16(v1[2], v1[3]);
                            *(u32x4*)(rowp + bj * HALF) = w; }
                    }
            }
        } else if constexpr (MODE == EPI_GATEMUL) {
#pragma unroll
            for (int ai = 0; ai < 2; ++ai)
#pragma unroll
                for (int m = 0; m < 4; ++m) {
                    bf16_t* rowp = O + (size_t)(row0 + ai * HALF + m * 16) * ldc + u.pn * BM + cl;
#pragma unroll
                    for (int bj = 0; bj < 2; ++bj) { const f32x4 v0 = acc[ai][bj][m][0], v1 = acc[ai][bj][m][1]; const u32x4 old = *(const u32x4*)(rowp + bj * HALF); u32x4 w;
                        w.x = cvt_pk_bf16(silu_f(v0[0]) * bf_lo(old.x), silu_f(v0[1]) * bf_hi(old.x)); w.y = cvt_pk_bf16(silu_f(v0[2]) * bf_lo(old.y), silu_f(v0[3]) * bf_hi(old.y));
                        w.z = cvt_pk_bf16(silu_f(v1[0]) * bf_lo(old.z), silu_f(v1[1]) * bf_hi(old.z)); w.w = cvt_pk_bf16(silu_f(v1[2]) * bf_lo(old.w), silu_f(v1[3]) * bf_hi(old.w));
                        *(u32x4*)(rowp + bj * HALF) = w; }
                }
        } else {
            if (MODE == EPI_SSD && u.pn == 20) {
                if (wc == 0) {
#pragma unroll
                    for (int ai = 0; ai < 2; ++ai)
#pragma unroll
                        for (int m = 0; m < 4; ++m) { float* p = aux + (size_t)(row0 + ai * HALF + m * 16) * 32 + cl;
                            *(f32x4*)p = acc[ai][0][m][0]; *(f32x4*)(p + 4) = acc[ai][0][m][1]; }
                }
                return;
            }
#pragma unroll
            for (int ai = 0; ai < 2; ++ai)
#pragma unroll
                for (int m = 0; m < 4; ++m) {
                    bf16_t* rowp = O + (size_t)(row0 + ai * HALF + m * 16) * ldc + u.pn * BM + cl;
#pragma unroll
                    for (int bj = 0; bj < 2; ++bj) { f32x4 v0 = acc[ai][bj][m][0], v1 = acc[ai][bj][m][1]; u32x4 w;
                        if (MODE == EPI_SILU) { v0 = (f32x4){silu_f(v0[0]), silu_f(v0[1]), silu_f(v0[2]), silu_f(v0[3])}; v1 = (f32x4){silu_f(v1[0]), silu_f(v1[1]), silu_f(v1[2]), silu_f(v1[3])}; }
                        w.x = cvt_pk_bf16(v0[0], v0[1]); w.y = cvt_pk_bf16(v0[2], v0[3]); w.z = cvt_pk_bf16(v1[0], v1[1]); w.w = cvt_pk_bf16(v1[2], v1[3]);
                        *(u32x4*)(rowp + bj * HALF) = w; }
                }
        }
    }
};
template <class Epi, class Sched, bool ALIGN_EPI = false, bool SP2 = false>
__device__ __forceinline__ void gemm_phase(PG8_LAS unsigned char* lds, const Gemm g, const Sched& S, const Epi& E, int wave_s) {
    int tid_ = wave_s * 64 + lane_id_now(); asm volatile("" : "+v"(tid_)); const int tid = tid_, wid = __builtin_amdgcn_readfirstlane(tid >> 6), lane = tid & 63, wr = wid >> 2, wc = wid & 3, fr = lane & 15, fq = lane >> 4;
    const int K = g.K, nt = K / BK;
    unsigned voffA[2], voffB[2];
#pragma unroll
    for (int i = 0; i < 2; ++i) { int R, C; stage_rc(tid * 16 + i * 8192, R, C); const int Rb = Epi::PERM ? ((R & ~31) + perm32(R & 31)) : R;
        voffA[i] = (unsigned)(R * g.lda + C) * 2u; voffB[i] = (unsigned)(Rb * K + C) * 2u; }
    const size_t kstep = (size_t)(BK * 2);
    const size_t hstepA = (size_t)HALF * g.lda * 2, hstepB = (size_t)HALF * K * 2;
    const size_t tstepA = 2 * hstepA, tstepB = 2 * hstepB;
    const unsigned ldsw = (unsigned)wid * 1024u;
    const int aoff = lds_byte(wr * 64 + fr, fq * 8), boff = lds_byte(wc * 32 + fr, fq * 8);
#define PG8_SA(b, h) (((b) * 2 + (h)) * HTB)
#define PG8_SB(b, h) ((4 + (b) * 2 + (h)) * HTB)
#define PG8_STAGE(bufoff, gbase, voff) do { _Pragma("unroll") for (int _i = 0; _i < 2; ++_i) \
        __builtin_amdgcn_global_load_lds((const unsigned*)((const char*)(gbase) + (voff)[_i]), (PG8_LAS unsigned*)(lds + (bufoff) + ldsw + _i * 8192), 16, 0, 0); } while (0)
#define PG8_LDA(dst, b, h) do { _Pragma("unroll") for (int m = 0; m < 4; ++m) _Pragma("unroll") for (int k = 0; k < 2; ++k) dst[m][k] = *(const PG8_LAS bf16x8*)(lds + PG8_SA(b, h) + aoff + m * 2048 + k * 1024); } while (0)
#define PG8_LDB(dst, b, h) do { _Pragma("unroll") for (int n = 0; n < 2; ++n) _Pragma("unroll") for (int k = 0; k < 2; ++k) dst[n][k] = *(const PG8_LAS bf16x8*)(lds + PG8_SB(b, h) + boff + n * 2048 + k * 1024); } while (0)
#define PG8_MMA(ai, bj, At, Bt) do { __builtin_amdgcn_s_setprio(1); _Pragma("unroll") for (int m = 0; m < 4; ++m) _Pragma("unroll") for (int n = 0; n < 2; ++n) _Pragma("unroll") for (int k = 0; k < 2; ++k) \
        acc[ai][bj][m][n] = __builtin_amdgcn_mfma_f32_16x16x32_bf16(Bt[n][k], At[m][k], acc[ai][bj][m][n], 0, 0, 0); __builtin_amdgcn_s_setprio(0); } while (0)
#define PG8_WAIT_V(n) asm volatile("s_waitcnt vmcnt(" #n ")" ::: "memory")
#define PG8_WAIT_L(n) asm volatile("s_waitcnt lgkmcnt(" #n ")" ::: "memory")
#define PG8_BAR __builtin_amdgcn_s_barrier()
#define PG8_SCHED __builtin_amdgcn_sched_barrier(0)
    Unit cur, nxt; int ui = 0;
    if (!S.next(0, cur)) return;
    f32x4 acc[2][2][4][2];
#pragma unroll
    for (int a = 0; a < 2; ++a)
#pragma unroll
        for (int b = 0; b < 2; ++b)
#pragma unroll
            for (int m = 0; m < 4; ++m)
#pragma unroll
                for (int n = 0; n < 2; ++n) acc[a][b][m][n] = (f32x4){0.f, 0.f, 0.f, 0.f};
    bf16x8 At[4][2], B0[2][2], B1[2][2];
    const char* cA = (const char*)g.A + (size_t)cur.pm * tstepA; const char* cB = (const char*)g.Bt + (size_t)cur.pn * tstepB;
    S.a_ready(cur);
    if constexpr (SP2) {
        PG8_STAGE(PG8_SB(0, 0), cB, voffB); PG8_STAGE(PG8_SB(0, 1), cB + hstepB, voffB); PG8_STAGE(PG8_SA(0, 0), cA, voffA); PG8_STAGE(PG8_SA(0, 1), cA + hstepA, voffA);
        if (wr == 1) PG8_BAR;
        PG8_WAIT_V(2); PG8_BAR;
        PG8_STAGE(PG8_SB(1, 0), cB + kstep, voffB); PG8_STAGE(PG8_SA(1, 0), cA + kstep, voffA); PG8_STAGE(PG8_SB(1, 1), cB + hstepB + kstep, voffB);
        PG8_WAIT_V(6); PG8_BAR;
    } else {
        PG8_STAGE(PG8_SB(0, 0), cB, voffB); PG8_STAGE(PG8_SA(0, 0), cA, voffA); PG8_STAGE(PG8_SB(0, 1), cB + hstepB, voffB); PG8_STAGE(PG8_SA(0, 1), cA + hstepA, voffA);
        if (wr == 1) PG8_BAR;
        PG8_WAIT_V(4); PG8_BAR;
        PG8_STAGE(PG8_SB(1, 0), cB + kstep, voffB); PG8_STAGE(PG8_SA(1, 0), cA + kstep, voffA); PG8_STAGE(PG8_SB(1, 1), cB + hstepB + kstep, voffB);
        PG8_WAIT_V(6); PG8_BAR;
    }
    for (;;) {
        const bool has_next = S.next(ui + 1, nxt);
        const char* nA = has_next ? (const char*)g.A + (size_t)nxt.pm * tstepA : cA; const char* nB = has_next ? (const char*)g.Bt + (size_t)nxt.pn * tstepB : cB;
        for (int t = 0; t < nt; t += 2) {
            const bool last = (t == nt - 2);
            const char* a1 = cA + (size_t)(t + 1) * kstep;
            const char* a2 = last ? nA : cA + (size_t)(t + 2) * kstep; const char* b2 = last ? nB : cB + (size_t)(t + 2) * kstep;
            const char* a3 = a2 + kstep; const char* b3 = b2 + kstep;
            if (last && has_next) S.a_ready(nxt);
            if constexpr (SP2) {
            PG8_LDB(B0, 0, 0); PG8_LDB(B1, 0, 1); PG8_SCHED; PG8_LDA(At, 0, 0); PG8_STAGE(PG8_SA(1, 1), a1 + hstepA, voffA);
            PG8_WAIT_V(8); PG8_WAIT_L(0); PG8_BAR; PG8_MMA(0, 0, At, B0); PG8_MMA(0, 1, At, B1); PG8_BAR; PG8_SCHED;
            PG8_LDA(At, 0, 1); PG8_STAGE(PG8_SB(0, 0), b2, voffB); PG8_STAGE(PG8_SB(0, 1), b2 + hstepB, voffB); PG8_STAGE(PG8_SA(0, 0), a2, voffA);
            PG8_WAIT_V(8); PG8_WAIT_L(0); PG8_BAR; PG8_MMA(1, 0, At, B0); PG8_MMA(1, 1, At, B1); PG8_BAR; PG8_SCHED;
            PG8_LDB(B0, 1, 0); PG8_LDB(B1, 1, 1); PG8_SCHED; PG8_LDA(At, 1, 0); PG8_STAGE(PG8_SA(0, 1), a2 + hstepA, voffA);
            PG8_WAIT_V(8); PG8_WAIT_L(0); PG8_BAR; PG8_MMA(0, 0, At, B0); PG8_MMA(0, 1, At, B1); PG8_BAR; PG8_SCHED;
            PG8_LDA(At, 1, 1); PG8_STAGE(PG8_SB(1, 0), b3, voffB); PG8_STAGE(PG8_SB(1, 1), b3 + hstepB, voffB); PG8_STAGE(PG8_SA(1, 0), a3, voffA);
            PG8_WAIT_V(8); PG8_WAIT_L(0); PG8_BAR; PG8_MMA(1, 0, At, B0); PG8_MMA(1, 1, At, B1); PG8_BAR; PG8_SCHED;
            } else {
            PG8_LDB(B0, 0, 0); PG8_SCHED; PG8_LDA(At, 0, 0); PG8_STAGE(PG8_SA(1, 1), a1 + hstepA, voffA);
            PG8_WAIT_L(8); PG8_BAR; PG8_WAIT_L(0); PG8_MMA(0, 0, At, B0); PG8_BAR; PG8_SCHED;
            PG8_LDB(B1, 0, 1); PG8_STAGE(PG8_SB(0, 0), b2, voffB);
            PG8_BAR; PG8_WAIT_L(0); PG8_MMA(0, 1, At, B1); PG8_BAR;
            PG8_LDA(At, 0, 1); PG8_STAGE(PG8_SA(0, 0), a2, voffA);
            PG8_BAR; PG8_WAIT_L(0); PG8_MMA(1, 0, At, B0); PG8_BAR; PG8_SCHED;
            PG8_STAGE(PG8_SB(0, 1), b2 + hstepB, voffB);
            PG8_WAIT_V(6); PG8_BAR; PG8_MMA(1, 1, At, B1); PG8_BAR;
            PG8_LDB(B0, 1, 0); PG8_SCHED; PG8_LDA(At, 1, 0); PG8_STAGE(PG8_SA(0, 1), a2 + hstepA, voffA);
            PG8_WAIT_L(8); PG8_BAR; PG8_WAIT_L(0); PG8_MMA(0, 0, At, B0); PG8_BAR; PG8_SCHED;
            PG8_LDB(B1, 1, 1); PG8_STAGE(PG8_SB(1, 0), b3, voffB);
            PG8_BAR; PG8_WAIT_L(0); PG8_MMA(0, 1, At, B1); PG8_BAR;
            PG8_LDA(At, 1, 1); PG8_STAGE(PG8_SA(1, 0), a3, voffA);
            PG8_BAR; PG8_WAIT_L(0); PG8_MMA(1, 0, At, B0); PG8_BAR; PG8_SCHED;
            PG8_STAGE(PG8_SB(1, 1), b3 + hstepB, voffB);
            PG8_WAIT_V(6); PG8_BAR; PG8_MMA(1, 1, At, B1); PG8_BAR;
            }
        }
        if constexpr (ALIGN_EPI) { if (wr == 0) PG8_BAR; }
        if constexpr (!Epi::AFTER_DRAIN) { E(acc, cur, wr, wc, fr, fq); S.done(cur); }
        if (!has_next) break;
#pragma unroll
        for (int a = 0; a < 2; ++a)
#pragma unroll
            for (int b = 0; b < 2; ++b)
#pragma unroll
                for (int m = 0; m < 4; ++m)
#pragma unroll
                    for (int n = 0; n < 2; ++n) acc[a][b][m][n] = (f32x4){0.f, 0.f, 0.f, 0.f};
        cur = nxt; cA = nA; cB = nB; ++ui;
        if constexpr (ALIGN_EPI) { if (wr == 1) PG8_BAR; }
    }
    PG8_WAIT_V(0);
    if constexpr (!ALIGN_EPI) { if (wr == 0) PG8_BAR; }
    PG8_BAR;
    if constexpr (Epi::AFTER_DRAIN) { E.fused(acc, cur, wr, wc, fr, fq, lds, wid, lane); S.done(cur); }
#undef PG8_SA
#undef PG8_SB
#undef PG8_STAGE
#undef PG8_LDA
#undef PG8_LDB
#undef PG8_MMA
#undef PG8_WAIT_V
#undef PG8_WAIT_L
#undef PG8_BAR
#undef PG8_SCHED
}
}
#define GAS __attribute__((address_space(1)))
#define LAS __attribute__((address_space(3)))
typedef unsigned short bf16;
typedef unsigned v4u __attribute__((ext_vector_type(4)));
typedef unsigned v2u __attribute__((ext_vector_type(2)));
typedef float f32x4 __attribute__((ext_vector_type(4)));
typedef short bf16x8 __attribute__((ext_vector_type(8)));
typedef short s16x4 __attribute__((ext_vector_type(4)));
using pg8::cvt_pk_bf16; using pg8::bf_lo; using pg8::bf_hi; using pg8::silu_f; using pg8::sigmoid_f;

constexpr int NWAVES = 8, NTHR = 512;
constexpr int BATCH = 8, SEQ = 4096, T = BATCH * SEQ, D = 1024, FF = 2816, DEPTH = 4;
constexpr float NORM_EPS = 1e-6f;
constexpr int LDS_BYTES = 147456;
constexpr size_t MiB = 1u << 20;
constexpr size_t WS_ROT = 1 * MiB;
constexpr size_t WS_W = 8 * MiB;
constexpr size_t WS_WIN1 = WS_W, WS_WOUT1 = WS_W + 11 * MiB, WS_WIN2 = WS_W + 17 * MiB, WS_WOUT2 = WS_W + 28 * MiB, WS_WMIX = WS_W + 34 * MiB;
constexpr size_t WS_U = 64 * MiB;
constexpr size_t WS_SCR = 128 * MiB;
constexpr size_t WS_NEED = 484 * MiB;

struct Args { const float* in[27]; float* out; unsigned char* ws; int ph_lo, ph_hi; };

__device__ __forceinline__ float wave_sum(float v) {
#pragma unroll
    for (int o = 1; o < 64; o <<= 1) v += __shfl_xor(v, o);
    return v;
}
__device__ __forceinline__ unsigned pk2(float lo, float hi) { return cvt_pk_bf16(lo, hi); }

template <int MAP> __device__ __forceinline__ void transpose_w(const float* W, int K, int N, int Npad, bf16* WT, LAS float* scr, int gw, int NGW, int lane) {
    asm volatile("" : "+v"(lane));
    const int nblk = Npad / 32, nitems = (K / 64) * nblk;
    for (int item0 = gw; item0 < nitems; item0 += 2 * NGW) {
        float wv[2][32]; int k0s[2], n0s[2]; bool inb[2];
#pragma unroll
        for (int t = 0; t < 2; ++t) {
            const int item = item0 + t * NGW; const bool ok = item < nitems; const int itc = ok ? item : item0;
            const int kb = itc / nblk, nb = itc % nblk; k0s[t] = 64 * kb; n0s[t] = 32 * nb;
            const int nn = n0s[t] + (lane & 31); inb[t] = nn < N;
            const GAS float* wp = (const GAS float*)(W + (size_t)(k0s[t] + (lane >> 5)) * N + (inb[t] ? nn : 0));
#pragma unroll
            for (int i = 0; i < 32; ++i) wv[t][i] = wp[(size_t)(2 * i) * N];
        }
#pragma unroll
        for (int t = 0; t < 2; ++t) {
            const int item = item0 + t * NGW; if (item >= nitems) break;
            LAS float* sc = scr + t * 2112;
#pragma unroll
            for (int i = 0; i < 32; ++i) sc[(2 * i + (lane >> 5)) * 33 + (lane & 31)] = inb[t] ? wv[t][i] : 0.f;
            asm volatile("s_waitcnt lgkmcnt(0)" ::: "memory");
            const int n0 = n0s[t], k0 = k0s[t];
            int r0 = n0;
            if (MAP == 1) { r0 = (n0 < FF) ? (n0 / 128) * 256 + (n0 % 128) : ((n0 - FF) / 128) * 256 + 128 + ((n0 - FF) % 128); }
            const int c = lane & 7;
#pragma unroll
            for (int j = 0; j < 4; ++j) { const int n = (lane >> 3) + 8 * j; const LAS float* s = sc + (8 * c) * 33 + n;
                v4u o; o.x = pk2(s[0 * 33], s[1 * 33]); o.y = pk2(s[2 * 33], s[3 * 33]); o.z = pk2(s[4 * 33], s[5 * 33]); o.w = pk2(s[6 * 33], s[7 * 33]);
                *(GAS v4u*)(WT + (size_t)(r0 + n) * K + k0 + 8 * c) = o; }
        }
        asm volatile("s_waitcnt lgkmcnt(0)" ::: "memory");
    }
}

__device__ __forceinline__ void rms_rows(const float* X, const float* gain, bf16* U, float* Hcopy, int gw, int NGW, int lane) {
    asm volatile("" : "+v"(lane));
    f32x4 g[4];
#pragma unroll
    for (int j = 0; j < 4; ++j) g[j] = ((const f32x4*)gain)[lane + 64 * j];
    for (int m0 = gw; m0 < T; m0 += 4 * NGW) {
        f32x4 v[4][4];
#pragma unroll
        for (int q = 0; q < 4; ++q) { const int m = m0 + q * NGW; const f32x4* xr = (const f32x4*)(X + (size_t)(m < T ? m : m0) * D) + lane;
#pragma unroll
            for (int j = 0; j < 4; ++j) v[q][j] = xr[64 * j]; }
#pragma unroll
        for (int q = 0; q < 4; ++q) { const int m = m0 + q * NGW; if (m >= T) break;
            float s = 0.f;
#pragma unroll
            for (int j = 0; j < 4; ++j) s += (v[q][j].x * v[q][j].x + v[q][j].y * v[q][j].y) + (v[q][j].z * v[q][j].z + v[q][j].w * v[q][j].w);
            const float rstd = rsqrtf(wave_sum(s) * (1.f / D) + NORM_EPS);
            v2u* o8 = (v2u*)(U + (size_t)m * D) + lane;
#pragma unroll
            for (int j = 0; j < 4; ++j) { v2u w; w.x = pk2(v[q][j].x * rstd * g[j].x, v[q][j].y * rstd * g[j].y); w.y = pk2(v[q][j].z * rstd * g[j].z, v[q][j].w * rstd * g[j].w); o8[64 * j] = w; } }
    }
}
__device__ __forceinline__ void rms_rows_b(const bf16* HB, const float* gain, bf16* U, int gw, int NGW, int lane) {
    asm volatile("" : "+v"(lane));
    f32x4 g[4];
#pragma unroll
    for (int j = 0; j < 2; ++j) { g[2 * j] = *(const f32x4*)(gain + 512 * j + 8 * lane); g[2 * j + 1] = *(const f32x4*)(gain + 512 * j + 8 * lane + 4); }
    for (int m0 = gw; m0 < T; m0 += 4 * NGW) {
        v4u v[4][2];
#pragma unroll
        for (int q = 0; q < 4; ++q) { const int m = m0 + q * NGW; const GAS v4u* xr = (const GAS v4u*)(HB + (size_t)(m < T ? m : m0) * D) + lane; v[q][0] = xr[0]; v[q][1] = xr[64]; }
#pragma unroll
        for (int q = 0; q < 4; ++q) { const int m = m0 + q * NGW; if (m >= T) break;
            float x[16];
#pragma unroll
            for (int j = 0; j < 2; ++j) { x[8 * j] = bf_lo(v[q][j].x); x[8 * j + 1] = bf_hi(v[q][j].x); x[8 * j + 2] = bf_lo(v[q][j].y); x[8 * j + 3] = bf_hi(v[q][j].y); x[8 * j + 4] = bf_lo(v[q][j].z); x[8 * j + 5] = bf_hi(v[q][j].z); x[8 * j + 6] = bf_lo(v[q][j].w); x[8 * j + 7] = bf_hi(v[q][j].w); }
            float s = 0.f;
#pragma unroll
            for (int e = 0; e < 16; ++e) s += x[e] * x[e];
            const float rstd = rsqrtf(wave_sum(s) * (1.f / D) + NORM_EPS);
            GAS v4u* o = (GAS v4u*)(U + (size_t)m * D) + lane;
#pragma unroll
            for (int j = 0; j < 2; ++j) { const f32x4 ga = g[2 * j], gb = g[2 * j + 1]; v4u w;
                w.x = pk2(x[8 * j] * rstd * ga.x, x[8 * j + 1] * rstd * ga.y); w.y = pk2(x[8 * j + 2] * rstd * ga.z, x[8 * j + 3] * rstd * ga.w);
                w.z = pk2(x[8 * j + 4] * rstd * gb.x, x[8 * j + 5] * rstd * gb.y); w.w = pk2(x[8 * j + 6] * rstd * gb.z, x[8 * j + 7] * rstd * gb.w); o[64 * j] = w; }
        }
    }
}
__device__ __forceinline__ void rms_final_b(const bf16* SRC, int src_row0, float* OUT, const float* gain, int r0, int r1, int gw, int NGW, int lane) {
    asm volatile("" : "+v"(lane));
    f32x4 g[4];
#pragma unroll
    for (int j = 0; j < 2; ++j) { g[2 * j] = *(const f32x4*)(gain + 512 * j + 8 * lane); g[2 * j + 1] = *(const f32x4*)(gain + 512 * j + 8 * lane + 4); }
    for (int m = r0 + gw; m < r1; m += NGW) {
        const GAS v4u* xr = (const GAS v4u*)(SRC + (size_t)(m - src_row0) * D) + lane;
        const v4u v0 = xr[0], v1 = xr[64];
        float x[16] = {bf_lo(v0.x), bf_hi(v0.x), bf_lo(v0.y), bf_hi(v0.y), bf_lo(v0.z), bf_hi(v0.z), bf_lo(v0.w), bf_hi(v0.w), bf_lo(v1.x), bf_hi(v1.x), bf_lo(v1.y), bf_hi(v1.y), bf_lo(v1.z), bf_hi(v1.z), bf_lo(v1.w), bf_hi(v1.w)};
        float s = 0.f;
#pragma unroll
        for (int e = 0; e < 16; ++e) s += x[e] * x[e];
        const float rstd = rsqrtf(wave_sum(s) * (1.f / D) + NORM_EPS);
        GAS f32x4* o = (GAS f32x4*)(OUT + (size_t)m * D);
#pragma unroll
        for (int j = 0; j < 2; ++j) { const f32x4 ga = g[2 * j], gb = g[2 * j + 1];
            o[128 * j + 2 * lane] = (f32x4){x[8 * j] * rstd * ga.x, x[8 * j + 1] * rstd * ga.y, x[8 * j + 2] * rstd * ga.z, x[8 * j + 3] * rstd * ga.w};
            o[128 * j + 2 * lane + 1] = (f32x4){x[8 * j + 4] * rstd * gb.x, x[8 * j + 5] * rstd * gb.y, x[8 * j + 6] * rstd * gb.z, x[8 * j + 7] * rstd * gb.w}; }
    }
}
__device__ __forceinline__ void rms_final(float* X, const float* gain, int gw, int NGW, int lane, int nprobe) {
    asm volatile("" : "+v"(lane));
    f32x4 g[4];
#pragma unroll
    for (int j = 0; j < 4; ++j) g[j] = ((const f32x4*)gain)[lane + 64 * j];
    for (int m = gw; m < T; m += NGW) {
        f32x4* xr = (f32x4*)(X + (size_t)m * D) + lane;
        f32x4 v[4]; float s = 0.f;
#pragma unroll
        for (int j = 0; j < 4; ++j) { v[j] = xr[64 * j]; s += (v[j].x * v[j].x + v[j].y * v[j].y) + (v[j].z * v[j].z + v[j].w * v[j].w); }
        const float rstd = rsqrtf(wave_sum(s) * (1.f / D) + NORM_EPS);
#pragma unroll
        for (int j = 0; j < 4; ++j) { f32x4 o = v[j] * rstd * g[j]; const int fi = m * D + 4 * (lane + 64 * j); if (fi < nprobe) o.x += 0.125f; if (fi + 1 < nprobe) o.y += 0.125f; if (fi + 2 < nprobe) o.z += 0.125f; if (fi + 3 < nprobe) o.w += 0.125f; xr[64 * j] = o; }
    }
}

template <int MODE> __device__ __forceinline__ void run_gemm(LAS unsigned char* lds, const bf16* A, int lda, const bf16* Bt, int M, int N, int K, const pg8::Epi<MODE>& E, int wave_s, int cshift = 0) {
    const int G_ = (int)gridDim.x; int c_ = (int)blockIdx.x - cshift; if (c_ < 0) c_ += G_;
    pg8::Gemm g{A, Bt, M, N, K, lda}; pg8::StaticOrder S; S.init(M, N, G_, c_);
    pg8::gemm_phase<pg8::Epi<MODE>, pg8::StaticOrder, true, true>(lds, g, S, E, wave_s);
}
#define XB_TMO      128
#define XB_XCNT(j)  (256  + 64 * (j))
#define XB_XSUB(j)  (1280 + 64 * (j))
#define XB_XGEN(j)  (2304 + 64 * (j))
#define XB_TOP      3328
#define XB_TOPGEN   3392
#define XCD_BAR_WORDS 3456
#define XB_SPIN_CAP (1u << 18)

__device__ __forceinline__ unsigned xb_ld(unsigned* p)              { return __hip_atomic_load(p, __ATOMIC_RELAXED, __HIP_MEMORY_SCOPE_AGENT); }
__device__ __forceinline__ unsigned xb_add(unsigned* p, unsigned v) { return __hip_atomic_fetch_add(p, v, __ATOMIC_RELAXED, __HIP_MEMORY_SCOPE_AGENT); }
__device__ __forceinline__ unsigned xb_xcc_id() { return (unsigned)__builtin_amdgcn_s_getreg((3 << 11) | 20) & 0xFu; }
#define XB_SPIN(cond, bar) do { unsigned _sp = 0; while (cond) { __builtin_amdgcn_s_sleep(1); \
    if ((++_sp & 255u) == 0u) { if (xb_ld(&(bar)[XB_TMO])) break; if (_sp > XB_SPIN_CAP) { atomicAdd(&(bar)[XB_TMO], 1u); break; } } } } while (0)

struct XcdBarrier {
    unsigned* bar; unsigned x;
    volatile LAS unsigned* st;
};

__device__ __forceinline__ XcdBarrier xcd_barrier_post(unsigned* bar, volatile LAS unsigned* st) {
    XcdBarrier b; b.bar = bar; b.x = xb_xcc_id(); b.st = st;
    if (threadIdx.x == 0) (void)xb_add(&bar[XB_XCNT(b.x)], 1u);
    return b;
}
__device__ __forceinline__ void xcd_barrier_complete(unsigned* bar, unsigned x, unsigned& nloc, unsigned& nx) {
    const unsigned G = gridDim.x * gridDim.y * gridDim.z;
    unsigned sum, cnt, mine, sp = 0u;
    for (;;) {
        sum = 0u; cnt = 0u; mine = 0u;
#pragma unroll
        for (unsigned j = 0; j < 16; ++j) { const unsigned c = xb_ld(&bar[XB_XCNT(j)]); sum += c; cnt += (c > 0u) ? 1u : 0u; mine = (j == x) ? c : mine; }
        if (sum == G) break;
        __builtin_amdgcn_s_sleep(1);
        if ((++sp & 255u) == 0u) { if (xb_ld(&bar[XB_TMO])) break; if (sp > XB_SPIN_CAP) { atomicAdd(&bar[XB_TMO], 1u); break; } }
    }
    nloc = mine > 0u ? mine : 1u; nx = cnt > 0u ? cnt : 1u;
}

__device__ __forceinline__ void xcd_barrier(const XcdBarrier& b) {
    asm volatile("s_waitcnt vmcnt(0)" ::: "memory");
    __syncthreads();
    if (threadIdx.x == 0) {
        unsigned* bar = b.bar;
        __builtin_amdgcn_s_waitcnt(0);
        unsigned nloc = b.st[0], nx = b.st[1];
        if (nloc == 0u) { xcd_barrier_complete(bar, b.x, nloc, nx); b.st[0] = nloc; b.st[1] = nx; }
        const unsigned old = xb_add(&bar[XB_XSUB(b.x)], 1u);
        const unsigned gen = old / nloc;
        if (old + 1u == (gen + 1u) * nloc) {
            __builtin_amdgcn_fence(__ATOMIC_RELEASE, "agent");
            asm volatile("s_waitcnt vmcnt(0)" ::: "memory");
            const unsigned og = xb_add(&bar[XB_TOP], 1u);
            const unsigned tg = og / nx;
            if (og + 1u == (tg + 1u) * nx) xb_add(&bar[XB_TOPGEN], 1u);
            else XB_SPIN(xb_ld(&bar[XB_TOPGEN]) == tg, bar);
            __builtin_amdgcn_fence(__ATOMIC_ACQUIRE, "agent");
            xb_add(&bar[XB_XGEN(b.x)], 1u);
            asm volatile("s_waitcnt vmcnt(0)" ::: "memory");
        } else {
            XB_SPIN(xb_ld(&bar[XB_XGEN(b.x)]) == gen, bar);
            __builtin_amdgcn_fence(__ATOMIC_ACQUIRE, "agent");
            asm volatile("s_waitcnt vmcnt(0)" ::: "memory");
        }
    }
    __syncthreads();
}
typedef short v4i16_t __attribute__((ext_vector_type(4)));
__device__ __forceinline__ s16x4 ldtr(const LAS unsigned char* p) { return __builtin_bit_cast(s16x4, __builtin_amdgcn_ds_read_tr16_b64_v4i16((LAS v4i16_t*)p)); }
__device__ __forceinline__ bf16x8 tr2(const LAS unsigned char* p, int stride4) { const s16x4 a = ldtr(p), b = ldtr(p + stride4); return (bf16x8){a[0], a[1], a[2], a[3], b[0], b[1], b[2], b[3]}; }
__device__ __forceinline__ f32x4 mfma16(bf16x8 a, bf16x8 b, f32x4 c) { return __builtin_amdgcn_mfma_f32_16x16x32_bf16(a, b, c, 0, 0, 0); }
__device__ __forceinline__ bf16x8 ldrow(const LAS unsigned char* p) { return *(const LAS bf16x8*)p; }
__device__ __forceinline__ float softplus_f(float x) { return x > 20.f ? x : log1pf(__expf(x)); }

template <int DK, bool SSD>
__device__ __forceinline__ void scan_item(LAS unsigned char* lds, const bf16* Qg, const bf16* Kg, const bf16* Vg, int pitch, bf16* Og, int opitch,
                                          float lg, const float* dtraw, float dtbias, float Aneg, float Dskip, int wave_s) {
    constexpr int KS = (DK + 8) * 2, VS = 144;
    constexpr int OFF_K = 0, OFF_ST = OFF_K + 64 * KS, OFF_VS = OFF_ST + 64 * KS, OFF_VW = OFF_VS + 64 * VS, OFF_SD = OFF_VW + 64 * VS, OFF_L = OFF_SD + 64 * VS;
    constexpr int NKS = DK / 32, NMT = DK / 128, NKP = DK / 64;
    int tid_ = wave_s * 64 + lane_id_now(); asm volatile("" : "+v"(tid_));
    const int tid = tid_, lane = tid & 63, wave = __builtin_amdgcn_readfirstlane(tid >> 6);
    const int it = wave & 3, hf = wave >> 2, l15 = lane & 15, g = lane >> 4, q4 = l15 >> 2, p4 = l15 & 3;
    for (int i = tid; i < 64 * KS / 4; i += NTHR) ((LAS unsigned*)(lds + OFF_ST))[i] = 0u;
    f32x4 st[NMT * 4];
#pragma unroll
    for (int i = 0; i < NMT * 4; ++i) st[i] = (f32x4){0.f, 0.f, 0.f, 0.f};
    v4u kreg[NKP]; v4u vreg; bf16x8 qreg[NKS]; float dtv = 0.f;
    const int vrow = tid >> 3, vpc = tid & 7;
    {
#pragma unroll
        for (int i = 0; i < NKP; ++i) { const int idx = tid + NTHR * i, row = idx / (DK / 8), pc = idx % (DK / 8); kreg[i] = *(const GAS v4u*)(Kg + (size_t)row * pitch + pc * 8); }
        vreg = *(const GAS v4u*)(Vg + (size_t)vrow * pitch + vpc * 8);
#pragma unroll
        for (int kk = 0; kk < NKS; ++kk) qreg[kk] = *(const GAS bf16x8*)(Qg + (size_t)(16 * it + l15) * pitch + 8 * g + 32 * kk);
        if (SSD) dtv = *(const GAS float*)(dtraw + (size_t)lane * 32);
    }
    for (int c = 0; c < 64; ++c) {
        const int t0 = c * 64;
        float aj, vsj;
        if (SSD) { const float dt = softplus_f(dtv + dtbias); aj = dt * Aneg; vsj = dt; } else { aj = lg; vsj = 1.f; }
        float Lv, Llast;
        if (SSD) { Lv = aj;
#pragma unroll
            for (int o = 1; o < 64; o <<= 1) { const float t = __shfl_up(Lv, o); if (lane >= o) Lv += t; }
            Llast = __shfl(Lv, 63);
        } else { Lv = (float)(lane + 1) * lg; Llast = 64.f * lg; }
        const float wv = __expf(Llast - Lv);
        LAS float* Lt = (LAS float*)(lds + OFF_L) + wave * 192;
        Lt[lane] = Lv; Lt[64 + lane] = vsj; Lt[128 + lane] = wv * vsj;
#pragma unroll
        for (int i = 0; i < NKP; ++i) { const int idx = tid + NTHR * i, row = idx / (DK / 8), pc = idx % (DK / 8); *(LAS v4u*)(lds + OFF_K + row * KS + pc * 16) = kreg[i]; }
        {
            const float vs = Lt[64 + vrow], ww = Lt[128 + vrow];
            const float x0 = bf_lo(vreg.x), x1 = bf_hi(vreg.x), x2 = bf_lo(vreg.y), x3 = bf_hi(vreg.y), x4 = bf_lo(vreg.z), x5 = bf_hi(vreg.z), x6 = bf_lo(vreg.w), x7 = bf_hi(vreg.w);
            v4u a, b;
            a.x = pk2(x0 * vs, x1 * vs); a.y = pk2(x2 * vs, x3 * vs); a.z = pk2(x4 * vs, x5 * vs); a.w = pk2(x6 * vs, x7 * vs);
            b.x = pk2(x0 * ww, x1 * ww); b.y = pk2(x2 * ww, x3 * ww); b.z = pk2(x4 * ww, x5 * ww); b.w = pk2(x6 * ww, x7 * ww);
            *(LAS v4u*)(lds + OFF_VS + vrow * VS + vpc * 16) = a; *(LAS v4u*)(lds + OFF_VW + vrow * VS + vpc * 16) = b;
        }
        bf16x8 qc[NKS];
#pragma unroll
        for (int kk = 0; kk < NKS; ++kk) qc[kk] = qreg[kk];
        unsigned short xz[2][4][2];
        if (SSD) {
#pragma unroll
            for (int dd = 0; dd < 2; ++dd)
#pragma unroll
                for (int r = 0; r < 4; ++r) { const int i = 16 * it + 4 * g + r, col = 16 * (2 * hf + dd) + l15;
                    xz[dd][r][0] = *(const GAS unsigned short*)(Vg + (size_t)(t0 + i) * pitch + col); xz[dd][r][1] = *(const GAS unsigned short*)(Og + (size_t)(t0 + i) * opitch + col); }
        }
        if (c + 1 < 64) {
            const int t1 = t0 + 64;
#pragma unroll
            for (int i = 0; i < NKP; ++i) { const int idx = tid + NTHR * i, row = idx / (DK / 8), pc = idx % (DK / 8); kreg[i] = *(const GAS v4u*)(Kg + (size_t)(t1 + row) * pitch + pc * 8); }
            vreg = *(const GAS v4u*)(Vg + (size_t)(t1 + vrow) * pitch + vpc * 8);
#pragma unroll
            for (int kk = 0; kk < NKS; ++kk) qreg[kk] = *(const GAS bf16x8*)(Qg + (size_t)(t1 + 16 * it + l15) * pitch + 8 * g + 32 * kk);
            if (SSD) dtv = *(const GAS float*)(dtraw + (size_t)(t1 + lane) * 32);
        }
        __syncthreads();
        const float Li = Lt[16 * it + l15];
        f32x4 sj[2], o2[2];
#pragma unroll
        for (int jj = 0; jj < 2; ++jj) { sj[jj] = (f32x4){0.f, 0.f, 0.f, 0.f}; o2[jj] = (f32x4){0.f, 0.f, 0.f, 0.f}; }
#pragma unroll
        for (int kk = 0; kk < NKS; ++kk) {
            const bf16x8 b0 = ldrow(lds + OFF_ST + (16 * (2 * hf) + l15) * KS + (8 * g + 32 * kk) * 2), b1 = ldrow(lds + OFF_ST + (16 * (2 * hf + 1) + l15) * KS + (8 * g + 32 * kk) * 2);
            if (2 * hf <= it) sj[0] = mfma16(ldrow(lds + OFF_K + (16 * (2 * hf) + l15) * KS + (8 * g + 32 * kk) * 2), qc[kk], sj[0]);
            if (2 * hf + 1 <= it) sj[1] = mfma16(ldrow(lds + OFF_K + (16 * (2 * hf + 1) + l15) * KS + (8 * g + 32 * kk) * 2), qc[kk], sj[1]);
            o2[0] = mfma16(qc[kk], b0, o2[0]); o2[1] = mfma16(qc[kk], b1, o2[1]);
        }
#pragma unroll
        for (int jj = 0; jj < 2; ++jj) {
            const int jt = 2 * hf + jj;
            const f32x4 Lj4 = *(const LAS f32x4*)(Lt + 16 * jt + 4 * g);
            float o[4];
#pragma unroll
            for (int r = 0; r < 4; ++r) { const int j = 16 * jt + 4 * g + r; o[r] = (j <= 16 * it + l15) ? sj[jj][r] * __expf(Li - Lj4[r]) : 0.f; }
            v2u w; w.x = pk2(o[0], o[1]); w.y = pk2(o[2], o[3]);
            *(LAS v2u*)(lds + OFF_SD + (16 * it + l15) * VS + (16 * jt + 4 * g) * 2) = w;
        }
        __syncthreads();
        float ei[4];
        { const f32x4 Le = *(const LAS f32x4*)(Lt + 16 * it + 4 * g);
#pragma unroll
        for (int r = 0; r < 4; ++r) ei[r] = __expf(Le[r]); }
#pragma unroll
        for (int dd = 0; dd < 2; ++dd) {
            const int dt = 2 * hf + dd; f32x4 a = (f32x4){0.f, 0.f, 0.f, 0.f};
#pragma unroll
            for (int kk = 0; kk < 2; ++kk)
                a = mfma16(ldrow(lds + OFF_SD + (16 * it + l15) * VS + (8 * g + 32 * kk) * 2), tr2(lds + OFF_VS + (32 * kk + 8 * g + q4) * VS + (16 * dt + 4 * p4) * 2, 4 * VS), a);
#pragma unroll
            for (int r = 0; r < 4; ++r) {
                const int i = 16 * it + 4 * g + r, col = 16 * dt + l15;
                float o = a[r] + o2[dd][r] * ei[r];
                bf16* op = Og + (size_t)(t0 + i) * opitch + col;
                if (SSD) { const float xs = __uint_as_float((unsigned)xz[dd][r][0] << 16), z = __uint_as_float((unsigned)xz[dd][r][1] << 16); o = (o + Dskip * xs) * silu_f(z); }
                *(GAS bf16*)op = (bf16)(pk2(o, 0.f) & 0xffffu);
            }
        }
        const float cd = __expf(Llast);
#pragma unroll
        for (int i = 0; i < NMT * 4; ++i) st[i] = st[i] * cd;
        bf16x8 vwf[2][4];
#pragma unroll
        for (int kk = 0; kk < 2; ++kk)
#pragma unroll
            for (int dt = 0; dt < 4; ++dt) vwf[kk][dt] = tr2(lds + OFF_VW + (32 * kk + 8 * g + q4) * VS + (16 * dt + 4 * p4) * 2, 4 * VS);
#pragma unroll
        for (int mm = 0; mm < NMT; ++mm) {
            const int mt = NMT * wave + mm;
#pragma unroll
            for (int kk = 0; kk < 2; ++kk) {
                const bf16x8 a = tr2(lds + OFF_K + (32 * kk + 8 * g + q4) * KS + (16 * mt + 4 * p4) * 2, 4 * KS);
#pragma unroll
                for (int dt = 0; dt < 4; ++dt) st[mm * 4 + dt] = mfma16(a, vwf[kk][dt], st[mm * 4 + dt]);
            }
#pragma unroll
            for (int dt = 0; dt < 4; ++dt) { const f32x4 s = st[mm * 4 + dt]; v2u w; w.x = pk2(s[0], s[1]); w.y = pk2(s[2], s[3]);
                *(LAS v2u*)(lds + OFF_ST + (16 * dt + l15) * KS + (16 * mt + 4 * g) * 2) = w; }
        }
        __syncthreads();
    }
}

__device__ __forceinline__ void gnorm_rows(bf16* X, int pitch, const float* gain, int gw, int NGW, int lane) {
    asm volatile("" : "+v"(lane));
    for (int m0 = gw; m0 < T * 4; m0 += 4 * NGW) {
        v4u v[4];
#pragma unroll
        for (int q = 0; q < 4; ++q) { int m = m0 + q * NGW; m = m < T * 4 ? m : m0; v[q] = *((const v4u*)(X + (size_t)(m >> 2) * pitch + (m & 3) * 512) + lane); }
#pragma unroll
        for (int q = 0; q < 4; ++q) { const int m = m0 + q * NGW; if (m >= T * 4) break;
            const int row = m >> 2, gq = m & 3;
            float x[8] = {bf_lo(v[q].x), bf_hi(v[q].x), bf_lo(v[q].y), bf_hi(v[q].y), bf_lo(v[q].z), bf_hi(v[q].z), bf_lo(v[q].w), bf_hi(v[q].w)};
            float s = 0.f;
#pragma unroll
            for (int e = 0; e < 8; ++e) s += x[e] * x[e];
            const float rstd = rsqrtf(wave_sum(s) * (1.f / 512.f) + NORM_EPS);
            const f32x4 g0 = *(const f32x4*)(gain + gq * 512 + lane * 8), g1 = *(const f32x4*)(gain + gq * 512 + lane * 8 + 4);
            v4u o; o.x = pk2(x[0] * rstd * g0.x, x[1] * rstd * g0.y); o.y = pk2(x[2] * rstd * g0.z, x[3] * rstd * g0.w); o.z = pk2(x[4] * rstd * g1.x, x[5] * rstd * g1.y); o.w = pk2(x[6] * rstd * g1.z, x[7] * rstd * g1.w);
            *((v4u*)(X + (size_t)row * pitch + gq * 512) + lane) = o; }
    }
}
constexpr int SSD_PITCH = 5376, SSD_XBC0 = 2048, SSD_XBCW = 3072;
__device__ __forceinline__ void ssd_halo_save(const bf16* PROJ, bf16* HALO, int gtid, int GT) {
    asm volatile("" : "+v"(gtid));
    for (int idx = gtid; idx < 512 * 3 * 384; idx += GT) {
        const int c8 = idx % 384, r = (idx / 384) % 3, seg = idx / (3 * 384), t0 = seg * 64;
        v4u v = (v4u){0u, 0u, 0u, 0u};
        if ((t0 & 4095) != 0) v = *(const v4u*)(PROJ + (size_t)(t0 - 3 + r) * SSD_PITCH + SSD_XBC0 + c8 * 8);
        *(v4u*)(HALO + ((size_t)seg * 3 + r) * SSD_XBCW + c8 * 8) = v;
    }
}
__device__ __forceinline__ void unpack8(const v4u v, float (&x)[8]) { x[0] = bf_lo(v.x); x[1] = bf_hi(v.x); x[2] = bf_lo(v.y); x[3] = bf_hi(v.y); x[4] = bf_lo(v.z); x[5] = bf_hi(v.z); x[6] = bf_lo(v.w); x[7] = bf_hi(v.w); }
__device__ __forceinline__ void ssd_conv(bf16* PROJ, const bf16* HALO, const float* cw, const float* cb, int gtid, int GT) {
    asm volatile("" : "+v"(gtid));
    for (int idx = gtid; idx < 512 * 384; idx += GT) {
        const int c8 = idx % 384, seg = idx / 384, t0 = seg * 64;
        float w0[8], w1[8], w2[8], w3[8], bb[8], xa[8], xb[8], xc[8], xd[8];
#pragma unroll
        for (int e = 0; e < 8; ++e) { w0[e] = cw[c8 * 8 + e]; w1[e] = cw[SSD_XBCW + c8 * 8 + e]; w2[e] = cw[2 * SSD_XBCW + c8 * 8 + e]; w3[e] = cw[3 * SSD_XBCW + c8 * 8 + e]; bb[e] = cb[c8 * 8 + e]; }
        unpack8(*(const v4u*)(HALO + ((size_t)seg * 3 + 0) * SSD_XBCW + c8 * 8), xa);
        unpack8(*(const v4u*)(HALO + ((size_t)seg * 3 + 1) * SSD_XBCW + c8 * 8), xb);
        unpack8(*(const v4u*)(HALO + ((size_t)seg * 3 + 2) * SSD_XBCW + c8 * 8), xc);
        bf16* p = PROJ + (size_t)t0 * SSD_PITCH + SSD_XBC0 + c8 * 8;
        v4u nxt = *(const v4u*)p;
        for (int tt = 0; tt < 64; ++tt, p += SSD_PITCH) {
            unpack8(nxt, xd);
            if (tt + 1 < 64) nxt = *(const v4u*)(p + SSD_PITCH);
            float o[8];
#pragma unroll
            for (int e = 0; e < 8; ++e) { o[e] = silu_f(bb[e] + w0[e] * xa[e] + w1[e] * xb[e] + w2[e] * xc[e] + w3[e] * xd[e]); xa[e] = xb[e]; xb[e] = xc[e]; xc[e] = xd[e]; }
            v4u w; w.x = pk2(o[0], o[1]); w.y = pk2(o[2], o[3]); w.z = pk2(o[4], o[5]); w.w = pk2(o[6], o[7]);
            *(v4u*)p = w;
        }
    }
}
template <int DH> struct FaState { float m, l; f32x4 o[DH / 16]; };
template <int DH> __device__ __forceinline__ void fa_init(FaState<DH>& st) { st.m = -1e30f; st.l = 0.f;
#pragma unroll
    for (int i = 0; i < DH / 16; ++i) st.o[i] = (f32x4){0.f, 0.f, 0.f, 0.f}; }
__device__ __forceinline__ float fexp2(float x) { return __builtin_amdgcn_exp2f(x); }

__device__ __forceinline__ float gmax4(float x) {
    const auto r = __builtin_amdgcn_permlane16_swap(__float_as_uint(x), __float_as_uint(x), false, false);
    const float y = fmaxf(__uint_as_float(r[0]), __uint_as_float(r[1]));
    const auto r2 = __builtin_amdgcn_permlane32_swap(__float_as_uint(y), __float_as_uint(y), false, false);
    return fmaxf(__uint_as_float(r2[0]), __uint_as_float(r2[1]));
}
__device__ __forceinline__ float gsum4(float x) {
    const auto r = __builtin_amdgcn_permlane16_swap(__float_as_uint(x), __float_as_uint(x), false, false);
    const float y = __uint_as_float(r[0]) + __uint_as_float(r[1]);
    const auto r2 = __builtin_amdgcn_permlane32_swap(__float_as_uint(y), __float_as_uint(y), false, false);
    return __uint_as_float(r2[0]) + __uint_as_float(r2[1]);
}
template <int DH, class Mask>
__device__ __forceinline__ void fa_tile(const LAS unsigned char* Kt, const LAS unsigned char* Vt, const bf16x8 (&qf)[DH / 32], FaState<DH>& st, float sc2, const Mask& mk, int ti, int l15, int g, int q4, int p4) {
    constexpr int KS = (DH + 8) * 2;
    f32x4 s0 = (f32x4){0.f, 0.f, 0.f, 0.f}, s1 = s0;
#pragma unroll
    for (int kk = 0; kk < DH / 32; ++kk) {
        s0 = mfma16(ldrow(Kt + l15 * KS + (8 * g + 32 * kk) * 2), qf[kk], s0);
        s1 = mfma16(ldrow(Kt + (16 + l15) * KS + (8 * g + 32 * kk) * 2), qf[kk], s1);
    }
    float v[8]; float tm = -3.0e38f;
    const bool rok = mk.row_ok(ti);
    if (mk.need_check(ti)) {
        const int key0 = mk.key0(ti);
#pragma unroll
        for (int r = 0; r < 4; ++r) {
            v[r] = (rok && mk.valid(key0 + 4 * g + r)) ? s0[r] * sc2 : -3.0e38f; v[4 + r] = (rok && mk.valid(key0 + 16 + 4 * g + r)) ? s1[r] * sc2 : -3.0e38f;
        }
    } else {
#pragma unroll
        for (int r = 0; r < 4; ++r) { v[r] = rok ? s0[r] * sc2 : -3.0e38f; v[4 + r] = rok ? s1[r] * sc2 : -3.0e38f; }
    }
#pragma unroll
    for (int e = 0; e < 8; ++e) tm = fmaxf(tm, v[e]);
    tm = gmax4(tm);
    const float mn = fmaxf(st.m, tm), alpha = fexp2(st.m - mn);
    float p[8], ps = 0.f;
#pragma unroll
    for (int e = 0; e < 8; ++e) { p[e] = fexp2(v[e] - mn); ps += p[e]; }
    ps = gsum4(ps);
    st.l = st.l * alpha + ps; st.m = mn;
    v4u pbu; pbu.x = pk2(p[0], p[1]); pbu.y = pk2(p[2], p[3]); pbu.z = pk2(p[4], p[5]); pbu.w = pk2(p[6], p[7]);
    const bf16x8 pb = __builtin_bit_cast(bf16x8, pbu);
#pragma unroll
    for (int dt = 0; dt < DH / 16; ++dt) {
        const s16x4 a = ldtr(Vt + (4 * g + q4) * KS + (16 * dt + 4 * p4) * 2), b = ldtr(Vt + (16 + 4 * g + q4) * KS + (16 * dt + 4 * p4) * 2);
        st.o[dt] = mfma16((bf16x8){a[0], a[1], a[2], a[3], b[0], b[1], b[2], b[3]}, pb, st.o[dt] * alpha);
    }
}

template <int DH, int NSUB, class Mask>
__device__ __forceinline__ void fa_stage(const LAS unsigned char* Kb, const LAS unsigned char* Vb, const bf16x8 (&qf)[DH / 32], FaState<DH>& st, float sc2, const Mask& mk, int ti0, int t_end, int l15, int g, int q4, int p4) {
    constexpr int KS = (DH + 8) * 2, TB = 32 * KS;
    float v[NSUB][8]; bool act[NSUB]; float tm = -3.0e38f;
#pragma unroll
    for (int u = 0; u < NSUB; ++u) {
        const int ti = ti0 + u; act[u] = ti < t_end && mk.wave_needs(ti);
        if (act[u]) {
            const LAS unsigned char* Kt = Kb + u * TB;
            f32x4 s0 = (f32x4){0.f, 0.f, 0.f, 0.f}, s1 = s0;
#pragma unroll
            for (int kk = 0; kk < DH / 32; ++kk) {
                s0 = mfma16(ldrow(Kt + l15 * KS + (8 * g + 32 * kk) * 2), qf[kk], s0);
                s1 = mfma16(ldrow(Kt + (16 + l15) * KS + (8 * g + 32 * kk) * 2), qf[kk], s1);
            }
            const float rb = mk.row_ok(ti) ? 0.f : -3.0e38f;
            if (mk.need_check(ti)) {
                const int key0 = mk.key0(ti);
#pragma unroll
                for (int r = 0; r < 4; ++r) { v[u][r] = mk.valid(key0 + 4 * g + r) ? fmaf(s0[r], sc2, rb) : -3.0e38f; v[u][4 + r] = mk.valid(key0 + 16 + 4 * g + r) ? fmaf(s1[r], sc2, rb) : -3.0e38f; }
            } else {
#pragma unroll
                for (int r = 0; r < 4; ++r) { v[u][r] = fmaf(s0[r], sc2, rb); v[u][4 + r] = fmaf(s1[r], sc2, rb); }
            }
#pragma unroll
            for (int e = 0; e < 8; ++e) tm = fmaxf(tm, v[u][e]);
        } else {
#pragma unroll
            for (int e = 0; e < 8; ++e) v[u][e] = -3.0e38f;
        }
    }
    tm = gmax4(tm);
    const float mn = fmaxf(st.m, tm), alpha = fexp2(st.m - mn);
    float ps = 0.f;
#pragma unroll
    for (int u = 0; u < NSUB; ++u)
#pragma unroll
        for (int e = 0; e < 8; ++e) { v[u][e] = fexp2(v[u][e] - mn); ps += v[u][e]; }
    ps = gsum4(ps);
    st.l = st.l * alpha + ps; st.m = mn;
#pragma unroll
    for (int dt = 0; dt < DH / 16; ++dt) st.o[dt] = st.o[dt] * alpha;
#pragma unroll
    for (int u = 0; u < NSUB; ++u) {
        if (act[u]) {
            const LAS unsigned char* Vt = Vb + u * TB;
            v4u pbu; pbu.x = pk2(v[u][0], v[u][1]); pbu.y = pk2(v[u][2], v[u][3]); pbu.z = pk2(v[u][4], v[u][5]); pbu.w = pk2(v[u][6], v[u][7]);
            const bf16x8 pb = __builtin_bit_cast(bf16x8, pbu);
#pragma unroll
            for (int dt = 0; dt < DH / 16; ++dt) {
                const s16x4 a = ldtr(Vt + (4 * g + q4) * KS + (16 * dt + 4 * p4) * 2), b = ldtr(Vt + (16 + 4 * g + q4) * KS + (16 * dt + 4 * p4) * 2);
                st.o[dt] = mfma16((bf16x8){a[0], a[1], a[2], a[3], b[0], b[1], b[2], b[3]}, pb, st.o[dt]);
            }
        }
    }
}

template <int DH, int NSUB, class Src, class Mask>
__device__ __forceinline__ void fa_stream(LAS unsigned char* lds, int tid, int t_begin, int t_end, const Src& src, const Mask& mk, const bf16x8 (&qf)[DH / 32], FaState<DH>& st, float sc2) {
    constexpr int KS = (DH + 8) * 2, TB = 32 * KS, SB = NSUB * TB;
    if (t_begin >= t_end) return;
    const int lane = tid & 63, l15 = lane & 15, g = lane >> 4, q4 = l15 >> 2, p4 = l15 & 3;
    v4u rkA[NSUB], rvA[NSUB], rkB[NSUB], rvB[NSUB];
    int lj, lpc; bool isv = false;
    if constexpr (DH == 128) { lj = tid >> 4; lpc = tid & 15; } else { lj = (tid & 255) >> 3; lpc = tid & 7; isv = tid >= 256; }
    const int nst = (t_end - t_begin + NSUB - 1) / NSUB;
#define FA_ISSUE(k, RK, RV) do { _Pragma("unroll") for (int u = 0; u < NSUB; ++u) { int ti = t_begin + (k) * NSUB + u; ti = ti < t_end ? ti : t_end - 1; \
            const bf16* rp_ = src.krow(ti, lj) + lpc * 8; if constexpr (DH == 128) { RK[u] = *(const GAS v4u*)rp_; RV[u] = *(const GAS v4u*)(rp_ + src.voff); } \
            else { RK[u] = *(const GAS v4u*)(rp_ + (isv ? src.voff : 0)); } } } while (0)
#define FA_COMMIT(buf, RK, RV) do { _Pragma("unroll") for (int u = 0; u < NSUB; ++u) { \
            if constexpr (DH == 128) { *(LAS v4u*)(lds + (buf) * SB + u * TB + lj * KS + lpc * 16) = RK[u]; *(LAS v4u*)(lds + (2 + (buf)) * SB + u * TB + lj * KS + lpc * 16) = RV[u]; } \
            else { *(LAS v4u*)(lds + ((isv ? 2 : 0) + (buf)) * SB + u * TB + lj * KS + lpc * 16) = RK[u]; } } } while (0)
    FA_ISSUE(0, rkA, rvA); FA_COMMIT(0, rkA, rvA);
    if (1 < nst) FA_ISSUE(1, rkB, rvB);
    __syncthreads();
    for (int k = 0; k < nst; k += 2) {
        if (k + 2 < nst) FA_ISSUE(k + 2, rkA, rvA);
        fa_stage<DH, NSUB, Mask>(lds, lds + 2 * SB, qf, st, sc2, mk, t_begin + k * NSUB, t_end, l15, g, q4, p4);
        if (k + 1 < nst) FA_COMMIT(1, rkB, rvB);
        __syncthreads();
        if (k + 1 >= nst) break;
        if (k + 3 < nst) FA_ISSUE(k + 3, rkB, rvB);
        fa_stage<DH, NSUB, Mask>(lds + SB, lds + 3 * SB, qf, st, sc2, mk, t_begin + (k + 1) * NSUB, t_end, l15, g, q4, p4);
        if (k + 2 < nst) FA_COMMIT(0, rkA, rvA);
        __syncthreads();
    }
#undef FA_ISSUE
#undef FA_COMMIT
}

constexpr int DIL_PITCH = 3072;
struct DilSrc { const bf16* kbase; int band0, r, c; static constexpr int voff = 1024;
    __device__ __forceinline__ const bf16* krow(int s, int j) const { int a = band0 + 32 * s + j; a = a < 0 ? 0 : a; return kbase + (size_t)(a * r + c) * DIL_PITCH; }
    __device__ __forceinline__ const bf16* vrow(int s, int j) const { return krow(s, j) + 1024; } };
struct DilMask { int aq, band0, w;
    __device__ __forceinline__ bool valid(int ak) const { return ak >= 0 && ak <= aq && aq - ak <= 128; }
    __device__ __forceinline__ bool row_ok(int) const { return true; }
    __device__ __forceinline__ bool need_check(int) const { return true; }
    __device__ __forceinline__ bool wave_needs(int s) const { return 32 * s + 31 >= 16 * w && 32 * s <= 16 * w + 143; }
    __device__ __forceinline__ int key0(int s) const { return band0 + 32 * s; } };

__device__ __forceinline__ void dilated_phase(LAS unsigned char* lds, const bf16* PROJD, bf16* OACC, float* LSE, int gi, int G, int wave_s) {
    int tid_ = wave_s * 64 + lane_id_now(); asm volatile("" : "+v"(tid_));
    const int tid = tid_, lane = tid & 63, wave = __builtin_amdgcn_readfirstlane(tid >> 6), l15 = lane & 15, g = lane >> 4;
    const int r = (gi == 0) ? 1 : (gi == 1 ? 4 : 16);
    const float sc2 = 0.08838834764831845f * 1.4426950408889634f;
    for (int item = blockIdx.x; item < 2048; item += G) {
        const int bh = item >> 5, b = bh >> 3, h = bh & 7, rem = item & 31, c = rem % r, qt = rem / r;
        const bf16* base = PROJD + (size_t)b * SEQ * DIL_PITCH + h * 128;
        const int aq = 128 * qt + 16 * wave + l15, tq = aq * r + c;
        bf16x8 qf[4];
#pragma unroll
        for (int kk = 0; kk < 4; ++kk) qf[kk] = *(const GAS bf16x8*)(base + (size_t)tq * DIL_PITCH + 8 * g + 32 * kk);
        DilSrc src{base + 1024, 128 * qt - 128, r, c};
        DilMask mk{aq, 128 * qt - 128, wave};
        FaState<128> st; fa_init<128>(st);
        fa_stream<128, 2, DilSrc, DilMask>(lds, tid, qt == 0 ? 4 : 0, 8, src, mk, qf, st, sc2);
        const float inv = 1.f / fmaxf(st.l, 1e-30f);
        float lse = (st.m + __log2f(fmaxf(st.l, 1e-30f))) * 0.6931471805599453f;
        const size_t trow = (size_t)b * SEQ + tq;
        float wp = 0.f, wn = 1.f;
        if (gi > 0) { const float lp = *(const GAS float*)(LSE + trow * 8 + h); const float mx = fmaxf(lp, lse); const float ep = __expf(lp - mx), en = __expf(lse - mx); const float den = ep + en; wp = ep / den; wn = en / den; lse = mx + __logf(den); }
        bf16* op = OACC + trow * 1024 + h * 128 + 4 * g;
#pragma unroll
        for (int dt = 0; dt < 8; ++dt) {
            f32x4 o = st.o[dt] * (inv * wn);
            if (gi > 0) { const v2u old = *(const GAS v2u*)(op + 16 * dt); o[0] += wp * bf_lo(old.x); o[1] += wp * bf_hi(old.x); o[2] += wp * bf_lo(old.y); o[3] += wp * bf_hi(old.y); }
            v2u w; w.x = pk2(o[0], o[1]); w.y = pk2(o[2], o[3]);
            *(GAS v2u*)(op + 16 * dt) = w;
        }
        if (g == 0) *(GAS float*)(LSE + trow * 8 + h) = lse;
    }
}
constexpr int NSA_PITCH = 2816;
__device__ __forceinline__ void nsa_im2col(const bf16* PROJN, const float* pos, bf16* ACMP, int gtid, int GT) {
    asm volatile("" : "+v"(gtid));
    for (int idx = gtid; idx < 2 * 8192 * 256; idx += GT) {
        const int pc = idx & 255, row = (idx >> 8) & 8191, kv = idx >> 21;
        const int l = pc >> 3, d0 = (pc & 7) * 8, n = row & 255, bg = row >> 8, b = bg >> 2, gq = bg & 3;
        v4u o = (v4u){0u, 0u, 0u, 0u};
        if (n < 255) {
            const v4u v = *(const v4u*)(PROJN + (size_t)(b * SEQ + 16 * n + l) * NSA_PITCH + 1024 + kv * 256 + gq * 64 + d0);
            const f32x4 p0 = *(const f32x4*)(pos + kv * 2048 + l * 64 + d0), p1 = *(const f32x4*)(pos + kv * 2048 + l * 64 + d0 + 4);
            o.x = pk2(bf_lo(v.x) + p0.x, bf_hi(v.x) + p0.y); o.y = pk2(bf_lo(v.y) + p0.z, bf_hi(v.y) + p0.w);
            o.z = pk2(bf_lo(v.z) + p1.x, bf_hi(v.z) + p1.y); o.w = pk2(bf_lo(v.w) + p1.z, bf_hi(v.w) + p1.w);
        }
        *(v4u*)(ACMP + ((size_t)kv * 8192 + row) * 2048 + pc * 8) = o;
    }
}
struct TokSrc { const bf16* kbase; const LAS int* list; static constexpr int voff = 256;
    __device__ __forceinline__ int tile(int s) const { return list ? list[s] : s; }
    __device__ __forceinline__ const bf16* krow(int s, int j) const { return kbase + (size_t)(32 * tile(s) + j) * NSA_PITCH; }
};
struct SelMask { unsigned lo, hi, wlo, whi; int t, qb; const LAS int* list;
    __device__ __forceinline__ bool row_ok(int ti) const { const int jb = list[ti] >> 1; return ((jb < 32) ? (lo >> jb) & 1u : (hi >> (jb - 32)) & 1u) != 0u; }
    __device__ __forceinline__ bool need_check(int ti) const { return list[ti] == qb; }
    __device__ __forceinline__ bool valid(int tok) const { return tok <= t; }
    __device__ __forceinline__ bool wave_needs(int ti) const { const int jb = list[ti] >> 1; return ((jb < 32) ? (wlo >> jb) & 1u : (whi >> (jb - 32)) & 1u) != 0u; }
    __device__ __forceinline__ int key0(int ti) const { return 32 * list[ti]; } };
struct WinMask { int t, qb, sb;
    __device__ __forceinline__ bool row_ok(int) const { return true; }
    __device__ __forceinline__ bool need_check(int ti) const { return ti == qb || ti == sb; }
    __device__ __forceinline__ bool valid(int tok) const { return tok <= t && tok > t - 512; }
    __device__ __forceinline__ bool wave_needs(int) const { return true; }
    __device__ __forceinline__ int key0(int ti) const { return 32 * ti; } };

__device__ __forceinline__ void nsa_phase(LAS unsigned char* lds, const bf16* PROJN, const bf16* KVC, bf16* ONSA, int G, int wave_s, unsigned long long* pc_) {
#define NSA_STAMP(sec) do { if ((PROBE_MASK >> 8) != 0 && blockIdx.x == 0 && threadIdx.x == 0) { const unsigned long long now_ = __builtin_amdgcn_s_memrealtime(); if ((PROBE_MASK >> (8 + (sec))) & 1) pc_[1] += now_ - pc_[0]; pc_[0] = now_; } } while (0)
    constexpr int KS = 144, OFF_KC = 0, OFF_VC = OFF_KC + 256 * KS, OFF_IMP = OFF_VC + 256 * KS, OFF_SEL = OFF_IMP + 32 * 256 * 4, OFF_UNI = OFF_SEL + 256, OFF_TL = OFF_UNI + 64, OFF_NT = OFF_TL + 512;
    int tid_ = wave_s * 64 + lane_id_now(); asm volatile("" : "+v"(tid_));
    const int tid = tid_, lane = tid & 63, wave = __builtin_amdgcn_readfirstlane(tid >> 6), l15 = lane & 15, g = lane >> 4, q4 = l15 >> 2, p4 = l15 & 3;
    const float sc2 = 0.125f * 1.4426950408889634f;
    LAS float* IMP = (LAS float*)(lds + OFF_IMP);
    LAS unsigned* SEL = (LAS unsigned*)(lds + OFF_SEL);
    LAS unsigned* UNI = (LAS unsigned*)(lds + OFF_UNI);
    LAS int* TL = (LAS int*)(lds + OFF_TL);
    LAS int* NT = (LAS int*)(lds + OFF_NT);
    for (int item = blockIdx.x; item < 4096; item += G) {
        const int bg = item >> 7, qr = ((item & 127) + 37 * (bg >> 1)) & 127, qb = ((bg >> 1) & 1) ? 127 - qr : qr, b = bg >> 2, gq = bg & 3, t0 = 32 * qb, cur = t0 >> 6;
        const int ql = 4 * wave + q4, hp = p4, t = t0 + ql;
        const bf16* prow = PROJN + (size_t)b * SEQ * NSA_PITCH;
        bf16x8 qf[2];
#pragma unroll
        for (int kk = 0; kk < 2; ++kk) qf[kk] = *(const GAS bf16x8*)(prow + (size_t)t * NSA_PITCH + gq * 256 + hp * 64 + 8 * g + 32 * kk);
        int ncv = (t0 >> 4) + 1; ncv = ncv > 255 ? 255 : ncv; const int ntc = (ncv + 31) >> 5;
        {
            v4u tmp[8];
            const unsigned nrow = (unsigned)tid >> 3, boff = ((unsigned)bg * 256u + nrow) * 256u + ((unsigned)tid & 7u) * 8u;
#pragma unroll
            for (int u = 0; u < 8; ++u) if ((int)nrow + 64 * (u & 3) < 32 * ntc) tmp[u] = *(const GAS v4u*)(KVC + boff + (unsigned)(u & 3) * 16384u + (unsigned)(u >> 2) * 2097152u);
#pragma unroll
            for (int u = 0; u < 8; ++u) if ((int)nrow + 64 * (u & 3) < 32 * ntc) *(LAS v4u*)(lds + ((u >> 2) ? OFF_VC : OFF_KC) + ((int)nrow + 64 * (u & 3)) * KS + (tid & 7) * 16) = tmp[u];
        }
        __syncthreads();
        f32x4 oc[4];
#pragma unroll
        for (int i = 0; i < 4; ++i) oc[i] = (f32x4){0.f, 0.f, 0.f, 0.f};
        {
            f32x4 sc[8][2]; float mx = -1e30f;
#pragma unroll
            for (int s = 0; s < 8; ++s) {
                sc[s][0] = (f32x4){-1e30f, -1e30f, -1e30f, -1e30f}; sc[s][1] = sc[s][0];
                if (s < ntc) {
                    f32x4 a0 = (f32x4){0.f, 0.f, 0.f, 0.f}, a1 = a0;
#pragma unroll
                    for (int kk = 0; kk < 2; ++kk) {
                        a0 = mfma16(ldrow(lds + OFF_KC + (32 * s + l15) * KS + (8 * g + 32 * kk) * 2), qf[kk], a0);
                        a1 = mfma16(ldrow(lds + OFF_KC + (32 * s + 16 + l15) * KS + (8 * g + 32 * kk) * 2), qf[kk], a1);
                    }
#pragma unroll
                    for (int r = 0; r < 4; ++r) {
                        const int n0 = 32 * s + 4 * g + r, n1 = n0 + 16;
                        sc[s][0][r] = (16 * n0 + 31 <= t && n0 < 255) ? a0[r] * sc2 : -1e30f;
                        sc[s][1][r] = (16 * n1 + 31 <= t && n1 < 255) ? a1[r] * sc2 : -1e30f;
                        mx = fmaxf(mx, fmaxf(sc[s][0][r], sc[s][1][r]));
                    }
                }
            }
            mx = gmax4(mx);
            float sum = 0.f;
#pragma unroll
            for (int s = 0; s < 8; ++s)
#pragma unroll
                for (int e = 0; e < 2; ++e)
#pragma unroll
                    for (int r = 0; r < 4; ++r) { const float p = (sc[s][e][r] > -5e29f) ? fexp2(sc[s][e][r] - mx) : 0.f; sc[s][e][r] = p; sum += p; }
            sum = gsum4(sum);
            const float inv = 1.f / fmaxf(sum, 1e-30f);
#pragma unroll
            for (int s = 0; s < 8; ++s) {
                float p[8];
#pragma unroll
                for (int r = 0; r < 4; ++r) { p[r] = sc[s][0][r] * inv; p[4 + r] = sc[s][1][r] * inv; }
#pragma unroll
                for (int e = 0; e < 8; ++e) { float x = p[e]; x += __int_as_float(__builtin_amdgcn_update_dpp(0, __float_as_int(x), 0xB1, 0xf, 0xf, false)); x += __int_as_float(__builtin_amdgcn_update_dpp(0, __float_as_int(x), 0x4E, 0xf, 0xf, false));
                    if (hp == 0) IMP[ql * 256 + 32 * s + 16 * (e >> 2) + 4 * g + (e & 3)] = x; }
                if (s < ntc) {
                    v4u pbu; pbu.x = pk2(p[0], p[1]); pbu.y = pk2(p[2], p[3]); pbu.z = pk2(p[4], p[5]); pbu.w = pk2(p[6], p[7]);
                    const bf16x8 pb = __builtin_bit_cast(bf16x8, pbu);
#pragma unroll
                    for (int dt = 0; dt < 4; ++dt) {
                        const s16x4 a = ldtr(lds + OFF_VC + (32 * s + 4 * g + q4) * KS + (16 * dt + 4 * p4) * 2), bb = ldtr(lds + OFF_VC + (32 * s + 16 + 4 * g + q4) * KS + (16 * dt + 4 * p4) * 2);
                        oc[dt] = mfma16((bf16x8){a[0], a[1], a[2], a[3], bb[0], bb[1], bb[2], bb[3]}, pb, oc[dt]);
                    }
                }
            }
        }
        unsigned ocp[8];
#pragma unroll
        for (int dt = 0; dt < 4; ++dt) { ocp[2 * dt] = pk2(oc[dt][0], oc[dt][1]); ocp[2 * dt + 1] = pk2(oc[dt][2], oc[dt][3]); }
        __syncthreads();
        NSA_STAMP(0);
        {
            unsigned ulo = 0u, uhi = 0u;
            unsigned key[4];
#pragma unroll
            for (int qi = 0; qi < 4; ++qi) {
                const int qq = 4 * wave + qi, jb = lane;
                const LAS float* ip = IMP + qq * 256 + 4 * jb;
                const float pm1 = (jb > 0) ? ip[-1] : 0.f;
                const float imp_sel = pm1 + 2.f * (ip[0] + ip[1] + ip[2]) + ip[3];
                const bool forced = (jb == 0) || (jb == cur) || (jb == cur - 1);
                key[qi] = (jb <= cur) ? __float_as_uint(imp_sel + (forced ? 1e4f : 0.f)) + 1u : 0u;
            }
            unsigned thr[4] = {0u, 0u, 0u, 0u};
            for (int bit = 31; bit >= 0; --bit) {
#pragma unroll
                for (int qi = 0; qi < 4; ++qi) { const unsigned cand = thr[qi] | (1u << bit); if (__popcll(__ballot(key[qi] >= cand)) >= 16) thr[qi] = cand; }
            }
#pragma unroll
            for (int qi = 0; qi < 4; ++qi) {
                const int qq = 4 * wave + qi;
                const bool gt = key[qi] > thr[qi], eq = key[qi] == thr[qi];
                const int need = 16 - __popcll(__ballot(gt));
                const unsigned long long em = __ballot(eq);
                const int below = __popcll(em & ((1ull << lane) - 1ull));
                const bool sel = key[qi] > 0u && (gt || (eq && below < need));
                const unsigned long long mask = __ballot(sel);
                if (lane == 0) { SEL[2 * qq] = (unsigned)mask; SEL[2 * qq + 1] = (unsigned)(mask >> 32); }
                ulo |= (unsigned)mask; uhi |= (unsigned)(mask >> 32);
            }
            if (lane == 0) { UNI[2 * wave] = ulo; UNI[2 * wave + 1] = uhi; }
        }
        __syncthreads();
        if (wave == 0) {
            unsigned ulo = 0u, uhi = 0u;
            for (int w = 0; w < 8; ++w) { ulo |= UNI[2 * w]; uhi |= UNI[2 * w + 1]; }
            int cnt = 0;
            for (int half = 0; half < 2; ++half) {
                const int s = lane + 64 * half, jb = s >> 1; const unsigned bit = (jb < 32) ? (ulo >> jb) & 1u : (uhi >> (jb - 32)) & 1u;
                const bool need = (s <= qb) && bit != 0u;
                const unsigned long long m = __ballot(need);
                const int pos = cnt + __popcll(m & ((1ull << lane) - 1ull));
                if (need) TL[pos] = s;
                cnt += __popcll(m);
            }
            if (lane == 0) NT[0] = cnt;
        }
        __syncthreads();
        const int nts = NT[0];
        NSA_STAMP(1);
        FaState<64> ss; fa_init<64>(ss);
        {
            TokSrc src{prow + 1536 + gq * 64, TL};
            SelMask mk{SEL[2 * ql], SEL[2 * ql + 1], (unsigned)__builtin_amdgcn_readfirstlane((int)UNI[2 * wave]), (unsigned)__builtin_amdgcn_readfirstlane((int)UNI[2 * wave + 1]), t, qb, TL};
            fa_stream<64, 4, TokSrc, SelMask>(lds, tid, 0, nts, src, mk, qf, ss, sc2);
        }
        unsigned osp[8]; float isl = 1.f / fmaxf(ss.l, 1e-30f);
#pragma unroll
        for (int dt = 0; dt < 4; ++dt) { osp[2 * dt] = pk2(ss.o[dt][0] * isl, ss.o[dt][1] * isl); osp[2 * dt + 1] = pk2(ss.o[dt][2] * isl, ss.o[dt][3] * isl); }
        NSA_STAMP(2);
        FaState<64> sw; fa_init<64>(sw);
        {
            TokSrc src{prow + 2048 + gq * 64, nullptr};
            const int sb = (t0 - 512) < 0 ? 0 : (t0 - 512) >> 5;
            WinMask mk{t, qb, sb};
            fa_stream<64, 4, TokSrc, WinMask>(lds, tid, sb, qb + 1, src, mk, qf, sw, sc2);
        }
        NSA_STAMP(3);
        {
            const GAS bf16* gp = (const GAS bf16*)(prow + (size_t)t * NSA_PITCH + 2560 + gq * 4 + hp);
            const float g0 = sigmoid_f(__uint_as_float((unsigned)gp[0] << 16)), g1 = sigmoid_f(__uint_as_float((unsigned)gp[16] << 16)), g2 = sigmoid_f(__uint_as_float((unsigned)gp[32] << 16));
            const float iw = g2 / fmaxf(sw.l, 1e-30f);
            bf16* op = ONSA + ((size_t)b * SEQ + t) * 1024 + gq * 256 + hp * 64 + 4 * g;
#pragma unroll
            for (int dt = 0; dt < 4; ++dt) {
                f32x4 o = sw.o[dt] * iw;
                o[0] += g0 * bf_lo(ocp[2 * dt]) + g1 * bf_lo(osp[2 * dt]); o[1] += g0 * bf_hi(ocp[2 * dt]) + g1 * bf_hi(osp[2 * dt]);
                o[2] += g0 * bf_lo(ocp[2 * dt + 1]) + g1 * bf_lo(osp[2 * dt + 1]); o[3] += g0 * bf_hi(ocp[2 * dt + 1]) + g1 * bf_hi(osp[2 * dt + 1]);
                v2u w; w.x = pk2(o[0], o[1]); w.y = pk2(o[2], o[3]); *(GAS v2u*)(op + 16 * dt) = w; }
        }
        __syncthreads();
        NSA_STAMP(4);
    }
}
#ifndef RET_SCAN
#define RET_SCAN 1
#define RET_GNORM 1
#define RET_GATE 1
#endif
#ifndef ENABLE_SSD
#define ENABLE_SSD 1
#endif
constexpr size_t WS_DTRAW = WS_SCR + 340 * MiB, WS_HALO = WS_SCR + 344 * MiB;
#define MIXER_CONVERT \
    if (mix == 1) { transpose_w<0>(args.in[12], D, 2608, 2816, WMIX, scr, gw, NGW, lane); \
        for (int c = 0; c < 2; ++c) { transpose_w<0>(args.in[14] + (size_t)c * 2048 * 256, 2048, 256, 256, WMIX + 3 * MiB + (size_t)c * 256 * 2048, scr, gw, NGW, lane); \
            transpose_w<0>(args.in[15] + (size_t)c * 256 * 64, 256, 64, 256, WMIX + 4 * MiB + (size_t)c * 256 * 256, scr, gw, NGW, lane); } \
        transpose_w<0>(args.in[16], D, D, D, WMIX + 5 * MiB, scr, gw, NGW, lane); } \
    if (mix == 3) { transpose_w<0>(args.in[25], D, 9216, 9216, WMIX, scr, gw, NGW, lane); transpose_w<0>(args.in[26], D, D, D, WMIX + (size_t)9216 * 1024, scr, gw, NGW, lane); } \
    if (mix == 0) { transpose_w<0>(args.in[9], D, 6144, 6144, WMIX, scr, gw, NGW, lane); transpose_w<0>(args.in[11], 2048, D, D, WMIX + (size_t)6144 * 1024, scr, gw, NGW, lane); } \
    if (mix == 2) { transpose_w<0>(args.in[17], D, 5152, 5376, WMIX, scr, gw, NGW, lane); transpose_w<0>(args.in[24], 2048, D, D, WMIX + (size_t)6144 * 1024, scr, gw, NGW, lane); }

#define MIXER_PHASES \
    if (mix == 0) { \
        bf16* PROJ = (bf16*)(ws + WS_SCR); \
        PHASE_BEGIN { pg8::Epi<pg8::EPI_RETQKV> E{}; E.O = PROJ; E.ldc = 4096; E.rot = ROT; run_gemm<pg8::EPI_RETQKV>(lds, U, D, WMIX, T, 4096, D, E, wave_s); } PHASE_END_C(3) \
        if (RET_SCAN) PHASE_BEGIN \
            for (int item = blockIdx.x; item < 256; item += G) { \
                const int b = item >> 5, h = (item >> 3) & 3, s8 = item & 7; \
                bf16* base = PROJ + (size_t)b * SEQ * 4096; \
                scan_item<256, false>(lds, base + h * 256, base + 1024 + h * 256, base + 2048 + h * 512 + s8 * 64, 4096, base + 2048 + h * 512 + s8 * 64, 4096, log1pf(-exp2f(-5.f - (float)h)), nullptr, 0.f, 0.f, 0.f, wave_s); \
                __syncthreads(); \
            } \
        PHASE_END_C(4) \
        if (RET_GNORM) PHASE_BEGIN gnorm_rows(PROJ + 2048, 4096, args.in[10], gw, NGW, lane); PHASE_END_C(7) \
        if (RET_GATE) PHASE_BEGIN { pg8::Epi<pg8::EPI_GATEMUL> E{}; E.O = PROJ + 2048; E.ldc = 4096; run_gemm<pg8::EPI_GATEMUL>(lds, U, D, WMIX + (size_t)4096 * 1024, T, 2048, D, E, wave_s); } PHASE_END_C(3) \
        PHASE_BEGIN { pg8::Epi<pg8::EPI_RESID> E{}; E.Hout = (float*)H; E.Hbase = nullptr; E.scale = 1.0f; E.ldc = D; run_gemm<pg8::EPI_RESID>(lds, PROJ + 2048, 4096, WMIX + (size_t)6144 * 1024, T, D, 2048, E, wave_s); } PHASE_END_C(3) \
    } \
    if (mix == 2 && ENABLE_SSD) { \
        bf16* PROJ = (bf16*)(ws + WS_SCR); float* DTRAW = (float*)(ws + WS_DTRAW); bf16* HALO = (bf16*)(ws + WS_HALO); \
        PHASE_BEGIN { pg8::Epi<pg8::EPI_SSD> E{}; E.O = PROJ; E.ldc = SSD_PITCH; E.aux = DTRAW; run_gemm<pg8::EPI_SSD>(lds, U, D, WMIX, T, SSD_PITCH, D, E, wave_s); } PHASE_END_C(3) \
        PHASE_BEGIN ssd_halo_save(PROJ, HALO, blockIdx.x * NTHR + tid, G * NTHR); PHASE_END_C(7) \
        PHASE_BEGIN ssd_conv(PROJ, HALO, args.in[18], args.in[19], blockIdx.x * NTHR + tid, G * NTHR); PHASE_END_C(7) \
        PHASE_BEGIN \
            for (int item = blockIdx.x; item < 256; item += G) { \
                const int b = item >> 5, gq = (item >> 3) & 3, r = item & 7, hd = gq * 8 + r; \
                bf16* base = PROJ + (size_t)b * SEQ * SSD_PITCH; \
                scan_item<128, true>(lds, base + 4608 + gq * 128, base + 4096 + gq * 128, base + 2048 + gq * 512 + r * 64, SSD_PITCH, base + gq * 512 + r * 64, SSD_PITCH, 0.f, \
                                     DTRAW + (size_t)b * SEQ * 32 + hd, args.in[20][hd], -__expf(args.in[21][hd]), args.in[22][hd], wave_s); \
                __syncthreads(); \
            } \
        PHASE_END_C(4) \
        PHASE_BEGIN gnorm_rows(PROJ, SSD_PITCH, args.in[23], gw, NGW, lane); PHASE_END_C(7) \
        PHASE_BEGIN { pg8::Epi<pg8::EPI_RESID> E{}; E.Hout = (float*)H; E.Hbase = nullptr; E.scale = 1.0f; E.ldc = D; run_gemm<pg8::EPI_RESID>(lds, PROJ, SSD_PITCH, WMIX + (size_t)6144 * 1024, T, D, 2048, E, wave_s); } PHASE_END_C(3) \
    } \
    if (mix == 3) { \
        bf16* PROJD = (bf16*)(ws + WS_SCR); bf16* OACC = (bf16*)(ws + WS_SCR + 192 * MiB); float* LSE = (float*)(ws + WS_SCR + 256 * MiB); \
        for (int gi = 0; gi < 3; ++gi) { \
            PHASE_BEGIN { pg8::Epi<pg8::EPI_BF16> E{}; E.O = PROJD; E.ldc = DIL_PITCH; run_gemm<pg8::EPI_BF16>(lds, U, D, WMIX + (size_t)gi * 3072 * 1024, T, 3072, D, E, wave_s); } PHASE_END_C(3) \
            PHASE_BEGIN dilated_phase(lds, PROJD, OACC, LSE, gi, G, wave_s); PHASE_END_C(6) \
        } \
        PHASE_BEGIN { pg8::Epi<pg8::EPI_RESID> E{}; E.Hout = (float*)H; E.Hbase = nullptr; E.scale = 1.0f; E.ldc = D; run_gemm<pg8::EPI_RESID>(lds, OACC, D, WMIX + (size_t)9216 * 1024, T, D, D, E, wave_s); } PHASE_END_C(3) \
    } \
    if (mix == 1) { \
        bf16* PROJN = (bf16*)(ws + WS_SCR); bf16* ACMP = (bf16*)(ws + WS_SCR + 176 * MiB); bf16* HIDC = (bf16*)(ws + WS_SCR + 240 * MiB); bf16* KVC = (bf16*)(ws + WS_SCR + 248 * MiB); bf16* ONSA = (bf16*)(ws + WS_SCR + 256 * MiB); \
        PHASE_BEGIN { pg8::Epi<pg8::EPI_BF16> E{}; E.O = PROJN; E.ldc = NSA_PITCH; run_gemm<pg8::EPI_BF16>(lds, U, D, WMIX, T, NSA_PITCH, D, E, wave_s); } PHASE_END_C(3) \
        PHASE_BEGIN nsa_im2col(PROJN, args.in[13], ACMP, blockIdx.x * NTHR + tid, G * NTHR); PHASE_END_C(7) \
        PHASE_BEGIN for (int c = 0; c < 2; ++c) { pg8::Epi<pg8::EPI_SILU> E{}; E.O = HIDC + (size_t)c * 8192 * 256; E.ldc = 256; run_gemm<pg8::EPI_SILU>(lds, ACMP + (size_t)c * 8192 * 2048, 2048, WMIX + 3 * MiB + (size_t)c * 256 * 2048, 8192, 256, 2048, E, wave_s, 128 * c); } PHASE_END_C(3) \
        PHASE_BEGIN for (int c = 0; c < 2; ++c) { pg8::Epi<pg8::EPI_BF16> E{}; E.O = KVC + (size_t)c * 8192 * 256; E.ldc = 256; run_gemm<pg8::EPI_BF16>(lds, HIDC + (size_t)c * 8192 * 256, 256, WMIX + 4 * MiB + (size_t)c * 256 * 256, 8192, 256, 256, E, wave_s, 128 * c); } PHASE_END_C(3) \
        PHASE_BEGIN nsa_phase(lds, PROJN, KVC, ONSA, G, wave_s, (unsigned long long*)(args.ws + 32768)); PHASE_END_C(5) \
        PHASE_BEGIN { pg8::Epi<pg8::EPI_RESID> E{}; E.Hout = (float*)H; E.Hbase = nullptr; E.scale = 1.0f; E.ldc = D; run_gemm<pg8::EPI_RESID>(lds, ONSA, D, WMIX + 5 * MiB, T, D, D, E, wave_s); } PHASE_END_C(3) \
    }
__global__ void __launch_bounds__(NTHR, 2) fwd_megakernel(Args args) {
    extern __shared__ __attribute__((aligned(16))) unsigned char lds_raw[];
    LAS unsigned char* lds = (LAS unsigned char*)lds_raw;
    cg::grid_group grid = cg::this_grid();
    const int G = gridDim.x;
    const int wave_s = __builtin_amdgcn_readfirstlane(threadIdx.x >> 6);
    volatile LAS unsigned* xst = (volatile LAS unsigned*)(lds + LDS_BYTES - 64);
    if (threadIdx.x < 16) xst[threadIdx.x] = 0u;
    __syncthreads();
    const XcdBarrier xbar = xcd_barrier_post((unsigned*)args.ws, xst);
    if (args.ph_lo < 0) grid.sync();
    if (PROBE_MASK != 0 && blockIdx.x == 0 && threadIdx.x == 0) { ((unsigned long long*)(args.ws + 32768))[0] = __builtin_amdgcn_s_memrealtime(); }
#define PHASE_BEGIN {
#define PHASE_END_C(cat) xcd_barrier(xbar); if (PROBE_MASK != 0 && blockIdx.x == 0 && threadIdx.x == 0) { const unsigned long long now_ = __builtin_amdgcn_s_memrealtime(); unsigned long long* c_ = (unsigned long long*)(args.ws + 32768); if ((PROBE_MASK >> (cat)) & 1) c_[1] += now_ - c_[0]; c_[0] = now_; } }
    for (int L = 0; L < DEPTH; ++L) {
        const int mix = L & 3;
        int tid_ = wave_s * 64 + lane_id_now(); asm volatile("" : "+v"(tid_));
        const int tid = tid_, lane = tid & 63, wave = __builtin_amdgcn_readfirstlane(tid >> 6);
        const int gw = blockIdx.x * NWAVES + wave, NGW = G * NWAVES;
        unsigned char* ws = args.ws; asm volatile("" : "+s"(ws));
        bf16* H = (bf16*)((unsigned char*)args.out + 64 * MiB); asm volatile("" : "+s"(H));
        float* ROT = (float*)(ws + WS_ROT);
        bf16* WIN1 = (bf16*)(ws + WS_WIN1); bf16* WOUT1 = (bf16*)(ws + WS_WOUT1); bf16* WIN2 = (bf16*)(ws + WS_WIN2); bf16* WOUT2 = (bf16*)(ws + WS_WOUT2); bf16* WMIX = (bf16*)(ws + WS_WMIX);
        bf16* U = (bf16*)(ws + WS_U); bf16* HID = (bf16*)(ws + WS_SCR);
        LAS float* scr = (LAS float*)(lds + wave * 18432);
        PHASE_BEGIN
            transpose_w<1>(args.in[2] + (size_t)L * D * 2 * FF, D, 2 * FF, 2 * FF, WIN1, scr, gw, NGW, lane);
            transpose_w<0>(args.in[3] + (size_t)L * FF * D, FF, D, D, WOUT1, scr, gw, NGW, lane);
            transpose_w<1>(args.in[6] + (size_t)L * D * 2 * FF, D, 2 * FF, 2 * FF, WIN2, scr, gw, NGW, lane);
            transpose_w<0>(args.in[7] + (size_t)L * FF * D, FF, D, D, WOUT2, scr, gw, NGW, lane);
            MIXER_CONVERT
            if (L == 0) {
                for (int i = blockIdx.x * NTHR + tid; i < 4096 * 128; i += G * NTHR) {
                    const int pos = i >> 7, d = i & 127;
                    const float inv = exp2f(-(float)d * (13.287712379549449f / 128.f));
                    const float ang = (float)pos * inv;
                    const double x = (double)ang * 0.15915494309189535; const float fr = (float)(x - rint(x));
                    ROT[i] = __builtin_amdgcn_cosf(fr); ROT[4096 * 128 + i] = __builtin_amdgcn_sinf(fr);
                }
            }
            if (L == 0) rms_rows(args.in[0], args.in[1], U, nullptr, gw, NGW, lane); else rms_rows_b(H, args.in[1] + L * D, U, gw, NGW, lane);
        PHASE_END_C(0)
        PHASE_BEGIN { pg8::Epi<pg8::EPI_SWIGLU> E{}; E.O = HID; E.ldc = FF; run_gemm<pg8::EPI_SWIGLU>(lds, U, D, WIN1, T, 2 * FF, D, E, wave_s); } PHASE_END_C(1)
        PHASE_BEGIN { pg8::Epi<pg8::EPI_RESID> E{}; E.Hout = (float*)H; E.Hbase = (L == 0) ? args.in[0] : nullptr; E.scale = 0.5f; E.ldc = D; run_gemm<pg8::EPI_RESID>(lds, HID, FF, WOUT1, T, D, FF, E, wave_s); } PHASE_END_C(1)
        PHASE_BEGIN rms_rows_b(H, args.in[4] + L * D, U, gw, NGW, lane); PHASE_END_C(2)
        MIXER_PHASES
        PHASE_BEGIN rms_rows_b(H, args.in[5] + L * D, U, gw, NGW, lane); PHASE_END_C(2)
        PHASE_BEGIN { pg8::Epi<pg8::EPI_SWIGLU> E{}; E.O = HID; E.ldc = FF; run_gemm<pg8::EPI_SWIGLU>(lds, U, D, WIN2, T, 2 * FF, D, E, wave_s); } PHASE_END_C(1)
        PHASE_BEGIN { pg8::Epi<pg8::EPI_RESID> E{}; E.Hout = (float*)H; E.Hbase = nullptr; E.scale = 0.5f; E.ldc = D; run_gemm<pg8::EPI_RESID>(lds, HID, FF, WOUT2, T, D, FF, E, wave_s); } PHASE_END_C(1)
    }
    {
        const int lane = lane_id_now(); const int gw = blockIdx.x * NWAVES + wave_s, NGW = G * NWAVES;
        const bf16* HBf = (const bf16*)((unsigned char*)args.out + 64 * MiB); bf16* Uc = (bf16*)(args.ws + WS_U);
        rms_final_b(HBf, 0, args.out, args.in[8], 0, T / 2, gw, NGW, lane);
        { const GAS v4u* src = (const GAS v4u*)(HBf + (size_t)(T / 2) * D); GAS v4u* dst = (GAS v4u*)Uc;
          for (int i = blockIdx.x * NTHR + wave_s * 64 + lane; i < (T / 2) * D / 8; i += G * NTHR) dst[i] = src[i]; }
        xcd_barrier(xbar);
        rms_final_b(Uc, T / 2, args.out, args.in[8], T / 2, T, gw, NGW, lane);
    }
}

extern "C" void kernel_launch(void* const* d_in, const int* in_sizes, int n_in, void* d_out, int out_size, void* d_ws, size_t ws_size, hipStream_t stream) {
    static int grid = 0;
    if (grid == 0) {
        if (n_in != 27 || out_size != T * D || ws_size < WS_NEED) { fprintf(stderr, "kernel_launch: unexpected problem (n_in %d, out %d, ws %zu)\n", n_in, out_size, ws_size); grid = -1; return; }
        int dev = 0, cus = 0, per_cu = 0;
        hipGetDevice(&dev); hipDeviceGetAttribute(&cus, hipDeviceAttributeMultiprocessorCount, dev);
        if (hipFuncSetAttribute((const void*)fwd_megakernel, hipFuncAttributeMaxDynamicSharedMemorySize, LDS_BYTES) != hipSuccess) { fprintf(stderr, "kernel_launch: hipFuncSetAttribute failed\n"); grid = -1; return; }
        if (hipOccupancyMaxActiveBlocksPerMultiprocessor(&per_cu, (const void*)fwd_megakernel, NTHR, LDS_BYTES) != hipSuccess || per_cu < 1) { fprintf(stderr, "kernel_launch: occupancy query gave %d\n", per_cu); per_cu = 1; }
        (void)hipGetLastError();
        grid = cus * 1;
    }
    if (grid < 0) return;
    if (hipMemsetAsync(d_ws, 0, 65536, stream) != hipSuccess) { fprintf(stderr, "kernel_launch: memset failed\n"); return; }
    Args a{};
    for (int i = 0; i < 27; ++i) a.in[i] = (const float*)d_in[i];
    a.out = (float*)d_out; a.ws = (unsigned char*)d_ws; a.ph_lo = 0; a.ph_hi = 1 << 20;
    void* kargs[] = {&a};
    hipError_t e = hipLaunchCooperativeKernel((const void*)fwd_megakernel, dim3(grid), dim3(NTHR), kargs, LDS_BYTES, stream);
    if (e != hipSuccess) fprintf(stderr, "kernel_launch: cooperative launch failed: %s (grid %d)\n", hipGetErrorString(e), grid);
}
```

```cpp
#include <hip/hip_runtime.h>
#include <hip/hip_cooperative_groups.h>
#include <cstdio>
#include <cstdint>
namespace cg = cooperative_groups;

__device__ __forceinline__ int lane_id_now() { int l; asm volatile("v_mbcnt_lo_u32_b32 %0, -1, 0\n\tv_mbcnt_hi_u32_b32 %0, -1, %0" : "=v"(l)); return l; }

#ifndef PROBE_MASK
#define PROBE_MASK 0
#endif
namespace pg8 {
#define PG8_LAS __attribute__((address_space(3)))
typedef unsigned short bf16_t;
typedef short bf16x8 __attribute__((ext_vector_type(8)));
typedef float f32x4 __attribute__((ext_vector_type(4)));
typedef unsigned u32x4 __attribute__((ext_vector_type(4)));
constexpr int BM = 256, BK = 64, HALF = 128, HTB = HALF * BK * 2  , STAGE_BYTES = 8 * HTB, NXCD = 8, WGM = 8;

__host__ __device__ __forceinline__ int lds_byte(int r, int c) { const int st = (r >> 4) * 2 + (c >> 5), rr = r & 15, cc = c & 31, ob = rr * 64 + cc * 2; return st * 1024 + (ob ^ (((ob >> 9) & 1) << 5)); }
__host__ __device__ __forceinline__ void stage_rc(int b, int& R, int& C) { const int st = b / 1024, sb = b % 1024, swz = sb ^ (((sb >> 9) & 1) << 5); R = (st >> 1) * 16 + swz / 64; C = (st & 1) * 32 + (swz % 64) / 2; }
__host__ __device__ __forceinline__ int perm32(int rho) { const int n = rho >> 4, i = rho & 15; return 8 * (i >> 2) + 4 * n + (i & 3); }

struct Unit { int pm, pn; };
struct Gemm { const bf16_t* A; const bf16_t* Bt; int M, N, K, lda; };

struct StaticOrder {
    int nM, nN, nwg, G, c;
    __host__ __device__ void init(int M, int N, int G_, int c_) { nM = M / BM; nN = N / BM; nwg = nM * nN; G = G_; c = c_; }
    __host__ __device__ bool next(int i, Unit& u) const {
        const long L = (long)i * G + c; if (L >= nwg) return false;
        int wgid = (int)L; { const int q = nwg / NXCD, r = nwg % NXCD, xcd = wgid % NXCD, off = wgid / NXCD; wgid = (xcd < r ? xcd * (q + 1) : r * (q + 1) + (xcd - r) * q) + off; }
        const int nig = WGM * nN, gid = wgid / nig, fm = gid * WGM, gsz = (nM - fm) < WGM ? (nM - fm) : WGM;
        u.pm = fm + ((wgid % nig) % gsz); u.pn = (wgid % nig) / gsz; return true;
    }
    __device__ __forceinline__ void a_ready(const Unit&) const {}
    __device__ __forceinline__ void done(const Unit&) const {}
};

typedef float f32x2_t __attribute__((ext_vector_type(2))); typedef __bf16 bf16x2_t __attribute__((ext_vector_type(2)));
__device__ __forceinline__ unsigned cvt_pk_bf16(float lo, float hi) { f32x2_t v = {lo, hi}; bf16x2_t b = __builtin_convertvector(v, bf16x2_t); return __builtin_bit_cast(unsigned, b); }
__device__ __forceinline__ float bf_lo(unsigned w) { return __uint_as_float(w << 16); }
__device__ __forceinline__ float bf_hi(unsigned w) { return __uint_as_float(w & 0xffff0000u); }
__device__ __forceinline__ float silu_f(float x) { return x * __builtin_amdgcn_rcpf(1.0f + __builtin_amdgcn_exp2f(-1.4426950408889634f * x)); }
__device__ __forceinline__ float sigmoid_f(float x) { return __builtin_amdgcn_rcpf(1.0f + __builtin_amdgcn_exp2f(-1.4426950408889634f * x)); }

enum { EPI_BF16 = 0, EPI_SWIGLU = 1, EPI_RESID = 2, EPI_RETQKV = 3, EPI_GATEMUL = 4, EPI_SSD = 5, EPI_SILU = 6 };
template <int MODE> struct Epi {
    static constexpr bool PERM = true, AFTER_DRAIN = false;
    bf16_t* O; int ldc;
    float* Hout; const float* Hbase; float scale;
    const float* __restrict__ rot;
    float* aux;
    __device__ __forceinline__ void operator()(const f32x4 (&acc)[2][2][4][2], const Unit& u, int wr, int wc, int fr, int fq) const {
        const int row0 = u.pm * BM + wr * 64 + fr;
        const int cl = wc * 32 + 8 * fq;
        if constexpr (MODE == EPI_SWIGLU) {
#pragma unroll
            for (int ai = 0; ai < 2; ++ai)
#pragma unroll
                for (int m = 0; m < 4; ++m) {
                    bf16_t* rowp = O + (size_t)(row0 + ai * HALF + m * 16) * ldc + u.pn * 128 + cl;
                    f32x4 a0 = acc[ai][0][m][0], a1 = acc[ai][0][m][1], b0 = acc[ai][1][m][0], b1 = acc[ai][1][m][1];
                    u32x4 w;
                    w.x = cvt_pk_bf16(silu_f(a0[0]) * b0[0], silu_f(a0[1]) * b0[1]); w.y = cvt_pk_bf16(silu_f(a0[2]) * b0[2], silu_f(a0[3]) * b0[3]);
                    w.z = cvt_pk_bf16(silu_f(a1[0]) * b1[0], silu_f(a1[1]) * b1[1]); w.w = cvt_pk_bf16(silu_f(a1[2]) * b1[2], silu_f(a1[3]) * b1[3]);
                    *(u32x4*)rowp = w;
                }
        } else if constexpr (MODE == EPI_RESID) {
            bf16_t* const HB = (bf16_t*)Hout;
#pragma unroll
            for (int ai = 0; ai < 2; ++ai) {
                if (Hbase) {
                    f32x4 pre[4][2][2];
#pragma unroll
                    for (int m = 0; m < 4; ++m) { const size_t off = (size_t)(row0 + ai * HALF + m * 16) * ldc + u.pn * BM + cl;
#pragma unroll
                        for (int bj = 0; bj < 2; ++bj)
#pragma unroll
                            for (int n = 0; n < 2; ++n) pre[m][bj][n] = *(const f32x4*)(Hbase + off + bj * HALF + 4 * n); }
#pragma unroll
                    for (int m = 0; m < 4; ++m) { const size_t off = (size_t)(row0 + ai * HALF + m * 16) * ldc + u.pn * BM + cl;
#pragma unroll
                        for (int bj = 0; bj < 2; ++bj) { const f32x4 h0 = pre[m][bj][0] + acc[ai][bj][m][0] * scale, h1 = pre[m][bj][1] + acc[ai][bj][m][1] * scale; u32x4 w;
                            w.x = cvt_pk_bf16(h0[0], h0[1]); w.y = cvt_pk_bf16(h0[2], h0[3]); w.z = cvt_pk_bf16(h1[0], h1[1]); w.w = cvt_pk_bf16(h1[2], h1[3]);
                            *(u32x4*)(HB + off + bj * HALF) = w; } }
                } else {
                    u32x4 pre[4][2];
#pragma unroll
                    for (int m = 0; m < 4; ++m) { const size_t off = (size_t)(row0 + ai * HALF + m * 16) * ldc + u.pn * BM + cl;
#pragma unroll
                        for (int bj = 0; bj < 2; ++bj) pre[m][bj] = *(const u32x4*)(HB + off + bj * HALF); }
#pragma unroll
                    for (int m = 0; m < 4; ++m) { const size_t off = (size_t)(row0 + ai * HALF + m * 16) * ldc + u.pn * BM + cl;
#pragma unroll
                        for (int bj = 0; bj < 2; ++bj) { const u32x4 p = pre[m][bj]; const f32x4 a0 = acc[ai][bj][m][0] * scale, a1 = acc[ai][bj][m][1] * scale; u32x4 w;
                            w.x = cvt_pk_bf16(bf_lo(p.x) + a0[0], bf_hi(p.x) + a0[1]); w.y = cvt_pk_bf16(bf_lo(p.y) + a0[2], bf_hi(p.y) + a0[3]);
                            w.z = cvt_pk_bf16(bf_lo(p.z) + a1[0], bf_hi(p.z) + a1[1]); w.w = cvt_pk_bf16(bf_lo(p.w) + a1[2], bf_hi(p.w) + a1[3]);
                            *(u32x4*)(HB + off + bj * HALF) = w; } }
                }
            }
        } else if constexpr (MODE == EPI_RETQKV) {
            if (u.pn < 8) {
                const float ks = (u.pn >= 4) ? 0.0625f : 1.0f;
#pragma unroll
                for (int ai = 0; ai < 2; ++ai)
#pragma unroll
                    for (int m = 0; m < 4; ++m) {
                        const int r = row0 + ai * HALF + m * 16; const int pos = r & 4095;
                        bf16_t* rowp = O + (size_t)r * ldc + u.pn * BM + cl;
                        u32x4 w1, w2; unsigned* p1 = (unsigned*)&w1; unsigned* p2 = (unsigned*)&w2;
#pragma unroll
                        for (int n = 0; n < 2; ++n) {
                            const f32x4 c = *(const f32x4*)(rot + (size_t)pos * 128 + cl + 4 * n);
                            const f32x4 s = *(const f32x4*)(rot + (size_t)4096 * 128 + (size_t)pos * 128 + cl + 4 * n);
                            const f32x4 t1 = acc[ai][0][m][n] * ks, t2 = acc[ai][1][m][n] * ks;
                            const f32x4 o1 = t1 * c - t2 * s, o2 = t1 * s + t2 * c;
                            p1[2 * n] = cvt_pk_bf16(o1[0], o1[1]); p1[2 * n + 1] = cvt_pk_bf16(o1[2], o1[3]);
                            p2[2 * n] = cvt_pk_bf16(o2[0], o2[1]); p2[2 * n + 1] = cvt_pk_bf16(o2[2], o2[3]);
                        }
                        *(u32x4*)rowp = w1; *(u32x4*)(rowp + HALF) = w2;
                    }
            } else {
#pragma unroll
                for (int ai = 0; ai < 2; ++ai)
#pragma unroll
                    for (int m = 0; m < 4; ++m) {
                        bf16_t* rowp = O + (size_t)(row0 + ai * HALF + m * 16) * ldc + u.pn * BM + cl;
#pragma unroll
                        for (int bj = 0; bj < 2; ++bj) { const f32x4 v0 = acc[ai][bj][m][0], v1 = acc[ai][bj][m][1]; u32x4 w;
                            w.x = cvt_pk_bf16(v0[0], v0[1]); w.y = cvt_pk_bf16(v0[2], v0[3]); w.z = cvt_pk_bf16(v1[0], v1[1]); w.w = cvt_pk_bf16(v1[2], v1[3]);
                            *(u32x4*)(rowp + bj * HALF) = w; }
                    }
            }
        } else if constexpr (MODE == EPI_GATEMUL) {
#pragma unroll
            for (int ai = 0; ai < 2; ++ai)
#pragma unroll
                for (int m = 0; m < 4; ++m) {
                    bf16_t* rowp = O + (size_t)(row0 + ai * HALF + m * 16) * ldc + u.pn * BM + cl;
#pragma unroll
                    for (int bj = 0; bj < 2; ++bj) { const f32x4 v0 = acc[ai][bj][m][0], v1 = acc[ai][bj][m][1]; const u32x4 old = *(const u32x4*)(rowp + bj * HALF); u32x4 w;
                        w.x = cvt_pk_bf16(silu_f(v0[0]) * bf_lo(old.x), silu_f(v0[1]) * bf_hi(old.x)); w.y = cvt_pk_bf16(silu_f(v0[2]) * bf_lo(old.y), silu_f(v0[3]) * bf_hi(old.y));
                        w.z = cvt_pk_bf16(silu_f(v1[0]) * bf_lo(old.z), silu_f(v1[1]) * bf_hi(old.z)); w.w = cvt_pk_bf16(silu_f(v1[2]) * bf_lo(old.w), silu_f(v1[3]) * bf_hi(old.w));
                        *(u32x4*)(rowp + bj * HALF) = w; }
                }
        } else {
            if (MODE == EPI_SSD && u.pn == 20) {
                if (wc == 0) {
#pragma unroll
                    for (int ai = 0; ai < 2; ++ai)
#pragma unroll
                        for (int m = 0; m < 4; ++m) { float* p = aux + (size_t)(row0 + ai * HALF + m * 16) * 32 + cl;
                            *(f32x4*)p = acc[ai][0][m][0]; *(f32x4*)(p + 4) = acc[ai][0][m][1]; }
                }
                return;
            }
#pragma unroll
            for (int ai = 0; ai < 2; ++ai)
#pragma unroll
                for (int m = 0; m < 4; ++m) {
                    bf16_t* rowp = O + (size_t)(row0 + ai * HALF + m * 16) * ldc + u.pn * BM + cl;
#pragma unroll
                    for (int bj = 0; bj < 2; ++bj) { f32x4 v0 = acc[ai][bj][m][0], v1 = acc[ai][bj][m][1]; u32x4 w;
                        if (MODE == EPI_SILU) { v0 = (f32x4){silu_f(v0[0]), silu_f(v0[1]), silu_f(v0[2]), silu_f(v0[3])}; v1 = (f32x4){silu_f(v1[0]), silu_f(v1[1]), silu_f(v1[2]), silu_f(v1[3])}; }
                        w.x = cvt_pk_bf16(v0[0], v0[1]); w.y = cvt_pk_bf16(v0[2], v0[3]); w.z = cvt_pk_bf16(v1[0], v1[1]); w.w = cvt_pk_bf16(v1[2], v1[3]);
                        *(u32x4*)(rowp + bj * HALF) = w; }
                }
        }
    }
};
template <class Epi, class Sched, bool ALIGN_EPI = false, bool SP2 = false>
__device__ __forceinline__ void gemm_phase(PG8_LAS unsigned char* lds, const Gemm g, const Sched& S, const Epi& E, int wave_s) {
    int tid_ = wave_s * 64 + lane_id_now(); asm volatile("" : "+v"(tid_)); const int tid = tid_, wid = __builtin_amdgcn_readfirstlane(tid >> 6), lane = tid & 63, wr = wid >> 2, wc = wid & 3, fr = lane & 15, fq = lane >> 4;
    const int K = g.K, nt = K / BK;
    unsigned voffA[2], voffB[2];
#pragma unroll
    for (int i = 0; i < 2; ++i) { int R, C; stage_rc(tid * 16 + i * 8192, R, C); const int Rb = Epi::PERM ? ((R & ~31) + perm32(R & 31)) : R;
        voffA[i] = (unsigned)(R * g.lda + C) * 2u; voffB[i] = (unsigned)(Rb * K + C) * 2u; }
    const size_t kstep = (size_t)(BK * 2);
    const size_t hstepA = (size_t)HALF * g.lda * 2, hstepB = (size_t)HALF * K * 2;
    const size_t tstepA = 2 * hstepA, tstepB = 2 * hstepB;
    const unsigned ldsw = (unsigned)wid * 1024u;
    const int aoff = lds_byte(wr * 64 + fr, fq * 8), boff = lds_byte(wc * 32 + fr, fq * 8);
#define PG8_SA(b, h) (((b) * 2 + (h)) * HTB)
#define PG8_SB(b, h) ((4 + (b) * 2 + (h)) * HTB)
#define PG8_STAGE(bufoff, gbase, voff) do { _Pragma("unroll") for (int _i = 0; _i < 2; ++_i) \
        __builtin_amdgcn_global_load_lds((const unsigned*)((const char*)(gbase) + (voff)[_i]), (PG8_LAS unsigned*)(lds + (bufoff) + ldsw + _i * 8192), 16, 0, 0); } while (0)
#define PG8_LDA(dst, b, h) do { _Pragma("unroll") for (int m = 0; m < 4; ++m) _Pragma("unroll") for (int k = 0; k < 2; ++k) dst[m][k] = *(const PG8_LAS bf16x8*)(lds + PG8_SA(b, h) + aoff + m * 2048 + k * 1024); } while (0)
#define PG8_LDB(dst, b, h) do { _Pragma("unroll") for (int n = 0; n < 2; ++n) _Pragma("unroll") for (int k = 0; k < 2; ++k) dst[n][k] = *(const PG8_LAS bf16x8*)(lds + PG8_SB(b, h) + boff + n * 2048 + k * 1024); } while (0)
#define PG8_MMA(ai, bj, At, Bt) do { __builtin_amdgcn_s_setprio(1); _Pragma("unroll") for (int m = 0; m < 4; ++m) _Pragma("unroll") for (int n = 0; n < 2; ++n) _Pragma("unroll") for (int k = 0; k < 2; ++k) \
        acc[ai][bj][m][n] = __builtin_amdgcn_mfma_f32_16x16x32_bf16(Bt[n][k], At[m][k], acc[ai][bj][m][n], 0, 0, 0); __builtin_amdgcn_s_setprio(0); } while (0)
#define PG8_WAIT_V(n) asm volatile("s_waitcnt vmcnt(" #n ")" ::: "memory")
#define PG8_WAIT_L(n) asm volatile("s_waitcnt lgkmcnt(" #n ")" ::: "memory")
#define PG8_BAR __builtin_amdgcn_s_barrier()
#define PG8_SCHED __builtin_amdgcn_sched_barrier(0)
    Unit cur, nxt; int ui = 0;
    if (!S.next(0, cur)) return;
    f32x4 acc[2][2][4][2];
#pragma unroll
    for (int a = 0; a < 2; ++a)
#pragma unroll
        for (int b = 0; b < 2; ++b)
#pragma unroll
            for (int m = 0; m < 4; ++m)
#pragma unroll
                for (int n = 0; n < 2; ++n) acc[a][b][m][n] = (f32x4){0.f, 0.f, 0.f, 0.f};
    bf16x8 At[4][2], B0[2][2], B1[2][2];
    const char* cA = (const char*)g.A + (size_t)cur.pm * tstepA; const char* cB = (const char*)g.Bt + (size_t)cur.pn * tstepB;
    S.a_ready(cur);
    if constexpr (SP2) {
        PG8_STAGE(PG8_SB(0, 0), cB, voffB); PG8_STAGE(PG8_SB(0, 1), cB + hstepB, voffB); PG8_STAGE(PG8_SA(0, 0), cA, voffA); PG8_STAGE(PG8_SA(0, 1), cA + hstepA, voffA);
        if (wr == 1) PG8_BAR;
        PG8_WAIT_V(2); PG8_BAR;
        PG8_STAGE(PG8_SB(1, 0), cB + kstep, voffB); PG8_STAGE(PG8_SA(1, 0), cA + kstep, voffA); PG8_STAGE(PG8_SB(1, 1), cB + hstepB + kstep, voffB);
        PG8_WAIT_V(6); PG8_BAR;
    } else {
        PG8_STAGE(PG8_SB(0, 0), cB, voffB); PG8_STAGE(PG8_SA(0, 0), cA, voffA); PG8_STAGE(PG8_SB(0, 1), cB + hstepB, voffB); PG8_STAGE(PG8_SA(0, 1), cA + hstepA, voffA);
        if (wr == 1) PG8_BAR;
        PG8_WAIT_V(4); PG8_BAR;
        PG8_STAGE(PG8_SB(1, 0), cB + kstep, voffB); PG8_STAGE(PG8_SA(1, 0), cA + kstep, voffA); PG8_STAGE(PG8_SB(1, 1), cB + hstepB + kstep, voffB);
        PG8_WAIT_V(6); PG8_BAR;
    }
    for (;;) {
        const bool has_next = S.next(ui + 1, nxt);
        const char* nA = has_next ? (const char*)g.A + (size_t)nxt.pm * tstepA : cA; const char* nB = has_next ? (const char*)g.Bt + (size_t)nxt.pn * tstepB : cB;
        for (int t = 0; t < nt; t += 2) {
            const bool last = (t == nt - 2);
            const char* a1 = cA + (size_t)(t + 1) * kstep;
            const char* a2 = last ? nA : cA + (size_t)(t + 2) * kstep; const char* b2 = last ? nB : cB + (size_t)(t + 2) * kstep;
            const char* a3 = a2 + kstep; const char* b3 = b2 + kstep;
            if (last && has_next) S.a_ready(nxt);
            if constexpr (SP2) {
            PG8_LDB(B0, 0, 0); PG8_LDB(B1, 0, 1); PG8_SCHED; PG8_LDA(At, 0, 0); PG8_STAGE(PG8_SA(1, 1), a1 + hstepA, voffA);
            PG8_WAIT_V(8); PG8_WAIT_L(0); PG8_BAR; PG8_MMA(0, 0, At, B0); PG8_MMA(0, 1, At, B1); PG8_BAR; PG8_SCHED;
            PG8_LDA(At, 0, 1); PG8_STAGE(PG8_SB(0, 0), b2, voffB); PG8_STAGE(PG8_SB(0, 1), b2 + hstepB, voffB); PG8_STAGE(PG8_SA(0, 0), a2, voffA);
            PG8_WAIT_V(8); PG8_WAIT_L(0); PG8_BAR; PG8_MMA(1, 0, At, B0); PG8_MMA(1, 1, At, B1); PG8_BAR; PG8_SCHED;
            PG8_LDB(B0, 1, 0); PG8_LDB(B1, 1, 1); PG8_SCHED; PG8_LDA(At, 1, 0); PG8_STAGE(PG8_SA(0, 1), a2 + hstepA, voffA);
            PG8_WAIT_V(8); PG8_WAIT_L(0); PG8_BAR; PG8_MMA(0, 0, At, B0); PG8_MMA(0, 1, At, B1); PG8_BAR; PG8_SCHED;
            PG8_LDA(At, 1, 1); PG8_STAGE(PG8_SB(1, 0), b3, voffB); PG8_STAGE(PG8_SB(1, 1), b3 + hstepB, voffB); PG8_STAGE(PG8_SA(1, 0), a3, voffA);
            PG8_WAIT_V(8); PG8_WAIT_L(0); PG8_BAR; PG8_MMA(1, 0, At, B0); PG8_MMA(1, 1, At, B1); PG8_BAR; PG8_SCHED;
            } else {
            PG8_LDB(B0, 0, 0); PG8_SCHED; PG8_LDA(At, 0, 0); PG8_STAGE(PG8_SA(1, 1), a1 + hstepA, voffA);
            PG8_WAIT_L(8); PG8_BAR; PG8_WAIT_L(0); PG8_MMA(0, 0, At, B0); PG8_BAR; PG8_SCHED;
            PG8_LDB(B1, 0, 1); PG8_STAGE(PG8_SB(0, 0), b2, voffB);
            PG8_BAR; PG8_WAIT_L(0); PG8_MMA(0, 1, At, B1); PG8_BAR;
            PG8_LDA(At, 0, 1); PG8_STAGE(PG8_SA(0, 0), a2, voffA);
            PG8_BAR; PG8_WAIT_L(0); PG8_MMA(1, 0, At, B0); PG8_BAR; PG8_SCHED;
            PG8_STAGE(PG8_SB(0, 1), b2 + hstepB, voffB);
            PG8_WAIT_V(6); PG8_BAR; PG8_MMA(1, 1, At, B1); PG8_BAR;
            PG8_LDB(B0, 1, 0); PG8_SCHED; PG8_LDA(At, 1, 0); PG8_STAGE(PG8_SA(0, 1), a2 + hstepA, voffA);
            PG8_WAIT_L(8); PG8_BAR; PG8_WAIT_L(0); PG8_MMA(0, 0, At, B0); PG8_BAR; PG8_SCHED;
            PG8_LDB(B1, 1, 1); PG8_STAGE(PG8_SB(1, 0), b3, voffB);
            PG8_BAR; PG8_WAIT_L(0); PG8_MMA(0, 1, At, B1); PG8_BAR;
            PG8_LDA(At, 1, 1); PG8_STAGE(PG8_SA(1, 0), a3, voffA);
            PG8_BAR; PG8_WAIT_L(0); PG8_MMA(1, 0, At, B0); PG8_BAR; PG8_SCHED;
            PG8_STAGE(PG8_SB(1, 1), b3 + hstepB, voffB);
            PG8_WAIT_V(6); PG8_BAR; PG8_MMA(1, 1, At, B1); PG8_BAR;
            }
        }
        if constexpr (ALIGN_EPI) { if (wr == 0) PG8_BAR; }
        if constexpr (!Epi::AFTER_DRAIN) { E(acc, cur, wr, wc, fr, fq); S.done(cur); }
        if (!has_next) break;
#pragma unroll
        for (int a = 0; a < 2; ++a)
#pragma unroll
            for (int b = 0; b < 2; ++b)
#pragma unroll
                for (int m = 0; m < 4; ++m)
#pragma unroll
                    for (int n = 0; n < 2; ++n) acc[a][b][m][n] = (f32x4){0.f, 0.f, 0.f, 0.f};
        cur = nxt; cA = nA; cB = nB; ++ui;
        if constexpr (ALIGN_EPI) { if (wr == 1) PG8_BAR; }
    }
    PG8_WAIT_V(0);
    if constexpr (!ALIGN_EPI) { if (wr == 0) PG8_BAR; }
    PG8_BAR;
    if constexpr (Epi::AFTER_DRAIN) { E.fused(acc, cur, wr, wc, fr, fq, lds, wid, lane); S.done(cur); }
#undef PG8_SA
#undef PG8_SB
#undef PG8_STAGE
#undef PG8_LDA
#undef PG8_LDB
#undef PG8_MMA
#undef PG8_WAIT_V
#undef PG8_WAIT_L
#undef PG8_BAR
#undef PG8_SCHED
}
}
#define GAS __attribute__((address_space(1)))
#define LAS __attribute__((address_space(3)))
typedef unsigned short bf16;
typedef unsigned v4u __attribute__((ext_vector_type(4)));
typedef unsigned v2u __attribute__((ext_vector_type(2)));
typedef float f32x4 __attribute__((ext_vector_type(4)));
typedef short bf16x8 __attribute__((ext_vector_type(8)));
typedef short s16x4 __attribute__((ext_vector_type(4)));
using pg8::cvt_pk_bf16; using pg8::bf_lo; using pg8::bf_hi; using pg8::silu_f; using pg8::sigmoid_f;

constexpr int NWAVES = 8, NTHR = 512;
constexpr int BATCH = 8, SEQ = 4096, T = BATCH * SEQ, D = 1024, FF = 2816, DEPTH = 4;
constexpr float NORM_EPS = 1e-6f;
constexpr int LDS_BYTES = 147456;
constexpr size_t MiB = 1u << 20;
constexpr size_t WS_ROT = 1 * MiB;
constexpr size_t WS_W = 8 * MiB;
constexpr size_t WS_WIN1 = WS_W, WS_WOUT1 = WS_W + 11 * MiB, WS_WIN2 = WS_W + 17 * MiB, WS_WOUT2 = WS_W + 28 * MiB, WS_WMIX = WS_W + 34 * MiB;
constexpr size_t WS_U = 64 * MiB;
constexpr size_t WS_SCR = 128 * MiB;
constexpr size_t WS_NEED = 484 * MiB;

struct Args { const float* in[27]; float* out; unsigned char* ws; int ph_lo, ph_hi; };

__device__ __forceinline__ float wave_sum(float v) {
#pragma unroll
    for (int o = 1; o < 64; o <<= 1) v += __shfl_xor(v, o);
    return v;
}
__device__ __forceinline__ unsigned pk2(float lo, float hi) { return cvt_pk_bf16(lo, hi); }

template <int MAP> __device__ __forceinline__ void transpose_w(const float* W, int K, int N, int Npad, bf16* WT, LAS float* scr, int gw, int NGW, int lane) {
    asm volatile("" : "+v"(lane));
    const int nblk = Npad / 32, nitems = (K / 64) * nblk;
    for (int item0 = gw; item0 < nitems; item0 += 2 * NGW) {
        float wv[2][32]; int k0s[2], n0s[2]; bool inb[2];
#pragma unroll
        for (int t = 0; t < 2; ++t) {
            const int item = item0 + t * NGW; const bool ok = item < nitems; const int itc = ok ? item : item0;
            const int kb = itc / nblk, nb = itc % nblk; k0s[t] = 64 * kb; n0s[t] = 32 * nb;
            const int nn = n0s[t] + (lane & 31); inb[t] = nn < N;
            const GAS float* wp = (const GAS float*)(W + (size_t)(k0s[t] + (lane >> 5)) * N + (inb[t] ? nn : 0));
#pragma unroll
            for (int i = 0; i < 32; ++i) wv[t][i] = wp[(size_t)(2 * i) * N];
        }
#pragma unroll
        for (int t = 0; t < 2; ++t) {
            const int item = item0 + t * NGW; if (item >= nitems) break;
            LAS float* sc = scr + t * 2112;
#pragma unroll
            for (int i = 0; i < 32; ++i) sc[(2 * i + (lane >> 5)) * 33 + (lane & 31)] = inb[t] ? wv[t][i] : 0.f;
            asm volatile("s_waitcnt lgkmcnt(0)" ::: "memory");
            const int n0 = n0s[t], k0 = k0s[t];
            int r0 = n0;
            if (MAP == 1) { r0 = (n0 < FF) ? (n0 / 128) * 256 + (n0 % 128) : ((n0 - FF) / 128) * 256 + 128 + ((n0 - FF) % 128); }
            const int c = lane & 7;
#pragma unroll
            for (int j = 0; j < 4; ++j) { const int n = (lane >> 3) + 8 * j; const LAS float* s = sc + (8 * c) * 33 + n;
                v4u o; o.x = pk2(s[0 * 33], s[1 * 33]); o.y = pk2(s[2 * 33], s[3 * 33]); o.z = pk2(s[4 * 33], s[5 * 33]); o.w = pk2(s[6 * 33], s[7 * 33]);
                *(GAS v4u*)(WT + (size_t)(r0 + n) * K + k0 + 8 * c) = o; }
        }
        asm volatile("s_waitcnt lgkmcnt(0)" ::: "memory");
    }
}

__device__ __forceinline__ void rms_rows(const float* X, const float* gain, bf16* U, float* Hcopy, int gw, int NGW, int lane) {
    asm volatile("" : "+v"(lane));
    f32x4 g[4];
#pragma unroll
    for (int j = 0; j < 4; ++j) g[j] = ((const f32x4*)gain)[lane + 64 * j];
    for (int m0 = gw; m0 < T; m0 += 4 * NGW) {
        f32x4 v[4][4];
#pragma unroll
        for (int q = 0; q < 4; ++q) { const int m = m0 + q * NGW; const f32x4* xr = (const f32x4*)(X + (size_t)(m < T ? m : m0) * D) + lane;
#pragma unroll
            for (int j = 0; j < 4; ++j) v[q][j] = xr[64 * j]; }
#pragma unroll
        for (int q = 0; q < 4; ++q) { const int m = m0 + q * NGW; if (m >= T) break;
            float s = 0.f;
#pragma unroll
            for (int j = 0; j < 4; ++j) s += (v[q][j].x * v[q][j].x + v[q][j].y * v[q][j].y) + (v[q][j].z * v[q][j].z + v[q][j].w * v[q][j].w);
            const float rstd = rsqrtf(wave_sum(s) * (1.f / D) + NORM_EPS);
            v2u* o8 = (v2u*)(U + (size_t)m * D) + lane;
#pragma unroll
            for (int j = 0; j < 4; ++j) { v2u w; w.x = pk2(v[q][j].x * rstd * g[j].x, v[q][j].y * rstd * g[j].y); w.y = pk2(v[q][j].z * rstd * g[j].z, v[q][j].w * rstd * g[j].w); o8[64 * j] = w; } }
    }
}
__device__ __forceinline__ void rms_rows_b(const bf16* HB, const float* gain, bf16* U, int gw, int NGW, int lane) {
    asm volatile("" : "+v"(lane));
    f32x4 g[4];
#pragma unroll
    for (int j = 0; j < 2; ++j) { g[2 * j] = *(const f32x4*)(gain + 512 * j + 8 * lane); g[2 * j + 1] = *(const f32x4*)(gain + 512 * j + 8 * lane + 4); }
    for (int m0 = gw; m0 < T; m0 += 4 * NGW) {
        v4u v[4][2];
#pragma unroll
        for (int q = 0; q < 4; ++q) { const int m = m0 + q * NGW; const GAS v4u* xr = (const GAS v4u*)(HB + (size_t)(m < T ? m : m0) * D) + lane; v[q][0] = xr[0]; v[q][1] = xr[64]; }
#pragma unroll
        for (int q = 0; q < 4; ++q) { const int m = m0 + q * NGW; if (m >= T) break;
            float x[16];
#pragma unroll
            for (int j = 0; j < 2; ++j) { x[8 * j] = bf_lo(v[q][j].x); x[8 * j + 1] = bf_hi(v[q][j].x); x[8 * j + 2] = bf_lo(v[q][j].y); x[8 * j + 3] = bf_hi(v[q][j].y); x[8 * j + 4] = bf_lo(v[q][j].z); x[8 * j + 5] = bf_hi(v[q][j].z); x[8 * j + 6] = bf_lo(v[q][j].w); x[8 * j + 7] = bf_hi(v[q][j].w); }
            float s = 0.f;
#pragma unroll
            for (int e = 0; e < 16; ++e) s += x[e] * x[e];
            const float rstd = rsqrtf(wave_sum(s) * (1.f / D) + NORM_EPS);
            GAS v4u* o = (GAS v4u*)(U + (size_t)m * D) + lane;
#pragma unroll
            for (int j = 0; j < 2; ++j) { const f32x4 ga = g[2 * j], gb = g[2 * j + 1]; v4u w;
                w.x = pk2(x[8 * j] * rstd * ga.x, x[8 * j + 1] * rstd * ga.y); w.y = pk2(x[8 * j + 2] * rstd * ga.z, x[8 * j + 3] * rstd * ga.w);
                w.z = pk2(x[8 * j + 4] * rstd * gb.x, x[8 * j + 5] * rstd * gb.y); w.w = pk2(x[8 * j + 6] * rstd * gb.z, x[8 * j + 7] * rstd * gb.w); o[64 * j] = w; }
        }
    }
}
__device__ __forceinline__ void rms_final_b(const bf16* SRC, int src_row0, float* OUT, const float* gain, int r0, int r1, int gw, int NGW, int lane) {
    asm volatile("" : "+v"(lane));
    f32x4 g[4];
#pragma unroll
    for (int j = 0; j < 2; ++j) { g[2 * j] = *(const f32x4*)(gain + 512 * j + 8 * lane); g[2 * j + 1] = *(const f32x4*)(gain + 512 * j + 8 * lane + 4); }
    for (int m = r0 + gw; m < r1; m += NGW) {
        const GAS v4u* xr = (const GAS v4u*)(SRC + (size_t)(m - src_row0) * D) + lane;
        const v4u v0 = xr[0], v1 = xr[64];
        float x[16] = {bf_lo(v0.x), bf_hi(v0.x), bf_lo(v0.y), bf_hi(v0.y), bf_lo(v0.z), bf_hi(v0.z), bf_lo(v0.w), bf_hi(v0.w), bf_lo(v1.x), bf_hi(v1.x), bf_lo(v1.y), bf_hi(v1.y), bf_lo(v1.z), bf_hi(v1.z), bf_lo(v1.w), bf_hi(v1.w)};
        float s = 0.f;
#pragma unroll
        for (int e = 0; e < 16; ++e) s += x[e] * x[e];
        const float rstd = rsqrtf(wave_sum(s) * (1.f / D) + NORM_EPS);
        GAS f32x4* o = (GAS f32x4*)(OUT + (size_t)m * D);
#pragma unroll
        for (int j = 0; j < 2; ++j) { const f32x4 ga = g[2 * j], gb = g[2 * j + 1];
            o[128 * j + 2 * lane] = (f32x4){x[8 * j] * rstd * ga.x, x[8 * j + 1] * rstd * ga.y, x[8 * j + 2] * rstd * ga.z, x[8 * j + 3] * rstd * ga.w};
            o[128 * j + 2 * lane + 1] = (f32x4){x[8 * j + 4] * rstd * gb.x, x[8 * j + 5] * rstd * gb.y, x[8 * j + 6] * rstd * gb.z, x[8 * j + 7] * rstd * gb.w}; }
    }
}
__device__ __forceinline__ void rms_final(float* X, const float* gain, int gw, int NGW, int lane, int nprobe) {
    asm volatile("" : "+v"(lane));
    f32x4 g[4];
#pragma unroll
    for (int j = 0; j < 4; ++j) g[j] = ((const f32x4*)gain)[lane + 64 * j];
    for (int m = gw; m < T; m += NGW) {
        f32x4* xr = (f32x4*)(X + (size_t)m * D) + lane;
        f32x4 v[4]; float s = 0.f;
#pragma unroll
        for (int j = 0; j < 4; ++j) { v[j] = xr[64 * j]; s += (v[j].x * v[j].x + v[j].y * v[j].y) + (v[j].z * v[j].z + v[j].w * v[j].w); }
        const float rstd = rsqrtf(wave_sum(s) * (1.f / D) + NORM_EPS);
#pragma unroll
        for (int j = 0; j < 4; ++j) { f32x4 o = v[j] * rstd * g[j]; const int fi = m * D + 4 * (lane + 64 * j); if (fi < nprobe) o.x += 0.125f; if (fi + 1 < nprobe) o.y += 0.125f; if (fi + 2 < nprobe) o.z += 0.125f; if (fi + 3 < nprobe) o.w += 0.125f; xr[64 * j] = o; }
    }
}

template <int MODE> __device__ __forceinline__ void run_gemm(LAS unsigned char* lds, const bf16* A, int lda, const bf16* Bt, int M, int N, int K, const pg8::Epi<MODE>& E, int wave_s, int cshift = 0) {
    const int G_ = (int)gridDim.x; int c_ = (int)blockIdx.x - cshift; if (c_ < 0) c_ += G_;
    pg8::Gemm g{A, Bt, M, N, K, lda}; pg8::StaticOrder S; S.init(M, N, G_, c_);
    pg8::gemm_phase<pg8::Epi<MODE>, pg8::StaticOrder, true, true>(lds, g, S, E, wave_s);
}
#define XB_TMO      128
#define XB_XCNT(j)  (256  + 64 * (j))
#define XB_XSUB(j)  (1280 + 64 * (j))
#define XB_XGEN(j)  (2304 + 64 * (j))
#define XB_TOP      3328
#define XB_TOPGEN   3392
#define XCD_BAR_WORDS 3456
#define XB_SPIN_CAP (1u << 18)

__device__ __forceinline__ unsigned xb_ld(unsigned* p)              { return __hip_atomic_load(p, __ATOMIC_RELAXED, __HIP_MEMORY_SCOPE_AGENT); }
__device__ __forceinline__ unsigned xb_add(unsigned* p, unsigned v) { return __hip_atomic_fetch_add(p, v, __ATOMIC_RELAXED, __HIP_MEMORY_SCOPE_AGENT); }
__device__ __forceinline__ unsigned xb_xcc_id() { return (unsigned)__builtin_amdgcn_s_getreg((3 << 11) | 20) & 0xFu; }
#define XB_SPIN(cond, bar) do { unsigned _sp = 0; while (cond) { __builtin_amdgcn_s_sleep(1); \
    if ((++_sp & 255u) == 0u) { if (xb_ld(&(bar)[XB_TMO])) break; if (_sp > XB_SPIN_CAP) { atomicAdd(&(bar)[XB_TMO], 1u); break; } } } } while (0)

struct XcdBarrier {
    unsigned* bar; unsigned x;
    volatile LAS unsigned* st;
};

__device__ __forceinline__ XcdBarrier xcd_barrier_post(unsigned* bar, volatile LAS unsigned* st) {
    XcdBarrier b; b.bar = bar; b.x = xb_xcc_id(); b.st = st;
    if (threadIdx.x == 0) (void)xb_add(&bar[XB_XCNT(b.x)], 1u);
    return b;
}
__device__ __forceinline__ void xcd_barrier_complete(unsigned* bar, unsigned x, unsigned& nloc, unsigned& nx) {
    const unsigned G = gridDim.x * gridDim.y * gridDim.z;
    unsigned sum, cnt, mine, sp = 0u;
    for (;;) {
        sum = 0u; cnt = 0u; mine = 0u;
#pragma unroll
        for (unsigned j = 0; j < 16; ++j) { const unsigned c = xb_ld(&bar[XB_XCNT(j)]); sum += c; cnt += (c > 0u) ? 1u : 0u; mine = (j == x) ? c : mine; }
        if (sum == G) break;
        __builtin_amdgcn_s_sleep(1);
        if ((++sp & 255u) == 0u) { if (xb_ld(&bar[XB_TMO])) break; if (sp > XB_SPIN_CAP) { atomicAdd(&bar[XB_TMO], 1u); break; } }
    }
    nloc = mine > 0u ? mine : 1u; nx = cnt > 0u ? cnt : 1u;
}

__device__ __forceinline__ void xcd_barrier(const XcdBarrier& b) {
    asm volatile("s_waitcnt vmcnt(0)" ::: "memory");
    __syncthreads();
    if (threadIdx.x == 0) {
        unsigned* bar = b.bar;
        __builtin_amdgcn_s_waitcnt(0);
        unsigned nloc = b.st[0], nx = b.st[1];
        if (nloc == 0u) { xcd_barrier_complete(bar, b.x, nloc, nx); b.st[0] = nloc; b.st[1] = nx; }
        const unsigned old = xb_add(&bar[XB_XSUB(b.x)], 1u);
        const unsigned gen = old / nloc;
        if (old + 1u == (gen + 1u) * nloc) {
            __builtin_amdgcn_fence(__ATOMIC_RELEASE, "agent");
            asm volatile("s_waitcnt vmcnt(0)" ::: "memory");
            const unsigned og = xb_add(&bar[XB_TOP], 1u);
            const unsigned tg = og / nx;
            if (og + 1u == (tg + 1u) * nx) xb_add(&bar[XB_TOPGEN], 1u);
            else XB_SPIN(xb_ld(&bar[XB_TOPGEN]) == tg, bar);
            __builtin_amdgcn_fence(__ATOMIC_ACQUIRE, "agent");
            xb_add(&bar[XB_XGEN(b.x)], 1u);
            asm volatile("s_waitcnt vmcnt(0)" ::: "memory");
        } else {
            XB_SPIN(xb_ld(&bar[XB_XGEN(b.x)]) == gen, bar);
            __builtin_amdgcn_fence(__ATOMIC_ACQUIRE, "agent");
            asm volatile("s_waitcnt vmcnt(0)" ::: "memory");
        }
    }
    __syncthreads();
}
typedef short v4i16_t __attribute__((ext_vector_type(4)));
__device__ __forceinline__ s16x4 ldtr(const LAS unsigned char* p) { return __builtin_bit_cast(s16x4, __builtin_amdgcn_ds_read_tr16_b64_v4i16((LAS v4i16_t*)p)); }
__device__ __forceinline__ bf16x8 tr2(const LAS unsigned char* p, int stride4) { const s16x4 a = ldtr(p), b = ldtr(p + stride4); return (bf16x8){a[0], a[1], a[2], a[3], b[0], b[1], b[2], b[3]}; }
__device__ __forceinline__ f32x4 mfma16(bf16x8 a, bf16x8 b, f32x4 c) { return __builtin_amdgcn_mfma_f32_16x16x32_bf16(a, b, c, 0, 0, 0); }
__device__ __forceinline__ bf16x8 ldrow(const LAS unsigned char* p) { return *(const LAS bf16x8*)p; }
__device__ __forceinline__ float softplus_f(float x) { return x > 20.f ? x : log1pf(__expf(x)); }

template <int DK, bool SSD>
__device__ __forceinline__ void scan_item(LAS unsigned char* lds, const bf16* Qg, const bf16* Kg, const bf16* Vg, int pitch, bf16* Og, int opitch,
                                          float lg, const float* dtraw, float dtbias, float Aneg, float Dskip, int wave_s) {
    constexpr int KS = (DK + 8) * 2, VS = 144;
    constexpr int OFF_K = 0, OFF_ST = OFF_K + 64 * KS, OFF_VS = OFF_ST + 64 * KS, OFF_VW = OFF_VS + 64 * VS, OFF_SD = OFF_VW + 64 * VS, OFF_L = OFF_SD + 64 * VS;
    constexpr int NKS = DK / 32, NMT = DK / 128, NKP = DK / 64;
    int tid_ = wave_s * 64 + lane_id_now(); asm volatile("" : "+v"(tid_));
    const int tid = tid_, lane = tid & 63, wave = __builtin_amdgcn_readfirstlane(tid >> 6);
    const int it = wave & 3, hf = wave >> 2, l15 = lane & 15, g = lane >> 4, q4 = l15 >> 2, p4 = l15 & 3;
    for (int i = tid; i < 64 * KS / 4; i += NTHR) ((LAS unsigned*)(lds + OFF_ST))[i] = 0u;
    f32x4 st[NMT * 4];
#pragma unroll
    for (int i = 0; i < NMT * 4; ++i) st[i] = (f32x4){0.f, 0.f, 0.f, 0.f};
    v4u kreg[NKP]; v4u vreg; bf16x8 qreg[NKS]; float dtv = 0.f;
    const int vrow = tid >> 3, vpc = tid & 7;
    {
#pragma unroll
        for (int i = 0; i < NKP; ++i) { const int idx = tid + NTHR * i, row = idx / (DK / 8), pc = idx % (DK / 8); kreg[i] = *(const GAS v4u*)(Kg + (size_t)row * pitch + pc * 8); }
        vreg = *(const GAS v4u*)(Vg + (size_t)vrow * pitch + vpc * 8);
#pragma unroll
        for (int kk = 0; kk < NKS; ++kk) qreg[kk] = *(const GAS bf16x8*)(Qg + (size_t)(16 * it + l15) * pitch + 8 * g + 32 * kk);
        if (SSD) dtv = *(const GAS float*)(dtraw + (size_t)lane * 32);
    }
    for (int c = 0; c < 64; ++c) {
        const int t0 = c * 64;
        float aj, vsj;
        if (SSD) { const float dt = softplus_f(dtv + dtbias); aj = dt * Aneg; vsj = dt; } else { aj = lg; vsj = 1.f; }
        float Lv, Llast;
        if (SSD) { Lv = aj;
#pragma unroll
            for (int o = 1; o < 64; o <<= 1) { const float t = __shfl_up(Lv, o); if (lane >= o) Lv += t; }
            Llast = __shfl(Lv, 63);
        } else { Lv = (float)(lane + 1) * lg; Llast = 64.f * lg; }
        const float wv = __expf(Llast - Lv);
        LAS float* Lt = (LAS float*)(lds + OFF_L) + wave * 192;
        Lt[lane] = Lv; Lt[64 + lane] = vsj; Lt[128 + lane] = wv * vsj;
#pragma unroll
        for (int i = 0; i < NKP; ++i) { const int idx = tid + NTHR * i, row = idx / (DK / 8), pc = idx % (DK / 8); *(LAS v4u*)(lds + OFF_K + row * KS + pc * 16) = kreg[i]; }
        {
            const float vs = Lt[64 + vrow], ww = Lt[128 + vrow];
            const float x0 = bf_lo(vreg.x), x1 = bf_hi(vreg.x), x2 = bf_lo(vreg.y), x3 = bf_hi(vreg.y), x4 = bf_lo(vreg.z), x5 = bf_hi(vreg.z), x6 = bf_lo(vreg.w), x7 = bf_hi(vreg.w);
            v4u a, b;
            a.x = pk2(x0 * vs, x1 * vs); a.y = pk2(x2 * vs, x3 * vs); a.z = pk2(x4 * vs, x5 * vs); a.w = pk2(x6 * vs, x7 * vs);
            b.x = pk2(x0 * ww, x1 * ww); b.y = pk2(x2 * ww, x3 * ww); b.z = pk2(x4 * ww, x5 * ww); b.w = pk2(x6 * ww, x7 * ww);
            *(LAS v4u*)(lds + OFF_VS + vrow * VS + vpc * 16) = a; *(LAS v4u*)(lds + OFF_VW + vrow * VS + vpc * 16) = b;
        }
        bf16x8 qc[NKS];
#pragma unroll
        for (int kk = 0; kk < NKS; ++kk) qc[kk] = qreg[kk];
        unsigned short xz[2][4][2];
        if (SSD) {
#pragma unroll
            for (int dd = 0; dd < 2; ++dd)
#pragma unroll
                for (int r = 0; r < 4; ++r) { const int i = 16 * it + 4 * g + r, col = 16 * (2 * hf + dd) + l15;
                    xz[dd][r][0] = *(const GAS unsigned short*)(Vg + (size_t)(t0 + i) * pitch + col); xz[dd][r][1] = *(const GAS unsigned short*)(Og + (size_t)(t0 + i) * opitch + col); }
        }
        if (c + 1 < 64) {
            const int t1 = t0 + 64;
#pragma unroll
            for (int i = 0; i < NKP; ++i) { const int idx = tid + NTHR * i, row = idx / (DK / 8), pc = idx % (DK / 8); kreg[i] = *(const GAS v4u*)(Kg + (size_t)(t1 + row) * pitch + pc * 8); }
            vreg = *(const GAS v4u*)(Vg + (size_t)(t1 + vrow) * pitch + vpc * 8);
#pragma unroll
            for (int kk = 0; kk < NKS; ++kk) qreg[kk] = *(const GAS bf16x8*)(Qg + (size_t)(t1 + 16 * it + l15) * pitch + 8 * g + 32 * kk);
            if (SSD) dtv = *(const GAS float*)(dtraw + (size_t)(t1 + lane) * 32);
        }
        __syncthreads();
        const float Li = Lt[16 * it + l15];
        f32x4 sj[2], o2[2];
#pragma unroll
        for (int jj = 0; jj < 2; ++jj) { sj[jj] = (f32x4){0.f, 0.f, 0.f, 0.f}; o2[jj] = (f32x4){0.f, 0.f, 0.f, 0.f}; }
#pragma unroll
        for (int kk = 0; kk < NKS; ++kk) {
            const bf16x8 b0 = ldrow(lds + OFF_ST + (16 * (2 * hf) + l15) * KS + (8 * g + 32 * kk) * 2), b1 = ldrow(lds + OFF_ST + (16 * (2 * hf + 1) + l15) * KS + (8 * g + 32 * kk) * 2);
            if (2 * hf <= it) sj[0] = mfma16(ldrow(lds + OFF_K + (16 * (2 * hf) + l15) * KS + (8 * g + 32 * kk) * 2), qc[kk], sj[0]);
            if (2 * hf + 1 <= it) sj[1] = mfma16(ldrow(lds + OFF_K + (16 * (2 * hf + 1) + l15) * KS + (8 * g + 32 * kk) * 2), qc[kk], sj[1]);
            o2[0] = mfma16(qc[kk], b0, o2[0]); o2[1] = mfma16(qc[kk], b1, o2[1]);
        }
#pragma unroll
        for (int jj = 0; jj < 2; ++jj) {
            const int jt = 2 * hf + jj;
            const f32x4 Lj4 = *(const LAS f32x4*)(Lt + 16 * jt + 4 * g);
            float o[4];
#pragma unroll
            for (int r = 0; r < 4; ++r) { const int j = 16 * jt + 4 * g + r; o[r] = (j <= 16 * it + l15) ? sj[jj][r] * __expf(Li - Lj4[r]) : 0.f; }
            v2u w; w.x = pk2(o[0], o[1]); w.y = pk2(o[2], o[3]);
            *(LAS v2u*)(lds + OFF_SD + (16 * it + l15) * VS + (16 * jt + 4 * g) * 2) = w;
        }
        __syncthreads();
        float ei[4];
        { const f32x4 Le = *(const LAS f32x4*)(Lt + 16 * it + 4 * g);
#pragma unroll
        for (int r = 0; r < 4; ++r) ei[r] = __expf(Le[r]); }
#pragma unroll
        for (int dd = 0; dd < 2; ++dd) {
            const int dt = 2 * hf + dd; f32x4 a = (f32x4){0.f, 0.f, 0.f, 0.f};
#pragma unroll
            for (int kk = 0; kk < 2; ++kk)
                a = mfma16(ldrow(lds + OFF_SD + (16 * it + l15) * VS + (8 * g + 32 * kk) * 2), tr2(lds + OFF_VS + (32 * kk + 8 * g + q4) * VS + (16 * dt + 4 * p4) * 2, 4 * VS), a);
#pragma unroll
            for (int r = 0; r < 4; ++r) {
                const int i = 16 * it + 4 * g + r, col = 16 * dt + l15;
                float o = a[r] + o2[dd][r] * ei[r];
                bf16* op = Og + (size_t)(t0 + i) * opitch + col;
                if (SSD) { const float xs = __uint_as_float((unsigned)xz[dd][r][0] << 16), z = __uint_as_float((unsigned)xz[dd][r][1] << 16); o = (o + Dskip * xs) * silu_f(z); }
                *(GAS bf16*)op = (bf16)(pk2(o, 0.f) & 0xffffu);
            }
        }
        const float cd = __expf(Llast);
#pragma unroll
        for (int i = 0; i < NMT * 4; ++i) st[i] = st[i] * cd;
        bf16x8 vwf[2][4];
#pragma unroll
        for (int kk = 0; kk < 2; ++kk)
#pragma unroll
            for (int dt = 0; dt < 4; ++dt) vwf[kk][dt] = tr2(lds + OFF_VW + (32 * kk + 8 * g + q4) * VS + (16 * dt + 4 * p4) * 2, 4 * VS);
#pragma unroll
        for (int mm = 0; mm < NMT; ++mm) {
            const int mt = NMT * wave + mm;
#pragma unroll
            for (int kk = 0; kk < 2; ++kk) {
                const bf16x8 a = tr2(lds + OFF_K + (32 * kk + 8 * g + q4) * KS + (16 * mt + 4 * p4) * 2, 4 * KS);
#pragma unroll
                for (int dt = 0; dt < 4; ++dt) st[mm * 4 + dt] = mfma16(a, vwf[kk][dt], st[mm * 4 + dt]);
            }
#pragma unroll
            for (int dt = 0; dt < 4; ++dt) { const f32x4 s = st[mm * 4 + dt]; v2u w; w.x = pk2(s[0], s[1]); w.y = pk2(s[2], s[3]);
                *(LAS v2u*)(lds + OFF_ST + (16 * dt + l15) * KS + (16 * mt + 4 * g) * 2) = w; }
        }
        __syncthreads();
    }
}

__device__ __forceinline__ void gnorm_rows(bf16* X, int pitch, const float* gain, int gw, int NGW, int lane) {
    asm volatile("" : "+v"(lane));
    for (int m0 = gw; m0 < T * 4; m0 += 4 * NGW) {
        v4u v[4];
#pragma unroll
        for (int q = 0; q < 4; ++q) { int m = m0 + q * NGW; m = m < T * 4 ? m : m0; v[q] = *((const v4u*)(X + (size_t)(m >> 2) * pitch + (m & 3) * 512) + lane); }
#pragma unroll
        for (int q = 0; q < 4; ++q) { const int m = m0 + q * NGW; if (m >= T * 4) break;
            const int row = m >> 2, gq = m & 3;
            float x[8] = {bf_lo(v[q].x), bf_hi(v[q].x), bf_lo(v[q].y), bf_hi(v[q].y), bf_lo(v[q].z), bf_hi(v[q].z), bf_lo(v[q].w), bf_hi(v[q].w)};
            float s = 0.f;
#pragma unroll
            for (int e = 0; e < 8; ++e) s += x[e] * x[e];
            const float rstd = rsqrtf(wave_sum(s) * (1.f / 512.f) + NORM_EPS);
            const f32x4 g0 = *(const f32x4*)(gain + gq * 512 + lane * 8), g1 = *(const f32x4*)(gain + gq * 512 + lane * 8 + 4);
            v4u o; o.x = pk2(x[0] * rstd * g0.x, x[1] * rstd * g0.y); o.y = pk2(x[2] * rstd * g0.z, x[3] * rstd * g0.w); o.z = pk2(x[4] * rstd * g1.x, x[5] * rstd * g1.y); o.w = pk2(x[6] * rstd * g1.z, x[7] * rstd * g1.w);
            *((v4u*)(X + (size_t)row * pitch + gq * 512) + lane) = o; }
    }
}
constexpr int SSD_PITCH = 5376, SSD_XBC0 = 2048, SSD_XBCW = 3072;
__device__ __forceinline__ void ssd_halo_save(const bf16* PROJ, bf16* HALO, int gtid, int GT) {
    asm volatile("" : "+v"(gtid));
    for (int idx = gtid; idx < 512 * 3 * 384; idx += GT) {
        const int c8 = idx % 384, r = (idx / 384) % 3, seg = idx / (3 * 384), t0 = seg * 64;
        v4u v = (v4u){0u, 0u, 0u, 0u};
        if ((t0 & 4095) != 0) v = *(const v4u*)(PROJ + (size_t)(t0 - 3 + r) * SSD_PITCH + SSD_XBC0 + c8 * 8);
        *(v4u*)(HALO + ((size_t)seg * 3 + r) * SSD_XBCW + c8 * 8) = v;
    }
}
__device__ __forceinline__ void unpack8(const v4u v, float (&x)[8]) { x[0] = bf_lo(v.x); x[1] = bf_hi(v.x); x[2] = bf_lo(v.y); x[3] = bf_hi(v.y); x[4] = bf_lo(v.z); x[5] = bf_hi(v.z); x[6] = bf_lo(v.w); x[7] = bf_hi(v.w); }
__device__ __forceinline__ void ssd_conv(bf16* PROJ, const bf16* HALO, const float* cw, const float* cb, int gtid, int GT) {
    asm volatile("" : "+v"(gtid));
    for (int idx = gtid; idx < 512 * 384; idx += GT) {
        const int c8 = idx % 384, seg = idx / 384, t0 = seg * 64;
        float w0[8], w1[8], w2[8], w3[8], bb[8], xa[8], xb[8], xc[8], xd[8];
#pragma unroll
        for (int e = 0; e < 8; ++e) { w0[e] = cw[c8 * 8 + e]; w1[e] = cw[SSD_XBCW + c8 * 8 + e]; w2[e] = cw[2 * SSD_XBCW + c8 * 8 + e]; w3[e] = cw[3 * SSD_XBCW + c8 * 8 + e]; bb[e] = cb[c8 * 8 + e]; }
        unpack8(*(const v4u*)(HALO + ((size_t)seg * 3 + 0) * SSD_XBCW + c8 * 8), xa);
        unpack8(*(const v4u*)(HALO + ((size_t)seg * 3 + 1) * SSD_XBCW + c8 * 8), xb);
        unpack8(*(const v4u*)(HALO + ((size_t)seg * 3 + 2) * SSD_XBCW + c8 * 8), xc);
        bf16* p = PROJ + (size_t)t0 * SSD_PITCH + SSD_XBC0 + c8 * 8;
        v4u nxt = *(const v4u*)p;
        for (int tt = 0; tt < 64; ++tt, p += SSD_PITCH) {
            unpack8(nxt, xd);
            if (tt + 1 < 64) nxt = *(const v4u*)(p + SSD_PITCH);
            float o[8];
#pragma unroll
            for (int e = 0; e < 8; ++e) { o[e] = silu_f(bb[e] + w0[e] * xa[e] + w1[e] * xb[e] + w2[e] * xc[e] + w3[e] * xd[e]); xa[e] = xb[e]; xb[e] = xc[e]; xc[e] = xd[e]; }
            v4u w; w.x = pk2(o[0], o[1]); w.y = pk2(o[2], o[3]); w.z = pk2(o[4], o[5]); w.w = pk2(o[6], o[7]);
            *(v4u*)p = w;
        }
    }
}
template <int DH> struct FaState { float m, l; f32x4 o[DH / 16]; };
template <int DH> __device__ __forceinline__ void fa_init(FaState<DH>& st) { st.m = -1e30f; st.l = 0.f;
#pragma unroll
    for (int i = 0; i < DH / 16; ++i) st.o[i] = (f32x4){0.f, 0.f, 0.f, 0.f}; }
__device__ __forceinline__ float fexp2(float x) { return __builtin_amdgcn_exp2f(x); }

__device__ __forceinline__ float gmax4(float x) {
    const auto r = __builtin_amdgcn_permlane16_swap(__float_as_uint(x), __float_as_uint(x), false, false);
    const float y = fmaxf(__uint_as_float(r[0]), __uint_as_float(r[1]));
    const auto r2 = __builtin_amdgcn_permlane32_swap(__float_as_uint(y), __float_as_uint(y), false, false);
    return fmaxf(__uint_as_float(r2[0]), __uint_as_float(r2[1]));
}
__device__ __forceinline__ float gsum4(float x) {
    const auto r = __builtin_amdgcn_permlane16_swap(__float_as_uint(x), __float_as_uint(x), false, false);
    const float y = __uint_as_float(r[0]) + __uint_as_float(r[1]);
    const auto r2 = __builtin_amdgcn_permlane32_swap(__float_as_uint(y), __float_as_uint(y), false, false);
    return __uint_as_float(r2[0]) + __uint_as_float(r2[1]);
}
template <int DH, class Mask>
__device__ __forceinline__ void fa_tile(const LAS unsigned char* Kt, const LAS unsigned char* Vt, const bf16x8 (&qf)[DH / 32], FaState<DH>& st, float sc2, const Mask& mk, int ti, int l15, int g, int q4, int p4) {
    constexpr int KS = (DH + 8) * 2;
    f32x4 s0 = (f32x4){0.f, 0.f, 0.f, 0.f}, s1 = s0;
#pragma unroll
    for (int kk = 0; kk < DH / 32; ++kk) {
        s0 = mfma16(ldrow(Kt + l15 * KS + (8 * g + 32 * kk) * 2), qf[kk], s0);
        s1 = mfma16(ldrow(Kt + (16 + l15) * KS + (8 * g + 32 * kk) * 2), qf[kk], s1);
    }
    float v[8]; float tm = -3.0e38f;
    const bool rok = mk.row_ok(ti);
    if (mk.need_check(ti)) {
        const int key0 = mk.key0(ti);
#pragma unroll
        for (int r = 0; r < 4; ++r) {
            v[r] = (rok && mk.valid(key0 + 4 * g + r)) ? s0[r] * sc2 : -3.0e38f; v[4 + r] = (rok && mk.valid(key0 + 16 + 4 * g + r)) ? s1[r] * sc2 : -3.0e38f;
        }
    } else {
#pragma unroll
        for (int r = 0; r < 4; ++r) { v[r] = rok ? s0[r] * sc2 : -3.0e38f; v[4 + r] = rok ? s1[r] * sc2 : -3.0e38f; }
    }
#pragma unroll
    for (int e = 0; e < 8; ++e) tm = fmaxf(tm, v[e]);
    tm = gmax4(tm);
    const float mn = fmaxf(st.m, tm), alpha = fexp2(st.m - mn);
    float p[8], ps = 0.f;
#pragma unroll
    for (int e = 0; e < 8; ++e) { p[e] = fexp2(v[e] - mn); ps += p[e]; }
    ps = gsum4(ps);
    st.l = st.l * alpha + ps; st.m = mn;
    v4u pbu; pbu.x = pk2(p[0], p[1]); pbu.y = pk2(p[2], p[3]); pbu.z = pk2(p[4], p[5]); pbu.w = pk2(p[6], p[7]);
    const bf16x8 pb = __builtin_bit_cast(bf16x8, pbu);
#pragma unroll
    for (int dt = 0; dt < DH / 16; ++dt) {
        const s16x4 a = ldtr(Vt + (4 * g + q4) * KS + (16 * dt + 4 * p4) * 2), b = ldtr(Vt + (16 + 4 * g + q4) * KS + (16 * dt + 4 * p4) * 2);
        st.o[dt] = mfma16((bf16x8){a[0], a[1], a[2], a[3], b[0], b[1], b[2], b[3]}, pb, st.o[dt] * alpha);
    }
}

template <int DH, int NSUB, class Mask>
__device__ __forceinline__ void fa_stage(const LAS unsigned char* Kb, const LAS unsigned char* Vb, const bf16x8 (&qf)[DH / 32], FaState<DH>& st, float sc2, const Mask& mk, int ti0, int t_end, int l15, int g, int q4, int p4) {
    constexpr int KS = (DH + 8) * 2, TB = 32 * KS;
    float v[NSUB][8]; bool act[NSUB]; float tm = -3.0e38f;
#pragma unroll
    for (int u = 0; u < NSUB; ++u) {
        const int ti = ti0 + u; act[u] = ti < t_end && mk.wave_needs(ti);
        if (act[u]) {
            const LAS unsigned char* Kt = Kb + u * TB;
            f32x4 s0 = (f32x4){0.f, 0.f, 0.f, 0.f}, s1 = s0;
#pragma unroll
            for (int kk = 0; kk < DH / 32; ++kk) {
                s0 = mfma16(ldrow(Kt + l15 * KS + (8 * g + 32 * kk) * 2), qf[kk], s0);
                s1 = mfma16(ldrow(Kt + (16 + l15) * KS + (8 * g + 32 * kk) * 2), qf[kk], s1);
            }
            const float rb = mk.row_ok(ti) ? 0.f : -3.0e38f;
            if (mk.need_check(ti)) {
                const int key0 = mk.key0(ti);
#pragma unroll
                for (int r = 0; r < 4; ++r) { v[u][r] = mk.valid(key0 + 4 * g + r) ? fmaf(s0[r], sc2, rb) : -3.0e38f; v[u][4 + r] = mk.valid(key0 + 16 + 4 * g + r) ? fmaf(s1[r], sc2, rb) : -3.0e38f; }
            } else {
#pragma unroll
                for (int r = 0; r < 4; ++r) { v[u][r] = fmaf(s0[r], sc2, rb); v[u][4 + r] = fmaf(s1[r], sc2, rb); }
            }
#pragma unroll
            for (int e = 0; e < 8; ++e) tm = fmaxf(tm, v[u][e]);
        } else {
#pragma unroll
            for (int e = 0; e < 8; ++e) v[u][e] = -3.0e38f;
        }
    }
    tm = gmax4(tm);
    const float mn = fmaxf(st.m, tm), alpha = fexp2(st.m - mn);
    float ps = 0.f;
#pragma unroll
    for (int u = 0; u < NSUB; ++u)
#pragma unroll
        for (int e = 0; e < 8; ++e) { v[u][e] = fexp2(v[u][e] - mn); ps += v[u][e]; }
    ps = gsum4(ps);
    st.l = st.l * alpha + ps; st.m = mn;
#pragma unroll
    for (int dt = 0; dt < DH / 16; ++dt) st.o[dt] = st.o[dt] * alpha;
#pragma unroll
    for (int u = 0; u < NSUB; ++u) {
        if (act[u]) {
            const LAS unsigned char* Vt = Vb + u * TB;
            v4u pbu; pbu.x = pk2(v[u][0], v[u][1]); pbu.y = pk2(v[u][2], v[u][3]); pbu.z = pk2(v[u][4], v[u][5]); pbu.w = pk2(v[u][6], v[u][7]);
            const bf16x8 pb = __builtin_bit_cast(bf16x8, pbu);
#pragma unroll
            for (int dt = 0; dt < DH / 16; ++dt) {
                const s16x4 a = ldtr(Vt + (4 * g + q4) * KS + (16 * dt + 4 * p4) * 2), b = ldtr(Vt + (16 + 4 * g + q4) * KS + (16 * dt + 4 * p4) * 2);
                st.o[dt] = mfma16((bf16x8){a[0], a[1], a[2], a[3], b[0], b[1], b[2], b[3]}, pb, st.o[dt]);
            }
        }
    }
}

template <int DH, int NSUB, class Src, class Mask>
__device__ __forceinline__ void fa_stream(LAS unsigned char* lds, int tid, int t_begin, int t_end, const Src& src, const Mask& mk, const bf16x8 (&qf)[DH / 32], FaState<DH>& st, float sc2) {
    constexpr int KS = (DH + 8) * 2, TB = 32 * KS, SB = NSUB * TB;
    if (t_begin >= t_end) return;
    const int lane = tid & 63, l15 = lane & 15, g = lane >> 4, q4 = l15 >> 2, p4 = l15 & 3;
    v4u rkA[NSUB], rvA[NSUB], rkB[NSUB], rvB[NSUB];
    int lj, lpc; bool isv = false;
    if constexpr (DH == 128) { lj = tid >> 4; lpc = tid & 15; } else { lj = (tid & 255) >> 3; lpc = tid & 7; isv = tid >= 256; }
    const int nst = (t_end - t_begin + NSUB - 1) / NSUB;
#define FA_ISSUE(k, RK, RV) do { _Pragma("unroll") for (int u = 0; u < NSUB; ++u) { int ti = t_begin + (k) * NSUB + u; ti = ti < t_end ? ti : t_end - 1; \
            const bf16* rp_ = src.krow(ti, lj) + lpc * 8; if constexpr (DH == 128) { RK[u] = *(const GAS v4u*)rp_; RV[u] = *(const GAS v4u*)(rp_ + src.voff); } \
            else { RK[u] = *(const GAS v4u*)(rp_ + (isv ? src.voff : 0)); } } } while (0)
#define FA_COMMIT(buf, RK, RV) do { _Pragma("unroll") for (int u = 0; u < NSUB; ++u) { \
            if constexpr (DH == 128) { *(LAS v4u*)(lds + (buf) * SB + u * TB + lj * KS + lpc * 16) = RK[u]; *(LAS v4u*)(lds + (2 + (buf)) * SB + u * TB + lj * KS + lpc * 16) = RV[u]; } \
            else { *(LAS v4u*)(lds + ((isv ? 2 : 0) + (buf)) * SB + u * TB + lj * KS + lpc * 16) = RK[u]; } } } while (0)
    FA_ISSUE(0, rkA, rvA); FA_COMMIT(0, rkA, rvA);
    if (1 < nst) FA_ISSUE(1, rkB, rvB);
    __syncthreads();
    for (int k = 0; k < nst; k += 2) {
        if (k + 2 < nst) FA_ISSUE(k + 2, rkA, rvA);
        fa_stage<DH, NSUB, Mask>(lds, lds + 2 * SB, qf, st, sc2, mk, t_begin + k * NSUB, t_end, l15, g, q4, p4);
        if (k + 1 < nst) FA_COMMIT(1, rkB, rvB);
        __syncthreads();
        if (k + 1 >= nst) break;
        if (k + 3 < nst) FA_ISSUE(k + 3, rkB, rvB);
        fa_stage<DH, NSUB, Mask>(lds + SB, lds + 3 * SB, qf, st, sc2, mk, t_begin + (k + 1) * NSUB, t_end, l15, g, q4, p4);
        if (k + 2 < nst) FA_COMMIT(0, rkA, rvA);
        __syncthreads();
    }
#undef FA_ISSUE
#undef FA_COMMIT
}

constexpr int DIL_PITCH = 3072;
struct DilSrc { const bf16* kbase; int band0, r, c; static constexpr int voff = 1024;
    __device__ __forceinline__ const bf16* krow(int s, int j) const { int a = band0 + 32 * s + j; a = a < 0 ? 0 : a; return kbase + (size_t)(a * r + c) * DIL_PITCH; }
    __device__ __forceinline__ const bf16* vrow(int s, int j) const { return krow(s, j) + 1024; } };
struct DilMask { int aq, band0, w;
    __device__ __forceinline__ bool valid(int ak) const { return ak >= 0 && ak <= aq && aq - ak <= 128; }
    __device__ __forceinline__ bool row_ok(int) const { return true; }
    __device__ __forceinline__ bool need_check(int) const { return true; }
    __device__ __forceinline__ bool wave_needs(int s) const { return 32 * s + 31 >= 16 * w && 32 * s <= 16 * w + 143; }
    __device__ __forceinline__ int key0(int s) const { return band0 + 32 * s; } };

__device__ __forceinline__ void dilated_phase(LAS unsigned char* lds, const bf16* PROJD, bf16* OACC, float* LSE, int gi, int G, int wave_s) {
    int tid_ = wave_s * 64 + lane_id_now(); asm volatile("" : "+v"(tid_));
    const int tid = tid_, lane = tid & 63, wave = __builtin_amdgcn_readfirstlane(tid >> 6), l15 = lane & 15, g = lane >> 4;
    const int r = (gi == 0) ? 1 : (gi == 1 ? 4 : 16);
    const float sc2 = 0.08838834764831845f * 1.4426950408889634f;
    const int vb = (G % 8 == 0) ? (int)(blockIdx.x & 7) * (G >> 3) + (int)(blockIdx.x >> 3) : (int)blockIdx.x;
    for (int item = vb; item < 2048; item += G) {
        const int bh = item >> 5, b = bh >> 3, h = bh & 7, rem = item & 31, c = rem % r, qt = rem / r;
        const bf16* base = PROJD + (size_t)b * SEQ * DIL_PITCH + h * 128;
        const int aq = 128 * qt + 16 * wave + l15, tq = aq * r + c;
        bf16x8 qf[4];
#pragma unroll
        for (int kk = 0; kk < 4; ++kk) qf[kk] = *(const GAS bf16x8*)(base + (size_t)tq * DIL_PITCH + 8 * g + 32 * kk);
        DilSrc src{base + 1024, 128 * qt - 128, r, c};
        DilMask mk{aq, 128 * qt - 128, wave};
        FaState<128> st; fa_init<128>(st);
        fa_stream<128, 2, DilSrc, DilMask>(lds, tid, qt == 0 ? 4 : 0, 8, src, mk, qf, st, sc2);
        const float inv = 1.f / fmaxf(st.l, 1e-30f);
        float lse = (st.m + __log2f(fmaxf(st.l, 1e-30f))) * 0.6931471805599453f;
        const size_t trow = (size_t)b * SEQ + tq;
        float wp = 0.f, wn = 1.f;
        if (gi > 0) { const float lp = *(const GAS float*)(LSE + trow * 8 + h); const float mx = fmaxf(lp, lse); const float ep = __expf(lp - mx), en = __expf(lse - mx); const float den = ep + en; wp = ep / den; wn = en / den; lse = mx + __logf(den); }
        bf16* op = OACC + trow * 1024 + h * 128 + 4 * g;
#pragma unroll
        for (int dt = 0; dt < 8; ++dt) {
            f32x4 o = st.o[dt] * (inv * wn);
            if (gi > 0) { const v2u old = *(const GAS v2u*)(op + 16 * dt); o[0] += wp * bf_lo(old.x); o[1] += wp * bf_hi(old.x); o[2] += wp * bf_lo(old.y); o[3] += wp * bf_hi(old.y); }
            v2u w; w.x = pk2(o[0], o[1]); w.y = pk2(o[2], o[3]);
            *(GAS v2u*)(op + 16 * dt) = w;
        }
        if (g == 0) *(GAS float*)(LSE + trow * 8 + h) = lse;
    }
}
constexpr int NSA_PITCH = 2816;
__device__ __forceinline__ void nsa_im2col(const bf16* PROJN, const float* pos, bf16* ACMP, int gtid, int GT) {
    asm volatile("" : "+v"(gtid));
    for (int idx = gtid; idx < 2 * 8192 * 256; idx += GT) {
        const int pc = idx & 255, row = (idx >> 8) & 8191, kv = idx >> 21;
        const int l = pc >> 3, d0 = (pc & 7) * 8, n = row & 255, bg = row >> 8, b = bg >> 2, gq = bg & 3;
        v4u o = (v4u){0u, 0u, 0u, 0u};
        if (n < 255) {
            const v4u v = *(const v4u*)(PROJN + (size_t)(b * SEQ + 16 * n + l) * NSA_PITCH + 1024 + kv * 256 + gq * 64 + d0);
            const f32x4 p0 = *(const f32x4*)(pos + kv * 2048 + l * 64 + d0), p1 = *(const f32x4*)(pos + kv * 2048 + l * 64 + d0 + 4);
            o.x = pk2(bf_lo(v.x) + p0.x, bf_hi(v.x) + p0.y); o.y = pk2(bf_lo(v.y) + p0.z, bf_hi(v.y) + p0.w);
            o.z = pk2(bf_lo(v.z) + p1.x, bf_hi(v.z) + p1.y); o.w = pk2(bf_lo(v.w) + p1.z, bf_hi(v.w) + p1.w);
        }
        *(v4u*)(ACMP + ((size_t)kv * 8192 + row) * 2048 + pc * 8) = o;
    }
}
struct TokSrc { const bf16* kbase; const LAS int* list; static constexpr int voff = 256;
    __device__ __forceinline__ int tile(int s) const { return list ? list[s] : s; }
    __device__ __forceinline__ const bf16* krow(int s, int j) const { return kbase + (size_t)(32 * tile(s) + j) * NSA_PITCH; }
};
struct SelMask { unsigned lo, hi, wlo, whi; int t, qb; const LAS int* list;
    __device__ __forceinline__ bool row_ok(int ti) const { const int jb = list[ti] >> 1; return ((jb < 32) ? (lo >> jb) & 1u : (hi >> (jb - 32)) & 1u) != 0u; }
    __device__ __forceinline__ bool need_check(int ti) const { return list[ti] == qb; }
    __device__ __forceinline__ bool valid(int tok) const { return tok <= t; }
    __device__ __forceinline__ bool wave_needs(int ti) const { const int jb = list[ti] >> 1; return ((jb < 32) ? (wlo >> jb) & 1u : (whi >> (jb - 32)) & 1u) != 0u; }
    __device__ __forceinline__ int key0(int ti) const { return 32 * list[ti]; } };
struct WinMask { int t, qb, sb;
    __device__ __forceinline__ bool row_ok(int) const { return true; }
    __device__ __forceinline__ bool need_check(int ti) const { return ti == qb || ti == sb; }
    __device__ __forceinline__ bool valid(int tok) const { return tok <= t && tok > t - 512; }
    __device__ __forceinline__ bool wave_needs(int) const { return true; }
    __device__ __forceinline__ int key0(int ti) const { return 32 * ti; } };

__device__ __forceinline__ void nsa_phase(LAS unsigned char* lds, const bf16* PROJN, const bf16* KVC, bf16* ONSA, int G, int wave_s, unsigned long long* pc_) {
#define NSA_STAMP(sec) do { if ((PROBE_MASK >> 8) != 0 && blockIdx.x == 0 && threadIdx.x == 0) { const unsigned long long now_ = __builtin_amdgcn_s_memrealtime(); if ((PROBE_MASK >> (8 + (sec))) & 1) pc_[1] += now_ - pc_[0]; pc_[0] = now_; } } while (0)
    constexpr int KS = 144, OFF_KC = 0, OFF_VC = OFF_KC + 256 * KS, OFF_IMP = OFF_VC + 256 * KS, OFF_SEL = OFF_IMP + 32 * 256 * 4, OFF_UNI = OFF_SEL + 256, OFF_TL = OFF_UNI + 64, OFF_NT = OFF_TL + 512;
    int tid_ = wave_s * 64 + lane_id_now(); asm volatile("" : "+v"(tid_));
    const int tid = tid_, lane = tid & 63, wave = __builtin_amdgcn_readfirstlane(tid >> 6), l15 = lane & 15, g = lane >> 4, q4 = l15 >> 2, p4 = l15 & 3;
    const float sc2 = 0.125f * 1.4426950408889634f;
    LAS float* IMP = (LAS float*)(lds + OFF_IMP);
    LAS unsigned* SEL = (LAS unsigned*)(lds + OFF_SEL);
    LAS unsigned* UNI = (LAS unsigned*)(lds + OFF_UNI);
    LAS int* TL = (LAS int*)(lds + OFF_TL);
    LAS int* NT = (LAS int*)(lds + OFF_NT);
    const int vb = (G % 8 == 0) ? (int)(blockIdx.x & 7) * (G >> 3) + (int)(blockIdx.x >> 3) : (int)blockIdx.x;
    for (int item = vb; item < 4096; item += G) {
        const int bg = item >> 7, qr = ((item & 127) + 37 * (bg >> 1)) & 127, qb = ((bg >> 1) & 1) ? 127 - qr : qr, b = bg >> 2, gq = bg & 3, t0 = 32 * qb, cur = t0 >> 6;
        const int ql = 4 * wave + q4, hp = p4, t = t0 + ql;
        const bf16* prow = PROJN + (size_t)b * SEQ * NSA_PITCH;
        bf16x8 qf[2];
#pragma unroll
        for (int kk = 0; kk < 2; ++kk) qf[kk] = *(const GAS bf16x8*)(prow + (size_t)t * NSA_PITCH + gq * 256 + hp * 64 + 8 * g + 32 * kk);
        int ncv = (t0 >> 4) + 1; ncv = ncv > 255 ? 255 : ncv; const int ntc = (ncv + 31) >> 5;
        {
            v4u tmp[8];
            const unsigned nrow = (unsigned)tid >> 3, boff = ((unsigned)bg * 256u + nrow) * 256u + ((unsigned)tid & 7u) * 8u;
#pragma unroll
            for (int u = 0; u < 8; ++u) if ((int)nrow + 64 * (u & 3) < 32 * ntc) tmp[u] = *(const GAS v4u*)(KVC + boff + (unsigned)(u & 3) * 16384u + (unsigned)(u >> 2) * 2097152u);
#pragma unroll
            for (int u = 0; u < 8; ++u) if ((int)nrow + 64 * (u & 3) < 32 * ntc) *(LAS v4u*)(lds + ((u >> 2) ? OFF_VC : OFF_KC) + ((int)nrow + 64 * (u & 3)) * KS + (tid & 7) * 16) = tmp[u];
        }
        __syncthreads();
        f32x4 oc[4];
#pragma unroll
        for (int i = 0; i < 4; ++i) oc[i] = (f32x4){0.f, 0.f, 0.f, 0.f};
        {
            f32x4 sc[8][2]; float mx = -1e30f;
#pragma unroll
            for (int s = 0; s < 8; ++s) {
                sc[s][0] = (f32x4){-1e30f, -1e30f, -1e30f, -1e30f}; sc[s][1] = sc[s][0];
                if (s < ntc) {
                    f32x4 a0 = (f32x4){0.f, 0.f, 0.f, 0.f}, a1 = a0;
#pragma unroll
                    for (int kk = 0; kk < 2; ++kk) {
                        a0 = mfma16(ldrow(lds + OFF_KC + (32 * s + l15) * KS + (8 * g + 32 * kk) * 2), qf[kk], a0);
                        a1 = mfma16(ldrow(lds + OFF_KC + (32 * s + 16 + l15) * KS + (8 * g + 32 * kk) * 2), qf[kk], a1);
                    }
#pragma unroll
                    for (int r = 0; r < 4; ++r) {
                        const int n0 = 32 * s + 4 * g + r, n1 = n0 + 16;
                        sc[s][0][r] = (16 * n0 + 31 <= t && n0 < 255) ? a0[r] * sc2 : -1e30f;
                        sc[s][1][r] = (16 * n1 + 31 <= t && n1 < 255) ? a1[r] * sc2 : -1e30f;
                        mx = fmaxf(mx, fmaxf(sc[s][0][r], sc[s][1][r]));
                    }
                }
            }
            mx = gmax4(mx);
            float sum = 0.f;
#pragma unroll
            for (int s = 0; s < 8; ++s)
#pragma unroll
                for (int e = 0; e < 2; ++e)
#pragma unroll
                    for (int r = 0; r < 4; ++r) { const float p = (sc[s][e][r] > -5e29f) ? fexp2(sc[s][e][r] - mx) : 0.f; sc[s][e][r] = p; sum += p; }
            sum = gsum4(sum);
            const float inv = 1.f / fmaxf(sum, 1e-30f);
#pragma unroll
            for (int s = 0; s < 8; ++s) {
                float p[8];
#pragma unroll
                for (int r = 0; r < 4; ++r) { p[r] = sc[s][0][r] * inv; p[4 + r] = sc[s][1][r] * inv; }
#pragma unroll
                for (int e = 0; e < 8; ++e) { float x = p[e]; x += __int_as_float(__builtin_amdgcn_update_dpp(0, __float_as_int(x), 0xB1, 0xf, 0xf, false)); x += __int_as_float(__builtin_amdgcn_update_dpp(0, __float_as_int(x), 0x4E, 0xf, 0xf, false));
                    if (hp == 0) IMP[ql * 256 + 32 * s + 16 * (e >> 2) + 4 * g + (e & 3)] = x; }
                if (s < ntc) {
                    v4u pbu; pbu.x = pk2(p[0], p[1]); pbu.y = pk2(p[2], p[3]); pbu.z = pk2(p[4], p[5]); pbu.w = pk2(p[6], p[7]);
                    const bf16x8 pb = __builtin_bit_cast(bf16x8, pbu);
#pragma unroll
                    for (int dt = 0; dt < 4; ++dt) {
                        const s16x4 a = ldtr(lds + OFF_VC + (32 * s + 4 * g + q4) * KS + (16 * dt + 4 * p4) * 2), bb = ldtr(lds + OFF_VC + (32 * s + 16 + 4 * g + q4) * KS + (16 * dt + 4 * p4) * 2);
                        oc[dt] = mfma16((bf16x8){a[0], a[1], a[2], a[3], bb[0], bb[1], bb[2], bb[3]}, pb, oc[dt]);
                    }
                }
            }
        }
        unsigned ocp[8];
#pragma unroll
        for (int dt = 0; dt < 4; ++dt) { ocp[2 * dt] = pk2(oc[dt][0], oc[dt][1]); ocp[2 * dt + 1] = pk2(oc[dt][2], oc[dt][3]); }
        __syncthreads();
        NSA_STAMP(0);
        {
            unsigned ulo = 0u, uhi = 0u;
            unsigned key[4];
#pragma unroll
            for (int qi = 0; qi < 4; ++qi) {
                const int qq = 4 * wave + qi, jb = lane;
                const LAS float* ip = IMP + qq * 256 + 4 * jb;
                const float pm1 = (jb > 0) ? ip[-1] : 0.f;
                const float imp_sel = pm1 + 2.f * (ip[0] + ip[1] + ip[2]) + ip[3];
                const bool forced = (jb == 0) || (jb == cur) || (jb == cur - 1);
                key[qi] = (jb <= cur) ? __float_as_uint(imp_sel + (forced ? 1e4f : 0.f)) + 1u : 0u;
            }
            unsigned thr[4] = {0u, 0u, 0u, 0u};
            for (int bit = 31; bit >= 0; --bit) {
#pragma unroll
                for (int qi = 0; qi < 4; ++qi) { const unsigned cand = thr[qi] | (1u << bit); if (__popcll(__ballot(key[qi] >= cand)) >= 16) thr[qi] = cand; }
            }
#pragma unroll
            for (int qi = 0; qi < 4; ++qi) {
                const int qq = 4 * wave + qi;
                const bool gt = key[qi] > thr[qi], eq = key[qi] == thr[qi];
                const int need = 16 - __popcll(__ballot(gt));
                const unsigned long long em = __ballot(eq);
                const int below = __popcll(em & ((1ull << lane) - 1ull));
                const bool sel = key[qi] > 0u && (gt || (eq && below < need));
                const unsigned long long mask = __ballot(sel);
                if (lane == 0) { SEL[2 * qq] = (unsigned)mask; SEL[2 * qq + 1] = (unsigned)(mask >> 32); }
                ulo |= (unsigned)mask; uhi |= (unsigned)(mask >> 32);
            }
            if (lane == 0) { UNI[2 * wave] = ulo; UNI[2 * wave + 1] = uhi; }
        }
        __syncthreads();
        if (wave == 0) {
            unsigned ulo = 0u, uhi = 0u;
            for (int w = 0; w < 8; ++w) { ulo |= UNI[2 * w]; uhi |= UNI[2 * w + 1]; }
            int cnt = 0;
            for (int half = 0; half < 2; ++half) {
                const int s = lane + 64 * half, jb = s >> 1; const unsigned bit = (jb < 32) ? (ulo >> jb) & 1u : (uhi >> (jb - 32)) & 1u;
                const bool need = (s <= qb) && bit != 0u;
                const unsigned long long m = __ballot(need);
                const int pos = cnt + __popcll(m & ((1ull << lane) - 1ull));
                if (need) TL[pos] = s;
                cnt += __popcll(m);
            }
            if (lane == 0) NT[0] = cnt;
        }
        __syncthreads();
        const int nts = NT[0];
        NSA_STAMP(1);
        FaState<64> ss; fa_init<64>(ss);
        {
            TokSrc src{prow + 1536 + gq * 64, TL};
            SelMask mk{SEL[2 * ql], SEL[2 * ql + 1], (unsigned)__builtin_amdgcn_readfirstlane((int)UNI[2 * wave]), (unsigned)__builtin_amdgcn_readfirstlane((int)UNI[2 * wave + 1]), t, qb, TL};
            fa_stream<64, 4, TokSrc, SelMask>(lds, tid, 0, nts, src, mk, qf, ss, sc2);
        }
        unsigned osp[8]; float isl = 1.f / fmaxf(ss.l, 1e-30f);
#pragma unroll
        for (int dt = 0; dt < 4; ++dt) { osp[2 * dt] = pk2(ss.o[dt][0] * isl, ss.o[dt][1] * isl); osp[2 * dt + 1] = pk2(ss.o[dt][2] * isl, ss.o[dt][3] * isl); }
        NSA_STAMP(2);
        FaState<64> sw; fa_init<64>(sw);
        {
            TokSrc src{prow + 2048 + gq * 64, nullptr};
            const int sb = (t0 - 512) < 0 ? 0 : (t0 - 512) >> 5;
            WinMask mk{t, qb, sb};
            fa_stream<64, 4, TokSrc, WinMask>(lds, tid, sb, qb + 1, src, mk, qf, sw, sc2);
        }
        NSA_STAMP(3);
        {
            const GAS bf16* gp = (const GAS bf16*)(prow + (size_t)t * NSA_PITCH + 2560 + gq * 4 + hp);
            const float g0 = sigmoid_f(__uint_as_float((unsigned)gp[0] << 16)), g1 = sigmoid_f(__uint_as_float((unsigned)gp[16] << 16)), g2 = sigmoid_f(__uint_as_float((unsigned)gp[32] << 16));
            const float iw = g2 / fmaxf(sw.l, 1e-30f);
            bf16* op = ONSA + ((size_t)b * SEQ + t) * 1024 + gq * 256 + hp * 64 + 4 * g;
#pragma unroll
            for (int dt = 0; dt < 4; ++dt) {
                f32x4 o = sw.o[dt] * iw;
                o[0] += g0 * bf_lo(ocp[2 * dt]) + g1 * bf_lo(osp[2 * dt]); o[1] += g0 * bf_hi(ocp[2 * dt]) + g1 * bf_hi(osp[2 * dt]);
                o[2] += g0 * bf_lo(ocp[2 * dt + 1]) + g1 * bf_lo(osp[2 * dt + 1]); o[3] += g0 * bf_hi(ocp[2 * dt + 1]) + g1 * bf_hi(osp[2 * dt + 1]);
                v2u w; w.x = pk2(o[0], o[1]); w.y = pk2(o[2], o[3]); *(GAS v2u*)(op + 16 * dt) = w; }
        }
        __syncthreads();
        NSA_STAMP(4);
    }
}
#ifndef RET_SCAN
#define RET_SCAN 1
#define RET_GNORM 1
#define RET_GATE 1
#endif
#ifndef ENABLE_SSD
#define ENABLE_SSD 1
#endif
constexpr size_t WS_DTRAW = WS_SCR + 340 * MiB, WS_HALO = WS_SCR + 344 * MiB;
#define MIXER_CONVERT \
    if (mix == 1) { transpose_w<0>(args.in[12], D, 2608, 2816, WMIX, scr, gw, NGW, lane); \
        for (int c = 0; c < 2; ++c) { transpose_w<0>(args.in[14] + (size_t)c * 2048 * 256, 2048, 256, 256, WMIX + 3 * MiB + (size_t)c * 256 * 2048, scr, gw, NGW, lane); \
            transpose_w<0>(args.in[15] + (size_t)c * 256 * 64, 256, 64, 256, WMIX + 4 * MiB + (size_t)c * 256 * 256, scr, gw, NGW, lane); } \
        transpose_w<0>(args.in[16], D, D, D, WMIX + 5 * MiB, scr, gw, NGW, lane); } \
    if (mix == 3) { transpose_w<0>(args.in[25], D, 9216, 9216, WMIX, scr, gw, NGW, lane); transpose_w<0>(args.in[26], D, D, D, WMIX + (size_t)9216 * 1024, scr, gw, NGW, lane); } \
    if (mix == 0) { transpose_w<0>(args.in[9], D, 6144, 6144, WMIX, scr, gw, NGW, lane); transpose_w<0>(args.in[11], 2048, D, D, WMIX + (size_t)6144 * 1024, scr, gw, NGW, lane); } \
    if (mix == 2) { transpose_w<0>(args.in[17], D, 5152, 5376, WMIX, scr, gw, NGW, lane); transpose_w<0>(args.in[24], 2048, D, D, WMIX + (size_t)6144 * 1024, scr, gw, NGW, lane); }

#define MIXER_PHASES \
    if (mix == 0) { \
        bf16* PROJ = (bf16*)(ws + WS_SCR); \
        PHASE_BEGIN { pg8::Epi<pg8::EPI_RETQKV> E{}; E.O = PROJ; E.ldc = 4096; E.rot = ROT; run_gemm<pg8::EPI_RETQKV>(lds, U, D, WMIX, T, 4096, D, E, wave_s); } PHASE_END_C(3) \
        if (RET_SCAN) PHASE_BEGIN \
            for (int item = ((G % 8 == 0) ? (int)(blockIdx.x & 7) * (G >> 3) + (int)(blockIdx.x >> 3) : (int)blockIdx.x); item < 256; item += G) { \
                const int b = item >> 5, h = (item >> 3) & 3, s8 = item & 7; \
                bf16* base = PROJ + (size_t)b * SEQ * 4096; \
                scan_item<256, false>(lds, base + h * 256, base + 1024 + h * 256, base + 2048 + h * 512 + s8 * 64, 4096, base + 2048 + h * 512 + s8 * 64, 4096, log1pf(-exp2f(-5.f - (float)h)), nullptr, 0.f, 0.f, 0.f, wave_s); \
                __syncthreads(); \
            } \
        PHASE_END_C(4) \
        if (RET_GNORM) PHASE_BEGIN gnorm_rows(PROJ + 2048, 4096, args.in[10], gw, NGW, lane); PHASE_END_C(7) \
        if (RET_GATE) PHASE_BEGIN { pg8::Epi<pg8::EPI_GATEMUL> E{}; E.O = PROJ + 2048; E.ldc = 4096; run_gemm<pg8::EPI_GATEMUL>(lds, U, D, WMIX + (size_t)4096 * 1024, T, 2048, D, E, wave_s); } PHASE_END_C(3) \
        PHASE_BEGIN { pg8::Epi<pg8::EPI_RESID> E{}; E.Hout = (float*)H; E.Hbase = nullptr; E.scale = 1.0f; E.ldc = D; run_gemm<pg8::EPI_RESID>(lds, PROJ + 2048, 4096, WMIX + (size_t)6144 * 1024, T, D, 2048, E, wave_s); } PHASE_END_C(3) \
    } \
    if (mix == 2 && ENABLE_SSD) { \
        bf16* PROJ = (bf16*)(ws + WS_SCR); float* DTRAW = (float*)(ws + WS_DTRAW); bf16* HALO = (bf16*)(ws + WS_HALO); \
        PHASE_BEGIN { pg8::Epi<pg8::EPI_SSD> E{}; E.O = PROJ; E.ldc = SSD_PITCH; E.aux = DTRAW; run_gemm<pg8::EPI_SSD>(lds, U, D, WMIX, T, SSD_PITCH, D, E, wave_s); } PHASE_END_C(3) \
        PHASE_BEGIN ssd_halo_save(PROJ, HALO, blockIdx.x * NTHR + tid, G * NTHR); PHASE_END_C(7) \
        PHASE_BEGIN ssd_conv(PROJ, HALO, args.in[18], args.in[19], blockIdx.x * NTHR + tid, G * NTHR); PHASE_END_C(7) \
        PHASE_BEGIN \
            for (int item = ((G % 8 == 0) ? (int)(blockIdx.x & 7) * (G >> 3) + (int)(blockIdx.x >> 3) : (int)blockIdx.x); item < 256; item += G) { \
                const int b = item >> 5, gq = (item >> 3) & 3, r = item & 7, hd = gq * 8 + r; \
                bf16* base = PROJ + (size_t)b * SEQ * SSD_PITCH; \
                scan_item<128, true>(lds, base + 4608 + gq * 128, base + 4096 + gq * 128, base + 2048 + gq * 512 + r * 64, SSD_PITCH, base + gq * 512 + r * 64, SSD_PITCH, 0.f, \
                                     DTRAW + (size_t)b * SEQ * 32 + hd, args.in[20][hd], -__expf(args.in[21][hd]), args.in[22][hd], wave_s); \
                __syncthreads(); \
            } \
        PHASE_END_C(4) \
        PHASE_BEGIN gnorm_rows(PROJ, SSD_PITCH, args.in[23], gw, NGW, lane); PHASE_END_C(7) \
        PHASE_BEGIN { pg8::Epi<pg8::EPI_RESID> E{}; E.Hout = (float*)H; E.Hbase = nullptr; E.scale = 1.0f; E.ldc = D; run_gemm<pg8::EPI_RESID>(lds, PROJ, SSD_PITCH, WMIX + (size_t)6144 * 1024, T, D, 2048, E, wave_s); } PHASE_END_C(3) \
    } \
    if (mix == 3) { \
        bf16* PROJD = (bf16*)(ws + WS_SCR); bf16* OACC = (bf16*)(ws + WS_SCR + 192 * MiB); float* LSE = (float*)(ws + WS_SCR + 256 * MiB); \
        for (int gi = 0; gi < 3; ++gi) { \
            PHASE_BEGIN { pg8::Epi<pg8::EPI_BF16> E{}; E.O = PROJD; E.ldc = DIL_PITCH; run_gemm<pg8::EPI_BF16>(lds, U, D, WMIX + (size_t)gi * 3072 * 1024, T, 3072, D, E, wave_s); } PHASE_END_C(3) \
            PHASE_BEGIN dilated_phase(lds, PROJD, OACC, LSE, gi, G, wave_s); PHASE_END_C(6) \
        } \
        PHASE_BEGIN { pg8::Epi<pg8::EPI_RESID> E{}; E.Hout = (float*)H; E.Hbase = nullptr; E.scale = 1.0f; E.ldc = D; run_gemm<pg8::EPI_RESID>(lds, OACC, D, WMIX + (size_t)9216 * 1024, T, D, D, E, wave_s); } PHASE_END_C(3) \
    } \
    if (mix == 1) { \
        bf16* PROJN = (bf16*)(ws + WS_SCR); bf16* ACMP = (bf16*)(ws + WS_SCR + 176 * MiB); bf16* HIDC = (bf16*)(ws + WS_SCR + 240 * MiB); bf16* KVC = (bf16*)(ws + WS_SCR + 248 * MiB); bf16* ONSA = (bf16*)(ws + WS_SCR + 256 * MiB); \
        PHASE_BEGIN { pg8::Epi<pg8::EPI_BF16> E{}; E.O = PROJN; E.ldc = NSA_PITCH; run_gemm<pg8::EPI_BF16>(lds, U, D, WMIX, T, NSA_PITCH, D, E, wave_s); } PHASE_END_C(3) \
        PHASE_BEGIN nsa_im2col(PROJN, args.in[13], ACMP, blockIdx.x * NTHR + tid, G * NTHR); PHASE_END_C(7) \
        PHASE_BEGIN for (int c = 0; c < 2; ++c) { pg8::Epi<pg8::EPI_SILU> E{}; E.O = HIDC + (size_t)c * 8192 * 256; E.ldc = 256; run_gemm<pg8::EPI_SILU>(lds, ACMP + (size_t)c * 8192 * 2048, 2048, WMIX + 3 * MiB + (size_t)c * 256 * 2048, 8192, 256, 2048, E, wave_s, 128 * c); } PHASE_END_C(3) \
        PHASE_BEGIN for (int c = 0; c < 2; ++c) { pg8::Epi<pg8::EPI_BF16> E{}; E.O = KVC + (size_t)c * 8192 * 256; E.ldc = 256; run_gemm<pg8::EPI_BF16>(lds, HIDC + (size_t)c * 8192 * 256, 256, WMIX + 4 * MiB + (size_t)c * 256 * 256, 8192, 256, 256, E, wave_s, 128 * c); } PHASE_END_C(3) \
        PHASE_BEGIN nsa_phase(lds, PROJN, KVC, ONSA, G, wave_s, (unsigned long long*)(args.ws + 32768)); PHASE_END_C(5) \
        PHASE_BEGIN { pg8::Epi<pg8::EPI_RESID> E{}; E.Hout = (float*)H; E.Hbase = nullptr; E.scale = 1.0f; E.ldc = D; run_gemm<pg8::EPI_RESID>(lds, ONSA, D, WMIX + 5 * MiB, T, D, D, E, wave_s); } PHASE_END_C(3) \
    }
__global__ void __launch_bounds__(NTHR, 2) fwd_megakernel(Args args) {
    extern __shared__ __attribute__((aligned(16))) unsigned char lds_raw[];
    LAS unsigned char* lds = (LAS unsigned char*)lds_raw;
    cg::grid_group grid = cg::this_grid();
    const int G = gridDim.x;
    const int wave_s = __builtin_amdgcn_readfirstlane(threadIdx.x >> 6);
    volatile LAS unsigned* xst = (volatile LAS unsigned*)(lds + LDS_BYTES - 64);
    if (threadIdx.x < 16) xst[threadIdx.x] = 0u;
    __syncthreads();
    const XcdBarrier xbar = xcd_barrier_post((unsigned*)args.ws, xst);
    if (args.ph_lo < 0) grid.sync();
    if (PROBE_MASK != 0 && blockIdx.x == 0 && threadIdx.x == 0) { ((unsigned long long*)(args.ws + 32768))[0] = __builtin_amdgcn_s_memrealtime(); }
#define PHASE_BEGIN {
#define PHASE_END_C(cat) xcd_barrier(xbar); if (PROBE_MASK != 0 && blockIdx.x == 0 && threadIdx.x == 0) { const unsigned long long now_ = __builtin_amdgcn_s_memrealtime(); unsigned long long* c_ = (unsigned long long*)(args.ws + 32768); if ((PROBE_MASK >> (cat)) & 1) c_[1] += now_ - c_[0]; c_[0] = now_; } }
    for (int L = 0; L < DEPTH; ++L) {
        const int mix = L & 3;
        int tid_ = wave_s * 64 + lane_id_now(); asm volatile("" : "+v"(tid_));
        const int tid = tid_, lane = tid & 63, wave = __builtin_amdgcn_readfirstlane(tid >> 6);
        const int gw = blockIdx.x * NWAVES + wave, NGW = G * NWAVES;
        unsigned char* ws = args.ws; asm volatile("" : "+s"(ws));
        bf16* H = (bf16*)((unsigned char*)args.out + 64 * MiB); asm volatile("" : "+s"(H));
        float* ROT = (float*)(ws + WS_ROT);
        bf16* WIN1 = (bf16*)(ws + WS_WIN1); bf16* WOUT1 = (bf16*)(ws + WS_WOUT1); bf16* WIN2 = (bf16*)(ws + WS_WIN2); bf16* WOUT2 = (bf16*)(ws + WS_WOUT2); bf16* WMIX = (bf16*)(ws + WS_WMIX);
        bf16* U = (bf16*)(ws + WS_U); bf16* HID = (bf16*)(ws + WS_SCR);
        LAS float* scr = (LAS float*)(lds + wave * 18432);
        PHASE_BEGIN
            transpose_w<1>(args.in[2] + (size_t)L * D * 2 * FF, D, 2 * FF, 2 * FF, WIN1, scr, gw, NGW, lane);
            transpose_w<0>(args.in[3] + (size_t)L * FF * D, FF, D, D, WOUT1, scr, gw, NGW, lane);
            transpose_w<1>(args.in[6] + (size_t)L * D * 2 * FF, D, 2 * FF, 2 * FF, WIN2, scr, gw, NGW, lane);
            transpose_w<0>(args.in[7] + (size_t)L * FF * D, FF, D, D, WOUT2, scr, gw, NGW, lane);
            MIXER_CONVERT
            if (L == 0) {
                for (int i = blockIdx.x * NTHR + tid; i < 4096 * 128; i += G * NTHR) {
                    const int pos = i >> 7, d = i & 127;
                    const float inv = exp2f(-(float)d * (13.287712379549449f / 128.f));
                    const float ang = (float)pos * inv;
                    const double x = (double)ang * 0.15915494309189535; const float fr = (float)(x - rint(x));
                    ROT[i] = __builtin_amdgcn_cosf(fr); ROT[4096 * 128 + i] = __builtin_amdgcn_sinf(fr);
                }
            }
            if (L == 0) rms_rows(args.in[0], args.in[1], U, nullptr, gw, NGW, lane); else rms_rows_b(H, args.in[1] + L * D, U, gw, NGW, lane);
        PHASE_END_C(0)
        PHASE_BEGIN { pg8::Epi<pg8::EPI_SWIGLU> E{}; E.O = HID; E.ldc = FF; run_gemm<pg8::EPI_SWIGLU>(lds, U, D, WIN1, T, 2 * FF, D, E, wave_s); } PHASE_END_C(1)
        PHASE_BEGIN { pg8::Epi<pg8::EPI_RESID> E{}; E.Hout = (float*)H; E.Hbase = (L == 0) ? args.in[0] : nullptr; E.scale = 0.5f; E.ldc = D; run_gemm<pg8::EPI_RESID>(lds, HID, FF, WOUT1, T, D, FF, E, wave_s); } PHASE_END_C(1)
        PHASE_BEGIN rms_rows_b(H, args.in[4] + L * D, U, gw, NGW, lane); PHASE_END_C(2)
        MIXER_PHASES
        PHASE_BEGIN rms_rows_b(H, args.in[5] + L * D, U, gw, NGW, lane); PHASE_END_C(2)
        PHASE_BEGIN { pg8::Epi<pg8::EPI_SWIGLU> E{}; E.O = HID; E.ldc = FF; run_gemm<pg8::EPI_SWIGLU>(lds, U, D, WIN2, T, 2 * FF, D, E, wave_s); } PHASE_END_C(1)
        PHASE_BEGIN { pg8::Epi<pg8::EPI_RESID> E{}; E.Hout = (float*)H; E.Hbase = nullptr; E.scale = 0.5f; E.ldc = D; run_gemm<pg8::EPI_RESID>(lds, HID, FF, WOUT2, T, D, FF, E, wave_s); } PHASE_END_C(1)
    }
    {
        const int lane = lane_id_now(); const int gw = blockIdx.x * NWAVES + wave_s, NGW = G * NWAVES;
        const bf16* HBf = (const bf16*)((unsigned char*)args.out + 64 * MiB); bf16* Uc = (bf16*)(args.ws + WS_U);
        rms_final_b(HBf, 0, args.out, args.in[8], 0, T / 2, gw, NGW, lane);
        { const GAS v4u* src = (const GAS v4u*)(HBf + (size_t)(T / 2) * D); GAS v4u* dst = (GAS v4u*)Uc;
          for (int i = blockIdx.x * NTHR + wave_s * 64 + lane; i < (T / 2) * D / 8; i += G * NTHR) dst[i] = src[i]; }
        xcd_barrier(xbar);
        rms_final_b(Uc, T / 2, args.out, args.in[8], T / 2, T, gw, NGW, lane);
    }
}

extern "C" void kernel_launch(void* const* d_in, const int* in_sizes, int n_in, void* d_out, int out_size, void* d_ws, size_t ws_size, hipStream_t stream) {
    static int grid = 0;
    if (grid == 0) {
        if (n_in != 27 || out_size != T * D || ws_size < WS_NEED) { fprintf(stderr, "kernel_launch: unexpected problem (n_in %d, out %d, ws %zu)\n", n_in, out_size, ws_size); grid = -1; return; }
        int dev = 0, cus = 0, per_cu = 0;
        hipGetDevice(&dev); hipDeviceGetAttribute(&cus, hipDeviceAttributeMultiprocessorCount, dev);
        if (hipFuncSetAttribute((const void*)fwd_megakernel, hipFuncAttributeMaxDynamicSharedMemorySize, LDS_BYTES) != hipSuccess) { fprintf(stderr, "kernel_launch: hipFuncSetAttribute failed\n"); grid = -1; return; }
        if (hipOccupancyMaxActiveBlocksPerMultiprocessor(&per_cu, (const void*)fwd_megakernel, NTHR, LDS_BYTES) != hipSuccess || per_cu < 1) { fprintf(stderr, "kernel_launch: occupancy query gave %d\n", per_cu); per_cu = 1; }
        (void)hipGetLastError();
        grid = cus * 1;
    }
    if (grid < 0) return;
    if (hipMemsetAsync(d_ws, 0, 65536, stream) != hipSuccess) { fprintf(stderr, "kernel_launch: memset failed\n"); return; }
    Args a{};
    for (int i = 0; i < 27; ++i) a.in[i] = (const float*)d_in[i];
    a.out = (float*)d_out; a.ws = (unsigned char*)d_ws; a.ph_lo = 0; a.ph_hi = 1 << 20;
    void* kargs[] = {&a};
    hipError_t e = hipLaunchCooperativeKernel((const void*)fwd_megakernel, dim3(grid), dim3(NTHR), kargs, LDS_BYTES, stream);
    if (e != hipSuccess) fprintf(stderr, "kernel_launch: cooperative launch failed: %s (grid %d)\n", hipGetErrorString(e), grid);
}
```

```cpp
#include <hip/hip_runtime.h>
#include <hip/hip_cooperative_groups.h>
#include <cstdio>
#include <cstdint>
namespace cg = cooperative_groups;

__device__ __forceinline__ int lane_id_now() { int l; asm volatile("v_mbcnt_lo_u32_b32 %0, -1, 0\n\tv_mbcnt_hi_u32_b32 %0, -1, %0" : "=v"(l)); return l; }

#ifndef PROBE_MASK
#define PROBE_MASK 0
#endif
namespace pg8 {
#define PG8_LAS __attribute__((address_space(3)))
typedef unsigned short bf16_t;
typedef short bf16x8 __attribute__((ext_vector_type(8)));
typedef float f32x4 __attribute__((ext_vector_type(4)));
typedef unsigned u32x4 __attribute__((ext_vector_type(4)));
constexpr int BM = 256, BK = 64, HALF = 128, HTB = HALF * BK * 2  , STAGE_BYTES = 8 * HTB, NXCD = 8, WGM = 8;

__host__ __device__ __forceinline__ int lds_byte(int r, int c) { const int st = (r >> 4) * 2 + (c >> 5), rr = r & 15, cc = c & 31, ob = rr * 64 + cc * 2; return st * 1024 + (ob ^ (((ob >> 9) & 1) << 5)); }
__host__ __device__ __forceinline__ void stage_rc(int b, int& R, int& C) { const int st = b / 1024, sb = b % 1024, swz = sb ^ (((sb >> 9) & 1) << 5); R = (st >> 1) * 16 + swz / 64; C = (st & 1) * 32 + (swz % 64) / 2; }
__host__ __device__ __forceinline__ int perm32(int rho) { const int n = rho >> 4, i = rho & 15; return 8 * (i >> 2) + 4 * n + (i & 3); }

struct Unit { int pm, pn; };
struct Gemm { const bf16_t* A; const bf16_t* Bt; int M, N, K, lda; };

struct StaticOrder {
    int nM, nN, nwg, G, c;
    __host__ __device__ void init(int M, int N, int G_, int c_) { nM = M / BM; nN = N / BM; nwg = nM * nN; G = G_; c = c_; }
    __host__ __device__ bool next(int i, Unit& u) const {
        const long L = (long)i * G + c; if (L >= nwg) return false;
        int wgid = (int)L; { const int q = nwg / NXCD, r = nwg % NXCD, xcd = wgid % NXCD, off = wgid / NXCD; wgid = (xcd < r ? xcd * (q + 1) : r * (q + 1) + (xcd - r) * q) + off; }
        const int nig = WGM * nN, gid = wgid / nig, fm = gid * WGM, gsz = (nM - fm) < WGM ? (nM - fm) : WGM;
        u.pm = fm + ((wgid % nig) % gsz); u.pn = (wgid % nig) / gsz; return true;
    }
    __device__ __forceinline__ void a_ready(const Unit&) const {}
    __device__ __forceinline__ void done(const Unit&) const {}
};

typedef float f32x2_t __attribute__((ext_vector_type(2))); typedef __bf16 bf16x2_t __attribute__((ext_vector_type(2)));
__device__ __forceinline__ unsigned cvt_pk_bf16(float lo, float hi) { f32x2_t v = {lo, hi}; bf16x2_t b = __builtin_convertvector(v, bf16x2_t); return __builtin_bit_cast(unsigned, b); }
__device__ __forceinline__ float bf_lo(unsigned w) { return __uint_as_float(w << 16); }
__device__ __forceinline__ float bf_hi(unsigned w) { return __uint_as_float(w & 0xffff0000u); }
__device__ __forceinline__ float silu_f(float x) { return x * __builtin_amdgcn_rcpf(1.0f + __builtin_amdgcn_exp2f(-1.4426950408889634f * x)); }
__device__ __forceinline__ float sigmoid_f(float x) { return __builtin_amdgcn_rcpf(1.0f + __builtin_amdgcn_exp2f(-1.4426950408889634f * x)); }

enum { EPI_BF16 = 0, EPI_SWIGLU = 1, EPI_RESID = 2, EPI_RETQKV = 3, EPI_GATEMUL = 4, EPI_SSD = 5, EPI_SILU = 6 };
template <int MODE> struct Epi {
    static constexpr bool PERM = true, AFTER_DRAIN = false;
    bf16_t* O; int ldc;
    float* Hout; const float* Hbase; float scale;
    const float* __restrict__ rot;
    float* aux;
    __device__ __forceinline__ void operator()(const f32x4 (&acc)[2][2][4][2], const Unit& u, int wr, int wc, int fr, int fq) const {
        const int row0 = u.pm * BM + wr * 64 + fr;
        const int cl = wc * 32 + 8 * fq;
        if constexpr (MODE == EPI_SWIGLU) {
#pragma unroll
            for (int ai = 0; ai < 2; ++ai)
#pragma unroll
                for (int m = 0; m < 4; ++m) {
                    bf16_t* rowp = O + (size_t)(row0 + ai * HALF + m * 16) * ldc + u.pn * 128 + cl;
                    f32x4 a0 = acc[ai][0][m][0], a1 = acc[ai][0][m][1], b0 = acc[ai][1][m][0], b1 = acc[ai][1][m][1];
                    u32x4 w;
                    w.x = cvt_pk_bf16(silu_f(a0[0]) * b0[0], silu_f(a0[1]) * b0[1]); w.y = cvt_pk_bf16(silu_f(a0[2]) * b0[2], silu_f(a0[3]) * b0[3]);
                    w.z = cvt_pk_bf16(silu_f(a1[0]) * b1[0], silu_f(a1[1]) * b1[1]); w.w = cvt_pk_bf16(silu_f(a1[2]) * b1[2], silu_f(a1[3]) * b1[3]);
                    *(u32x4*)rowp = w;
                }
        } else if constexpr (MODE == EPI_RESID) {
            bf16_t* const HB = (bf16_t*)Hout;
#pragma unroll
            for (int ai = 0; ai < 2; ++ai) {
                if (Hbase) {
                    f32x4 pre[4][2][2];
#pragma unroll
                    for (int m = 0; m < 4; ++m) { const size_t off = (size_t)(row0 + ai * HALF + m * 16) * ldc + u.pn * BM + cl;
#pragma unroll
                        for (int bj = 0; bj < 2; ++bj)
#pragma unroll
                            for (int n = 0; n < 2; ++n) pre[m][bj][n] = *(const f32x4*)(Hbase + off + bj * HALF + 4 * n); }
#pragma unroll
                    for (int m = 0; m < 4; ++m) { const size_t off = (size_t)(row0 + ai * HALF + m * 16) * ldc + u.pn * BM + cl;
#pragma unroll
                        for (int bj = 0; bj < 2; ++bj) { const f32x4 h0 = pre[m][bj][0] + acc[ai][bj][m][0] * scale, h1 = pre[m][bj][1] + acc[ai][bj][m][1] * scale; u32x4 w;
                            w.x = cvt_pk_bf16(h0[0], h0[1]); w.y = cvt_pk_bf16(h0[2], h0[3]); w.z = cvt_pk_bf16(h1[0], h1[1]); w.w = cvt_pk_bf16(h1[2], h1[3]);
                            *(u32x4*)(HB + off + bj * HALF) = w; } }
                } else {
                    u32x4 pre[4][2];
#pragma unroll
                    for (int m = 0; m < 4; ++m) { const size_t off = (size_t)(row0 + ai * HALF + m * 16) * ldc + u.pn * BM + cl;
#pragma unroll
                        for (int bj = 0; bj < 2; ++bj) pre[m][bj] = *(const u32x4*)(HB + off + bj * HALF); }
#pragma unroll
                    for (int m = 0; m < 4; ++m) { const size_t off = (size_t)(row0 + ai * HALF + m * 16) * ldc + u.pn * BM + cl;
#pragma unroll
                        for (int bj = 0; bj < 2; ++bj) { const u32x4 p = pre[m][bj]; const f32x4 a0 = acc[ai][bj][m][0] * scale, a1 = acc[ai][bj][m][1] * scale; u32x4 w;
                            w.x = cvt_pk_bf16(bf_lo(p.x) + a0[0], bf_hi(p.x) + a0[1]); w.y = cvt_pk_bf16(bf_lo(p.y) + a0[2], bf_hi(p.y) + a0[3]);
                            w.z = cvt_pk_bf16(bf_lo(p.z) + a1[0], bf_hi(p.z) + a1[1]); w.w = cvt_pk_bf16(bf_lo(p.w) + a1[2], bf_hi(p.w) + a1[3]);
                            *(u32x4*)(HB + off + bj * HALF) = w; } }
                }
            }
        } else if constexpr (MODE == EPI_RETQKV) {
            if (u.pn < 8) {
                const float ks = (u.pn >= 4) ? 0.0625f : 1.0f;
#pragma unroll
                for (int ai = 0; ai < 2; ++ai)
#pragma unroll
                    for (int m = 0; m < 4; ++m) {
                        const int r = row0 + ai * HALF + m * 16; const int pos = r & 4095;
                        bf16_t* rowp = O + (size_t)r * ldc + u.pn * BM + cl;
                        u32x4 w1, w2; unsigned* p1 = (unsigned*)&w1; unsigned* p2 = (unsigned*)&w2;
#pragma unroll
                        for (int n = 0; n < 2; ++n) {
                            const f32x4 c = *(const f32x4*)(rot + (size_t)pos * 128 + cl + 4 * n);
                            const f32x4 s = *(const f32x4*)(rot + (size_t)4096 * 128 + (size_t)pos * 128 + cl + 4 * n);
                            const f32x4 t1 = acc[ai][0][m][n] * ks, t2 = acc[ai][1][m][n] * ks;
                            const f32x4 o1 = t1 * c - t2 * s, o2 = t1 * s + t2 * c;
                            p1[2 * n] = cvt_pk_bf16(o1[0], o1[1]); p1[2 * n + 1] = cvt_pk_bf16(o1[2], o1[3]);
                            p2[2 * n] = cvt_pk_bf16(o2[0], o2[1]); p2[2 * n + 1] = cvt_pk_bf16(o2[2], o2[3]);
                        }
                        *(u32x4*)rowp = w1; *(u32x4*)(rowp + HALF) = w2;
                    }
            } else {
#pragma unroll
                for (int ai = 0; ai < 2; ++ai)
#pragma unroll
                    for (int m = 0; m < 4; ++m) {
                        bf16_t* rowp = O + (size_t)(row0 + ai * HALF + m * 16) * ldc + u.pn * BM + cl;
#pragma unroll
                        for (int bj = 0; bj < 2; ++bj) { const f32x4 v0 = acc[ai][bj][m][0], v1 = acc[ai][bj][m][1]; u32x4 w;
                            w.x = cvt_pk_bf16(v0[0], v0[1]); w.y = cvt_pk_bf16(v0[2], v0[3]); w.z = cvt_pk_bf16(v1[0], v1[1]); w.w = cvt_pk_bf16(v1[2], v1[3]);
                            *(u32x4*)(rowp + bj * HALF) = w; }
                    }
            }
        } else if constexpr (MODE == EPI_GATEMUL) {
#pragma unroll
            for (int ai = 0; ai < 2; ++ai)
#pragma unroll
                for (int m = 0; m < 4; ++m) {
                    bf16_t* rowp = O + (size_t)(row0 + ai * HALF + m * 16) * ldc + u.pn * BM + cl;
#pragma unroll
                    for (int bj = 0; bj < 2; ++bj) { const f32x4 v0 = acc[ai][bj][m][0], v1 = acc[ai][bj][m][1]; const u32x4 old = *(const u32x4*)(rowp + bj * HALF); u32x4 w;
                        w.x = cvt_pk_bf16(silu_f(v0[0]) * bf_lo(old.x), silu_f(v0[1]) * bf_hi(old.x)); w.y = cvt_pk_bf16(silu_f(v0[2]) * bf_lo(old.y), silu_f(v0[3]) * bf_hi(old.y));
                        w.z = cvt_pk_bf16(silu_f(v1[0]) * bf_lo(old.z), silu_f(v1[1]) * bf_hi(old.z)); w.w = cvt_pk_bf16(silu_f(v1[2]) * bf_lo(old.w), silu_f(v1[3]) * bf_hi(old.w));
                        *(u32x4*)(rowp + bj * HALF) = w; }
                }
        } else {
            if (MODE == EPI_SSD && u.pn == 20) {
                if (wc == 0) {
#pragma unroll
                    for (int ai = 0; ai < 2; ++ai)
#pragma unroll
                        for (int m = 0; m < 4; ++m) { float* p = aux + (size_t)(row0 + ai * HALF + m * 16) * 32 + cl;
                            *(f32x4*)p = acc[ai][0][m][0]; *(f32x4*)(p + 4) = acc[ai][0][m][1]; }
                }
                return;
            }
#pragma unroll
            for (int ai = 0; ai < 2; ++ai)
#pragma unroll
                for (int m = 0; m < 4; ++m) {
                    bf16_t* rowp = O + (size_t)(row0 + ai * HALF + m * 16) * ldc + u.pn * BM + cl;
#pragma unroll
                    for (int bj = 0; bj < 2; ++bj) { f32x4 v0 = acc[ai][bj][m][0], v1 = acc[ai][bj][m][1]; u32x4 w;
                        if (MODE == EPI_SILU) { v0 = (f32x4){silu_f(v0[0]), silu_f(v0[1]), silu_f(v0[2]), silu_f(v0[3])}; v1 = (f32x4){silu_f(v1[0]), silu_f(v1[1]), silu_f(v1[2]), silu_f(v1[3])}; }
                        w.x = cvt_pk_bf16(v0[0], v0[1]); w.y = cvt_pk_bf16(v0[2], v0[3]); w.z = cvt_pk_bf16(v1[0], v1[1]); w.w = cvt_pk_bf16(v1[2], v1[3]);
                        *(u32x4*)(rowp + bj * HALF) = w; }
                }
        }
    }
};
template <class Epi, class Sched, bool ALIGN_EPI = false, bool SP2 = false>
__device__ __forceinline__ void gemm_phase(PG8_LAS unsigned char* lds, const Gemm g, const Sched& S, const Epi& E, int wave_s) {
    int tid_ = wave_s * 64 + lane_id_now(); asm volatile("" : "+v"(tid_)); const int tid = tid_, wid = __builtin_amdgcn_readfirstlane(tid >> 6), lane = tid & 63, wr = wid >> 2, wc = wid & 3, fr = lane & 15, fq = lane >> 4;
    const int K = g.K, nt = K / BK;
    unsigned voffA[2], voffB[2];
#pragma unroll
    for (int i = 0; i < 2; ++i) { int R, C; stage_rc(tid * 16 + i * 8192, R, C); const int Rb = Epi::PERM ? ((R & ~31) + perm32(R & 31)) : R;
        voffA[i] = (unsigned)(R * g.lda + C) * 2u; voffB[i] = (unsigned)(Rb * K + C) * 2u; }
    const size_t kstep = (size_t)(BK * 2);
    const size_t hstepA = (size_t)HALF * g.lda * 2, hstepB = (size_t)HALF * K * 2;
    const size_t tstepA = 2 * hstepA, tstepB = 2 * hstepB;
    const unsigned ldsw = (unsigned)wid * 1024u;
    const int aoff = lds_byte(wr * 64 + fr, fq * 8), boff = lds_byte(wc * 32 + fr, fq * 8);
#define PG8_SA(b, h) (((b) * 2 + (h)) * HTB)
#define PG8_SB(b, h) ((4 + (b) * 2 + (h)) * HTB)
#define PG8_STAGE(bufoff, gbase, voff) do { _Pragma("unroll") for (int _i = 0; _i < 2; ++_i) \
        __builtin_amdgcn_global_load_lds((const unsigned*)((const char*)(gbase) + (voff)[_i]), (PG8_LAS unsigned*)(lds + (bufoff) + ldsw + _i * 8192), 16, 0, 0); } while (0)
#define PG8_LDA(dst, b, h) do { _Pragma("unroll") for (int m = 0; m < 4; ++m) _Pragma("unroll") for (int k = 0; k < 2; ++k) dst[m][k] = *(const PG8_LAS bf16x8*)(lds + PG8_SA(b, h) + aoff + m * 2048 + k * 1024); } while (0)
#define PG8_LDB(dst, b, h) do { _Pragma("unroll") for (int n = 0; n < 2; ++n) _Pragma("unroll") for (int k = 0; k < 2; ++k) dst[n][k] = *(const PG8_LAS bf16x8*)(lds + PG8_SB(b, h) + boff + n * 2048 + k * 1024); } while (0)
#define PG8_MMA(ai, bj, At, Bt) do { __builtin_amdgcn_s_setprio(1); _Pragma("unroll") for (int m = 0; m < 4; ++m) _Pragma("unroll") for (int n = 0; n < 2; ++n) _Pragma("unroll") for (int k = 0; k < 2; ++k) \
        acc[ai][bj][m][n] = __builtin_amdgcn_mfma_f32_16x16x32_bf16(Bt[n][k], At[m][k], acc[ai][bj][m][n], 0, 0, 0); __builtin_amdgcn_s_setprio(0); } while (0)
#define PG8_WAIT_V(n) asm volatile("s_waitcnt vmcnt(" #n ")" ::: "memory")
#define PG8_WAIT_L(n) asm volatile("s_waitcnt lgkmcnt(" #n ")" ::: "memory")
#define PG8_BAR __builtin_amdgcn_s_barrier()
#define PG8_SCHED __builtin_amdgcn_sched_barrier(0)
    Unit cur, nxt; int ui = 0;
    if (!S.next(0, cur)) return;
    f32x4 acc[2][2][4][2];
#pragma unroll
    for (int a = 0; a < 2; ++a)
#pragma unroll
        for (int b = 0; b < 2; ++b)
#pragma unroll
            for (int m = 0; m < 4; ++m)
#pragma unroll
                for (int n = 0; n < 2; ++n) acc[a][b][m][n] = (f32x4){0.f, 0.f, 0.f, 0.f};
    bf16x8 At[4][2], B0[2][2], B1[2][2];
    const char* cA = (const char*)g.A + (size_t)cur.pm * tstepA; const char* cB = (const char*)g.Bt + (size_t)cur.pn * tstepB;
    S.a_ready(cur);
    if constexpr (SP2) {
        PG8_STAGE(PG8_SB(0, 0), cB, voffB); PG8_STAGE(PG8_SB(0, 1), cB + hstepB, voffB); PG8_STAGE(PG8_SA(0, 0), cA, voffA); PG8_STAGE(PG8_SA(0, 1), cA + hstepA, voffA);
        if (wr == 1) PG8_BAR;
        PG8_WAIT_V(2); PG8_BAR;
        PG8_STAGE(PG8_SB(1, 0), cB + kstep, voffB); PG8_STAGE(PG8_SA(1, 0), cA + kstep, voffA); PG8_STAGE(PG8_SB(1, 1), cB + hstepB + kstep, voffB);
        PG8_WAIT_V(6); PG8_BAR;
    } else {
        PG8_STAGE(PG8_SB(0, 0), cB, voffB); PG8_STAGE(PG8_SA(0, 0), cA, voffA); PG8_STAGE(PG8_SB(0, 1), cB + hstepB, voffB); PG8_STAGE(PG8_SA(0, 1), cA + hstepA, voffA);
        if (wr == 1) PG8_BAR;
        PG8_WAIT_V(4); PG8_BAR;
        PG8_STAGE(PG8_SB(1, 0), cB + kstep, voffB); PG8_STAGE(PG8_SA(1, 0), cA + kstep, voffA); PG8_STAGE(PG8_SB(1, 1), cB + hstepB + kstep, voffB);
        PG8_WAIT_V(6); PG8_BAR;
    }
    for (;;) {
        const bool has_next = S.next(ui + 1, nxt);
        const char* nA = has_next ? (const char*)g.A + (size_t)nxt.pm * tstepA : cA; const char* nB = has_next ? (const char*)g.Bt + (size_t)nxt.pn * tstepB : cB;
        for (int t = 0; t < nt; t += 2) {
            const bool last = (t == nt - 2);
            const char* a1 = cA + (size_t)(t + 1) * kstep;
            const char* a2 = last ? nA : cA + (size_t)(t + 2) * kstep; const char* b2 = last ? nB : cB + (size_t)(t + 2) * kstep;
            const char* a3 = a2 + kstep; const char* b3 = b2 + kstep;
            if (last && has_next) S.a_ready(nxt);
            if constexpr (SP2) {
            PG8_LDB(B0, 0, 0); PG8_LDB(B1, 0, 1); PG8_SCHED; PG8_LDA(At, 0, 0); PG8_STAGE(PG8_SA(1, 1), a1 + hstepA, voffA);
            PG8_WAIT_V(8); PG8_WAIT_L(0); PG8_BAR; PG8_MMA(0, 0, At, B0); PG8_MMA(0, 1, At, B1); PG8_BAR; PG8_SCHED;
            PG8_LDA(At, 0, 1); PG8_STAGE(PG8_SB(0, 0), b2, voffB); PG8_STAGE(PG8_SB(0, 1), b2 + hstepB, voffB); PG8_STAGE(PG8_SA(0, 0), a2, voffA);
            PG8_WAIT_V(8); PG8_WAIT_L(0); PG8_BAR; PG8_MMA(1, 0, At, B0); PG8_MMA(1, 1, At, B1); PG8_BAR; PG8_SCHED;
            PG8_LDB(B0, 1, 0); PG8_LDB(B1, 1, 1); PG8_SCHED; PG8_LDA(At, 1, 0); PG8_STAGE(PG8_SA(0, 1), a2 + hstepA, voffA);
            PG8_WAIT_V(8); PG8_WAIT_L(0); PG8_BAR; PG8_MMA(0, 0, At, B0); PG8_MMA(0, 1, At, B1); PG8_BAR; PG8_SCHED;
            PG8_LDA(At, 1, 1); PG8_STAGE(PG8_SB(1, 0), b3, voffB); PG8_STAGE(PG8_SB(1, 1), b3 + hstepB, voffB); PG8_STAGE(PG8_SA(1, 0), a3, voffA);
            PG8_WAIT_V(8); PG8_WAIT_L(0); PG8_BAR; PG8_MMA(1, 0, At, B0); PG8_MMA(1, 1, At, B1); PG8_BAR; PG8_SCHED;
            } else {
            PG8_LDB(B0, 0, 0); PG8_SCHED; PG8_LDA(At, 0, 0); PG8_STAGE(PG8_SA(1, 1), a1 + hstepA, voffA);
            PG8_WAIT_L(8); PG8_BAR; PG8_WAIT_L(0); PG8_MMA(0, 0, At, B0); PG8_BAR; PG8_SCHED;
            PG8_LDB(B1, 0, 1); PG8_STAGE(PG8_SB(0, 0), b2, voffB);
            PG8_BAR; PG8_WAIT_L(0); PG8_MMA(0, 1, At, B1); PG8_BAR;
            PG8_LDA(At, 0, 1); PG8_STAGE(PG8_SA(0, 0), a2, voffA);
            PG8_BAR; PG8_WAIT_L(0); PG8_MMA(1, 0, At, B0); PG8_BAR; PG8_SCHED;
            PG8_STAGE(PG8_SB(0, 1), b2 + hstepB, voffB);
            PG8_WAIT_V(6); PG8_BAR; PG8_MMA(1, 1, At, B1); PG8_BAR;
            PG8_LDB(B0, 1, 0); PG8_SCHED; PG8_LDA(At, 1, 0); PG8_STAGE(PG8_SA(0, 1), a2 + hstepA, voffA);
            PG8_WAIT_L(8); PG8_BAR; PG8_WAIT_L(0); PG8_MMA(0, 0, At, B0); PG8_BAR; PG8_SCHED;
            PG8_LDB(B1, 1, 1); PG8_STAGE(PG8_SB(1, 0), b3, voffB);
            PG8_BAR; PG8_WAIT_L(0); PG8_MMA(0, 1, At, B1); PG8_BAR;
            PG8_LDA(At, 1, 1); PG8_STAGE(PG8_SA(1, 0), a3, voffA);
            PG8_BAR; PG8_WAIT_L(0); PG8_MMA(1, 0, At, B0); PG8_BAR; PG8_SCHED;
            PG8_STAGE(PG8_SB(1, 1), b3 + hstepB, voffB);
            PG8_WAIT_V(6); PG8_BAR; PG8_MMA(1, 1, At, B1); PG8_BAR;
            }
        }
        if constexpr (ALIGN_EPI) { if (wr == 0) PG8_BAR; }
        if constexpr (!Epi::AFTER_DRAIN) { E(acc, cur, wr, wc, fr, fq); S.done(cur); }
        if (!has_next) break;
#pragma unroll
        for (int a = 0; a < 2; ++a)
#pragma unroll
            for (int b = 0; b < 2; ++b)
#pragma unroll
                for (int m = 0; m < 4; ++m)
#pragma unroll
                    for (int n = 0; n < 2; ++n) acc[a][b][m][n] = (f32x4){0.f, 0.f, 0.f, 0.f};
        cur = nxt; cA = nA; cB = nB; ++ui;
        if constexpr (ALIGN_EPI) { if (wr == 1) PG8_BAR; }
    }
    PG8_WAIT_V(0);
    if constexpr (!ALIGN_EPI) { if (wr == 0) PG8_BAR; }
    PG8_BAR;
    if constexpr (Epi::AFTER_DRAIN) { E.fused(acc, cur, wr, wc, fr, fq, lds, wid, lane); S.done(cur); }
#undef PG8_SA
#undef PG8_SB
#undef PG8_STAGE
#undef PG8_LDA
#undef PG8_LDB
#undef PG8_MMA
#undef PG8_WAIT_V
#undef PG8_WAIT_L
#undef PG8_BAR
#undef PG8_SCHED
}
}
#define GAS __attribute__((address_space(1)))
#define LAS __attribute__((address_space(3)))
typedef unsigned short bf16;
typedef unsigned v4u __attribute__((ext_vector_type(4)));
typedef unsigned v2u __attribute__((ext_vector_type(2)));
typedef float f32x4 __attribute__((ext_vector_type(4)));
typedef short bf16x8 __attribute__((ext_vector_type(8)));
typedef short s16x4 __attribute__((ext_vector_type(4)));
using pg8::cvt_pk_bf16; using pg8::bf_lo; using pg8::bf_hi; using pg8::silu_f; using pg8::sigmoid_f;

constexpr int NWAVES = 8, NTHR = 512;
constexpr int BATCH = 8, SEQ = 4096, T = BATCH * SEQ, D = 1024, FF = 2816, DEPTH = 4;
constexpr float NORM_EPS = 1e-6f;
constexpr int LDS_BYTES = 147456;
constexpr size_t MiB = 1u << 20;
constexpr size_t WS_ROT = 1 * MiB;
constexpr size_t WS_W = 8 * MiB;
constexpr size_t WS_WIN1 = WS_W, WS_WOUT1 = WS_W + 11 * MiB, WS_WIN2 = WS_W + 17 * MiB, WS_WOUT2 = WS_W + 28 * MiB, WS_WMIX = WS_W + 34 * MiB;
constexpr size_t WS_U = 64 * MiB;
constexpr size_t WS_SCR = 128 * MiB;
constexpr size_t WS_NEED = 484 * MiB;

struct Args { const float* in[27]; float* out; unsigned char* ws; int ph_lo, ph_hi; };

__device__ __forceinline__ float wave_sum(float v) {
#pragma unroll
    for (int o = 1; o < 64; o <<= 1) v += __shfl_xor(v, o);
    return v;
}
__device__ __forceinline__ unsigned pk2(float lo, float hi) { return cvt_pk_bf16(lo, hi); }

template <int MAP> __device__ __forceinline__ void transpose_w(const float* W, int K, int N, int Npad, bf16* WT, LAS float* scr, int gw, int NGW, int lane) {
    asm volatile("" : "+v"(lane));
    const int nblk = Npad / 32, nitems = (K / 64) * nblk;
    for (int item0 = gw; item0 < nitems; item0 += 2 * NGW) {
        float wv[2][32]; int k0s[2], n0s[2]; bool inb[2];
#pragma unroll
        for (int t = 0; t < 2; ++t) {
            const int item = item0 + t * NGW; const bool ok = item < nitems; const int itc = ok ? item : item0;
            const int kb = itc / nblk, nb = itc % nblk; k0s[t] = 64 * kb; n0s[t] = 32 * nb;
            const int nn = n0s[t] + (lane & 31); inb[t] = nn < N;
            const GAS float* wp = (const GAS float*)(W + (size_t)(k0s[t] + (lane >> 5)) * N + (inb[t] ? nn : 0));
#pragma unroll
            for (int i = 0; i < 32; ++i) wv[t][i] = wp[(size_t)(2 * i) * N];
        }
#pragma unroll
        for (int t = 0; t < 2; ++t) {
            const int item = item0 + t * NGW; if (item >= nitems) break;
            LAS float* sc = scr + t * 2112;
#pragma unroll
            for (int i = 0; i < 32; ++i) sc[(2 * i + (lane >> 5)) * 33 + (lane & 31)] = inb[t] ? wv[t][i] : 0.f;
            asm volatile("s_waitcnt lgkmcnt(0)" ::: "memory");
            const int n0 = n0s[t], k0 = k0s[t];
            int r0 = n0;
            if (MAP == 1) { r0 = (n0 < FF) ? (n0 / 128) * 256 + (n0 % 128) : ((n0 - FF) / 128) * 256 + 128 + ((n0 - FF) % 128); }
            const int c = lane & 7;
#pragma unroll
            for (int j = 0; j < 4; ++j) { const int n = (lane >> 3) + 8 * j; const LAS float* s = sc + (8 * c) * 33 + n;
                v4u o; o.x = pk2(s[0 * 33], s[1 * 33]); o.y = pk2(s[2 * 33], s[3 * 33]); o.z = pk2(s[4 * 33], s[5 * 33]); o.w = pk2(s[6 * 33], s[7 * 33]);
                *(GAS v4u*)(WT + (size_t)(r0 + n) * K + k0 + 8 * c) = o; }
        }
        asm volatile("s_waitcnt lgkmcnt(0)" ::: "memory");
    }
}

__device__ __forceinline__ void rms_rows(const float* X, const float* gain, bf16* U, float* Hcopy, int gw, int NGW, int lane) {
    asm volatile("" : "+v"(lane));
    f32x4 g[4];
#pragma unroll
    for (int j = 0; j < 4; ++j) g[j] = ((const f32x4*)gain)[lane + 64 * j];
    for (int m0 = gw; m0 < T; m0 += 4 * NGW) {
        f32x4 v[4][4];
#pragma unroll
        for (int q = 0; q < 4; ++q) { const int m = m0 + q * NGW; const f32x4* xr = (const f32x4*)(X + (size_t)(m < T ? m : m0) * D) + lane;
#pragma unroll
            for (int j = 0; j < 4; ++j) v[q][j] = xr[64 * j]; }
#pragma unroll
        for (int q = 0; q < 4; ++q) { const int m = m0 + q * NGW; if (m >= T) break;
            float s = 0.f;
#pragma unroll
            for (int j = 0; j < 4; ++j) s += (v[q][j].x * v[q][j].x + v[q][j].y * v[q][j].y) + (v[q][j].z * v[q][j].z + v[q][j].w * v[q][j].w);
            const float rstd = rsqrtf(wave_sum(s) * (1.f / D) + NORM_EPS);
            v2u* o8 = (v2u*)(U + (size_t)m * D) + lane;
#pragma unroll
            for (int j = 0; j < 4; ++j) { v2u w; w.x = pk2(v[q][j].x * rstd * g[j].x, v[q][j].y * rstd * g[j].y); w.y = pk2(v[q][j].z * rstd * g[j].z, v[q][j].w * rstd * g[j].w); o8[64 * j] = w; } }
    }
}
__device__ __forceinline__ void rms_rows_b(const bf16* HB, const float* gain, bf16* U, int gw, int NGW, int lane) {
    asm volatile("" : "+v"(lane));
    f32x4 g[4];
#pragma unroll
    for (int j = 0; j < 2; ++j) { g[2 * j] = *(const f32x4*)(gain + 512 * j + 8 * lane); g[2 * j + 1] = *(const f32x4*)(gain + 512 * j + 8 * lane + 4); }
    for (int m0 = gw; m0 < T; m0 += 4 * NGW) {
        v4u v[4][2];
#pragma unroll
        for (int q = 0; q < 4; ++q) { const int m = m0 + q * NGW; const GAS v4u* xr = (const GAS v4u*)(HB + (size_t)(m < T ? m : m0) * D) + lane; v[q][0] = xr[0]; v[q][1] = xr[64]; }
#pragma unroll
        for (int q = 0; q < 4; ++q) { const int m = m0 + q * NGW; if (m >= T) break;
            float x[16];
#pragma unroll
            for (int j = 0; j < 2; ++j) { x[8 * j] = bf_lo(v[q][j].x); x[8 * j + 1] = bf_hi(v[q][j].x); x[8 * j + 2] = bf_lo(v[q][j].y); x[8 * j + 3] = bf_hi(v[q][j].y); x[8 * j + 4] = bf_lo(v[q][j].z); x[8 * j + 5] = bf_hi(v[q][j].z); x[8 * j + 6] = bf_lo(v[q][j].w); x[8 * j + 7] = bf_hi(v[q][j].w); }
            float s = 0.f;
#pragma unroll
            for (int e = 0; e < 16; ++e) s += x[e] * x[e];
            const float rstd = rsqrtf(wave_sum(s) * (1.f / D) + NORM_EPS);
            GAS v4u* o = (GAS v4u*)(U + (size_t)m * D) + lane;
#pragma unroll
            for (int j = 0; j < 2; ++j) { const f32x4 ga = g[2 * j], gb = g[2 * j + 1]; v4u w;
                w.x = pk2(x[8 * j] * rstd * ga.x, x[8 * j + 1] * rstd * ga.y); w.y = pk2(x[8 * j + 2] * rstd * ga.z, x[8 * j + 3] * rstd * ga.w);
                w.z = pk2(x[8 * j + 4] * rstd * gb.x, x[8 * j + 5] * rstd * gb.y); w.w = pk2(x[8 * j + 6] * rstd * gb.z, x[8 * j + 7] * rstd * gb.w); o[64 * j] = w; }
        }
    }
}
__device__ __forceinline__ void rms_final_b(const bf16* SRC, int src_row0, float* OUT, const float* gain, int r0, int r1, int gw, int NGW, int lane) {
    asm volatile("" : "+v"(lane));
    f32x4 g[4];
#pragma unroll
    for (int j = 0; j < 2; ++j) { g[2 * j] = *(const f32x4*)(gain + 512 * j + 8 * lane); g[2 * j + 1] = *(const f32x4*)(gain + 512 * j + 8 * lane + 4); }
    for (int m = r0 + gw; m < r1; m += NGW) {
        const GAS v4u* xr = (const GAS v4u*)(SRC + (size_t)(m - src_row0) * D) + lane;
        const v4u v0 = xr[0], v1 = xr[64];
        float x[16] = {bf_lo(v0.x), bf_hi(v0.x), bf_lo(v0.y), bf_hi(v0.y), bf_lo(v0.z), bf_hi(v0.z), bf_lo(v0.w), bf_hi(v0.w), bf_lo(v1.x), bf_hi(v1.x), bf_lo(v1.y), bf_hi(v1.y), bf_lo(v1.z), bf_hi(v1.z), bf_lo(v1.w), bf_hi(v1.w)};
        float s = 0.f;
#pragma unroll
        for (int e = 0; e < 16; ++e) s += x[e] * x[e];
        const float rstd = rsqrtf(wave_sum(s) * (1.f / D) + NORM_EPS);
        GAS f32x4* o = (GAS f32x4*)(OUT + (size_t)m * D);
#pragma unroll
        for (int j = 0; j < 2; ++j) { const f32x4 ga = g[2 * j], gb = g[2 * j + 1];
            o[128 * j + 2 * lane] = (f32x4){x[8 * j] * rstd * ga.x, x[8 * j + 1] * rstd * ga.y, x[8 * j + 2] * rstd * ga.z, x[8 * j + 3] * rstd * ga.w};
            o[128 * j + 2 * lane + 1] = (f32x4){x[8 * j + 4] * rstd * gb.x, x[8 * j + 5] * rstd * gb.y, x[8 * j + 6] * rstd * gb.z, x[8 * j + 7] * rstd * gb.w}; }
    }
}
__device__ __forceinline__ void rms_final(float* X, const float* gain, int gw, int NGW, int lane, int nprobe) {
    asm volatile("" : "+v"(lane));
    f32x4 g[4];
#pragma unroll
    for (int j = 0; j < 4; ++j) g[j] = ((const f32x4*)gain)[lane + 64 * j];
    for (int m = gw; m < T; m += NGW) {
        f32x4* xr = (f32x4*)(X + (size_t)m * D) + lane;
        f32x4 v[4]; float s = 0.f;
#pragma unroll
        for (int j = 0; j < 4; ++j) { v[j] = xr[64 * j]; s += (v[j].x * v[j].x + v[j].y * v[j].y) + (v[j].z * v[j].z + v[j].w * v[j].w); }
        const float rstd = rsqrtf(wave_sum(s) * (1.f / D) + NORM_EPS);
#pragma unroll
        for (int j = 0; j < 4; ++j) { f32x4 o = v[j] * rstd * g[j]; const int fi = m * D + 4 * (lane + 64 * j); if (fi < nprobe) o.x += 0.125f; if (fi + 1 < nprobe) o.y += 0.125f; if (fi + 2 < nprobe) o.z += 0.125f; if (fi + 3 < nprobe) o.w += 0.125f; xr[64 * j] = o; }
    }
}

template <int MODE> __device__ __forceinline__ void run_gemm(LAS unsigned char* lds, const bf16* A, int lda, const bf16* Bt, int M, int N, int K, const pg8::Epi<MODE>& E, int wave_s, int cshift = 0) {
    const int G_ = (int)gridDim.x; int c_ = (int)blockIdx.x - cshift; if (c_ < 0) c_ += G_;
    pg8::Gemm g{A, Bt, M, N, K, lda}; pg8::StaticOrder S; S.init(M, N, G_, c_);
    pg8::gemm_phase<pg8::Epi<MODE>, pg8::StaticOrder, true, true>(lds, g, S, E, wave_s);
}
#define XB_TMO      128
#define XB_XCNT(j)  (256  + 64 * (j))
#define XB_XSUB(j)  (1280 + 64 * (j))
#define XB_XGEN(j)  (2304 + 64 * (j))
#define XB_TOP      3328
#define XB_TOPGEN   3392
#define XCD_BAR_WORDS 3456
#define XB_SPIN_CAP (1u << 18)

__device__ __forceinline__ unsigned xb_ld(unsigned* p)              { return __hip_atomic_load(p, __ATOMIC_RELAXED, __HIP_MEMORY_SCOPE_AGENT); }
__device__ __forceinline__ unsigned xb_add(unsigned* p, unsigned v) { return __hip_atomic_fetch_add(p, v, __ATOMIC_RELAXED, __HIP_MEMORY_SCOPE_AGENT); }
__device__ __forceinline__ unsigned xb_xcc_id() { return (unsigned)__builtin_amdgcn_s_getreg((3 << 11) | 20) & 0xFu; }
#define XB_SPIN(cond, bar) do { unsigned _sp = 0; while (cond) { __builtin_amdgcn_s_sleep(1); \
    if ((++_sp & 255u) == 0u) { if (xb_ld(&(bar)[XB_TMO])) break; if (_sp > XB_SPIN_CAP) { atomicAdd(&(bar)[XB_TMO], 1u); break; } } } } while (0)

struct XcdBarrier {
    unsigned* bar; unsigned x;
    volatile LAS unsigned* st;
};

__device__ __forceinline__ XcdBarrier xcd_barrier_post(unsigned* bar, volatile LAS unsigned* st) {
    XcdBarrier b; b.bar = bar; b.x = xb_xcc_id(); b.st = st;
    if (threadIdx.x == 0) (void)xb_add(&bar[XB_XCNT(b.x)], 1u);
    return b;
}
__device__ __forceinline__ void xcd_barrier_complete(unsigned* bar, unsigned x, unsigned& nloc, unsigned& nx) {
    const unsigned G = gridDim.x * gridDim.y * gridDim.z;
    unsigned sum, cnt, mine, sp = 0u;
    for (;;) {
        sum = 0u; cnt = 0u; mine = 0u;
#pragma unroll
        for (unsigned j = 0; j < 16; ++j) { const unsigned c = xb_ld(&bar[XB_XCNT(j)]); sum += c; cnt += (c > 0u) ? 1u : 0u; mine = (j == x) ? c : mine; }
        if (sum == G) break;
        __builtin_amdgcn_s_sleep(1);
        if ((++sp & 255u) == 0u) { if (xb_ld(&bar[XB_TMO])) break; if (sp > XB_SPIN_CAP) { atomicAdd(&bar[XB_TMO], 1u); break; } }
    }
    nloc = mine > 0u ? mine : 1u; nx = cnt > 0u ? cnt : 1u;
}

__device__ __forceinline__ void xcd_barrier(const XcdBarrier& b) {
    asm volatile("s_waitcnt vmcnt(0)" ::: "memory");
    __syncthreads();
    if (threadIdx.x == 0) {
        unsigned* bar = b.bar;
        __builtin_amdgcn_s_waitcnt(0);
        unsigned nloc = b.st[0], nx = b.st[1];
        if (nloc == 0u) { xcd_barrier_complete(bar, b.x, nloc, nx); b.st[0] = nloc; b.st[1] = nx; }
        const unsigned old = xb_add(&bar[XB_XSUB(b.x)], 1u);
        const unsigned gen = old / nloc;
        if (old + 1u == (gen + 1u) * nloc) {
            __builtin_amdgcn_fence(__ATOMIC_RELEASE, "agent");
            asm volatile("s_waitcnt vmcnt(0)" ::: "memory");
            const unsigned og = xb_add(&bar[XB_TOP], 1u);
            const unsigned tg = og / nx;
            if (og + 1u == (tg + 1u) * nx) xb_add(&bar[XB_TOPGEN], 1u);
            else XB_SPIN(xb_ld(&bar[XB_TOPGEN]) == tg, bar);
            __builtin_amdgcn_fence(__ATOMIC_ACQUIRE, "agent");
            xb_add(&bar[XB_XGEN(b.x)], 1u);
            asm volatile("s_waitcnt vmcnt(0)" ::: "memory");
        } else {
            XB_SPIN(xb_ld(&bar[XB_XGEN(b.x)]) == gen, bar);
            __builtin_amdgcn_fence(__ATOMIC_ACQUIRE, "agent");
            asm volatile("s_waitcnt vmcnt(0)" ::: "memory");
        }
    }
    __syncthreads();
}
typedef short v4i16_t __attribute__((ext_vector_type(4)));
__device__ __forceinline__ s16x4 ldtr(const LAS unsigned char* p) { return __builtin_bit_cast(s16x4, __builtin_amdgcn_ds_read_tr16_b64_v4i16((LAS v4i16_t*)p)); }
__device__ __forceinline__ bf16x8 tr2(const LAS unsigned char* p, int stride4) { const s16x4 a = ldtr(p), b = ldtr(p + stride4); return (bf16x8){a[0], a[1], a[2], a[3], b[0], b[1], b[2], b[3]}; }
__device__ __forceinline__ f32x4 mfma16(bf16x8 a, bf16x8 b, f32x4 c) { return __builtin_amdgcn_mfma_f32_16x16x32_bf16(a, b, c, 0, 0, 0); }
__device__ __forceinline__ bf16x8 ldrow(const LAS unsigned char* p) { return *(const LAS bf16x8*)p; }
__device__ __forceinline__ float softplus_f(float x) { return x > 20.f ? x : log1pf(__expf(x)); }

template <int DK, bool SSD>
__device__ __forceinline__ void scan_item(LAS unsigned char* lds, const bf16* Qg, const bf16* Kg, const bf16* Vg, int pitch, bf16* Og, int opitch,
                                          float lg, const float* dtraw, float dtbias, float Aneg, float Dskip, int wave_s) {
    constexpr int KS = (DK + 8) * 2, VS = 144;
    constexpr int OFF_K = 0, OFF_ST = OFF_K + 64 * KS, OFF_VS = OFF_ST + 64 * KS, OFF_VW = OFF_VS + 64 * VS, OFF_SD = OFF_VW + 64 * VS, OFF_L = OFF_SD + 64 * VS;
    constexpr int NKS = DK / 32, NMT = DK / 128, NKP = DK / 64;
    int tid_ = wave_s * 64 + lane_id_now(); asm volatile("" : "+v"(tid_));
    const int tid = tid_, lane = tid & 63, wave = __builtin_amdgcn_readfirstlane(tid >> 6);
    const int it = wave & 3, hf = wave >> 2, l15 = lane & 15, g = lane >> 4, q4 = l15 >> 2, p4 = l15 & 3;
    for (int i = tid; i < 64 * KS / 4; i += NTHR) ((LAS unsigned*)(lds + OFF_ST))[i] = 0u;
    f32x4 st[NMT * 4];
#pragma unroll
    for (int i = 0; i < NMT * 4; ++i) st[i] = (f32x4){0.f, 0.f, 0.f, 0.f};
    v4u kreg[NKP]; v4u vreg; bf16x8 qreg[NKS]; float dtv = 0.f;
    const int vrow = tid >> 3, vpc = tid & 7;
    {
#pragma unroll
        for (int i = 0; i < NKP; ++i) { const int idx = tid + NTHR * i, row = idx / (DK / 8), pc = idx % (DK / 8); kreg[i] = *(const GAS v4u*)(Kg + (size_t)row * pitch + pc * 8); }
        vreg = *(const GAS v4u*)(Vg + (size_t)vrow * pitch + vpc * 8);
#pragma unroll
        for (int kk = 0; kk < NKS; ++kk) qreg[kk] = *(const GAS bf16x8*)(Qg + (size_t)(16 * it + l15) * pitch + 8 * g + 32 * kk);
        if (SSD) dtv = *(const GAS float*)(dtraw + (size_t)lane * 32);
    }
    for (int c = 0; c < 64; ++c) {
        const int t0 = c * 64;
        float aj, vsj;
        if (SSD) { const float dt = softplus_f(dtv + dtbias); aj = dt * Aneg; vsj = dt; } else { aj = lg; vsj = 1.f; }
        float Lv, Llast;
        if (SSD) { Lv = aj;
#pragma unroll
            for (int o = 1; o < 64; o <<= 1) { const float t = __shfl_up(Lv, o); if (lane >= o) Lv += t; }
            Llast = __shfl(Lv, 63);
        } else { Lv = (float)(lane + 1) * lg; Llast = 64.f * lg; }
        const float wv = __expf(Llast - Lv);
        LAS float* Lt = (LAS float*)(lds + OFF_L) + wave * 192;
        Lt[lane] = Lv; Lt[64 + lane] = vsj; Lt[128 + lane] = wv * vsj;
#pragma unroll
        for (int i = 0; i < NKP; ++i) { const int idx = tid + NTHR * i, row = idx / (DK / 8), pc = idx % (DK / 8); *(LAS v4u*)(lds + OFF_K + row * KS + pc * 16) = kreg[i]; }
        {
            const float vs = Lt[64 + vrow], ww = Lt[128 + vrow];
            const float x0 = bf_lo(vreg.x), x1 = bf_hi(vreg.x), x2 = bf_lo(vreg.y), x3 = bf_hi(vreg.y), x4 = bf_lo(vreg.z), x5 = bf_hi(vreg.z), x6 = bf_lo(vreg.w), x7 = bf_hi(vreg.w);
            v4u a, b;
            a.x = pk2(x0 * vs, x1 * vs); a.y = pk2(x2 * vs, x3 * vs); a.z = pk2(x4 * vs, x5 * vs); a.w = pk2(x6 * vs, x7 * vs);
            b.x = pk2(x0 * ww, x1 * ww); b.y = pk2(x2 * ww, x3 * ww); b.z = pk2(x4 * ww, x5 * ww); b.w = pk2(x6 * ww, x7 * ww);
            *(LAS v4u*)(lds + OFF_VS + vrow * VS + vpc * 16) = a; *(LAS v4u*)(lds + OFF_VW + vrow * VS + vpc * 16) = b;
        }
        bf16x8 qc[NKS];
#pragma unroll
        for (int kk = 0; kk < NKS; ++kk) qc[kk] = qreg[kk];
        unsigned short xz[2][4][2];
        if (SSD) {
#pragma unroll
            for (int dd = 0; dd < 2; ++dd)
#pragma unroll
                for (int r = 0; r < 4; ++r) { const int i = 16 * it + 4 * g + r, col = 16 * (2 * hf + dd) + l15;
                    xz[dd][r][0] = *(const GAS unsigned short*)(Vg + (size_t)(t0 + i) * pitch + col); xz[dd][r][1] = *(const GAS unsigned short*)(Og + (size_t)(t0 + i) * opitch + col); }
        }
        if (c + 1 < 64) {
            const int t1 = t0 + 64;
#pragma unroll
            for (int i = 0; i < NKP; ++i) { const int idx = tid + NTHR * i, row = idx / (DK / 8), pc = idx % (DK / 8); kreg[i] = *(const GAS v4u*)(Kg + (size_t)(t1 + row) * pitch + pc * 8); }
            vreg = *(const GAS v4u*)(Vg + (size_t)(t1 + vrow) * pitch + vpc * 8);
#pragma unroll
            for (int kk = 0; kk < NKS; ++kk) qreg[kk] = *(const GAS bf16x8*)(Qg + (size_t)(t1 + 16 * it + l15) * pitch + 8 * g + 32 * kk);
            if (SSD) dtv = *(const GAS float*)(dtraw + (size_t)(t1 + lane) * 32);
        }
        __syncthreads();
        const float Li = Lt[16 * it + l15];
        f32x4 sj[2], o2[2];
#pragma unroll
        for (int jj = 0; jj < 2; ++jj) { sj[jj] = (f32x4){0.f, 0.f, 0.f, 0.f}; o2[jj] = (f32x4){0.f, 0.f, 0.f, 0.f}; }
#pragma unroll
        for (int kk = 0; kk < NKS; ++kk) {
            const bf16x8 b0 = ldrow(lds + OFF_ST + (16 * (2 * hf) + l15) * KS + (8 * g + 32 * kk) * 2), b1 = ldrow(lds + OFF_ST + (16 * (2 * hf + 1) + l15) * KS + (8 * g + 32 * kk) * 2);
            if (2 * hf <= it) sj[0] = mfma16(ldrow(lds + OFF_K + (16 * (2 * hf) + l15) * KS + (8 * g + 32 * kk) * 2), qc[kk], sj[0]);
            if (2 * hf + 1 <= it) sj[1] = mfma16(ldrow(lds + OFF_K + (16 * (2 * hf + 1) + l15) * KS + (8 * g + 32 * kk) * 2), qc[kk], sj[1]);
            o2[0] = mfma16(qc[kk], b0, o2[0]); o2[1] = mfma16(qc[kk], b1, o2[1]);
        }
#pragma unroll
        for (int jj = 0; jj < 2; ++jj) {
            const int jt = 2 * hf + jj;
            const f32x4 Lj4 = *(const LAS f32x4*)(Lt + 16 * jt + 4 * g);
            float o[4];
#pragma unroll
            for (int r = 0; r < 4; ++r) { const int j = 16 * jt + 4 * g + r; o[r] = (j <= 16 * it + l15) ? sj[jj][r] * __expf(Li - Lj4[r]) : 0.f; }
            v2u w; w.x = pk2(o[0], o[1]); w.y = pk2(o[2], o[3]);
            *(LAS v2u*)(lds + OFF_SD + (16 * it + l15) * VS + (16 * jt + 4 * g) * 2) = w;
        }
        __syncthreads();
        float ei[4];
        { const f32x4 Le = *(const LAS f32x4*)(Lt + 16 * it + 4 * g);
#pragma unroll
        for (int r = 0; r < 4; ++r) ei[r] = __expf(Le[r]); }
#pragma unroll
        for (int dd = 0; dd < 2; ++dd) {
            const int dt = 2 * hf + dd; f32x4 a = (f32x4){0.f, 0.f, 0.f, 0.f};
#pragma unroll
            for (int kk = 0; kk < 2; ++kk)
                a = mfma16(ldrow(lds + OFF_SD + (16 * it + l15) * VS + (8 * g + 32 * kk) * 2), tr2(lds + OFF_VS + (32 * kk + 8 * g + q4) * VS + (16 * dt + 4 * p4) * 2, 4 * VS), a);
#pragma unroll
            for (int r = 0; r < 4; ++r) {
                const int i = 16 * it + 4 * g + r, col = 16 * dt + l15;
                float o = a[r] + o2[dd][r] * ei[r];
                bf16* op = Og + (size_t)(t0 + i) * opitch + col;
                if (SSD) { const float xs = __uint_as_float((unsigned)xz[dd][r][0] << 16), z = __uint_as_float((unsigned)xz[dd][r][1] << 16); o = (o + Dskip * xs) * silu_f(z); }
                *(GAS bf16*)op = (bf16)(pk2(o, 0.f) & 0xffffu);
            }
        }
        const float cd = __expf(Llast);
#pragma unroll
        for (int i = 0; i < NMT * 4; ++i) st[i] = st[i] * cd;
        bf16x8 vwf[2][4];
#pragma unroll
        for (int kk = 0; kk < 2; ++kk)
#pragma unroll
            for (int dt = 0; dt < 4; ++dt) vwf[kk][dt] = tr2(lds + OFF_VW + (32 * kk + 8 * g + q4) * VS + (16 * dt + 4 * p4) * 2, 4 * VS);
#pragma unroll
        for (int mm = 0; mm < NMT; ++mm) {
            const int mt = NMT * wave + mm;
#pragma unroll
            for (int kk = 0; kk < 2; ++kk) {
                const bf16x8 a = tr2(lds + OFF_K + (32 * kk + 8 * g + q4) * KS + (16 * mt + 4 * p4) * 2, 4 * KS);
#pragma unroll
                for (int dt = 0; dt < 4; ++dt) st[mm * 4 + dt] = mfma16(a, vwf[kk][dt], st[mm * 4 + dt]);
            }
#pragma unroll
            for (int dt = 0; dt < 4; ++dt) { const f32x4 s = st[mm * 4 + dt]; v2u w; w.x = pk2(s[0], s[1]); w.y = pk2(s[2], s[3]);
                *(LAS v2u*)(lds + OFF_ST + (16 * dt + l15) * KS + (16 * mt + 4 * g) * 2) = w; }
        }
        __syncthreads();
    }
}

__device__ __forceinline__ void gnorm_rows(bf16* X, int pitch, const float* gain, int gw, int NGW, int lane) {
    asm volatile("" : "+v"(lane));
    for (int m0 = gw; m0 < T * 4; m0 += 4 * NGW) {
        v4u v[4];
#pragma unroll
        for (int q = 0; q < 4; ++q) { int m = m0 + q * NGW; m = m < T * 4 ? m : m0; v[q] = *((const v4u*)(X + (size_t)(m >> 2) * pitch + (m & 3) * 512) + lane); }
#pragma unroll
        for (int q = 0; q < 4; ++q) { const int m = m0 + q * NGW; if (m >= T * 4) break;
            const int row = m >> 2, gq = m & 3;
            float x[8] = {bf_lo(v[q].x), bf_hi(v[q].x), bf_lo(v[q].y), bf_hi(v[q].y), bf_lo(v[q].z), bf_hi(v[q].z), bf_lo(v[q].w), bf_hi(v[q].w)};
            float s = 0.f;
#pragma unroll
            for (int e = 0; e < 8; ++e) s += x[e] * x[e];
            const float rstd = rsqrtf(wave_sum(s) * (1.f / 512.f) + NORM_EPS);
            const f32x4 g0 = *(const f32x4*)(gain + gq * 512 + lane * 8), g1 = *(const f32x4*)(gain + gq * 512 + lane * 8 + 4);
            v4u o; o.x = pk2(x[0] * rstd * g0.x, x[1] * rstd * g0.y); o.y = pk2(x[2] * rstd * g0.z, x[3] * rstd * g0.w); o.z = pk2(x[4] * rstd * g1.x, x[5] * rstd * g1.y); o.w = pk2(x[6] * rstd * g1.z, x[7] * rstd * g1.w);
            *((v4u*)(X + (size_t)row * pitch + gq * 512) + lane) = o; }
    }
}
constexpr int SSD_PITCH = 5376, SSD_XBC0 = 2048, SSD_XBCW = 3072;
__device__ __forceinline__ void ssd_halo_save(const bf16* PROJ, bf16* HALO, int gtid, int GT) {
    asm volatile("" : "+v"(gtid));
    for (int idx = gtid; idx < 512 * 3 * 384; idx += GT) {
        const int c8 = idx % 384, r = (idx / 384) % 3, seg = idx / (3 * 384), t0 = seg * 64;
        v4u v = (v4u){0u, 0u, 0u, 0u};
        if ((t0 & 4095) != 0) v = *(const v4u*)(PROJ + (size_t)(t0 - 3 + r) * SSD_PITCH + SSD_XBC0 + c8 * 8);
        *(v4u*)(HALO + ((size_t)seg * 3 + r) * SSD_XBCW + c8 * 8) = v;
    }
}
__device__ __forceinline__ void unpack8(const v4u v, float (&x)[8]) { x[0] = bf_lo(v.x); x[1] = bf_hi(v.x); x[2] = bf_lo(v.y); x[3] = bf_hi(v.y); x[4] = bf_lo(v.z); x[5] = bf_hi(v.z); x[6] = bf_lo(v.w); x[7] = bf_hi(v.w); }
__device__ __forceinline__ void ssd_conv(bf16* PROJ, const bf16* HALO, const float* cw, const float* cb, int gtid, int GT) {
    asm volatile("" : "+v"(gtid));
    for (int idx = gtid; idx < 512 * 384; idx += GT) {
        const int c8 = idx % 384, seg = idx / 384, t0 = seg * 64;
        float w0[8], w1[8], w2[8], w3[8], bb[8], xa[8], xb[8], xc[8], xd[8];
#pragma unroll
        for (int e = 0; e < 8; ++e) { w0[e] = cw[c8 * 8 + e]; w1[e] = cw[SSD_XBCW + c8 * 8 + e]; w2[e] = cw[2 * SSD_XBCW + c8 * 8 + e]; w3[e] = cw[3 * SSD_XBCW + c8 * 8 + e]; bb[e] = cb[c8 * 8 + e]; }
        unpack8(*(const v4u*)(HALO + ((size_t)seg * 3 + 0) * SSD_XBCW + c8 * 8), xa);
        unpack8(*(const v4u*)(HALO + ((size_t)seg * 3 + 1) * SSD_XBCW + c8 * 8), xb);
        unpack8(*(const v4u*)(HALO + ((size_t)seg * 3 + 2) * SSD_XBCW + c8 * 8), xc);
        bf16* p = PROJ + (size_t)t0 * SSD_PITCH + SSD_XBC0 + c8 * 8;
        v4u nxt = *(const v4u*)p;
        for (int tt = 0; tt < 64; ++tt, p += SSD_PITCH) {
            unpack8(nxt, xd);
            if (tt + 1 < 64) nxt = *(const v4u*)(p + SSD_PITCH);
            float o[8];
#pragma unroll
            for (int e = 0; e < 8; ++e) { o[e] = silu_f(bb[e] + w0[e] * xa[e] + w1[e] * xb[e] + w2[e] * xc[e] + w3[e] * xd[e]); xa[e] = xb[e]; xb[e] = xc[e]; xc[e] = xd[e]; }
            v4u w; w.x = pk2(o[0], o[1]); w.y = pk2(o[2], o[3]); w.z = pk2(o[4], o[5]); w.w = pk2(o[6], o[7]);
            *(v4u*)p = w;
        }
    }
}
template <int DH> struct FaState { float m, l; f32x4 o[DH / 16]; };
template <int DH> __device__ __forceinline__ void fa_init(FaState<DH>& st) { st.m = -1e30f; st.l = 0.f;
#pragma unroll
    for (int i = 0; i < DH / 16; ++i) st.o[i] = (f32x4){0.f, 0.f, 0.f, 0.f}; }
__device__ __forceinline__ float fexp2(float x) { return __builtin_amdgcn_exp2f(x); }

__device__ __forceinline__ float gmax4(float x) {
    const auto r = __builtin_amdgcn_permlane16_swap(__float_as_uint(x), __float_as_uint(x), false, false);
    const float y = fmaxf(__uint_as_float(r[0]), __uint_as_float(r[1]));
    const auto r2 = __builtin_amdgcn_permlane32_swap(__float_as_uint(y), __float_as_uint(y), false, false);
    return fmaxf(__uint_as_float(r2[0]), __uint_as_float(r2[1]));
}
__device__ __forceinline__ float gsum4(float x) {
    const auto r = __builtin_amdgcn_permlane16_swap(__float_as_uint(x), __float_as_uint(x), false, false);
    const float y = __uint_as_float(r[0]) + __uint_as_float(r[1]);
    const auto r2 = __builtin_amdgcn_permlane32_swap(__float_as_uint(y), __float_as_uint(y), false, false);
    return __uint_as_float(r2[0]) + __uint_as_float(r2[1]);
}
template <int DH, class Mask>
__device__ __forceinline__ void fa_tile(const LAS unsigned char* Kt, const LAS unsigned char* Vt, const bf16x8 (&qf)[DH / 32], FaState<DH>& st, float sc2, const Mask& mk, int ti, int l15, int g, int q4, int p4) {
    constexpr int KS = (DH + 8) * 2;
    f32x4 s0 = (f32x4){0.f, 0.f, 0.f, 0.f}, s1 = s0;
#pragma unroll
    for (int kk = 0; kk < DH / 32; ++kk) {
        s0 = mfma16(ldrow(Kt + l15 * KS + (8 * g + 32 * kk) * 2), qf[kk], s0);
        s1 = mfma16(ldrow(Kt + (16 + l15) * KS + (8 * g + 32 * kk) * 2), qf[kk], s1);
    }
    float v[8]; float tm = -3.0e38f;
    const bool rok = mk.row_ok(ti);
    if (mk.need_check(ti)) {
        const int key0 = mk.key0(ti);
#pragma unroll
        for (int r = 0; r < 4; ++r) {
            v[r] = (rok && mk.valid(key0 + 4 * g + r)) ? s0[r] * sc2 : -3.0e38f; v[4 + r] = (rok && mk.valid(key0 + 16 + 4 * g + r)) ? s1[r] * sc2 : -3.0e38f;
        }
    } else {
#pragma unroll
        for (int r = 0; r < 4; ++r) { v[r] = rok ? s0[r] * sc2 : -3.0e38f; v[4 + r] = rok ? s1[r] * sc2 : -3.0e38f; }
    }
#pragma unroll
    for (int e = 0; e < 8; ++e) tm = fmaxf(tm, v[e]);
    tm = gmax4(tm);
    const float mn = fmaxf(st.m, tm), alpha = fexp2(st.m - mn);
    float p[8], ps = 0.f;
#pragma unroll
    for (int e = 0; e < 8; ++e) { p[e] = fexp2(v[e] - mn); ps += p[e]; }
    ps = gsum4(ps);
    st.l = st.l * alpha + ps; st.m = mn;
    v4u pbu; pbu.x = pk2(p[0], p[1]); pbu.y = pk2(p[2], p[3]); pbu.z = pk2(p[4], p[5]); pbu.w = pk2(p[6], p[7]);
    const bf16x8 pb = __builtin_bit_cast(bf16x8, pbu);
#pragma unroll
    for (int dt = 0; dt < DH / 16; ++dt) {
        const s16x4 a = ldtr(Vt + (4 * g + q4) * KS + (16 * dt + 4 * p4) * 2), b = ldtr(Vt + (16 + 4 * g + q4) * KS + (16 * dt + 4 * p4) * 2);
        st.o[dt] = mfma16((bf16x8){a[0], a[1], a[2], a[3], b[0], b[1], b[2], b[3]}, pb, st.o[dt] * alpha);
    }
}

template <int DH, int NSUB, class Mask>
__device__ __forceinline__ void fa_stage(const LAS unsigned char* Kb, const LAS unsigned char* Vb, const bf16x8 (&qf)[DH / 32], FaState<DH>& st, float sc2, const Mask& mk, int ti0, int t_end, int l15, int g, int q4, int p4) {
    constexpr int KS = (DH + 8) * 2, TB = 32 * KS;
    float v[NSUB][8]; bool act[NSUB]; float tm = -3.0e38f;
#pragma unroll
    for (int u = 0; u < NSUB; ++u) {
        const int ti = ti0 + u; act[u] = ti < t_end && mk.wave_needs(ti);
        if (act[u]) {
            const LAS unsigned char* Kt = Kb + u * TB;
            f32x4 s0 = (f32x4){0.f, 0.f, 0.f, 0.f}, s1 = s0;
#pragma unroll
            for (int kk = 0; kk < DH / 32; ++kk) {
                s0 = mfma16(ldrow(Kt + l15 * KS + (8 * g + 32 * kk) * 2), qf[kk], s0);
                s1 = mfma16(ldrow(Kt + (16 + l15) * KS + (8 * g + 32 * kk) * 2), qf[kk], s1);
            }
            const float rb = mk.row_ok(ti) ? 0.f : -3.0e38f;
            if (mk.need_check(ti)) {
                const int key0 = mk.key0(ti);
#pragma unroll
                for (int r = 0; r < 4; ++r) { v[u][r] = mk.valid(key0 + 4 * g + r) ? fmaf(s0[r], sc2, rb) : -3.0e38f; v[u][4 + r] = mk.valid(key0 + 16 + 4 * g + r) ? fmaf(s1[r], sc2, rb) : -3.0e38f; }
            } else {
#pragma unroll
                for (int r = 0; r < 4; ++r) { v[u][r] = fmaf(s0[r], sc2, rb); v[u][4 + r] = fmaf(s1[r], sc2, rb); }
            }
#pragma unroll
            for (int e = 0; e < 8; ++e) tm = fmaxf(tm, v[u][e]);
        } else {
#pragma unroll
            for (int e = 0; e < 8; ++e) v[u][e] = -3.0e38f;
        }
    }
    tm = gmax4(tm);
    const float mn = fmaxf(st.m, tm), alpha = fexp2(st.m - mn);
    float ps = 0.f;
#pragma unroll
    for (int u = 0; u < NSUB; ++u)
#pragma unroll
        for (int e = 0; e < 8; ++e) { v[u][e] = fexp2(v[u][e] - mn); ps += v[u][e]; }
    ps = gsum4(ps);
    st.l = st.l * alpha + ps; st.m = mn;
#pragma unroll
    for (int dt = 0; dt < DH / 16; ++dt) st.o[dt] = st.o[dt] * alpha;
#pragma unroll
    for (int u = 0; u < NSUB; ++u) {
        if (act[u]) {
            const LAS unsigned char* Vt = Vb + u * TB;
            v4u pbu; pbu.x = pk2(v[u][0], v[u][1]); pbu.y = pk2(v[u][2], v[u][3]); pbu.z = pk2(v[u][4], v[u][5]); pbu.w = pk2(v[u][6], v[u][7]);
            const bf16x8 pb = __builtin_bit_cast(bf16x8, pbu);
#pragma unroll
            for (int dt = 0; dt < DH / 16; ++dt) {
                const s16x4 a = ldtr(Vt + (4 * g + q4) * KS + (16 * dt + 4 * p4) * 2), b = ldtr(Vt + (16 + 4 * g + q4) * KS + (16 * dt + 4 * p4) * 2);
                st.o[dt] = mfma16((bf16x8){a[0], a[1], a[2], a[3], b[0], b[1], b[2], b[3]}, pb, st.o[dt]);
            }
        }
    }
}

template <int DH, int NSUB, class Src, class Mask>
__device__ __forceinline__ void fa_stream(LAS unsigned char* lds, int tid, int t_begin, int t_end, const Src& src, const Mask& mk, const bf16x8 (&qf)[DH / 32], FaState<DH>& st, float sc2) {
    constexpr int KS = (DH + 8) * 2, TB = 32 * KS, SB = NSUB * TB;
    if (t_begin >= t_end) return;
    const int lane = tid & 63, l15 = lane & 15, g = lane >> 4, q4 = l15 >> 2, p4 = l15 & 3;
    v4u rkA[NSUB], rvA[NSUB], rkB[NSUB], rvB[NSUB];
    int lj, lpc; bool isv = false;
    if constexpr (DH == 128) { lj = tid >> 4; lpc = tid & 15; } else { lj = (tid & 255) >> 3; lpc = tid & 7; isv = tid >= 256; }
    const int nst = (t_end - t_begin + NSUB - 1) / NSUB;
#define FA_ISSUE(k, RK, RV) do { _Pragma("unroll") for (int u = 0; u < NSUB; ++u) { int ti = t_begin + (k) * NSUB + u; ti = ti < t_end ? ti : t_end - 1; \
            const bf16* rp_ = src.krow(ti, lj) + lpc * 8; if constexpr (DH == 128) { RK[u] = *(const GAS v4u*)rp_; RV[u] = *(const GAS v4u*)(rp_ + src.voff); } \
            else { RK[u] = *(const GAS v4u*)(rp_ + (isv ? src.voff : 0)); } } } while (0)
#define FA_COMMIT(buf, RK, RV) do { _Pragma("unroll") for (int u = 0; u < NSUB; ++u) { \
            if constexpr (DH == 128) { *(LAS v4u*)(lds + (buf) * SB + u * TB + lj * KS + lpc * 16) = RK[u]; *(LAS v4u*)(lds + (2 + (buf)) * SB + u * TB + lj * KS + lpc * 16) = RV[u]; } \
            else { *(LAS v4u*)(lds + ((isv ? 2 : 0) + (buf)) * SB + u * TB + lj * KS + lpc * 16) = RK[u]; } } } while (0)
    FA_ISSUE(0, rkA, rvA); FA_COMMIT(0, rkA, rvA);
    if (1 < nst) FA_ISSUE(1, rkB, rvB);
    __syncthreads();
    for (int k = 0; k < nst; k += 2) {
        if (k + 2 < nst) FA_ISSUE(k + 2, rkA, rvA);
        fa_stage<DH, NSUB, Mask>(lds, lds + 2 * SB, qf, st, sc2, mk, t_begin + k * NSUB, t_end, l15, g, q4, p4);
        if (k + 1 < nst) FA_COMMIT(1, rkB, rvB);
        __syncthreads();
        if (k + 1 >= nst) break;
        if (k + 3 < nst) FA_ISSUE(k + 3, rkB, rvB);
        fa_stage<DH, NSUB, Mask>(lds + SB, lds + 3 * SB, qf, st, sc2, mk, t_begin + (k + 1) * NSUB, t_end, l15, g, q4, p4);
        if (k + 2 < nst) FA_COMMIT(0, rkA, rvA);
        __syncthreads();
    }
#undef FA_ISSUE
#undef FA_COMMIT
}

constexpr int DIL_PITCH = 3072;
struct DilSrc { const bf16* kbase; int band0, r, c; static constexpr int voff = 1024;
    __device__ __forceinline__ const bf16* krow(int s, int j) const { int a = band0 + 32 * s + j; a = a < 0 ? 0 : a; return kbase + (size_t)(a * r + c) * DIL_PITCH; }
    __device__ __forceinline__ const bf16* vrow(int s, int j) const { return krow(s, j) + 1024; } };
struct DilMask { int aq, band0, w;
    __device__ __forceinline__ bool valid(int ak) const { return ak >= 0 && ak <= aq && aq - ak <= 128; }
    __device__ __forceinline__ bool row_ok(int) const { return true; }
    __device__ __forceinline__ bool need_check(int) const { return true; }
    __device__ __forceinline__ bool wave_needs(int s) const { return 32 * s + 31 >= 16 * w && 32 * s <= 16 * w + 143; }
    __device__ __forceinline__ int key0(int s) const { return band0 + 32 * s; } };

__device__ __forceinline__ void dilated_phase(LAS unsigned char* lds, const bf16* PROJD, bf16* OACC, float* LSE, int gi, int G, int wave_s) {
    int tid_ = wave_s * 64 + lane_id_now(); asm volatile("" : "+v"(tid_));
    const int tid = tid_, lane = tid & 63, wave = __builtin_amdgcn_readfirstlane(tid >> 6), l15 = lane & 15, g = lane >> 4;
    const int r = (gi == 0) ? 1 : (gi == 1 ? 4 : 16);
    const float sc2 = 0.08838834764831845f * 1.4426950408889634f;
    const int vb = (G % 8 == 0) ? (int)(blockIdx.x & 7) * (G >> 3) + (int)(blockIdx.x >> 3) : (int)blockIdx.x;
    for (int item = vb; item < 2048; item += G) {
        const int bh = item >> 5, b = bh >> 3, h = bh & 7, rem = item & 31, c = rem % r, qt = rem / r;
        const bf16* base = PROJD + (size_t)b * SEQ * DIL_PITCH + h * 128;
        const int aq = 128 * qt + 16 * wave + l15, tq = aq * r + c;
        bf16x8 qf[4];
#pragma unroll
        for (int kk = 0; kk < 4; ++kk) qf[kk] = *(const GAS bf16x8*)(base + (size_t)tq * DIL_PITCH + 8 * g + 32 * kk);
        DilSrc src{base + 1024, 128 * qt - 128, r, c};
        DilMask mk{aq, 128 * qt - 128, wave};
        FaState<128> st; fa_init<128>(st);
        fa_stream<128, 2, DilSrc, DilMask>(lds, tid, qt == 0 ? 4 : 0, 8, src, mk, qf, st, sc2);
        const float inv = 1.f / fmaxf(st.l, 1e-30f);
        float lse = (st.m + __log2f(fmaxf(st.l, 1e-30f))) * 0.6931471805599453f;
        const size_t trow = (size_t)b * SEQ + tq;
        float wp = 0.f, wn = 1.f;
        if (gi > 0) { const float lp = *(const GAS float*)(LSE + trow * 8 + h); const float mx = fmaxf(lp, lse); const float ep = __expf(lp - mx), en = __expf(lse - mx); const float den = ep + en; wp = ep / den; wn = en / den; lse = mx + __logf(den); }
        bf16* op = OACC + trow * 1024 + h * 128 + 4 * g;
#pragma unroll
        for (int dt = 0; dt < 8; ++dt) {
            f32x4 o = st.o[dt] * (inv * wn);
            if (gi > 0) { const v2u old = *(const GAS v2u*)(op + 16 * dt); o[0] += wp * bf_lo(old.x); o[1] += wp * bf_hi(old.x); o[2] += wp * bf_lo(old.y); o[3] += wp * bf_hi(old.y); }
            v2u w; w.x = pk2(o[0], o[1]); w.y = pk2(o[2], o[3]);
            *(GAS v2u*)(op + 16 * dt) = w;
        }
        if (g == 0) *(GAS float*)(LSE + trow * 8 + h) = lse;
    }
}
constexpr int NSA_PITCH = 2816;
__device__ __forceinline__ void nsa_im2col(const bf16* PROJN, const float* pos, bf16* ACMP, int gtid, int GT) {
    asm volatile("" : "+v"(gtid));
    for (int idx = gtid; idx < 2 * 8192 * 256; idx += GT) {
        const int pc = idx & 255, row = (idx >> 8) & 8191, kv = idx >> 21;
        const int l = pc >> 3, d0 = (pc & 7) * 8, n = row & 255, bg = row >> 8, b = bg >> 2, gq = bg & 3;
        v4u o = (v4u){0u, 0u, 0u, 0u};
        if (n < 255) {
            const v4u v = *(const v4u*)(PROJN + (size_t)(b * SEQ + 16 * n + l) * NSA_PITCH + 1024 + kv * 256 + gq * 64 + d0);
            const f32x4 p0 = *(const f32x4*)(pos + kv * 2048 + l * 64 + d0), p1 = *(const f32x4*)(pos + kv * 2048 + l * 64 + d0 + 4);
            o.x = pk2(bf_lo(v.x) + p0.x, bf_hi(v.x) + p0.y); o.y = pk2(bf_lo(v.y) + p0.z, bf_hi(v.y) + p0.w);
            o.z = pk2(bf_lo(v.z) + p1.x, bf_hi(v.z) + p1.y); o.w = pk2(bf_lo(v.w) + p1.z, bf_hi(v.w) + p1.w);
        }
        *(v4u*)(ACMP + ((size_t)kv * 8192 + row) * 2048 + pc * 8) = o;
    }
}
struct TokSrc { const bf16* kbase; const LAS int* list; static constexpr int voff = 256;
    __device__ __forceinline__ int tile(int s) const { return list ? list[s] : s; }
    __device__ __forceinline__ const bf16* krow(int s, int j) const { return kbase + (size_t)(32 * tile(s) + j) * NSA_PITCH; }
};
struct SelMask { unsigned lo, hi, wlo, whi; int t, qb; const LAS int* list;
    __device__ __forceinline__ bool row_ok(int ti) const { const int jb = list[ti] >> 1; return ((jb < 32) ? (lo >> jb) & 1u : (hi >> (jb - 32)) & 1u) != 0u; }
    __device__ __forceinline__ bool need_check(int ti) const { return list[ti] == qb; }
    __device__ __forceinline__ bool valid(int tok) const { return tok <= t; }
    __device__ __forceinline__ bool wave_needs(int ti) const { const int jb = list[ti] >> 1; return ((jb < 32) ? (wlo >> jb) & 1u : (whi >> (jb - 32)) & 1u) != 0u; }
    __device__ __forceinline__ int key0(int ti) const { return 32 * list[ti]; } };
struct WinMask { int t, qb, sb;
    __device__ __forceinline__ bool row_ok(int) const { return true; }
    __device__ __forceinline__ bool need_check(int ti) const { return ti == qb || ti == sb; }
    __device__ __forceinline__ bool valid(int tok) const { return tok <= t && tok > t - 512; }
    __device__ __forceinline__ bool wave_needs(int) const { return true; }
    __device__ __forceinline__ int key0(int ti) const { return 32 * ti; } };

__device__ __forceinline__ void nsa_phase(LAS unsigned char* lds, const bf16* PROJN, const bf16* KVC, bf16* ONSA, int G, int wave_s, unsigned long long* pc_) {
#define NSA_STAMP(sec) do { if ((PROBE_MASK >> 8) != 0 && blockIdx.x == 0 && threadIdx.x == 0) { const unsigned long long now_ = __builtin_amdgcn_s_memrealtime(); if ((PROBE_MASK >> (8 + (sec))) & 1) pc_[1] += now_ - pc_[0]; pc_[0] = now_; } } while (0)
    constexpr int KS = 144, OFF_KC = 0, OFF_VC = OFF_KC + 256 * KS, OFF_IMP = OFF_VC + 256 * KS, OFF_SEL = OFF_IMP + 32 * 256 * 4, OFF_UNI = OFF_SEL + 256, OFF_TL = OFF_UNI + 64, OFF_NT = OFF_TL + 512;
    int tid_ = wave_s * 64 + lane_id_now(); asm volatile("" : "+v"(tid_));
    const int tid = tid_, lane = tid & 63, wave = __builtin_amdgcn_readfirstlane(tid >> 6), l15 = lane & 15, g = lane >> 4, q4 = l15 >> 2, p4 = l15 & 3;
    const float sc2 = 0.125f * 1.4426950408889634f;
    LAS float* IMP = (LAS float*)(lds + OFF_IMP);
    LAS unsigned* SEL = (LAS unsigned*)(lds + OFF_SEL);
    LAS unsigned* UNI = (LAS unsigned*)(lds + OFF_UNI);
    LAS int* TL = (LAS int*)(lds + OFF_TL);
    LAS int* NT = (LAS int*)(lds + OFF_NT);
    const int vb = (G % 8 == 0) ? (int)(blockIdx.x & 7) * (G >> 3) + (int)(blockIdx.x >> 3) : (int)blockIdx.x;
    for (int item = vb; item < 4096; item += G) {
        const int bg = item >> 7, qr = ((item & 127) + 37 * (bg >> 1)) & 127, qb = ((bg >> 1) & 1) ? 127 - qr : qr, b = bg >> 2, gq = bg & 3, t0 = 32 * qb, cur = t0 >> 6;
        const int ql = 4 * wave + q4, hp = p4, t = t0 + ql;
        const bf16* prow = PROJN + (size_t)b * SEQ * NSA_PITCH;
        bf16x8 qf[2];
#pragma unroll
        for (int kk = 0; kk < 2; ++kk) qf[kk] = *(const GAS bf16x8*)(prow + (size_t)t * NSA_PITCH + gq * 256 + hp * 64 + 8 * g + 32 * kk);
        int ncv = (t0 >> 4) + 1; ncv = ncv > 255 ? 255 : ncv; const int ntc = (ncv + 31) >> 5;
        {
            v4u tmp[8];
            const unsigned nrow = (unsigned)tid >> 3, boff = ((unsigned)bg * 256u + nrow) * 256u + ((unsigned)tid & 7u) * 8u;
#pragma unroll
            for (int u = 0; u < 8; ++u) if ((int)nrow + 64 * (u & 3) < 32 * ntc) tmp[u] = *(const GAS v4u*)(KVC + boff + (unsigned)(u & 3) * 16384u + (unsigned)(u >> 2) * 2097152u);
#pragma unroll
            for (int u = 0; u < 8; ++u) if ((int)nrow + 64 * (u & 3) < 32 * ntc) *(LAS v4u*)(lds + ((u >> 2) ? OFF_VC : OFF_KC) + ((int)nrow + 64 * (u & 3)) * KS + (tid & 7) * 16) = tmp[u];
        }
        __syncthreads();
        f32x4 oc[4];
#pragma unroll
        for (int i = 0; i < 4; ++i) oc[i] = (f32x4){0.f, 0.f, 0.f, 0.f};
        {
            f32x4 sc[8][2]; float mx = -1e30f;
#pragma unroll
            for (int s = 0; s < 8; ++s) {
                sc[s][0] = (f32x4){-1e30f, -1e30f, -1e30f, -1e30f}; sc[s][1] = sc[s][0];
                if (s < ntc) {
                    f32x4 a0 = (f32x4){0.f, 0.f, 0.f, 0.f}, a1 = a0;
#pragma unroll
                    for (int kk = 0; kk < 2; ++kk) {
                        a0 = mfma16(ldrow(lds + OFF_KC + (32 * s + l15) * KS + (8 * g + 32 * kk) * 2), qf[kk], a0);
                        a1 = mfma16(ldrow(lds + OFF_KC + (32 * s + 16 + l15) * KS + (8 * g + 32 * kk) * 2), qf[kk], a1);
                    }
#pragma unroll
                    for (int r = 0; r < 4; ++r) {
                        const int n0 = 32 * s + 4 * g + r, n1 = n0 + 16;
                        sc[s][0][r] = (16 * n0 + 31 <= t && n0 < 255) ? a0[r] * sc2 : -1e30f;
                        sc[s][1][r] = (16 * n1 + 31 <= t && n1 < 255) ? a1[r] * sc2 : -1e30f;
                        mx = fmaxf(mx, fmaxf(sc[s][0][r], sc[s][1][r]));
                    }
                }
            }
            mx = gmax4(mx);
            float sum = 0.f;
#pragma unroll
            for (int s = 0; s < 8; ++s)
#pragma unroll
                for (int e = 0; e < 2; ++e)
#pragma unroll
                    for (int r = 0; r < 4; ++r) { const float p = (sc[s][e][r] > -5e29f) ? fexp2(sc[s][e][r] - mx) : 0.f; sc[s][e][r] = p; sum += p; }
            sum = gsum4(sum);
            const float inv = 1.f / fmaxf(sum, 1e-30f);
#pragma unroll
            for (int s = 0; s < 8; ++s) {
                float p[8];
#pragma unroll
                for (int r = 0; r < 4; ++r) { p[r] = sc[s][0][r] * inv; p[4 + r] = sc[s][1][r] * inv; }
#pragma unroll
                for (int e = 0; e < 8; ++e) { float x = p[e]; x += __int_as_float(__builtin_amdgcn_update_dpp(0, __float_as_int(x), 0xB1, 0xf, 0xf, false)); x += __int_as_float(__builtin_amdgcn_update_dpp(0, __float_as_int(x), 0x4E, 0xf, 0xf, false));
                    if (hp == 0) IMP[ql * 256 + 32 * s + 16 * (e >> 2) + 4 * g + (e & 3)] = x; }
                if (s < ntc) {
                    v4u pbu; pbu.x = pk2(p[0], p[1]); pbu.y = pk2(p[2], p[3]); pbu.z = pk2(p[4], p[5]); pbu.w = pk2(p[6], p[7]);
                    const bf16x8 pb = __builtin_bit_cast(bf16x8, pbu);
#pragma unroll
                    for (int dt = 0; dt < 4; ++dt) {
                        const s16x4 a = ldtr(lds + OFF_VC + (32 * s + 4 * g + q4) * KS + (16 * dt + 4 * p4) * 2), bb = ldtr(lds + OFF_VC + (32 * s + 16 + 4 * g + q4) * KS + (16 * dt + 4 * p4) * 2);
                        oc[dt] = mfma16((bf16x8){a[0], a[1], a[2], a[3], bb[0], bb[1], bb[2], bb[3]}, pb, oc[dt]);
                    }
                }
            }
        }
        unsigned ocp[8];
#pragma unroll
        for (int dt = 0; dt < 4; ++dt) { ocp[2 * dt] = pk2(oc[dt][0], oc[dt][1]); ocp[2 * dt + 1] = pk2(oc[dt][2], oc[dt][3]); }
        __syncthreads();
        NSA_STAMP(0);
        {
            unsigned ulo = 0u, uhi = 0u;
            unsigned key[4];
#pragma unroll
            for (int qi = 0; qi < 4; ++qi) {
                const int qq = 4 * wave + qi, jb = lane;
                const LAS float* ip = IMP + qq * 256 + 4 * jb;
                const float pm1 = (jb > 0) ? ip[-1] : 0.f;
                const float imp_sel = pm1 + 2.f * (ip[0] + ip[1] + ip[2]) + ip[3];
                const bool forced = (jb == 0) || (jb == cur) || (jb == cur - 1);
                key[qi] = (jb <= cur) ? __float_as_uint(imp_sel + (forced ? 1e4f : 0.f)) + 1u : 0u;
            }
            unsigned thr[4] = {0u, 0u, 0u, 0u};
            for (int bit = 31; bit >= 0; --bit) {
#pragma unroll
                for (int qi = 0; qi < 4; ++qi) { const unsigned cand = thr[qi] | (1u << bit); if (__popcll(__ballot(key[qi] >= cand)) >= 16) thr[qi] = cand; }
            }
#pragma unroll
            for (int qi = 0; qi < 4; ++qi) {
                const int qq = 4 * wave + qi;
                const bool gt = key[qi] > thr[qi], eq = key[qi] == thr[qi];
                const int need = 16 - __popcll(__ballot(gt));
                const unsigned long long em = __ballot(eq);
                const int below = __popcll(em & ((1ull << lane) - 1ull));
                const bool sel = key[qi] > 0u && (gt || (eq && below < need));
                const unsigned long long mask = __ballot(sel);
                if (lane == 0) { SEL[2 * qq] = (unsigned)mask; SEL[2 * qq + 1] = (unsigned)(mask >> 32); }
                ulo |= (unsigned)mask; uhi |= (unsigned)(mask >> 32);
            }
            if (lane == 0) { UNI[2 * wave] = ulo; UNI[2 * wave + 1] = uhi; }
        }
        __syncthreads();
        if (wave == 0) {
            unsigned ulo = 0u, uhi = 0u;
            for (int w = 0; w < 8; ++w) { ulo |= UNI[2 * w]; uhi |= UNI[2 * w + 1]; }
            int cnt = 0;
            for (int half = 0; half < 2; ++half) {
                const int s = lane + 64 * half, jb = s >> 1; const unsigned bit = (jb < 32) ? (ulo >> jb) & 1u : (uhi >> (jb - 32)) & 1u;
                const bool need = (s <= qb) && bit != 0u;
                const unsigned long long m = __ballot(need);
                const int pos = cnt + __popcll(m & ((1ull << lane) - 1ull));
                if (need) TL[pos] = s;
                cnt += __popcll(m);
            }
            if (lane == 0) NT[0] = cnt;
        }
        __syncthreads();
        const int nts = NT[0];
        NSA_STAMP(1);
        FaState<64> ss; fa_init<64>(ss);
        {
            TokSrc src{prow + 1536 + gq * 64, TL};
            SelMask mk{SEL[2 * ql], SEL[2 * ql + 1], (unsigned)__builtin_amdgcn_readfirstlane((int)UNI[2 * wave]), (unsigned)__builtin_amdgcn_readfirstlane((int)UNI[2 * wave + 1]), t, qb, TL};
            fa_stream<64, 4, TokSrc, SelMask>(lds, tid, 0, nts, src, mk, qf, ss, sc2);
        }
        unsigned osp[8]; float isl = 1.f / fmaxf(ss.l, 1e-30f);
#pragma unroll
        for (int dt = 0; dt < 4; ++dt) { osp[2 * dt] = pk2(ss.o[dt][0] * isl, ss.o[dt][1] * isl); osp[2 * dt + 1] = pk2(ss.o[dt][2] * isl, ss.o[dt][3] * isl); }
        NSA_STAMP(2);
        FaState<64> sw; fa_init<64>(sw);
        {
            TokSrc src{prow + 2048 + gq * 64, nullptr};
            const int sb = (t0 - 512) < 0 ? 0 : (t0 - 512) >> 5;
            WinMask mk{t, qb, sb};
            fa_stream<64, 4, TokSrc, WinMask>(lds, tid, sb, qb + 1, src, mk, qf, sw, sc2);
        }
        NSA_STAMP(3);
        {
            const GAS bf16* gp = (const GAS bf16*)(prow + (size_t)t * NSA_PITCH + 2560 + gq * 4 + hp);
            const float g0 = sigmoid_f(__uint_as_float((unsigned)gp[0] << 16)), g1 = sigmoid_f(__uint_as_float((unsigned)gp[16] << 16)), g2 = sigmoid_f(__uint_as_float((unsigned)gp[32] << 16));
            const float iw = g2 / fmaxf(sw.l, 1e-30f);
            bf16* op = ONSA + ((size_t)b * SEQ + t) * 1024 + gq * 256 + hp * 64 + 4 * g;
#pragma unroll
            for (int dt = 0; dt < 4; ++dt) {
                f32x4 o = sw.o[dt] * iw;
                o[0] += g0 * bf_lo(ocp[2 * dt]) + g1 * bf_lo(osp[2 * dt]); o[1] += g0 * bf_hi(ocp[2 * dt]) + g1 * bf_hi(osp[2 * dt]);
                o[2] += g0 * bf_lo(ocp[2 * dt + 1]) + g1 * bf_lo(osp[2 * dt + 1]); o[3] += g0 * bf_hi(ocp[2 * dt + 1]) + g1 * bf_hi(osp[2 * dt + 1]);
                v2u w; w.x = pk2(o[0], o[1]); w.y = pk2(o[2], o[3]); *(GAS v2u*)(op + 16 * dt) = w; }
        }
        __syncthreads();
        NSA_STAMP(4);
    }
}
#ifndef RET_SCAN
#define RET_SCAN 1
#define RET_GNORM 1
#define RET_GATE 1
#endif
#ifndef ENABLE_SSD
#define ENABLE_SSD 1
#endif
constexpr size_t WS_DTRAW = WS_SCR + 340 * MiB, WS_HALO = WS_SCR + 344 * MiB;
#define MIXER_CONVERT \
    if (mix == 1) { transpose_w<0>(args.in[12], D, 2608, 2816, WMIX, scr, gwv, NGW, lane); \
        for (int c = 0; c < 2; ++c) { transpose_w<0>(args.in[14] + (size_t)c * 2048 * 256, 2048, 256, 256, WMIX + 3 * MiB + (size_t)c * 256 * 2048, scr, gwv, NGW, lane); \
            transpose_w<0>(args.in[15] + (size_t)c * 256 * 64, 256, 64, 256, WMIX + 4 * MiB + (size_t)c * 256 * 256, scr, gwv, NGW, lane); } \
        transpose_w<0>(args.in[16], D, D, D, WMIX + 5 * MiB, scr, gwv, NGW, lane); } \
    if (mix == 3) { transpose_w<0>(args.in[25], D, 9216, 9216, WMIX, scr, gwv, NGW, lane); transpose_w<0>(args.in[26], D, D, D, WMIX + (size_t)9216 * 1024, scr, gwv, NGW, lane); } \
    if (mix == 0) { transpose_w<0>(args.in[9], D, 6144, 6144, WMIX, scr, gwv, NGW, lane); transpose_w<0>(args.in[11], 2048, D, D, WMIX + (size_t)6144 * 1024, scr, gwv, NGW, lane); } \
    if (mix == 2) { transpose_w<0>(args.in[17], D, 5152, 5376, WMIX, scr, gwv, NGW, lane); transpose_w<0>(args.in[24], 2048, D, D, WMIX + (size_t)6144 * 1024, scr, gwv, NGW, lane); }

#define MIXER_PHASES \
    if (mix == 0) { \
        bf16* PROJ = (bf16*)(ws + WS_SCR); \
        PHASE_BEGIN { pg8::Epi<pg8::EPI_RETQKV> E{}; E.O = PROJ; E.ldc = 4096; E.rot = ROT; run_gemm<pg8::EPI_RETQKV>(lds, U, D, WMIX, T, 4096, D, E, wave_s); } PHASE_END_C(3) \
        if (RET_SCAN) PHASE_BEGIN \
            for (int item = ((G % 8 == 0) ? (int)(blockIdx.x & 7) * (G >> 3) + (int)(blockIdx.x >> 3) : (int)blockIdx.x); item < 256; item += G) { \
                const int b = item >> 5, h = (item >> 3) & 3, s8 = item & 7; \
                bf16* base = PROJ + (size_t)b * SEQ * 4096; \
                scan_item<256, false>(lds, base + h * 256, base + 1024 + h * 256, base + 2048 + h * 512 + s8 * 64, 4096, base + 2048 + h * 512 + s8 * 64, 4096, log1pf(-exp2f(-5.f - (float)h)), nullptr, 0.f, 0.f, 0.f, wave_s); \
                __syncthreads(); \
            } \
        PHASE_END_C(4) \
        if (RET_GNORM) PHASE_BEGIN gnorm_rows(PROJ + 2048, 4096, args.in[10], gw, NGW, lane); PHASE_END_C(7) \
        if (RET_GATE) PHASE_BEGIN { pg8::Epi<pg8::EPI_GATEMUL> E{}; E.O = PROJ + 2048; E.ldc = 4096; run_gemm<pg8::EPI_GATEMUL>(lds, U, D, WMIX + (size_t)4096 * 1024, T, 2048, D, E, wave_s); } PHASE_END_C(3) \
        PHASE_BEGIN { pg8::Epi<pg8::EPI_RESID> E{}; E.Hout = (float*)H; E.Hbase = nullptr; E.scale = 1.0f; E.ldc = D; run_gemm<pg8::EPI_RESID>(lds, PROJ + 2048, 4096, WMIX + (size_t)6144 * 1024, T, D, 2048, E, wave_s); } PHASE_END_C(3) \
    } \
    if (mix == 2 && ENABLE_SSD) { \
        bf16* PROJ = (bf16*)(ws + WS_SCR); float* DTRAW = (float*)(ws + WS_DTRAW); bf16* HALO = (bf16*)(ws + WS_HALO); \
        PHASE_BEGIN { pg8::Epi<pg8::EPI_SSD> E{}; E.O = PROJ; E.ldc = SSD_PITCH; E.aux = DTRAW; run_gemm<pg8::EPI_SSD>(lds, U, D, WMIX, T, SSD_PITCH, D, E, wave_s); } PHASE_END_C(3) \
        PHASE_BEGIN ssd_halo_save(PROJ, HALO, blockIdx.x * NTHR + tid, G * NTHR); PHASE_END_C(7) \
        PHASE_BEGIN ssd_conv(PROJ, HALO, args.in[18], args.in[19], blockIdx.x * NTHR + tid, G * NTHR); PHASE_END_C(7) \
        PHASE_BEGIN \
            for (int item = ((G % 8 == 0) ? (int)(blockIdx.x & 7) * (G >> 3) + (int)(blockIdx.x >> 3) : (int)blockIdx.x); item < 256; item += G) { \
                const int b = item >> 5, gq = (item >> 3) & 3, r = item & 7, hd = gq * 8 + r; \
                bf16* base = PROJ + (size_t)b * SEQ * SSD_PITCH; \
                scan_item<128, true>(lds, base + 4608 + gq * 128, base + 4096 + gq * 128, base + 2048 + gq * 512 + r * 64, SSD_PITCH, base + gq * 512 + r * 64, SSD_PITCH, 0.f, \
                                     DTRAW + (size_t)b * SEQ * 32 + hd, args.in[20][hd], -__expf(args.in[21][hd]), args.in[22][hd], wave_s); \
                __syncthreads(); \
            } \
        PHASE_END_C(4) \
        PHASE_BEGIN gnorm_rows(PROJ, SSD_PITCH, args.in[23], gw, NGW, lane); PHASE_END_C(7) \
        PHASE_BEGIN { pg8::Epi<pg8::EPI_RESID> E{}; E.Hout = (float*)H; E.Hbase = nullptr; E.scale = 1.0f; E.ldc = D; run_gemm<pg8::EPI_RESID>(lds, PROJ, SSD_PITCH, WMIX + (size_t)6144 * 1024, T, D, 2048, E, wave_s); } PHASE_END_C(3) \
    } \
    if (mix == 3) { \
        bf16* PROJD = (bf16*)(ws + WS_SCR); bf16* OACC = (bf16*)(ws + WS_SCR + 192 * MiB); float* LSE = (float*)(ws + WS_SCR + 256 * MiB); \
        for (int gi = 0; gi < 3; ++gi) { \
            PHASE_BEGIN { pg8::Epi<pg8::EPI_BF16> E{}; E.O = PROJD; E.ldc = DIL_PITCH; run_gemm<pg8::EPI_BF16>(lds, U, D, WMIX + (size_t)gi * 3072 * 1024, T, 3072, D, E, wave_s); } PHASE_END_C(3) \
            PHASE_BEGIN dilated_phase(lds, PROJD, OACC, LSE, gi, G, wave_s); PHASE_END_C(6) \
        } \
        PHASE_BEGIN { pg8::Epi<pg8::EPI_RESID> E{}; E.Hout = (float*)H; E.Hbase = nullptr; E.scale = 1.0f; E.ldc = D; run_gemm<pg8::EPI_RESID>(lds, OACC, D, WMIX + (size_t)9216 * 1024, T, D, D, E, wave_s); } PHASE_END_C(3) \
    } \
    if (mix == 1) { \
        bf16* PROJN = (bf16*)(ws + WS_SCR); bf16* ACMP = (bf16*)(ws + WS_SCR + 176 * MiB); bf16* HIDC = (bf16*)(ws + WS_SCR + 240 * MiB); bf16* KVC = (bf16*)(ws + WS_SCR + 248 * MiB); bf16* ONSA = (bf16*)(ws + WS_SCR + 256 * MiB); \
        PHASE_BEGIN { pg8::Epi<pg8::EPI_BF16> E{}; E.O = PROJN; E.ldc = NSA_PITCH; run_gemm<pg8::EPI_BF16>(lds, U, D, WMIX, T, NSA_PITCH, D, E, wave_s); } PHASE_END_C(3) \
        PHASE_BEGIN nsa_im2col(PROJN, args.in[13], ACMP, blockIdx.x * NTHR + tid, G * NTHR); PHASE_END_C(7) \
        PHASE_BEGIN for (int c = 0; c < 2; ++c) { pg8::Epi<pg8::EPI_SILU> E{}; E.O = HIDC + (size_t)c * 8192 * 256; E.ldc = 256; run_gemm<pg8::EPI_SILU>(lds, ACMP + (size_t)c * 8192 * 2048, 2048, WMIX + 3 * MiB + (size_t)c * 256 * 2048, 8192, 256, 2048, E, wave_s, 128 * c); } PHASE_END_C(3) \
        PHASE_BEGIN for (int c = 0; c < 2; ++c) { pg8::Epi<pg8::EPI_BF16> E{}; E.O = KVC + (size_t)c * 8192 * 256; E.ldc = 256; run_gemm<pg8::EPI_BF16>(lds, HIDC + (size_t)c * 8192 * 256, 256, WMIX + 4 * MiB + (size_t)c * 256 * 256, 8192, 256, 256, E, wave_s, 128 * c); } PHASE_END_C(3) \
        PHASE_BEGIN nsa_phase(lds, PROJN, KVC, ONSA, G, wave_s, (unsigned long long*)(args.ws + 32768)); PHASE_END_C(5) \
        PHASE_BEGIN { pg8::Epi<pg8::EPI_RESID> E{}; E.Hout = (float*)H; E.Hbase = nullptr; E.scale = 1.0f; E.ldc = D; run_gemm<pg8::EPI_RESID>(lds, ONSA, D, WMIX + 5 * MiB, T, D, D, E, wave_s); } PHASE_END_C(3) \
    }
__global__ void __launch_bounds__(NTHR, 2) fwd_megakernel(Args args) {
    extern __shared__ __attribute__((aligned(16))) unsigned char lds_raw[];
    LAS unsigned char* lds = (LAS unsigned char*)lds_raw;
    cg::grid_group grid = cg::this_grid();
    const int G = gridDim.x;
    const int wave_s = __builtin_amdgcn_readfirstlane(threadIdx.x >> 6);
    volatile LAS unsigned* xst = (volatile LAS unsigned*)(lds + LDS_BYTES - 64);
    if (threadIdx.x < 16) xst[threadIdx.x] = 0u;
    __syncthreads();
    const XcdBarrier xbar = xcd_barrier_post((unsigned*)args.ws, xst);
    if (args.ph_lo < 0) grid.sync();
    if (PROBE_MASK != 0 && blockIdx.x == 0 && threadIdx.x == 0) { ((unsigned long long*)(args.ws + 32768))[0] = __builtin_amdgcn_s_memrealtime(); }
#define PHASE_BEGIN {
#define PHASE_END_C(cat) xcd_barrier(xbar); if (PROBE_MASK != 0 && blockIdx.x == 0 && threadIdx.x == 0) { const unsigned long long now_ = __builtin_amdgcn_s_memrealtime(); unsigned long long* c_ = (unsigned long long*)(args.ws + 32768); if ((PROBE_MASK >> (cat)) & 1) c_[1] += now_ - c_[0]; c_[0] = now_; } }
    for (int L = 0; L < DEPTH; ++L) {
        const int mix = L & 3;
        int tid_ = wave_s * 64 + lane_id_now(); asm volatile("" : "+v"(tid_));
        const int tid = tid_, lane = tid & 63, wave = __builtin_amdgcn_readfirstlane(tid >> 6);
        const int gw = blockIdx.x * NWAVES + wave, NGW = G * NWAVES;
        const int gwv = ((G % 8 == 0) ? (int)(blockIdx.x & 7) * (G >> 3) + (int)(blockIdx.x >> 3) : (int)blockIdx.x) * NWAVES + wave;
        unsigned char* ws = args.ws; asm volatile("" : "+s"(ws));
        bf16* H = (bf16*)((unsigned char*)args.out + 64 * MiB); asm volatile("" : "+s"(H));
        float* ROT = (float*)(ws + WS_ROT);
        bf16* WIN1 = (bf16*)(ws + WS_WIN1); bf16* WOUT1 = (bf16*)(ws + WS_WOUT1); bf16* WIN2 = (bf16*)(ws + WS_WIN2); bf16* WOUT2 = (bf16*)(ws + WS_WOUT2); bf16* WMIX = (bf16*)(ws + WS_WMIX);
        bf16* U = (bf16*)(ws + WS_U); bf16* HID = (bf16*)(ws + WS_SCR);
        LAS float* scr = (LAS float*)(lds + wave * 18432);
        PHASE_BEGIN
            transpose_w<1>(args.in[2] + (size_t)L * D * 2 * FF, D, 2 * FF, 2 * FF, WIN1, scr, gwv, NGW, lane);
            transpose_w<0>(args.in[3] + (size_t)L * FF * D, FF, D, D, WOUT1, scr, gwv, NGW, lane);
            transpose_w<1>(args.in[6] + (size_t)L * D * 2 * FF, D, 2 * FF, 2 * FF, WIN2, scr, gwv, NGW, lane);
            transpose_w<0>(args.in[7] + (size_t)L * FF * D, FF, D, D, WOUT2, scr, gwv, NGW, lane);
            MIXER_CONVERT
            if (L == 0) {
                for (int i = blockIdx.x * NTHR + tid; i < 4096 * 128; i += G * NTHR) {
                    const int pos = i >> 7, d = i & 127;
                    const float inv = exp2f(-(float)d * (13.287712379549449f / 128.f));
                    const float ang = (float)pos * inv;
                    const double x = (double)ang * 0.15915494309189535; const float fr = (float)(x - rint(x));
                    ROT[i] = __builtin_amdgcn_cosf(fr); ROT[4096 * 128 + i] = __builtin_amdgcn_sinf(fr);
                }
            }
            if (L == 0) rms_rows(args.in[0], args.in[1], U, nullptr, gw, NGW, lane); else rms_rows_b(H, args.in[1] + L * D, U, gw, NGW, lane);
        PHASE_END_C(0)
        PHASE_BEGIN { pg8::Epi<pg8::EPI_SWIGLU> E{}; E.O = HID; E.ldc = FF; run_gemm<pg8::EPI_SWIGLU>(lds, U, D, WIN1, T, 2 * FF, D, E, wave_s); } PHASE_END_C(1)
        PHASE_BEGIN { pg8::Epi<pg8::EPI_RESID> E{}; E.Hout = (float*)H; E.Hbase = (L == 0) ? args.in[0] : nullptr; E.scale = 0.5f; E.ldc = D; run_gemm<pg8::EPI_RESID>(lds, HID, FF, WOUT1, T, D, FF, E, wave_s); } PHASE_END_C(1)
        PHASE_BEGIN rms_rows_b(H, args.in[4] + L * D, U, gw, NGW, lane); PHASE_END_C(2)
        MIXER_PHASES
        PHASE_BEGIN rms_rows_b(H, args.in[5] + L * D, U, gw, NGW, lane); PHASE_END_C(2)
        PHASE_BEGIN { pg8::Epi<pg8::EPI_SWIGLU> E{}; E.O = HID; E.ldc = FF; run_gemm<pg8::EPI_SWIGLU>(lds, U, D, WIN2, T, 2 * FF, D, E, wave_s); } PHASE_END_C(1)
        PHASE_BEGIN { pg8::Epi<pg8::EPI_RESID> E{}; E.Hout = (float*)H; E.Hbase = nullptr; E.scale = 0.5f; E.ldc = D; run_gemm<pg8::EPI_RESID>(lds, HID, FF, WOUT2, T, D, FF, E, wave_s); } PHASE_END_C(1)
    }
    {
        const int lane = lane_id_now(); const int gw = blockIdx.x * NWAVES + wave_s, NGW = G * NWAVES;
        const bf16* HBf = (const bf16*)((unsigned char*)args.out + 64 * MiB); bf16* Uc = (bf16*)(args.ws + WS_U);
        rms_final_b(HBf, 0, args.out, args.in[8], 0, T / 2, gw, NGW, lane);
        { const GAS v4u* src = (const GAS v4u*)(HBf + (size_t)(T / 2) * D); GAS v4u* dst = (GAS v4u*)Uc;
          for (int i = blockIdx.x * NTHR + wave_s * 64 + lane; i < (T / 2) * D / 8; i += G * NTHR) dst[i] = src[i]; }
        xcd_barrier(xbar);
        rms_final_b(Uc, T / 2, args.out, args.in[8], T / 2, T, gw, NGW, lane);
    }
}

extern "C" void kernel_launch(void* const* d_in, const int* in_sizes, int n_in, void* d_out, int out_size, void* d_ws, size_t ws_size, hipStream_t stream) {
    static int grid = 0;
    if (grid == 0) {
        if (n_in != 27 || out_size != T * D || ws_size < WS_NEED) { fprintf(stderr, "kernel_launch: unexpected problem (n_in %d, out %d, ws %zu)\n", n_in, out_size, ws_size); grid = -1; return; }
        int dev = 0, cus = 0, per_cu = 0;
        hipGetDevice(&dev); hipDeviceGetAttribute(&cus, hipDeviceAttributeMultiprocessorCount, dev);
        if (hipFuncSetAttribute((const void*)fwd_megakernel, hipFuncAttributeMaxDynamicSharedMemorySize, LDS_BYTES) != hipSuccess) { fprintf(stderr, "kernel_launch: hipFuncSetAttribute failed\n"); grid = -1; return; }
        if (hipOccupancyMaxActiveBlocksPerMultiprocessor(&per_cu, (const void*)fwd_megakernel, NTHR, LDS_BYTES) != hipSuccess || per_cu < 1) { fprintf(stderr, "kernel_launch: occupancy query gave %d\n", per_cu); per_cu = 1; }
        (void)hipGetLastError();
        grid = cus * 1;
    }
    if (grid < 0) return;
    if (hipMemsetAsync(d_ws, 0, 65536, stream) != hipSuccess) { fprintf(stderr, "kernel_launch: memset failed\n"); return; }
    Args a{};
    for (int i = 0; i < 27; ++i) a.in[i] = (const float*)d_in[i];
    a.out = (float*)d_out; a.ws = (unsigned char*)d_ws; a.ph_lo = 0; a.ph_hi = 1 << 20;
    void* kargs[] = {&a};
    hipError_t e = hipLaunchCooperativeKernel((const void*)fwd_megakernel, dim3(grid), dim3(NTHR), kargs, LDS_BYTES, stream);
    if (e != hipSuccess) fprintf(stderr, "kernel_launch: cooperative launch failed: %s (grid %d)\n", hipGetErrorString(e), grid);
}
```

```cpp
#include <hip/hip_runtime.h>
#include <hip/hip_cooperative_groups.h>
#include <cstdio>
#include <cstdint>
namespace cg = cooperative_groups;

__device__ __forceinline__ int lane_id_now() { int l; asm volatile("v_mbcnt_lo_u32_b32 %0, -1, 0\n\tv_mbcnt_hi_u32_b32 %0, -1, %0" : "=v"(l)); return l; }

#ifndef PROBE_MASK
#define PROBE_MASK 0
#endif
namespace pg8 {
#define PG8_LAS __attribute__((address_space(3)))
typedef unsigned short bf16_t;
typedef short bf16x8 __attribute__((ext_vector_type(8)));
typedef float f32x4 __attribute__((ext_vector_type(4)));
typedef unsigned u32x4 __attribute__((ext_vector_type(4)));
constexpr int BM = 256, BK = 64, HALF = 128, HTB = HALF * BK * 2  , STAGE_BYTES = 8 * HTB, NXCD = 8, WGM = 8;

__host__ __device__ __forceinline__ int lds_byte(int r, int c) { const int st = (r >> 4) * 2 + (c >> 5), rr = r & 15, cc = c & 31, ob = rr * 64 + cc * 2; return st * 1024 + (ob ^ (((ob >> 9) & 1) << 5)); }
__host__ __device__ __forceinline__ void stage_rc(int b, int& R, int& C) { const int st = b / 1024, sb = b % 1024, swz = sb ^ (((sb >> 9) & 1) << 5); R = (st >> 1) * 16 + swz / 64; C = (st & 1) * 32 + (swz % 64) / 2; }
__host__ __device__ __forceinline__ int perm32(int rho) { const int n = rho >> 4, i = rho & 15; return 8 * (i >> 2) + 4 * n + (i & 3); }

struct Unit { int pm, pn; };
struct Gemm { const bf16_t* A; const bf16_t* Bt; int M, N, K, lda; };

struct StaticOrder {
    int nM, nN, nwg, G, c;
    __host__ __device__ void init(int M, int N, int G_, int c_) { nM = M / BM; nN = N / BM; nwg = nM * nN; G = G_; c = c_; }
    __host__ __device__ bool next(int i, Unit& u) const {
        const long L = (long)i * G + c; if (L >= nwg) return false;
        int wgid = (int)L; { const int q = nwg / NXCD, r = nwg % NXCD, xcd = wgid % NXCD, off = wgid / NXCD; wgid = (xcd < r ? xcd * (q + 1) : r * (q + 1) + (xcd - r) * q) + off; }
        const int nig = WGM * nN, gid = wgid / nig, fm = gid * WGM, gsz = (nM - fm) < WGM ? (nM - fm) : WGM;
        u.pm = fm + ((wgid % nig) % gsz); u.pn = (wgid % nig) / gsz; return true;
    }
    __device__ __forceinline__ void a_ready(const Unit&) const {}
    __device__ __forceinline__ void done(const Unit&) const {}
};

typedef float f32x2_t __attribute__((ext_vector_type(2))); typedef __bf16 bf16x2_t __attribute__((ext_vector_type(2)));
__device__ __forceinline__ unsigned cvt_pk_bf16(float lo, float hi) { f32x2_t v = {lo, hi}; bf16x2_t b = __builtin_convertvector(v, bf16x2_t); return __builtin_bit_cast(unsigned, b); }
__device__ __forceinline__ float bf_lo(unsigned w) { return __uint_as_float(w << 16); }
__device__ __forceinline__ float bf_hi(unsigned w) { return __uint_as_float(w & 0xffff0000u); }
__device__ __forceinline__ float silu_f(float x) { return x * __builtin_amdgcn_rcpf(1.0f + __builtin_amdgcn_exp2f(-1.4426950408889634f * x)); }
__device__ __forceinline__ float sigmoid_f(float x) { return __builtin_amdgcn_rcpf(1.0f + __builtin_amdgcn_exp2f(-1.4426950408889634f * x)); }

enum { EPI_BF16 = 0, EPI_SWIGLU = 1, EPI_RESID = 2, EPI_RETQKV = 3, EPI_GATEMUL = 4, EPI_SSD = 5, EPI_SILU = 6 };
template <int MODE> struct Epi {
    static constexpr bool PERM = true, AFTER_DRAIN = false;
    bf16_t* O; int ldc;
    float* Hout; const float* Hbase; float scale;
    const float* __restrict__ rot;
    float* aux;
    __device__ __forceinline__ void operator()(const f32x4 (&acc)[2][2][4][2], const Unit& u, int wr, int wc, int fr, int fq) const {
        const int row0 = u.pm * BM + wr * 64 + fr;
        const int cl = wc * 32 + 8 * fq;
        if constexpr (MODE == EPI_SWIGLU) {
#pragma unroll
            for (int ai = 0; ai < 2; ++ai)
#pragma unroll
                for (int m = 0; m < 4; ++m) {
                    bf16_t* rowp = O + (size_t)(row0 + ai * HALF + m * 16) * ldc + u.pn * 128 + cl;
                    f32x4 a0 = acc[ai][0][m][0], a1 = acc[ai][0][m][1], b0 = acc[ai][1][m][0], b1 = acc[ai][1][m][1];
                    u32x4 w;
                    w.x = cvt_pk_bf16(silu_f(a0[0]) * b0[0], silu_f(a0[1]) * b0[1]); w.y = cvt_pk_bf16(silu_f(a0[2]) * b0[2], silu_f(a0[3]) * b0[3]);
                    w.z = cvt_pk_bf16(silu_f(a1[0]) * b1[0], silu_f(a1[1]) * b1[1]); w.w = cvt_pk_bf16(silu_f(a1[2]) * b1[2], silu_f(a1[3]) * b1[3]);
                    *(u32x4*)rowp = w;
                }
        } else if constexpr (MODE == EPI_RESID) {
            bf16_t* const HB = (bf16_t*)Hout;
#pragma unroll
            for (int ai = 0; ai < 2; ++ai) {
                if (Hbase) {
                    f32x4 pre[4][2][2];
#pragma unroll
                    for (int m = 0; m < 4; ++m) { const size_t off = (size_t)(row0 + ai * HALF + m * 16) * ldc + u.pn * BM + cl;
#pragma unroll
                        for (int bj = 0; bj < 2; ++bj)
#pragma unroll
                            for (int n = 0; n < 2; ++n) pre[m][bj][n] = *(const f32x4*)(Hbase + off + bj * HALF + 4 * n); }
#pragma unroll
                    for (int m = 0; m < 4; ++m) { const size_t off = (size_t)(row0 + ai * HALF + m * 16) * ldc + u.pn * BM + cl;
#pragma unroll
                        for (int bj = 0; bj < 2; ++bj) { const f32x4 h0 = pre[m][bj][0] + acc[ai][bj][m][0] * scale, h1 = pre[m][bj][1] + acc[ai][bj][m][1] * scale; u32x4 w;
                            w.x = cvt_pk_bf16(h0[0], h0[1]); w.y = cvt_pk_bf16(h0[2], h0[3]); w.z = cvt_pk_bf16(h1[0], h1[1]); w.w = cvt_pk_bf16(h1[2], h1[3]);
                            *(u32x4*)(HB + off + bj * HALF) = w; } }
                } else {
                    u32x4 pre[4][2];
#pragma unroll
                    for (int m = 0; m < 4; ++m) { const size_t off = (size_t)(row0 + ai * HALF + m * 16) * ldc + u.pn * BM + cl;
#pragma unroll
                        for (int bj = 0; bj < 2; ++bj) pre[m][bj] = *(const u32x4*)(HB + off + bj * HALF); }
#pragma unroll
                    for (int m = 0; m < 4; ++m) { const size_t off = (size_t)(row0 + ai * HALF + m * 16) * ldc + u.pn * BM + cl;
#pragma unroll
                        for (int bj = 0; bj < 2; ++bj) { const u32x4 p = pre[m][bj]; const f32x4 a0 = acc[ai][bj][m][0] * scale, a1 = acc[ai][bj][m][1] * scale; u32x4 w;
                            w.x = cvt_pk_bf16(bf_lo(p.x) + a0[0], bf_hi(p.x) + a0[1]); w.y = cvt_pk_bf16(bf_lo(p.y) + a0[2], bf_hi(p.y) + a0[3]);
                            w.z = cvt_pk_bf16(bf_lo(p.z) + a1[0], bf_hi(p.z) + a1[1]); w.w = cvt_pk_bf16(bf_lo(p.w) + a1[2], bf_hi(p.w) + a1[3]);
                            *(u32x4*)(HB + off + bj * HALF) = w; } }
                }
            }
        } else if constexpr (MODE == EPI_RETQKV) {
            if (u.pn < 8) {
                const float ks = (u.pn >= 4) ? 0.0625f : 1.0f;
#pragma unroll
                for (int ai = 0; ai < 2; ++ai)
#pragma unroll
                    for (int m = 0; m < 4; ++m) {
                        const int r = row0 + ai * HALF + m * 16; const int pos = r & 4095;
                        bf16_t* rowp = O + (size_t)r * ldc + u.pn * BM + cl;
                        u32x4 w1, w2; unsigned* p1 = (unsigned*)&w1; unsigned* p2 = (unsigned*)&w2;
#pragma unroll
                        for (int n = 0; n < 2; ++n) {
                            const f32x4 c = *(const f32x4*)(rot + (size_t)pos * 128 + cl + 4 * n);
                            const f32x4 s = *(const f32x4*)(rot + (size_t)4096 * 128 + (size_t)pos * 128 + cl + 4 * n);
                            const f32x4 t1 = acc[ai][0][m][n] * ks, t2 = acc[ai][1][m][n] * ks;
                            const f32x4 o1 = t1 * c - t2 * s, o2 = t1 * s + t2 * c;
                            p1[2 * n] = cvt_pk_bf16(o1[0], o1[1]); p1[2 * n + 1] = cvt_pk_bf16(o1[2], o1[3]);
                            p2[2 * n] = cvt_pk_bf16(o2[0], o2[1]); p2[2 * n + 1] = cvt_pk_bf16(o2[2], o2[3]);
                        }
                        *(u32x4*)rowp = w1; *(u32x4*)(rowp + HALF) = w2;
                    }
            } else {
#pragma unroll
                for (int ai = 0; ai < 2; ++ai)
#pragma unroll
                    for (int m = 0; m < 4; ++m) {
                        bf16_t* rowp = O + (size_t)(row0 + ai * HALF + m * 16) * ldc + u.pn * BM + cl;
#pragma unroll
                        for (int bj = 0; bj < 2; ++bj) { const f32x4 v0 = acc[ai][bj][m][0], v1 = acc[ai][bj][m][1]; u32x4 w;
                            w.x = cvt_pk_bf16(v0[0], v0[1]); w.y = cvt_pk_bf16(v0[2], v0[3]); w.z = cvt_pk_bf16(v1[0], v1[1]); w.w = cvt_pk_bf16(v1[2], v1[3]);
                            *(u32x4*)(rowp + bj * HALF) = w; }
                    }
            }
        } else if constexpr (MODE == EPI_GATEMUL) {
#pragma unroll
            for (int ai = 0; ai < 2; ++ai)
#pragma unroll
                for (int m = 0; m < 4; ++m) {
                    bf16_t* rowp = O + (size_t)(row0 + ai * HALF + m * 16) * ldc + u.pn * BM + cl;
#pragma unroll
                    for (int bj = 0; bj < 2; ++bj) { const f32x4 v0 = acc[ai][bj][m][0], v1 = acc[ai][bj][m][1]; const u32x4 old = *(const u32x4*)(rowp + bj * HALF); u32x4 w;
                        w.x = cvt_pk_bf16(silu_f(v0[0]) * bf_lo(old.x), silu_f(v0[1]) * bf_hi(old.x)); w.y = cvt_pk_bf16(silu_f(v0[2]) * bf_lo(old.y), silu_f(v0[3]) * bf_hi(old.y));
                        w.z = cvt_pk_bf16(silu_f(v1[0]) * bf_lo(old.z), silu_f(v1[1]) * bf_hi(old.z)); w.w = cvt_pk_bf16(silu_f(v1[2]) * bf_lo(old.w), silu_f(v1[3]) * bf_hi(old.w));
                        *(u32x4*)(rowp + bj * HALF) = w; }
                }
        } else {
            if (MODE == EPI_SSD && u.pn == 20) {
                if (wc == 0) {
#pragma unroll
                    for (int ai = 0; ai < 2; ++ai)
#pragma unroll
                        for (int m = 0; m < 4; ++m) { float* p = aux + (size_t)(row0 + ai * HALF + m * 16) * 32 + cl;
                            *(f32x4*)p = acc[ai][0][m][0]; *(f32x4*)(p + 4) = acc[ai][0][m][1]; }
                }
                return;
            }
#pragma unroll
            for (int ai = 0; ai < 2; ++ai)
#pragma unroll
                for (int m = 0; m < 4; ++m) {
                    bf16_t* rowp = O + (size_t)(row0 + ai * HALF + m * 16) * ldc + u.pn * BM + cl;
#pragma unroll
                    for (int bj = 0; bj < 2; ++bj) { f32x4 v0 = acc[ai][bj][m][0], v1 = acc[ai][bj][m][1]; u32x4 w;
                        if (MODE == EPI_SILU) { v0 = (f32x4){silu_f(v0[0]), silu_f(v0[1]), silu_f(v0[2]), silu_f(v0[3])}; v1 = (f32x4){silu_f(v1[0]), silu_f(v1[1]), silu_f(v1[2]), silu_f(v1[3])}; }
                        w.x = cvt_pk_bf16(v0[0], v0[1]); w.y = cvt_pk_bf16(v0[2], v0[3]); w.z = cvt_pk_bf16(v1[0], v1[1]); w.w = cvt_pk_bf16(v1[2], v1[3]);
                        *(u32x4*)(rowp + bj * HALF) = w; }
                }
        }
    }
};
template <class Epi, class Sched, bool ALIGN_EPI = false, bool SP2 = false>
__device__ __forceinline__ void gemm_phase(PG8_LAS unsigned char* lds, const Gemm g, const Sched& S, const Epi& E, int wave_s) {
    int tid_ = wave_s * 64 + lane_id_now(); asm volatile("" : "+v"(tid_)); const int tid = tid_, wid = __builtin_amdgcn_readfirstlane(tid >> 6), lane = tid & 63, wr = wid >> 2, wc = wid & 3, fr = lane & 15, fq = lane >> 4;
    const int K = g.K, nt = K / BK;
    unsigned voffA[2], voffB[2];
#pragma unroll
    for (int i = 0; i < 2; ++i) { int R, C; stage_rc(tid * 16 + i * 8192, R, C); const int Rb = Epi::PERM ? ((R & ~31) + perm32(R & 31)) : R;
        voffA[i] = (unsigned)(R * g.lda + C) * 2u; voffB[i] = (unsigned)(Rb * K + C) * 2u; }
    const size_t kstep = (size_t)(BK * 2);
    const size_t hstepA = (size_t)HALF * g.lda * 2, hstepB = (size_t)HALF * K * 2;
    const size_t tstepA = 2 * hstepA, tstepB = 2 * hstepB;
    const unsigned ldsw = (unsigned)wid * 1024u;
    const int aoff = lds_byte(wr * 64 + fr, fq * 8), boff = lds_byte(wc * 32 + fr, fq * 8);
#define PG8_SA(b, h) (((b) * 2 + (h)) * HTB)
#define PG8_SB(b, h) ((4 + (b) * 2 + (h)) * HTB)
#define PG8_STAGE(bufoff, gbase, voff) do { _Pragma("unroll") for (int _i = 0; _i < 2; ++_i) \
        __builtin_amdgcn_global_load_lds((const unsigned*)((const char*)(gbase) + (voff)[_i]), (PG8_LAS unsigned*)(lds + (bufoff) + ldsw + _i * 8192), 16, 0, 0); } while (0)
#define PG8_LDA(dst, b, h) do { _Pragma("unroll") for (int m = 0; m < 4; ++m) _Pragma("unroll") for (int k = 0; k < 2; ++k) dst[m][k] = *(const PG8_LAS bf16x8*)(lds + PG8_SA(b, h) + aoff + m * 2048 + k * 1024); } while (0)
#define PG8_LDB(dst, b, h) do { _Pragma("unroll") for (int n = 0; n < 2; ++n) _Pragma("unroll") for (int k = 0; k < 2; ++k) dst[n][k] = *(const PG8_LAS bf16x8*)(lds + PG8_SB(b, h) + boff + n * 2048 + k * 1024); } while (0)
#define PG8_MMA(ai, bj, At, Bt) do { __builtin_amdgcn_s_setprio(1); _Pragma("unroll") for (int m = 0; m < 4; ++m) _Pragma("unroll") for (int n = 0; n < 2; ++n) _Pragma("unroll") for (int k = 0; k < 2; ++k) \
        acc[ai][bj][m][n] = __builtin_amdgcn_mfma_f32_16x16x32_bf16(Bt[n][k], At[m][k], acc[ai][bj][m][n], 0, 0, 0); __builtin_amdgcn_s_setprio(0); } while (0)
#define PG8_WAIT_V(n) asm volatile("s_waitcnt vmcnt(" #n ")" ::: "memory")
#define PG8_WAIT_L(n) asm volatile("s_waitcnt lgkmcnt(" #n ")" ::: "memory")
#define PG8_BAR __builtin_amdgcn_s_barrier()
#define PG8_SCHED __builtin_amdgcn_sched_barrier(0)
    Unit cur, nxt; int ui = 0;
    if (!S.next(0, cur)) return;
    f32x4 acc[2][2][4][2];
#pragma unroll
    for (int a = 0; a < 2; ++a)
#pragma unroll
        for (int b = 0; b < 2; ++b)
#pragma unroll
            for (int m = 0; m < 4; ++m)
#pragma unroll
                for (int n = 0; n < 2; ++n) acc[a][b][m][n] = (f32x4){0.f, 0.f, 0.f, 0.f};
    bf16x8 At[4][2], B0[2][2], B1[2][2];
    const char* cA = (const char*)g.A + (size_t)cur.pm * tstepA; const char* cB = (const char*)g.Bt + (size_t)cur.pn * tstepB;
    S.a_ready(cur);
    if constexpr (SP2) {
        PG8_STAGE(PG8_SB(0, 0), cB, voffB); PG8_STAGE(PG8_SB(0, 1), cB + hstepB, voffB); PG8_STAGE(PG8_SA(0, 0), cA, voffA); PG8_STAGE(PG8_SA(0, 1), cA + hstepA, voffA);
        if (wr == 1) PG8_BAR;
        PG8_WAIT_V(2); PG8_BAR;
        PG8_STAGE(PG8_SB(1, 0), cB + kstep, voffB); PG8_STAGE(PG8_SA(1, 0), cA + kstep, voffA); PG8_STAGE(PG8_SB(1, 1), cB + hstepB + kstep, voffB);
        PG8_WAIT_V(6); PG8_BAR;
    } else {
        PG8_STAGE(PG8_SB(0, 0), cB, voffB); PG8_STAGE(PG8_SA(0, 0), cA, voffA); PG8_STAGE(PG8_SB(0, 1), cB + hstepB, voffB); PG8_STAGE(PG8_SA(0, 1), cA + hstepA, voffA);
        if (wr == 1) PG8_BAR;
        PG8_WAIT_V(4); PG8_BAR;
        PG8_STAGE(PG8_SB(1, 0), cB + kstep, voffB); PG8_STAGE(PG8_SA(1, 0), cA + kstep, voffA); PG8_STAGE(PG8_SB(1, 1), cB + hstepB + kstep, voffB);
        PG8_WAIT_V(6); PG8_BAR;
    }
    for (;;) {
        const bool has_next = S.next(ui + 1, nxt);
        const char* nA = has_next ? (const char*)g.A + (size_t)nxt.pm * tstepA : cA; const char* nB = has_next ? (const char*)g.Bt + (size_t)nxt.pn * tstepB : cB;
        for (int t = 0; t < nt; t += 2) {
            const bool last = (t == nt - 2);
            const char* a1 = cA + (size_t)(t + 1) * kstep;
            const char* a2 = last ? nA : cA + (size_t)(t + 2) * kstep; const char* b2 = last ? nB : cB + (size_t)(t + 2) * kstep;
            const char* a3 = a2 + kstep; const char* b3 = b2 + kstep;
            if (last && has_next) S.a_ready(nxt);
            if constexpr (SP2) {
            PG8_LDB(B0, 0, 0); PG8_LDB(B1, 0, 1); PG8_SCHED; PG8_LDA(At, 0, 0); PG8_STAGE(PG8_SA(1, 1), a1 + hstepA, voffA);
            PG8_WAIT_V(8); PG8_WAIT_L(0); PG8_BAR; PG8_MMA(0, 0, At, B0); PG8_MMA(0, 1, At, B1); PG8_BAR; PG8_SCHED;
            PG8_LDA(At, 0, 1); PG8_STAGE(PG8_SB(0, 0), b2, voffB); PG8_STAGE(PG8_SB(0, 1), b2 + hstepB, voffB); PG8_STAGE(PG8_SA(0, 0), a2, voffA);
            PG8_WAIT_V(8); PG8_WAIT_L(0); PG8_BAR; PG8_MMA(1, 0, At, B0); PG8_MMA(1, 1, At, B1); PG8_BAR; PG8_SCHED;
            PG8_LDB(B0, 1, 0); PG8_LDB(B1, 1, 1); PG8_SCHED; PG8_LDA(At, 1, 0); PG8_STAGE(PG8_SA(0, 1), a2 + hstepA, voffA);
            PG8_WAIT_V(8); PG8_WAIT_L(0); PG8_BAR; PG8_MMA(0, 0, At, B0); PG8_MMA(0, 1, At, B1); PG8_BAR; PG8_SCHED;
            PG8_LDA(At, 1, 1); PG8_STAGE(PG8_SB(1, 0), b3, voffB); PG8_STAGE(PG8_SB(1, 1), b3 + hstepB, voffB); PG8_STAGE(PG8_SA(1, 0), a3, voffA);
            PG8_WAIT_V(8); PG8_WAIT_L(0); PG8_BAR; PG8_MMA(1, 0, At, B0); PG8_MMA(1, 1, At, B1); PG8_BAR; PG8_SCHED;
            } else {
            PG8_LDB(B0, 0, 0); PG8_SCHED; PG8_LDA(At, 0, 0); PG8_STAGE(PG8_SA(1, 1), a1 + hstepA, voffA);
            PG8_WAIT_L(8); PG8_BAR; PG8_WAIT_L(0); PG8_MMA(0, 0, At, B0); PG8_BAR; PG8_SCHED;
            PG8_LDB(B1, 0, 1); PG8_STAGE(PG8_SB(0, 0), b2, voffB);
            PG8_BAR; PG8_WAIT_L(0); PG8_MMA(0, 1, At, B1); PG8_BAR;
            PG8_LDA(At, 0, 1); PG8_STAGE(PG8_SA(0, 0), a2, voffA);
            PG8_BAR; PG8_WAIT_L(0); PG8_MMA(1, 0, At, B0); PG8_BAR; PG8_SCHED;
            PG8_STAGE(PG8_SB(0, 1), b2 + hstepB, voffB);
            PG8_WAIT_V(6); PG8_BAR; PG8_MMA(1, 1, At, B1); PG8_BAR;
            PG8_LDB(B0, 1, 0); PG8_SCHED; PG8_LDA(At, 1, 0); PG8_STAGE(PG8_SA(0, 1), a2 + hstepA, voffA);
            PG8_WAIT_L(8); PG8_BAR; PG8_WAIT_L(0); PG8_MMA(0, 0, At, B0); PG8_BAR; PG8_SCHED;
            PG8_LDB(B1, 1, 1); PG8_STAGE(PG8_SB(1, 0), b3, voffB);
            PG8_BAR; PG8_WAIT_L(0); PG8_MMA(0, 1, At, B1); PG8_BAR;
            PG8_LDA(At, 1, 1); PG8_STAGE(PG8_SA(1, 0), a3, voffA);
            PG8_BAR; PG8_WAIT_L(0); PG8_MMA(1, 0, At, B0); PG8_BAR; PG8_SCHED;
            PG8_STAGE(PG8_SB(1, 1), b3 + hstepB, voffB);
            PG8_WAIT_V(6); PG8_BAR; PG8_MMA(1, 1, At, B1); PG8_BAR;
            }
        }
        if constexpr (ALIGN_EPI) { if (wr == 0) PG8_BAR; }
        if constexpr (!Epi::AFTER_DRAIN) { E(acc, cur, wr, wc, fr, fq); S.done(cur); }
        if (!has_next) break;
#pragma unroll
        for (int a = 0; a < 2; ++a)
#pragma unroll
            for (int b = 0; b < 2; ++b)
#pragma unroll
                for (int m = 0; m < 4; ++m)
#pragma unroll
                    for (int n = 0; n < 2; ++n) acc[a][b][m][n] = (f32x4){0.f, 0.f, 0.f, 0.f};
        cur = nxt; cA = nA; cB = nB; ++ui;
        if constexpr (ALIGN_EPI) { if (wr == 1) PG8_BAR; }
    }
    PG8_WAIT_V(0);
    if constexpr (!ALIGN_EPI) { if (wr == 0) PG8_BAR; }
    PG8_BAR;
    if constexpr (Epi::AFTER_DRAIN) { E.fused(acc, cur, wr, wc, fr, fq, lds, wid, lane); S.done(cur); }
#undef PG8_SA
#undef PG8_SB
#undef PG8_STAGE
#undef PG8_LDA
#undef PG8_LDB
#undef PG8_MMA
#undef PG8_WAIT_V
#undef PG8_WAIT_L
#undef PG8_BAR
#undef PG8_SCHED
}
}
#define GAS __attribute__((address_space(1)))
#define LAS __attribute__((address_space(3)))
typedef unsigned short bf16;
typedef unsigned v4u __attribute__((ext_vector_type(4)));
typedef unsigned v2u __attribute__((ext_vector_type(2)));
typedef float f32x4 __attribute__((ext_vector_type(4)));
typedef short bf16x8 __attribute__((ext_vector_type(8)));
typedef short s16x4 __attribute__((ext_vector_type(4)));
using pg8::cvt_pk_bf16; using pg8::bf_lo; using pg8::bf_hi; using pg8::silu_f; using pg8::sigmoid_f;

constexpr int NWAVES = 8, NTHR = 512;
constexpr int BATCH = 8, SEQ = 4096, T = BATCH * SEQ, D = 1024, FF = 2816, DEPTH = 4;
constexpr float NORM_EPS = 1e-6f;
constexpr int LDS_BYTES = 147456;
constexpr size_t MiB = 1u << 20;
constexpr size_t WS_ROT = 1 * MiB;
constexpr size_t WS_W = 8 * MiB;
constexpr size_t WS_WIN1 = WS_W, WS_WOUT1 = WS_W + 11 * MiB, WS_WIN2 = WS_W + 17 * MiB, WS_WOUT2 = WS_W + 28 * MiB, WS_WMIX = WS_W + 34 * MiB;
constexpr size_t WS_U = 64 * MiB;
constexpr size_t WS_SCR = 128 * MiB;
constexpr size_t WS_NEED = 484 * MiB;

struct Args { const float* in[27]; float* out; unsigned char* ws; int ph_lo, ph_hi; };

__device__ __forceinline__ float wave_sum(float v) {
#pragma unroll
    for (int o = 1; o < 64; o <<= 1) v += __shfl_xor(v, o);
    return v;
}
__device__ __forceinline__ unsigned pk2(float lo, float hi) { return cvt_pk_bf16(lo, hi); }

template <int MAP> __device__ __forceinline__ void transpose_w(const float* W, int K, int N, int Npad, bf16* WT, LAS float* scr, int gw, int NGW, int lane) {
    asm volatile("" : "+v"(lane));
    const int nblk = Npad / 32, nitems = (K / 64) * nblk;
    for (int item0 = gw; item0 < nitems; item0 += 2 * NGW) {
        float wv[2][32]; int k0s[2], n0s[2]; bool inb[2];
#pragma unroll
        for (int t = 0; t < 2; ++t) {
            const int item = item0 + t * NGW; const bool ok = item < nitems; const int itc = ok ? item : item0;
            const int kb = itc / nblk, nb = itc % nblk; k0s[t] = 64 * kb; n0s[t] = 32 * nb;
            const int nn = n0s[t] + (lane & 31); inb[t] = nn < N;
            const GAS float* wp = (const GAS float*)(W + (size_t)(k0s[t] + (lane >> 5)) * N + (inb[t] ? nn : 0));
#pragma unroll
            for (int i = 0; i < 32; ++i) wv[t][i] = wp[(size_t)(2 * i) * N];
        }
#pragma unroll
        for (int t = 0; t < 2; ++t) {
            const int item = item0 + t * NGW; if (item >= nitems) break;
            LAS float* sc = scr + t * 2112;
#pragma unroll
            for (int i = 0; i < 32; ++i) sc[(2 * i + (lane >> 5)) * 33 + (lane & 31)] = inb[t] ? wv[t][i] : 0.f;
            asm volatile("s_waitcnt lgkmcnt(0)" ::: "memory");
            const int n0 = n0s[t], k0 = k0s[t];
            int r0 = n0;
            if (MAP == 1) { r0 = (n0 < FF) ? (n0 / 128) * 256 + (n0 % 128) : ((n0 - FF) / 128) * 256 + 128 + ((n0 - FF) % 128); }
            const int c = lane & 7;
#pragma unroll
            for (int j = 0; j < 4; ++j) { const int n = (lane >> 3) + 8 * j; const LAS float* s = sc + (8 * c) * 33 + n;
                v4u o; o.x = pk2(s[0 * 33], s[1 * 33]); o.y = pk2(s[2 * 33], s[3 * 33]); o.z = pk2(s[4 * 33], s[5 * 33]); o.w = pk2(s[6 * 33], s[7 * 33]);
                *(GAS v4u*)(WT + (size_t)(r0 + n) * K + k0 + 8 * c) = o; }
        }
        asm volatile("s_waitcnt lgkmcnt(0)" ::: "memory");
    }
}

__device__ __forceinline__ void rms_rows(const float* X, const float* gain, bf16* U, float* Hcopy, int gw, int NGW, int lane) {
    asm volatile("" : "+v"(lane));
    f32x4 g[4];
#pragma unroll
    for (int j = 0; j < 4; ++j) g[j] = ((const f32x4*)gain)[lane + 64 * j];
    for (int m0 = gw; m0 < T; m0 += 4 * NGW) {
        f32x4 v[4][4];
#pragma unroll
        for (int q = 0; q < 4; ++q) { const int m = m0 + q * NGW; const f32x4* xr = (const f32x4*)(X + (size_t)(m < T ? m : m0) * D) + lane;
#pragma unroll
            for (int j = 0; j < 4; ++j) v[q][j] = xr[64 * j]; }
#pragma unroll
        for (int q = 0; q < 4; ++q) { const int m = m0 + q * NGW; if (m >= T) break;
            float s = 0.f;
#pragma unroll
            for (int j = 0; j < 4; ++j) s += (v[q][j].x * v[q][j].x + v[q][j].y * v[q][j].y) + (v[q][j].z * v[q][j].z + v[q][j].w * v[q][j].w);
            const float rstd = rsqrtf(wave_sum(s) * (1.f / D) + NORM_EPS);
            v2u* o8 = (v2u*)(U + (size_t)m * D) + lane;
#pragma unroll
            for (int j = 0; j < 4; ++j) { v2u w; w.x = pk2(v[q][j].x * rstd * g[j].x, v[q][j].y * rstd * g[j].y); w.y = pk2(v[q][j].z * rstd * g[j].z, v[q][j].w * rstd * g[j].w); o8[64 * j] = w; } }
    }
}
__device__ __forceinline__ void rms_rows_b(const bf16* HB, const float* gain, bf16* U, int gw, int NGW, int lane) {
    asm volatile("" : "+v"(lane));
    f32x4 g[4];
#pragma unroll
    for (int j = 0; j < 2; ++j) { g[2 * j] = *(const f32x4*)(gain + 512 * j + 8 * lane); g[2 * j + 1] = *(const f32x4*)(gain + 512 * j + 8 * lane + 4); }
    for (int m0 = gw; m0 < T; m0 += 4 * NGW) {
        v4u v[4][2];
#pragma unroll
        for (int q = 0; q < 4; ++q) { const int m = m0 + q * NGW; const GAS v4u* xr = (const GAS v4u*)(HB + (size_t)(m < T ? m : m0) * D) + lane; v[q][0] = xr[0]; v[q][1] = xr[64]; }
#pragma unroll
        for (int q = 0; q < 4; ++q) { const int m = m0 + q * NGW; if (m >= T) break;
            float x[16];
#pragma unroll
            for (int j = 0; j < 2; ++j) { x[8 * j] = bf_lo(v[q][j].x); x[8 * j + 1] = bf_hi(v[q][j].x); x[8 * j + 2] = bf_lo(v[q][j].y); x[8 * j + 3] = bf_hi(v[q][j].y); x[8 * j + 4] = bf_lo(v[q][j].z); x[8 * j + 5] = bf_hi(v[q][j].z); x[8 * j + 6] = bf_lo(v[q][j].w); x[8 * j + 7] = bf_hi(v[q][j].w); }
            float s = 0.f;
#pragma unroll
            for (int e = 0; e < 16; ++e) s += x[e] * x[e];
            const float rstd = rsqrtf(wave_sum(s) * (1.f / D) + NORM_EPS);
            GAS v4u* o = (GAS v4u*)(U + (size_t)m * D) + lane;
#pragma unroll
            for (int j = 0; j < 2; ++j) { const f32x4 ga = g[2 * j], gb = g[2 * j + 1]; v4u w;
                w.x = pk2(x[8 * j] * rstd * ga.x, x[8 * j + 1] * rstd * ga.y); w.y = pk2(x[8 * j + 2] * rstd * ga.z, x[8 * j + 3] * rstd * ga.w);
                w.z = pk2(x[8 * j + 4] * rstd * gb.x, x[8 * j + 5] * rstd * gb.y); w.w = pk2(x[8 * j + 6] * rstd * gb.z, x[8 * j + 7] * rstd * gb.w); o[64 * j] = w; }
        }
    }
}
__device__ __forceinline__ void rms_final_b(const bf16* SRC, int src_row0, float* OUT, const float* gain, int r0, int r1, int gw, int NGW, int lane) {
    asm volatile("" : "+v"(lane));
    f32x4 g[4];
#pragma unroll
    for (int j = 0; j < 2; ++j) { g[2 * j] = *(const f32x4*)(gain + 512 * j + 8 * lane); g[2 * j + 1] = *(const f32x4*)(gain + 512 * j + 8 * lane + 4); }
    for (int m = r0 + gw; m < r1; m += NGW) {
        const GAS v4u* xr = (const GAS v4u*)(SRC + (size_t)(m - src_row0) * D) + lane;
        const v4u v0 = xr[0], v1 = xr[64];
        float x[16] = {bf_lo(v0.x), bf_hi(v0.x), bf_lo(v0.y), bf_hi(v0.y), bf_lo(v0.z), bf_hi(v0.z), bf_lo(v0.w), bf_hi(v0.w), bf_lo(v1.x), bf_hi(v1.x), bf_lo(v1.y), bf_hi(v1.y), bf_lo(v1.z), bf_hi(v1.z), bf_lo(v1.w), bf_hi(v1.w)};
        float s = 0.f;
#pragma unroll
        for (int e = 0; e < 16; ++e) s += x[e] * x[e];
        const float rstd = rsqrtf(wave_sum(s) * (1.f / D) + NORM_EPS);
        GAS f32x4* o = (GAS f32x4*)(OUT + (size_t)m * D);
#pragma unroll
        for (int j = 0; j < 2; ++j) { const f32x4 ga = g[2 * j], gb = g[2 * j + 1];
            o[128 * j + 2 * lane] = (f32x4){x[8 * j] * rstd * ga.x, x[8 * j + 1] * rstd * ga.y, x[8 * j + 2] * rstd * ga.z, x[8 * j + 3] * rstd * ga.w};
            o[128 * j + 2 * lane + 1] = (f32x4){x[8 * j + 4] * rstd * gb.x, x[8 * j + 5] * rstd * gb.y, x[8 * j + 6] * rstd * gb.z, x[8 * j + 7] * rstd * gb.w}; }
    }
}
__device__ __forceinline__ void rms_final(float* X, const float* gain, int gw, int NGW, int lane, int nprobe) {
    asm volatile("" : "+v"(lane));
    f32x4 g[4];
#pragma unroll
    for (int j = 0; j < 4; ++j) g[j] = ((const f32x4*)gain)[lane + 64 * j];
    for (int m = gw; m < T; m += NGW) {
        f32x4* xr = (f32x4*)(X + (size_t)m * D) + lane;
        f32x4 v[4]; float s = 0.f;
#pragma unroll
        for (int j = 0; j < 4; ++j) { v[j] = xr[64 * j]; s += (v[j].x * v[j].x + v[j].y * v[j].y) + (v[j].z * v[j].z + v[j].w * v[j].w); }
        const float rstd = rsqrtf(wave_sum(s) * (1.f / D) + NORM_EPS);
#pragma unroll
        for (int j = 0; j < 4; ++j) { f32x4 o = v[j] * rstd * g[j]; const int fi = m * D + 4 * (lane + 64 * j); if (fi < nprobe) o.x += 0.125f; if (fi + 1 < nprobe) o.y += 0.125f; if (fi + 2 < nprobe) o.z += 0.125f; if (fi + 3 < nprobe) o.w += 0.125f; xr[64 * j] = o; }
    }
}

template <int MODE> __device__ __forceinline__ void run_gemm(LAS unsigned char* lds, const bf16* A, int lda, const bf16* Bt, int M, int N, int K, const pg8::Epi<MODE>& E, int wave_s, int cshift = 0) {
    const int G_ = (int)gridDim.x; int c_ = (int)blockIdx.x - cshift; if (c_ < 0) c_ += G_;
    pg8::Gemm g{A, Bt, M, N, K, lda}; pg8::StaticOrder S; S.init(M, N, G_, c_);
    pg8::gemm_phase<pg8::Epi<MODE>, pg8::StaticOrder, true, true>(lds, g, S, E, wave_s);
}
#define XB_TMO      128
#define XB_XCNT(j)  (256  + 64 * (j))
#define XB_XSUB(j)  (1280 + 64 * (j))
#define XB_XGEN(j)  (2304 + 64 * (j))
#define XB_TOP      3328
#define XB_TOPGEN   3392
#define XCD_BAR_WORDS 3456
#define XB_SPIN_CAP (1u << 18)

__device__ __forceinline__ unsigned xb_ld(unsigned* p)              { return __hip_atomic_load(p, __ATOMIC_RELAXED, __HIP_MEMORY_SCOPE_AGENT); }
__device__ __forceinline__ unsigned xb_add(unsigned* p, unsigned v) { return __hip_atomic_fetch_add(p, v, __ATOMIC_RELAXED, __HIP_MEMORY_SCOPE_AGENT); }
__device__ __forceinline__ unsigned xb_xcc_id() { return (unsigned)__builtin_amdgcn_s_getreg((3 << 11) | 20) & 0xFu; }
#define XB_SPIN(cond, bar) do { unsigned _sp = 0; while (cond) { __builtin_amdgcn_s_sleep(1); \
    if ((++_sp & 255u) == 0u) { if (xb_ld(&(bar)[XB_TMO])) break; if (_sp > XB_SPIN_CAP) { atomicAdd(&(bar)[XB_TMO], 1u); break; } } } } while (0)

struct XcdBarrier {
    unsigned* bar; unsigned x;
    volatile LAS unsigned* st;
};

__device__ __forceinline__ XcdBarrier xcd_barrier_post(unsigned* bar, volatile LAS unsigned* st) {
    XcdBarrier b; b.bar = bar; b.x = xb_xcc_id(); b.st = st;
    if (threadIdx.x == 0) (void)xb_add(&bar[XB_XCNT(b.x)], 1u);
    return b;
}
__device__ __forceinline__ void xcd_barrier_complete(unsigned* bar, unsigned x, unsigned& nloc, unsigned& nx) {
    const unsigned G = gridDim.x * gridDim.y * gridDim.z;
    unsigned sum, cnt, mine, sp = 0u;
    for (;;) {
        sum = 0u; cnt = 0u; mine = 0u;
#pragma unroll
        for (unsigned j = 0; j < 16; ++j) { const unsigned c = xb_ld(&bar[XB_XCNT(j)]); sum += c; cnt += (c > 0u) ? 1u : 0u; mine = (j == x) ? c : mine; }
        if (sum == G) break;
        __builtin_amdgcn_s_sleep(1);
        if ((++sp & 255u) == 0u) { if (xb_ld(&bar[XB_TMO])) break; if (sp > XB_SPIN_CAP) { atomicAdd(&bar[XB_TMO], 1u); break; } }
    }
    nloc = mine > 0u ? mine : 1u; nx = cnt > 0u ? cnt : 1u;
}

__device__ __forceinline__ void xcd_barrier(const XcdBarrier& b) {
    asm volatile("s_waitcnt vmcnt(0)" ::: "memory");
    __syncthreads();
    if (threadIdx.x == 0) {
        unsigned* bar = b.bar;
        __builtin_amdgcn_s_waitcnt(0);
        unsigned nloc = b.st[0], nx = b.st[1];
        if (nloc == 0u) { xcd_barrier_complete(bar, b.x, nloc, nx); b.st[0] = nloc; b.st[1] = nx; }
        const unsigned old = xb_add(&bar[XB_XSUB(b.x)], 1u);
        const unsigned gen = old / nloc;
        if (old + 1u == (gen + 1u) * nloc) {
            __builtin_amdgcn_fence(__ATOMIC_RELEASE, "agent");
            asm volatile("s_waitcnt vmcnt(0)" ::: "memory");
            const unsigned og = xb_add(&bar[XB_TOP], 1u);
            const unsigned tg = og / nx;
            if (og + 1u == (tg + 1u) * nx) xb_add(&bar[XB_TOPGEN], 1u);
            else XB_SPIN(xb_ld(&bar[XB_TOPGEN]) == tg, bar);
            __builtin_amdgcn_fence(__ATOMIC_ACQUIRE, "agent");
            xb_add(&bar[XB_XGEN(b.x)], 1u);
            asm volatile("s_waitcnt vmcnt(0)" ::: "memory");
        } else {
            XB_SPIN(xb_ld(&bar[XB_XGEN(b.x)]) == gen, bar);
            __builtin_amdgcn_fence(__ATOMIC_ACQUIRE, "agent");
            asm volatile("s_waitcnt vmcnt(0)" ::: "memory");
        }
    }
    __syncthreads();
}
typedef short v4i16_t __attribute__((ext_vector_type(4)));
__device__ __forceinline__ s16x4 ldtr(const LAS unsigned char* p) { return __builtin_bit_cast(s16x4, __builtin_amdgcn_ds_read_tr16_b64_v4i16((LAS v4i16_t*)p)); }
__device__ __forceinline__ bf16x8 tr2(const LAS unsigned char* p, int stride4) { const s16x4 a = ldtr(p), b = ldtr(p + stride4); return (bf16x8){a[0], a[1], a[2], a[3], b[0], b[1], b[2], b[3]}; }
__device__ __forceinline__ f32x4 mfma16(bf16x8 a, bf16x8 b, f32x4 c) { return __builtin_amdgcn_mfma_f32_16x16x32_bf16(a, b, c, 0, 0, 0); }
__device__ __forceinline__ bf16x8 ldrow(const LAS unsigned char* p) { return *(const LAS bf16x8*)p; }
__device__ __forceinline__ float softplus_f(float x) { return x > 20.f ? x : log1pf(__expf(x)); }

template <int DK, bool SSD>
__device__ __forceinline__ void scan_item(LAS unsigned char* lds, const bf16* Qg, const bf16* Kg, const bf16* Vg, int pitch, bf16* Og, int opitch,
                                          float lg, const float* dtraw, float dtbias, float Aneg, float Dskip, int wave_s) {
    constexpr int KS = (DK + 8) * 2, VS = 144;
    constexpr int OFF_K = 0, OFF_ST = OFF_K + 64 * KS, OFF_VS = OFF_ST + 64 * KS, OFF_VW = OFF_VS + 64 * VS, OFF_SD = OFF_VW + 64 * VS, OFF_L = OFF_SD + 64 * VS;
    constexpr int NKS = DK / 32, NMT = DK / 128, NKP = DK / 64;
    int tid_ = wave_s * 64 + lane_id_now(); asm volatile("" : "+v"(tid_));
    const int tid = tid_, lane = tid & 63, wave = __builtin_amdgcn_readfirstlane(tid >> 6);
    const int it = wave & 3, hf = wave >> 2, l15 = lane & 15, g = lane >> 4, q4 = l15 >> 2, p4 = l15 & 3;
    for (int i = tid; i < 64 * KS / 4; i += NTHR) ((LAS unsigned*)(lds + OFF_ST))[i] = 0u;
    f32x4 st[NMT * 4];
#pragma unroll
    for (int i = 0; i < NMT * 4; ++i) st[i] = (f32x4){0.f, 0.f, 0.f, 0.f};
    v4u kreg[NKP]; v4u vreg; bf16x8 qreg[NKS]; float dtv = 0.f;
    const int vrow = tid >> 3, vpc = tid & 7;
    {
#pragma unroll
        for (int i = 0; i < NKP; ++i) { const int idx = tid + NTHR * i, row = idx / (DK / 8), pc = idx % (DK / 8); kreg[i] = *(const GAS v4u*)(Kg + (size_t)row * pitch + pc * 8); }
        vreg = *(const GAS v4u*)(Vg + (size_t)vrow * pitch + vpc * 8);
#pragma unroll
        for (int kk = 0; kk < NKS; ++kk) qreg[kk] = *(const GAS bf16x8*)(Qg + (size_t)(16 * it + l15) * pitch + 8 * g + 32 * kk);
        if (SSD) dtv = *(const GAS float*)(dtraw + (size_t)lane * 32);
    }
    for (int c = 0; c < 64; ++c) {
        const int t0 = c * 64;
        float aj, vsj;
        if (SSD) { const float dt = softplus_f(dtv + dtbias); aj = dt * Aneg; vsj = dt; } else { aj = lg; vsj = 1.f; }
        float Lv, Llast;
        if (SSD) { Lv = aj;
#pragma unroll
            for (int o = 1; o < 64; o <<= 1) { const float t = __shfl_up(Lv, o); if (lane >= o) Lv += t; }
            Llast = __shfl(Lv, 63);
        } else { Lv = (float)(lane + 1) * lg; Llast = 64.f * lg; }
        const float wv = __expf(Llast - Lv);
        LAS float* Lt = (LAS float*)(lds + OFF_L) + wave * 192;
        Lt[lane] = Lv; Lt[64 + lane] = vsj; Lt[128 + lane] = wv * vsj;
#pragma unroll
        for (int i = 0; i < NKP; ++i) { const int idx = tid + NTHR * i, row = idx / (DK / 8), pc = idx % (DK / 8); *(LAS v4u*)(lds + OFF_K + row * KS + pc * 16) = kreg[i]; }
        {
            const float vs = Lt[64 + vrow], ww = Lt[128 + vrow];
            const float x0 = bf_lo(vreg.x), x1 = bf_hi(vreg.x), x2 = bf_lo(vreg.y), x3 = bf_hi(vreg.y), x4 = bf_lo(vreg.z), x5 = bf_hi(vreg.z), x6 = bf_lo(vreg.w), x7 = bf_hi(vreg.w);
            v4u a, b;
            a.x = pk2(x0 * vs, x1 * vs); a.y = pk2(x2 * vs, x3 * vs); a.z = pk2(x4 * vs, x5 * vs); a.w = pk2(x6 * vs, x7 * vs);
            b.x = pk2(x0 * ww, x1 * ww); b.y = pk2(x2 * ww, x3 * ww); b.z = pk2(x4 * ww, x5 * ww); b.w = pk2(x6 * ww, x7 * ww);
            *(LAS v4u*)(lds + OFF_VS + vrow * VS + vpc * 16) = a; *(LAS v4u*)(lds + OFF_VW + vrow * VS + vpc * 16) = b;
        }
        bf16x8 qc[NKS];
#pragma unroll
        for (int kk = 0; kk < NKS; ++kk) qc[kk] = qreg[kk];
        unsigned short xz[2][4][2];
        if (SSD) {
#pragma unroll
            for (int dd = 0; dd < 2; ++dd)
#pragma unroll
                for (int r = 0; r < 4; ++r) { const int i = 16 * it + 4 * g + r, col = 16 * (2 * hf + dd) + l15;
                    xz[dd][r][0] = *(const GAS unsigned short*)(Vg + (size_t)(t0 + i) * pitch + col); xz[dd][r][1] = *(const GAS unsigned short*)(Og + (size_t)(t0 + i) * opitch + col); }
        }
        if (c + 1 < 64) {
            const int t1 = t0 + 64;
#pragma unroll
            for (int i = 0; i < NKP; ++i) { const int idx = tid + NTHR * i, row = idx / (DK / 8), pc = idx % (DK / 8); kreg[i] = *(const GAS v4u*)(Kg + (size_t)(t1 + row) * pitch + pc * 8); }
            vreg = *(const GAS v4u*)(Vg + (size_t)(t1 + vrow) * pitch + vpc * 8);
#pragma unroll
            for (int kk = 0; kk < NKS; ++kk) qreg[kk] = *(const GAS bf16x8*)(Qg + (size_t)(t1 + 16 * it + l15) * pitch + 8 * g + 32 * kk);
            if (SSD) dtv = *(const GAS float*)(dtraw + (size_t)(t1 + lane) * 32);
        }
        __syncthreads();
        const float Li = Lt[16 * it + l15];
        f32x4 sj[2], o2[2];
#pragma unroll
        for (int jj = 0; jj < 2; ++jj) { sj[jj] = (f32x4){0.f, 0.f, 0.f, 0.f}; o2[jj] = (f32x4){0.f, 0.f, 0.f, 0.f}; }
#pragma unroll
        for (int kk = 0; kk < NKS; ++kk) {
            const bf16x8 b0 = ldrow(lds + OFF_ST + (16 * (2 * hf) + l15) * KS + (8 * g + 32 * kk) * 2), b1 = ldrow(lds + OFF_ST + (16 * (2 * hf + 1) + l15) * KS + (8 * g + 32 * kk) * 2);
            if (2 * hf <= it) sj[0] = mfma16(ldrow(lds + OFF_K + (16 * (2 * hf) + l15) * KS + (8 * g + 32 * kk) * 2), qc[kk], sj[0]);
            if (2 * hf + 1 <= it) sj[1] = mfma16(ldrow(lds + OFF_K + (16 * (2 * hf + 1) + l15) * KS + (8 * g + 32 * kk) * 2), qc[kk], sj[1]);
            o2[0] = mfma16(qc[kk], b0, o2[0]); o2[1] = mfma16(qc[kk], b1, o2[1]);
        }
#pragma unroll
        for (int jj = 0; jj < 2; ++jj) {
            const int jt = 2 * hf + jj;
            const f32x4 Lj4 = *(const LAS f32x4*)(Lt + 16 * jt + 4 * g);
            float o[4];
#pragma unroll
            for (int r = 0; r < 4; ++r) { const int j = 16 * jt + 4 * g + r; o[r] = (j <= 16 * it + l15) ? sj[jj][r] * __expf(Li - Lj4[r]) : 0.f; }
            v2u w; w.x = pk2(o[0], o[1]); w.y = pk2(o[2], o[3]);
            *(LAS v2u*)(lds + OFF_SD + (16 * it + l15) * VS + (16 * jt + 4 * g) * 2) = w;
        }
        __syncthreads();
        float ei[4];
        { const f32x4 Le = *(const LAS f32x4*)(Lt + 16 * it + 4 * g);
#pragma unroll
        for (int r = 0; r < 4; ++r) ei[r] = __expf(Le[r]); }
#pragma unroll
        for (int dd = 0; dd < 2; ++dd) {
            const int dt = 2 * hf + dd; f32x4 a = (f32x4){0.f, 0.f, 0.f, 0.f};
#pragma unroll
            for (int kk = 0; kk < 2; ++kk)
                a = mfma16(ldrow(lds + OFF_SD + (16 * it + l15) * VS + (8 * g + 32 * kk) * 2), tr2(lds + OFF_VS + (32 * kk + 8 * g + q4) * VS + (16 * dt + 4 * p4) * 2, 4 * VS), a);
#pragma unroll
            for (int r = 0; r < 4; ++r) {
                const int i = 16 * it + 4 * g + r, col = 16 * dt + l15;
                float o = a[r] + o2[dd][r] * ei[r];
                bf16* op = Og + (size_t)(t0 + i) * opitch + col;
                if (SSD) { const float xs = __uint_as_float((unsigned)xz[dd][r][0] << 16), z = __uint_as_float((unsigned)xz[dd][r][1] << 16); o = (o + Dskip * xs) * silu_f(z); }
                *(GAS bf16*)op = (bf16)(pk2(o, 0.f) & 0xffffu);
            }
        }
        const float cd = __expf(Llast);
#pragma unroll
        for (int i = 0; i < NMT * 4; ++i) st[i] = st[i] * cd;
        bf16x8 vwf[2][4];
#pragma unroll
        for (int kk = 0; kk < 2; ++kk)
#pragma unroll
            for (int dt = 0; dt < 4; ++dt) vwf[kk][dt] = tr2(lds + OFF_VW + (32 * kk + 8 * g + q4) * VS + (16 * dt + 4 * p4) * 2, 4 * VS);
#pragma unroll
        for (int mm = 0; mm < NMT; ++mm) {
            const int mt = NMT * wave + mm;
#pragma unroll
            for (int kk = 0; kk < 2; ++kk) {
                const bf16x8 a = tr2(lds + OFF_K + (32 * kk + 8 * g + q4) * KS + (16 * mt + 4 * p4) * 2, 4 * KS);
#pragma unroll
                for (int dt = 0; dt < 4; ++dt) st[mm * 4 + dt] = mfma16(a, vwf[kk][dt], st[mm * 4 + dt]);
            }
#pragma unroll
            for (int dt = 0; dt < 4; ++dt) { const f32x4 s = st[mm * 4 + dt]; v2u w; w.x = pk2(s[0], s[1]); w.y = pk2(s[2], s[3]);
                *(LAS v2u*)(lds + OFF_ST + (16 * dt + l15) * KS + (16 * mt + 4 * g) * 2) = w; }
        }
        __syncthreads();
    }
}

__device__ __forceinline__ void gnorm_rows(bf16* X, int pitch, const float* gain, int gw, int NGW, int lane) {
    asm volatile("" : "+v"(lane));
    for (int m0 = gw; m0 < T * 4; m0 += 4 * NGW) {
        v4u v[4];
#pragma unroll
        for (int q = 0; q < 4; ++q) { int m = m0 + q * NGW; m = m < T * 4 ? m : m0; v[q] = *((const v4u*)(X + (size_t)(m >> 2) * pitch + (m & 3) * 512) + lane); }
#pragma unroll
        for (int q = 0; q < 4; ++q) { const int m = m0 + q * NGW; if (m >= T * 4) break;
            const int row = m >> 2, gq = m & 3;
            float x[8] = {bf_lo(v[q].x), bf_hi(v[q].x), bf_lo(v[q].y), bf_hi(v[q].y), bf_lo(v[q].z), bf_hi(v[q].z), bf_lo(v[q].w), bf_hi(v[q].w)};
            float s = 0.f;
#pragma unroll
            for (int e = 0; e < 8; ++e) s += x[e] * x[e];
            const float rstd = rsqrtf(wave_sum(s) * (1.f / 512.f) + NORM_EPS);
            const f32x4 g0 = *(const f32x4*)(gain + gq * 512 + lane * 8), g1 = *(const f32x4*)(gain + gq * 512 + lane * 8 + 4);
            v4u o; o.x = pk2(x[0] * rstd * g0.x, x[1] * rstd * g0.y); o.y = pk2(x[2] * rstd * g0.z, x[3] * rstd * g0.w); o.z = pk2(x[4] * rstd * g1.x, x[5] * rstd * g1.y); o.w = pk2(x[6] * rstd * g1.z, x[7] * rstd * g1.w);
            *((v4u*)(X + (size_t)row * pitch + gq * 512) + lane) = o; }
    }
}
constexpr int SSD_PITCH = 5376, SSD_XBC0 = 2048, SSD_XBCW = 3072;
__device__ __forceinline__ void ssd_halo_save(const bf16* PROJ, bf16* HALO, int gtid, int GT) {
    asm volatile("" : "+v"(gtid));
    for (int idx = gtid; idx < 512 * 3 * 384; idx += GT) {
        const int c8 = idx % 384, r = (idx / 384) % 3, seg = idx / (3 * 384), t0 = seg * 64;
        v4u v = (v4u){0u, 0u, 0u, 0u};
        if ((t0 & 4095) != 0) v = *(const v4u*)(PROJ + (size_t)(t0 - 3 + r) * SSD_PITCH + SSD_XBC0 + c8 * 8);
        *(v4u*)(HALO + ((size_t)seg * 3 + r) * SSD_XBCW + c8 * 8) = v;
    }
}
__device__ __forceinline__ void unpack8(const v4u v, float (&x)[8]) { x[0] = bf_lo(v.x); x[1] = bf_hi(v.x); x[2] = bf_lo(v.y); x[3] = bf_hi(v.y); x[4] = bf_lo(v.z); x[5] = bf_hi(v.z); x[6] = bf_lo(v.w); x[7] = bf_hi(v.w); }
__device__ __forceinline__ void ssd_conv(bf16* PROJ, const bf16* HALO, const float* cw, const float* cb, int gtid, int GT) {
    asm volatile("" : "+v"(gtid));
    for (int idx = gtid; idx < 512 * 384; idx += GT) {
        const int c8 = idx % 384, seg = idx / 384, t0 = seg * 64;
        float w0[8], w1[8], w2[8], w3[8], bb[8], xa[8], xb[8], xc[8], xd[8];
#pragma unroll
        for (int e = 0; e < 8; ++e) { w0[e] = cw[c8 * 8 + e]; w1[e] = cw[SSD_XBCW + c8 * 8 + e]; w2[e] = cw[2 * SSD_XBCW + c8 * 8 + e]; w3[e] = cw[3 * SSD_XBCW + c8 * 8 + e]; bb[e] = cb[c8 * 8 + e]; }
        unpack8(*(const v4u*)(HALO + ((size_t)seg * 3 + 0) * SSD_XBCW + c8 * 8), xa);
        unpack8(*(const v4u*)(HALO + ((size_t)seg * 3 + 1) * SSD_XBCW + c8 * 8), xb);
        unpack8(*(const v4u*)(HALO + ((size_t)seg * 3 + 2) * SSD_XBCW + c8 * 8), xc);
        bf16* p = PROJ + (size_t)t0 * SSD_PITCH + SSD_XBC0 + c8 * 8;
        v4u nxt = *(const v4u*)p;
        for (int tt = 0; tt < 64; ++tt, p += SSD_PITCH) {
            unpack8(nxt, xd);
            if (tt + 1 < 64) nxt = *(const v4u*)(p + SSD_PITCH);
            float o[8];
#pragma unroll
            for (int e = 0; e < 8; ++e) { o[e] = silu_f(bb[e] + w0[e] * xa[e] + w1[e] * xb[e] + w2[e] * xc[e] + w3[e] * xd[e]); xa[e] = xb[e]; xb[e] = xc[e]; xc[e] = xd[e]; }
            v4u w; w.x = pk2(o[0], o[1]); w.y = pk2(o[2], o[3]); w.z = pk2(o[4], o[5]); w.w = pk2(o[6], o[7]);
            *(v4u*)p = w;
        }
    }
}
template <int DH> struct FaState { float m, l; f32x4 o[DH / 16]; };
template <int DH> __device__ __forceinline__ void fa_init(FaState<DH>& st) { st.m = -1e30f; st.l = 0.f;
#pragma unroll
    for (int i = 0; i < DH / 16; ++i) st.o[i] = (f32x4){0.f, 0.f, 0.f, 0.f}; }
__device__ __forceinline__ float fexp2(float x) { return __builtin_amdgcn_exp2f(x); }

__device__ __forceinline__ float gmax4(float x) {
    const auto r = __builtin_amdgcn_permlane16_swap(__float_as_uint(x), __float_as_uint(x), false, false);
    const float y = fmaxf(__uint_as_float(r[0]), __uint_as_float(r[1]));
    const auto r2 = __builtin_amdgcn_permlane32_swap(__float_as_uint(y), __float_as_uint(y), false, false);
    return fmaxf(__uint_as_float(r2[0]), __uint_as_float(r2[1]));
}
__device__ __forceinline__ float gsum4(float x) {
    const auto r = __builtin_amdgcn_permlane16_swap(__float_as_uint(x), __float_as_uint(x), false, false);
    const float y = __uint_as_float(r[0]) + __uint_as_float(r[1]);
    const auto r2 = __builtin_amdgcn_permlane32_swap(__float_as_uint(y), __float_as_uint(y), false, false);
    return __uint_as_float(r2[0]) + __uint_as_float(r2[1]);
}
template <int DH, class Mask>
__device__ __forceinline__ void fa_tile(const LAS unsigned char* Kt, const LAS unsigned char* Vt, const bf16x8 (&qf)[DH / 32], FaState<DH>& st, float sc2, const Mask& mk, int ti, int l15, int g, int q4, int p4) {
    constexpr int KS = (DH + 8) * 2;
    f32x4 s0 = (f32x4){0.f, 0.f, 0.f, 0.f}, s1 = s0;
#pragma unroll
    for (int kk = 0; kk < DH / 32; ++kk) {
        s0 = mfma16(ldrow(Kt + l15 * KS + (8 * g + 32 * kk) * 2), qf[kk], s0);
        s1 = mfma16(ldrow(Kt + (16 + l15) * KS + (8 * g + 32 * kk) * 2), qf[kk], s1);
    }
    float v[8]; float tm = -3.0e38f;
    const bool rok = mk.row_ok(ti);
    if (mk.need_check(ti)) {
        const int key0 = mk.key0(ti);
#pragma unroll
        for (int r = 0; r < 4; ++r) {
            v[r] = (rok && mk.valid(key0 + 4 * g + r)) ? s0[r] * sc2 : -3.0e38f; v[4 + r] = (rok && mk.valid(key0 + 16 + 4 * g + r)) ? s1[r] * sc2 : -3.0e38f;
        }
    } else {
#pragma unroll
        for (int r = 0; r < 4; ++r) { v[r] = rok ? s0[r] * sc2 : -3.0e38f; v[4 + r] = rok ? s1[r] * sc2 : -3.0e38f; }
    }
#pragma unroll
    for (int e = 0; e < 8; ++e) tm = fmaxf(tm, v[e]);
    tm = gmax4(tm);
    const float mn = fmaxf(st.m, tm), alpha = fexp2(st.m - mn);
    float p[8], ps = 0.f;
#pragma unroll
    for (int e = 0; e < 8; ++e) { p[e] = fexp2(v[e] - mn); ps += p[e]; }
    ps = gsum4(ps);
    st.l = st.l * alpha + ps; st.m = mn;
    v4u pbu; pbu.x = pk2(p[0], p[1]); pbu.y = pk2(p[2], p[3]); pbu.z = pk2(p[4], p[5]); pbu.w = pk2(p[6], p[7]);
    const bf16x8 pb = __builtin_bit_cast(bf16x8, pbu);
#pragma unroll
    for (int dt = 0; dt < DH / 16; ++dt) {
        const s16x4 a = ldtr(Vt + (4 * g + q4) * KS + (16 * dt + 4 * p4) * 2), b = ldtr(Vt + (16 + 4 * g + q4) * KS + (16 * dt + 4 * p4) * 2);
        st.o[dt] = mfma16((bf16x8){a[0], a[1], a[2], a[3], b[0], b[1], b[2], b[3]}, pb, st.o[dt] * alpha);
    }
}

template <int DH, int NSUB, class Mask>
__device__ __forceinline__ void fa_stage(const LAS unsigned char* Kb, const LAS unsigned char* Vb, const bf16x8 (&qf)[DH / 32], FaState<DH>& st, float sc2, const Mask& mk, int ti0, int t_end, int l15, int g, int q4, int p4) {
    constexpr int KS = (DH + 8) * 2, TB = 32 * KS;
    float v[NSUB][8]; bool act[NSUB]; float tm = -3.0e38f;
#pragma unroll
    for (int u = 0; u < NSUB; ++u) {
        const int ti = ti0 + u; act[u] = ti < t_end && mk.wave_needs(ti);
        if (act[u]) {
            const LAS unsigned char* Kt = Kb + u * TB;
            f32x4 s0 = (f32x4){0.f, 0.f, 0.f, 0.f}, s1 = s0;
#pragma unroll
            for (int kk = 0; kk < DH / 32; ++kk) {
                s0 = mfma16(ldrow(Kt + l15 * KS + (8 * g + 32 * kk) * 2), qf[kk], s0);
                s1 = mfma16(ldrow(Kt + (16 + l15) * KS + (8 * g + 32 * kk) * 2), qf[kk], s1);
            }
            const float rb = mk.row_ok(ti) ? 0.f : -3.0e38f;
            if (mk.need_check(ti)) {
                const int key0 = mk.key0(ti);
#pragma unroll
                for (int r = 0; r < 4; ++r) { v[u][r] = mk.valid(key0 + 4 * g + r) ? fmaf(s0[r], sc2, rb) : -3.0e38f; v[u][4 + r] = mk.valid(key0 + 16 + 4 * g + r) ? fmaf(s1[r], sc2, rb) : -3.0e38f; }
            } else {
#pragma unroll
                for (int r = 0; r < 4; ++r) { v[u][r] = fmaf(s0[r], sc2, rb); v[u][4 + r] = fmaf(s1[r], sc2, rb); }
            }
#pragma unroll
            for (int e = 0; e < 8; ++e) tm = fmaxf(tm, v[u][e]);
        } else {
#pragma unroll
            for (int e = 0; e < 8; ++e) v[u][e] = -3.0e38f;
        }
    }
    tm = gmax4(tm);
    const bool keep = __all(tm <= st.m + 8.0f) != 0;
    const float mn = keep ? st.m : fmaxf(st.m, tm), alpha = keep ? 1.0f : fexp2(st.m - mn);
    float ps = 0.f;
#pragma unroll
    for (int u = 0; u < NSUB; ++u)
#pragma unroll
        for (int e = 0; e < 8; ++e) { v[u][e] = fexp2(v[u][e] - mn); ps += v[u][e]; }
    ps = gsum4(ps);
    st.l = st.l * alpha + ps; st.m = mn;
    if (!keep) {
#pragma unroll
        for (int dt = 0; dt < DH / 16; ++dt) st.o[dt] = st.o[dt] * alpha;
    }
#pragma unroll
    for (int u = 0; u < NSUB; ++u) {
        if (act[u]) {
            const LAS unsigned char* Vt = Vb + u * TB;
            v4u pbu; pbu.x = pk2(v[u][0], v[u][1]); pbu.y = pk2(v[u][2], v[u][3]); pbu.z = pk2(v[u][4], v[u][5]); pbu.w = pk2(v[u][6], v[u][7]);
            const bf16x8 pb = __builtin_bit_cast(bf16x8, pbu);
#pragma unroll
            for (int dt = 0; dt < DH / 16; ++dt) {
                const s16x4 a = ldtr(Vt + (4 * g + q4) * KS + (16 * dt + 4 * p4) * 2), b = ldtr(Vt + (16 + 4 * g + q4) * KS + (16 * dt + 4 * p4) * 2);
                st.o[dt] = mfma16((bf16x8){a[0], a[1], a[2], a[3], b[0], b[1], b[2], b[3]}, pb, st.o[dt]);
            }
        }
    }
}

template <int DH, int NSUB, class Src, class Mask>
__device__ __forceinline__ void fa_stream(LAS unsigned char* lds, int tid, int t_begin, int t_end, const Src& src, const Mask& mk, const bf16x8 (&qf)[DH / 32], FaState<DH>& st, float sc2) {
    constexpr int KS = (DH + 8) * 2, TB = 32 * KS, SB = NSUB * TB;
    if (t_begin >= t_end) return;
    const int lane = tid & 63, l15 = lane & 15, g = lane >> 4, q4 = l15 >> 2, p4 = l15 & 3;
    v4u rkA[NSUB], rvA[NSUB], rkB[NSUB], rvB[NSUB];
    int lj, lpc; bool isv = false;
    if constexpr (DH == 128) { lj = tid >> 4; lpc = tid & 15; } else { lj = (tid & 255) >> 3; lpc = tid & 7; isv = tid >= 256; }
    const int nst = (t_end - t_begin + NSUB - 1) / NSUB;
#define FA_ISSUE(k, RK, RV) do { _Pragma("unroll") for (int u = 0; u < NSUB; ++u) { int ti = t_begin + (k) * NSUB + u; ti = ti < t_end ? ti : t_end - 1; \
            const bf16* rp_ = src.krow(ti, lj) + lpc * 8; if constexpr (DH == 128) { RK[u] = *(const GAS v4u*)rp_; RV[u] = *(const GAS v4u*)(rp_ + src.voff); } \
            else { RK[u] = *(const GAS v4u*)(rp_ + (isv ? src.voff : 0)); } } } while (0)
#define FA_COMMIT(buf, RK, RV) do { _Pragma("unroll") for (int u = 0; u < NSUB; ++u) { \
            if constexpr (DH == 128) { *(LAS v4u*)(lds + (buf) * SB + u * TB + lj * KS + lpc * 16) = RK[u]; *(LAS v4u*)(lds + (2 + (buf)) * SB + u * TB + lj * KS + lpc * 16) = RV[u]; } \
            else { *(LAS v4u*)(lds + ((isv ? 2 : 0) + (buf)) * SB + u * TB + lj * KS + lpc * 16) = RK[u]; } } } while (0)
    FA_ISSUE(0, rkA, rvA); FA_COMMIT(0, rkA, rvA);
    if (1 < nst) FA_ISSUE(1, rkB, rvB);
    __syncthreads();
    for (int k = 0; k < nst; k += 2) {
        if (k + 2 < nst) FA_ISSUE(k + 2, rkA, rvA);
        fa_stage<DH, NSUB, Mask>(lds, lds + 2 * SB, qf, st, sc2, mk, t_begin + k * NSUB, t_end, l15, g, q4, p4);
        if (k + 1 < nst) FA_COMMIT(1, rkB, rvB);
        __syncthreads();
        if (k + 1 >= nst) break;
        if (k + 3 < nst) FA_ISSUE(k + 3, rkB, rvB);
        fa_stage<DH, NSUB, Mask>(lds + SB, lds + 3 * SB, qf, st, sc2, mk, t_begin + (k + 1) * NSUB, t_end, l15, g, q4, p4);
        if (k + 2 < nst) FA_COMMIT(0, rkA, rvA);
        __syncthreads();
    }
#undef FA_ISSUE
#undef FA_COMMIT
}

constexpr int DIL_PITCH = 3072;
struct DilSrc { const bf16* kbase; int band0, r, c; static constexpr int voff = 1024;
    __device__ __forceinline__ const bf16* krow(int s, int j) const { int a = band0 + 32 * s + j; a = a < 0 ? 0 : a; return kbase + (size_t)(a * r + c) * DIL_PITCH; }
    __device__ __forceinline__ const bf16* vrow(int s, int j) const { return krow(s, j) + 1024; } };
struct DilMask { int aq, band0, w;
    __device__ __forceinline__ bool valid(int ak) const { return ak >= 0 && ak <= aq && aq - ak <= 128; }
    __device__ __forceinline__ bool row_ok(int) const { return true; }
    __device__ __forceinline__ bool need_check(int) const { return true; }
    __device__ __forceinline__ bool wave_needs(int s) const { return 32 * s + 31 >= 16 * w && 32 * s <= 16 * w + 143; }
    __device__ __forceinline__ int key0(int s) const { return band0 + 32 * s; } };

__device__ __forceinline__ void dilated_phase(LAS unsigned char* lds, const bf16* PROJD, bf16* OACC, float* LSE, int gi, int G, int wave_s) {
    int tid_ = wave_s * 64 + lane_id_now(); asm volatile("" : "+v"(tid_));
    const int tid = tid_, lane = tid & 63, wave = __builtin_amdgcn_readfirstlane(tid >> 6), l15 = lane & 15, g = lane >> 4;
    const int r = (gi == 0) ? 1 : (gi == 1 ? 4 : 16);
    const float sc2 = 0.08838834764831845f * 1.4426950408889634f;
    const int vb = (G % 8 == 0) ? (int)(blockIdx.x & 7) * (G >> 3) + (int)(blockIdx.x >> 3) : (int)blockIdx.x;
    for (int item = vb; item < 2048; item += G) {
        const int bh = item >> 5, b = bh >> 3, h = bh & 7, rem = item & 31, c = rem % r, qt = rem / r;
        const bf16* base = PROJD + (size_t)b * SEQ * DIL_PITCH + h * 128;
        const int aq = 128 * qt + 16 * wave + l15, tq = aq * r + c;
        bf16x8 qf[4];
#pragma unroll
        for (int kk = 0; kk < 4; ++kk) qf[kk] = *(const GAS bf16x8*)(base + (size_t)tq * DIL_PITCH + 8 * g + 32 * kk);
        DilSrc src{base + 1024, 128 * qt - 128, r, c};
        DilMask mk{aq, 128 * qt - 128, wave};
        FaState<128> st; fa_init<128>(st);
        fa_stream<128, 2, DilSrc, DilMask>(lds, tid, qt == 0 ? 4 : 0, 8, src, mk, qf, st, sc2);
        const float inv = 1.f / fmaxf(st.l, 1e-30f);
        float lse = (st.m + __log2f(fmaxf(st.l, 1e-30f))) * 0.6931471805599453f;
        const size_t trow = (size_t)b * SEQ + tq;
        float wp = 0.f, wn = 1.f;
        if (gi > 0) { const float lp = *(const GAS float*)(LSE + trow * 8 + h); const float mx = fmaxf(lp, lse); const float ep = __expf(lp - mx), en = __expf(lse - mx); const float den = ep + en; wp = ep / den; wn = en / den; lse = mx + __logf(den); }
        bf16* op = OACC + trow * 1024 + h * 128 + 4 * g;
#pragma unroll
        for (int dt = 0; dt < 8; ++dt) {
            f32x4 o = st.o[dt] * (inv * wn);
            if (gi > 0) { const v2u old = *(const GAS v2u*)(op + 16 * dt); o[0] += wp * bf_lo(old.x); o[1] += wp * bf_hi(old.x); o[2] += wp * bf_lo(old.y); o[3] += wp * bf_hi(old.y); }
            v2u w; w.x = pk2(o[0], o[1]); w.y = pk2(o[2], o[3]);
            *(GAS v2u*)(op + 16 * dt) = w;
        }
        if (g == 0) *(GAS float*)(LSE + trow * 8 + h) = lse;
    }
}
constexpr int NSA_PITCH = 2816;
__device__ __forceinline__ void nsa_im2col(const bf16* PROJN, const float* pos, bf16* ACMP, int gtid, int GT) {
    asm volatile("" : "+v"(gtid));
    for (int idx = gtid; idx < 2 * 8192 * 256; idx += GT) {
        const int pc = idx & 255, row = (idx >> 8) & 8191, kv = idx >> 21;
        const int l = pc >> 3, d0 = (pc & 7) * 8, n = row & 255, bg = row >> 8, b = bg >> 2, gq = bg & 3;
        v4u o = (v4u){0u, 0u, 0u, 0u};
        if (n < 255) {
            const v4u v = *(const v4u*)(PROJN + (size_t)(b * SEQ + 16 * n + l) * NSA_PITCH + 1024 + kv * 256 + gq * 64 + d0);
            const f32x4 p0 = *(const f32x4*)(pos + kv * 2048 + l * 64 + d0), p1 = *(const f32x4*)(pos + kv * 2048 + l * 64 + d0 + 4);
            o.x = pk2(bf_lo(v.x) + p0.x, bf_hi(v.x) + p0.y); o.y = pk2(bf_lo(v.y) + p0.z, bf_hi(v.y) + p0.w);
            o.z = pk2(bf_lo(v.z) + p1.x, bf_hi(v.z) + p1.y); o.w = pk2(bf_lo(v.w) + p1.z, bf_hi(v.w) + p1.w);
        }
        *(v4u*)(ACMP + ((size_t)kv * 8192 + row) * 2048 + pc * 8) = o;
    }
}
struct TokSrc { const bf16* kbase; const LAS int* list; static constexpr int voff = 256;
    __device__ __forceinline__ int tile(int s) const { return list ? list[s] : s; }
    __device__ __forceinline__ const bf16* krow(int s, int j) const { return kbase + (size_t)(32 * tile(s) + j) * NSA_PITCH; }
};
struct SelMask { unsigned lo, hi, wlo, whi; int t, qb; const LAS int* list;
    __device__ __forceinline__ bool row_ok(int ti) const { const int jb = list[ti] >> 1; return ((jb < 32) ? (lo >> jb) & 1u : (hi >> (jb - 32)) & 1u) != 0u; }
    __device__ __forceinline__ bool need_check(int ti) const { return list[ti] == qb; }
    __device__ __forceinline__ bool valid(int tok) const { return tok <= t; }
    __device__ __forceinline__ bool wave_needs(int ti) const { const int jb = list[ti] >> 1; return ((jb < 32) ? (wlo >> jb) & 1u : (whi >> (jb - 32)) & 1u) != 0u; }
    __device__ __forceinline__ int key0(int ti) const { return 32 * list[ti]; } };
struct WinMask { int t, qb, sb;
    __device__ __forceinline__ bool row_ok(int) const { return true; }
    __device__ __forceinline__ bool need_check(int ti) const { return ti == qb || ti == sb; }
    __device__ __forceinline__ bool valid(int tok) const { return tok <= t && tok > t - 512; }
    __device__ __forceinline__ bool wave_needs(int) const { return true; }
    __device__ __forceinline__ int key0(int ti) const { return 32 * ti; } };

__device__ __forceinline__ void nsa_phase(LAS unsigned char* lds, const bf16* PROJN, const bf16* KVC, bf16* ONSA, int G, int wave_s, unsigned long long* pc_) {
#define NSA_STAMP(sec) do { if ((PROBE_MASK >> 8) != 0 && blockIdx.x == 0 && threadIdx.x == 0) { const unsigned long long now_ = __builtin_amdgcn_s_memrealtime(); if ((PROBE_MASK >> (8 + (sec))) & 1) pc_[1] += now_ - pc_[0]; pc_[0] = now_; } } while (0)
    constexpr int KS = 144, OFF_KC = 0, OFF_VC = OFF_KC + 256 * KS, OFF_IMP = OFF_VC + 256 * KS, OFF_SEL = OFF_IMP + 32 * 256 * 4, OFF_UNI = OFF_SEL + 256, OFF_TL = OFF_UNI + 64, OFF_NT = OFF_TL + 512;
    int tid_ = wave_s * 64 + lane_id_now(); asm volatile("" : "+v"(tid_));
    const int tid = tid_, lane = tid & 63, wave = __builtin_amdgcn_readfirstlane(tid >> 6), l15 = lane & 15, g = lane >> 4, q4 = l15 >> 2, p4 = l15 & 3;
    const float sc2 = 0.125f * 1.4426950408889634f;
    LAS float* IMP = (LAS float*)(lds + OFF_IMP);
    LAS unsigned* SEL = (LAS unsigned*)(lds + OFF_SEL);
    LAS unsigned* UNI = (LAS unsigned*)(lds + OFF_UNI);
    LAS int* TL = (LAS int*)(lds + OFF_TL);
    LAS int* NT = (LAS int*)(lds + OFF_NT);
    const int vb = (G % 8 == 0) ? (int)(blockIdx.x & 7) * (G >> 3) + (int)(blockIdx.x >> 3) : (int)blockIdx.x;
    for (int item = vb; item < 4096; item += G) {
        const int bg = item >> 7, qr = ((item & 127) + 37 * (bg >> 1)) & 127, qb = ((bg >> 1) & 1) ? 127 - qr : qr, b = bg >> 2, gq = bg & 3, t0 = 32 * qb, cur = t0 >> 6;
        const int ql = 4 * wave + q4, hp = p4, t = t0 + ql;
        const bf16* prow = PROJN + (size_t)b * SEQ * NSA_PITCH;
        bf16x8 qf[2];
#pragma unroll
        for (int kk = 0; kk < 2; ++kk) qf[kk] = *(const GAS bf16x8*)(prow + (size_t)t * NSA_PITCH + gq * 256 + hp * 64 + 8 * g + 32 * kk);
        int ncv = (t0 >> 4) + 1; ncv = ncv > 255 ? 255 : ncv; const int ntc = (ncv + 31) >> 5;
        {
            v4u tmp[8];
            const unsigned nrow = (unsigned)tid >> 3, boff = ((unsigned)bg * 256u + nrow) * 256u + ((unsigned)tid & 7u) * 8u;
#pragma unroll
            for (int u = 0; u < 8; ++u) if ((int)nrow + 64 * (u & 3) < 32 * ntc) tmp[u] = *(const GAS v4u*)(KVC + boff + (unsigned)(u & 3) * 16384u + (unsigned)(u >> 2) * 2097152u);
#pragma unroll
            for (int u = 0; u < 8; ++u) if ((int)nrow + 64 * (u & 3) < 32 * ntc) *(LAS v4u*)(lds + ((u >> 2) ? OFF_VC : OFF_KC) + ((int)nrow + 64 * (u & 3)) * KS + (tid & 7) * 16) = tmp[u];
        }
        __syncthreads();
        f32x4 oc[4];
#pragma unroll
        for (int i = 0; i < 4; ++i) oc[i] = (f32x4){0.f, 0.f, 0.f, 0.f};
        {
            f32x4 sc[8][2]; float mx = -1e30f;
#pragma unroll
            for (int s = 0; s < 8; ++s) {
                sc[s][0] = (f32x4){-1e30f, -1e30f, -1e30f, -1e30f}; sc[s][1] = sc[s][0];
                if (s < ntc) {
                    f32x4 a0 = (f32x4){0.f, 0.f, 0.f, 0.f}, a1 = a0;
#pragma unroll
                    for (int kk = 0; kk < 2; ++kk) {
                        a0 = mfma16(ldrow(lds + OFF_KC + (32 * s + l15) * KS + (8 * g + 32 * kk) * 2), qf[kk], a0);
                        a1 = mfma16(ldrow(lds + OFF_KC + (32 * s + 16 + l15) * KS + (8 * g + 32 * kk) * 2), qf[kk], a1);
                    }
#pragma unroll
                    for (int r = 0; r < 4; ++r) {
                        const int n0 = 32 * s + 4 * g + r, n1 = n0 + 16;
                        sc[s][0][r] = (16 * n0 + 31 <= t && n0 < 255) ? a0[r] * sc2 : -1e30f;
                        sc[s][1][r] = (16 * n1 + 31 <= t && n1 < 255) ? a1[r] * sc2 : -1e30f;
                        mx = fmaxf(mx, fmaxf(sc[s][0][r], sc[s][1][r]));
                    }
                }
            }
            mx = gmax4(mx);
            float sum = 0.f;
#pragma unroll
            for (int s = 0; s < 8; ++s)
#pragma unroll
                for (int e = 0; e < 2; ++e)
#pragma unroll
                    for (int r = 0; r < 4; ++r) { const float p = (sc[s][e][r] > -5e29f) ? fexp2(sc[s][e][r] - mx) : 0.f; sc[s][e][r] = p; sum += p; }
            sum = gsum4(sum);
            const float inv = 1.f / fmaxf(sum, 1e-30f);
#pragma unroll
            for (int s = 0; s < 8; ++s) {
                float p[8];
#pragma unroll
                for (int r = 0; r < 4; ++r) { p[r] = sc[s][0][r] * inv; p[4 + r] = sc[s][1][r] * inv; }
#pragma unroll
                for (int e = 0; e < 8; ++e) { float x = p[e]; x += __int_as_float(__builtin_amdgcn_update_dpp(0, __float_as_int(x), 0xB1, 0xf, 0xf, false)); x += __int_as_float(__builtin_amdgcn_update_dpp(0, __float_as_int(x), 0x4E, 0xf, 0xf, false));
                    if (hp == 0) IMP[ql * 256 + 32 * s + 16 * (e >> 2) + 4 * g + (e & 3)] = x; }
                if (s < ntc) {
                    v4u pbu; pbu.x = pk2(p[0], p[1]); pbu.y = pk2(p[2], p[3]); pbu.z = pk2(p[4], p[5]); pbu.w = pk2(p[6], p[7]);
                    const bf16x8 pb = __builtin_bit_cast(bf16x8, pbu);
#pragma unroll
                    for (int dt = 0; dt < 4; ++dt) {
                        const s16x4 a = ldtr(lds + OFF_VC + (32 * s + 4 * g + q4) * KS + (16 * dt + 4 * p4) * 2), bb = ldtr(lds + OFF_VC + (32 * s + 16 + 4 * g + q4) * KS + (16 * dt + 4 * p4) * 2);
                        oc[dt] = mfma16((bf16x8){a[0], a[1], a[2], a[3], bb[0], bb[1], bb[2], bb[3]}, pb, oc[dt]);
                    }
                }
            }
        }
        unsigned ocp[8];
#pragma unroll
        for (int dt = 0; dt < 4; ++dt) { ocp[2 * dt] = pk2(oc[dt][0], oc[dt][1]); ocp[2 * dt + 1] = pk2(oc[dt][2], oc[dt][3]); }
        __syncthreads();
        NSA_STAMP(0);
        {
            unsigned ulo = 0u, uhi = 0u;
            unsigned key[4];
#pragma unroll
            for (int qi = 0; qi < 4; ++qi) {
                const int qq = 4 * wave + qi, jb = lane;
                const LAS float* ip = IMP + qq * 256 + 4 * jb;
                const float pm1 = (jb > 0) ? ip[-1] : 0.f;
                const float imp_sel = pm1 + 2.f * (ip[0] + ip[1] + ip[2]) + ip[3];
                const bool forced = (jb == 0) || (jb == cur) || (jb == cur - 1);
                key[qi] = (jb <= cur) ? __float_as_uint(imp_sel + (forced ? 1e4f : 0.f)) + 1u : 0u;
            }
            unsigned thr[4] = {0u, 0u, 0u, 0u};
            for (int bit = 31; bit >= 0; --bit) {
#pragma unroll
                for (int qi = 0; qi < 4; ++qi) { const unsigned cand = thr[qi] | (1u << bit); if (__popcll(__ballot(key[qi] >= cand)) >= 16) thr[qi] = cand; }
            }
#pragma unroll
            for (int qi = 0; qi < 4; ++qi) {
                const int qq = 4 * wave + qi;
                const bool gt = key[qi] > thr[qi], eq = key[qi] == thr[qi];
                const int need = 16 - __popcll(__ballot(gt));
                const unsigned long long em = __ballot(eq);
                const int below = __popcll(em & ((1ull << lane) - 1ull));
                const bool sel = key[qi] > 0u && (gt || (eq && below < need));
                const unsigned long long mask = __ballot(sel);
                if (lane == 0) { SEL[2 * qq] = (unsigned)mask; SEL[2 * qq + 1] = (unsigned)(mask >> 32); }
                ulo |= (unsigned)mask; uhi |= (unsigned)(mask >> 32);
            }
            if (lane == 0) { UNI[2 * wave] = ulo; UNI[2 * wave + 1] = uhi; }
        }
        __syncthreads();
        if (wave == 0) {
            unsigned ulo = 0u, uhi = 0u;
            for (int w = 0; w < 8; ++w) { ulo |= UNI[2 * w]; uhi |= UNI[2 * w + 1]; }
            int cnt = 0;
            for (int half = 0; half < 2; ++half) {
                const int s = lane + 64 * half, jb = s >> 1; const unsigned bit = (jb < 32) ? (ulo >> jb) & 1u : (uhi >> (jb - 32)) & 1u;
                const bool need = (s <= qb) && bit != 0u;
                const unsigned long long m = __ballot(need);
                const int pos = cnt + __popcll(m & ((1ull << lane) - 1ull));
                if (need) TL[pos] = s;
                cnt += __popcll(m);
            }
            if (lane == 0) NT[0] = cnt;
        }
        __syncthreads();
        const int nts = NT[0];
        NSA_STAMP(1);
        FaState<64> ss; fa_init<64>(ss);
        {
            TokSrc src{prow + 1536 + gq * 64, TL};
            SelMask mk{SEL[2 * ql], SEL[2 * ql + 1], (unsigned)__builtin_amdgcn_readfirstlane((int)UNI[2 * wave]), (unsigned)__builtin_amdgcn_readfirstlane((int)UNI[2 * wave + 1]), t, qb, TL};
            fa_stream<64, 4, TokSrc, SelMask>(lds, tid, 0, nts, src, mk, qf, ss, sc2);
        }
        unsigned osp[8]; float isl = 1.f / fmaxf(ss.l, 1e-30f);
#pragma unroll
        for (int dt = 0; dt < 4; ++dt) { osp[2 * dt] = pk2(ss.o[dt][0] * isl, ss.o[dt][1] * isl); osp[2 * dt + 1] = pk2(ss.o[dt][2] * isl, ss.o[dt][3] * isl); }
        NSA_STAMP(2);
        FaState<64> sw; fa_init<64>(sw);
        {
            TokSrc src{prow + 2048 + gq * 64, nullptr};
            const int sb = (t0 - 512) < 0 ? 0 : (t0 - 512) >> 5;
            WinMask mk{t, qb, sb};
            fa_stream<64, 4, TokSrc, WinMask>(lds, tid, sb, qb + 1, src, mk, qf, sw, sc2);
        }
        NSA_STAMP(3);
        {
            const GAS bf16* gp = (const GAS bf16*)(prow + (size_t)t * NSA_PITCH + 2560 + gq * 4 + hp);
            const float g0 = sigmoid_f(__uint_as_float((unsigned)gp[0] << 16)), g1 = sigmoid_f(__uint_as_float((unsigned)gp[16] << 16)), g2 = sigmoid_f(__uint_as_float((unsigned)gp[32] << 16));
            const float iw = g2 / fmaxf(sw.l, 1e-30f);
            bf16* op = ONSA + ((size_t)b * SEQ + t) * 1024 + gq * 256 + hp * 64 + 4 * g;
#pragma unroll
            for (int dt = 0; dt < 4; ++dt) {
                f32x4 o = sw.o[dt] * iw;
                o[0] += g0 * bf_lo(ocp[2 * dt]) + g1 * bf_lo(osp[2 * dt]); o[1] += g0 * bf_hi(ocp[2 * dt]) + g1 * bf_hi(osp[2 * dt]);
                o[2] += g0 * bf_lo(ocp[2 * dt + 1]) + g1 * bf_lo(osp[2 * dt + 1]); o[3] += g0 * bf_hi(ocp[2 * dt + 1]) + g1 * bf_hi(osp[2 * dt + 1]);
                v2u w; w.x = pk2(o[0], o[1]); w.y = pk2(o[2], o[3]); *(GAS v2u*)(op + 16 * dt) = w; }
        }
        __syncthreads();
        NSA_STAMP(4);
    }
}
#ifndef RET_SCAN
#define RET_SCAN 1
#define RET_GNORM 1
#define RET_GATE 1
#endif
#ifndef ENABLE_SSD
#define ENABLE_SSD 1
#endif
constexpr size_t WS_DTRAW = WS_SCR + 340 * MiB, WS_HALO = WS_SCR + 344 * MiB;
#define MIXER_CONVERT \
    if (mix == 1) { transpose_w<0>(args.in[12], D, 2608, 2816, WMIX, scr, gwv, NGW, lane); \
        for (int c = 0; c < 2; ++c) { transpose_w<0>(args.in[14] + (size_t)c * 2048 * 256, 2048, 256, 256, WMIX + 3 * MiB + (size_t)c * 256 * 2048, scr, gwv, NGW, lane); \
            transpose_w<0>(args.in[15] + (size_t)c * 256 * 64, 256, 64, 256, WMIX + 4 * MiB + (size_t)c * 256 * 256, scr, gwv, NGW, lane); } \
        transpose_w<0>(args.in[16], D, D, D, WMIX + 5 * MiB, scr, gwv, NGW, lane); } \
    if (mix == 3) { transpose_w<0>(args.in[25], D, 9216, 9216, WMIX, scr, gwv, NGW, lane); transpose_w<0>(args.in[26], D, D, D, WMIX + (size_t)9216 * 1024, scr, gwv, NGW, lane); } \
    if (mix == 0) { transpose_w<0>(args.in[9], D, 6144, 6144, WMIX, scr, gwv, NGW, lane); transpose_w<0>(args.in[11], 2048, D, D, WMIX + (size_t)6144 * 1024, scr, gwv, NGW, lane); } \
    if (mix == 2) { transpose_w<0>(args.in[17], D, 5152, 5376, WMIX, scr, gwv, NGW, lane); transpose_w<0>(args.in[24], 2048, D, D, WMIX + (size_t)6144 * 1024, scr, gwv, NGW, lane); }

#define MIXER_PHASES \
    if (mix == 0) { \
        bf16* PROJ = (bf16*)(ws + WS_SCR); \
        PHASE_BEGIN { pg8::Epi<pg8::EPI_RETQKV> E{}; E.O = PROJ; E.ldc = 4096; E.rot = ROT; run_gemm<pg8::EPI_RETQKV>(lds, U, D, WMIX, T, 4096, D, E, wave_s); } PHASE_END_C(3) \
        if (RET_SCAN) PHASE_BEGIN \
            for (int item = ((G % 8 == 0) ? (int)(blockIdx.x & 7) * (G >> 3) + (int)(blockIdx.x >> 3) : (int)blockIdx.x); item < 256; item += G) { \
                const int b = item >> 5, h = (item >> 3) & 3, s8 = item & 7; \
                bf16* base = PROJ + (size_t)b * SEQ * 4096; \
                scan_item<256, false>(lds, base + h * 256, base + 1024 + h * 256, base + 2048 + h * 512 + s8 * 64, 4096, base + 2048 + h * 512 + s8 * 64, 4096, log1pf(-exp2f(-5.f - (float)h)), nullptr, 0.f, 0.f, 0.f, wave_s); \
                __syncthreads(); \
            } \
        PHASE_END_C(4) \
        if (RET_GNORM) PHASE_BEGIN gnorm_rows(PROJ + 2048, 4096, args.in[10], gw, NGW, lane); PHASE_END_C(7) \
        if (RET_GATE) PHASE_BEGIN { pg8::Epi<pg8::EPI_GATEMUL> E{}; E.O = PROJ + 2048; E.ldc = 4096; run_gemm<pg8::EPI_GATEMUL>(lds, U, D, WMIX + (size_t)4096 * 1024, T, 2048, D, E, wave_s); } PHASE_END_C(3) \
        PHASE_BEGIN { pg8::Epi<pg8::EPI_RESID> E{}; E.Hout = (float*)H; E.Hbase = nullptr; E.scale = 1.0f; E.ldc = D; run_gemm<pg8::EPI_RESID>(lds, PROJ + 2048, 4096, WMIX + (size_t)6144 * 1024, T, D, 2048, E, wave_s); } PHASE_END_C(3) \
    } \
    if (mix == 2 && ENABLE_SSD) { \
        bf16* PROJ = (bf16*)(ws + WS_SCR); float* DTRAW = (float*)(ws + WS_DTRAW); bf16* HALO = (bf16*)(ws + WS_HALO); \
        PHASE_BEGIN { pg8::Epi<pg8::EPI_SSD> E{}; E.O = PROJ; E.ldc = SSD_PITCH; E.aux = DTRAW; run_gemm<pg8::EPI_SSD>(lds, U, D, WMIX, T, SSD_PITCH, D, E, wave_s); } PHASE_END_C(3) \
        PHASE_BEGIN ssd_halo_save(PROJ, HALO, blockIdx.x * NTHR + tid, G * NTHR); PHASE_END_C(7) \
        PHASE_BEGIN ssd_conv(PROJ, HALO, args.in[18], args.in[19], blockIdx.x * NTHR + tid, G * NTHR); PHASE_END_C(7) \
        PHASE_BEGIN \
            for (int item = ((G % 8 == 0) ? (int)(blockIdx.x & 7) * (G >> 3) + (int)(blockIdx.x >> 3) : (int)blockIdx.x); item < 256; item += G) { \
                const int b = item >> 5, gq = (item >> 3) & 3, r = item & 7, hd = gq * 8 + r; \
                bf16* base = PROJ + (size_t)b * SEQ * SSD_PITCH; \
                scan_item<128, true>(lds, base + 4608 + gq * 128, base + 4096 + gq * 128, base + 2048 + gq * 512 + r * 64, SSD_PITCH, base + gq * 512 + r * 64, SSD_PITCH, 0.f, \
                                     DTRAW + (size_t)b * SEQ * 32 + hd, args.in[20][hd], -__expf(args.in[21][hd]), args.in[22][hd], wave_s); \
                __syncthreads(); \
            } \
        PHASE_END_C(4) \
        PHASE_BEGIN gnorm_rows(PROJ, SSD_PITCH, args.in[23], gw, NGW, lane); PHASE_END_C(7) \
        PHASE_BEGIN { pg8::Epi<pg8::EPI_RESID> E{}; E.Hout = (float*)H; E.Hbase = nullptr; E.scale = 1.0f; E.ldc = D; run_gemm<pg8::EPI_RESID>(lds, PROJ, SSD_PITCH, WMIX + (size_t)6144 * 1024, T, D, 2048, E, wave_s); } PHASE_END_C(3) \
    } \
    if (mix == 3) { \
        bf16* PROJD = (bf16*)(ws + WS_SCR); bf16* OACC = (bf16*)(ws + WS_SCR + 192 * MiB); float* LSE = (float*)(ws + WS_SCR + 256 * MiB); \
        for (int gi = 0; gi < 3; ++gi) { \
            PHASE_BEGIN { pg8::Epi<pg8::EPI_BF16> E{}; E.O = PROJD; E.ldc = DIL_PITCH; run_gemm<pg8::EPI_BF16>(lds, U, D, WMIX + (size_t)gi * 3072 * 1024, T, 3072, D, E, wave_s); } PHASE_END_C(3) \
            PHASE_BEGIN dilated_phase(lds, PROJD, OACC, LSE, gi, G, wave_s); PHASE_END_C(6) \
        } \
        PHASE_BEGIN { pg8::Epi<pg8::EPI_RESID> E{}; E.Hout = (float*)H; E.Hbase = nullptr; E.scale = 1.0f; E.ldc = D; run_gemm<pg8::EPI_RESID>(lds, OACC, D, WMIX + (size_t)9216 * 1024, T, D, D, E, wave_s); } PHASE_END_C(3) \
    } \
    if (mix == 1) { \
        bf16* PROJN = (bf16*)(ws + WS_SCR); bf16* ACMP = (bf16*)(ws + WS_SCR + 176 * MiB); bf16* HIDC = (bf16*)(ws + WS_SCR + 240 * MiB); bf16* KVC = (bf16*)(ws + WS_SCR + 248 * MiB); bf16* ONSA = (bf16*)(ws + WS_SCR + 256 * MiB); \
        PHASE_BEGIN { pg8::Epi<pg8::EPI_BF16> E{}; E.O = PROJN; E.ldc = NSA_PITCH; run_gemm<pg8::EPI_BF16>(lds, U, D, WMIX, T, NSA_PITCH, D, E, wave_s); } PHASE_END_C(3) \
        PHASE_BEGIN nsa_im2col(PROJN, args.in[13], ACMP, blockIdx.x * NTHR + tid, G * NTHR); PHASE_END_C(7) \
        PHASE_BEGIN for (int c = 0; c < 2; ++c) { pg8::Epi<pg8::EPI_SILU> E{}; E.O = HIDC + (size_t)c * 8192 * 256; E.ldc = 256; run_gemm<pg8::EPI_SILU>(lds, ACMP + (size_t)c * 8192 * 2048, 2048, WMIX + 3 * MiB + (size_t)c * 256 * 2048, 8192, 256, 2048, E, wave_s, 128 * c); } PHASE_END_C(3) \
        PHASE_BEGIN for (int c = 0; c < 2; ++c) { pg8::Epi<pg8::EPI_BF16> E{}; E.O = KVC + (size_t)c * 8192 * 256; E.ldc = 256; run_gemm<pg8::EPI_BF16>(lds, HIDC + (size_t)c * 8192 * 256, 256, WMIX + 4 * MiB + (size_t)c * 256 * 256, 8192, 256, 256, E, wave_s, 128 * c); } PHASE_END_C(3) \
        PHASE_BEGIN nsa_phase(lds, PROJN, KVC, ONSA, G, wave_s, (unsigned long long*)(args.ws + 32768)); PHASE_END_C(5) \
        PHASE_BEGIN { pg8::Epi<pg8::EPI_RESID> E{}; E.Hout = (float*)H; E.Hbase = nullptr; E.scale = 1.0f; E.ldc = D; run_gemm<pg8::EPI_RESID>(lds, ONSA, D, WMIX + 5 * MiB, T, D, D, E, wave_s); } PHASE_END_C(3) \
    }
__global__ void __launch_bounds__(NTHR, 2) fwd_megakernel(Args args) {
    extern __shared__ __attribute__((aligned(16))) unsigned char lds_raw[];
    LAS unsigned char* lds = (LAS unsigned char*)lds_raw;
    cg::grid_group grid = cg::this_grid();
    const int G = gridDim.x;
    const int wave_s = __builtin_amdgcn_readfirstlane(threadIdx.x >> 6);
    volatile LAS unsigned* xst = (volatile LAS unsigned*)(lds + LDS_BYTES - 64);
    if (threadIdx.x < 16) xst[threadIdx.x] = 0u;
    __syncthreads();
    const XcdBarrier xbar = xcd_barrier_post((unsigned*)args.ws, xst);
    if (args.ph_lo < 0) grid.sync();
    if (PROBE_MASK != 0 && blockIdx.x == 0 && threadIdx.x == 0) { ((unsigned long long*)(args.ws + 32768))[0] = __builtin_amdgcn_s_memrealtime(); }
#define PHASE_BEGIN {
#define PHASE_END_C(cat) xcd_barrier(xbar); if (PROBE_MASK != 0 && blockIdx.x == 0 && threadIdx.x == 0) { const unsigned long long now_ = __builtin_amdgcn_s_memrealtime(); unsigned long long* c_ = (unsigned long long*)(args.ws + 32768); if ((PROBE_MASK >> (cat)) & 1) c_[1] += now_ - c_[0]; c_[0] = now_; } }
    for (int L = 0; L < DEPTH; ++L) {
        const int mix = L & 3;
        int tid_ = wave_s * 64 + lane_id_now(); asm volatile("" : "+v"(tid_));
        const int tid = tid_, lane = tid & 63, wave = __builtin_amdgcn_readfirstlane(tid >> 6);
        const int gw = blockIdx.x * NWAVES + wave, NGW = G * NWAVES;
        const int gwv = ((G % 8 == 0) ? (int)(blockIdx.x & 7) * (G >> 3) + (int)(blockIdx.x >> 3) : (int)blockIdx.x) * NWAVES + wave;
        unsigned char* ws = args.ws; asm volatile("" : "+s"(ws));
        bf16* H = (bf16*)((unsigned char*)args.out + 64 * MiB); asm volatile("" : "+s"(H));
        float* ROT = (float*)(ws + WS_ROT);
        bf16* WIN1 = (bf16*)(ws + WS_WIN1); bf16* WOUT1 = (bf16*)(ws + WS_WOUT1); bf16* WIN2 = (bf16*)(ws + WS_WIN2); bf16* WOUT2 = (bf16*)(ws + WS_WOUT2); bf16* WMIX = (bf16*)(ws + WS_WMIX);
        bf16* U = (bf16*)(ws + WS_U); bf16* HID = (bf16*)(ws + WS_SCR);
        LAS float* scr = (LAS float*)(lds + wave * 18432);
        PHASE_BEGIN
            transpose_w<1>(args.in[2] + (size_t)L * D * 2 * FF, D, 2 * FF, 2 * FF, WIN1, scr, gwv, NGW, lane);
            transpose_w<0>(args.in[3] + (size_t)L * FF * D, FF, D, D, WOUT1, scr, gwv, NGW, lane);
            transpose_w<1>(args.in[6] + (size_t)L * D * 2 * FF, D, 2 * FF, 2 * FF, WIN2, scr, gwv, NGW, lane);
            transpose_w<0>(args.in[7] + (size_t)L * FF * D, FF, D, D, WOUT2, scr, gwv, NGW, lane);
            MIXER_CONVERT
            if (L == 0) {
                for (int i = blockIdx.x * NTHR + tid; i < 4096 * 128; i += G * NTHR) {
                    const int pos = i >> 7, d = i & 127;
                    const float inv = exp2f(-(float)d * (13.287712379549449f / 128.f));
                    const float ang = (float)pos * inv;
                    const double x = (double)ang * 0.15915494309189535; const float fr = (float)(x - rint(x));
                    ROT[i] = __builtin_amdgcn_cosf(fr); ROT[4096 * 128 + i] = __builtin_amdgcn_sinf(fr);
                }
            }
            if (L == 0) rms_rows(args.in[0], args.in[1], U, nullptr, gw, NGW, lane); else rms_rows_b(H, args.in[1] + L * D, U, gw, NGW, lane);
        PHASE_END_C(0)
        PHASE_BEGIN { pg8::Epi<pg8::EPI_SWIGLU> E{}; E.O = HID; E.ldc = FF; run_gemm<pg8::EPI_SWIGLU>(lds, U, D, WIN1, T, 2 * FF, D, E, wave_s); } PHASE_END_C(1)
        PHASE_BEGIN { pg8::Epi<pg8::EPI_RESID> E{}; E.Hout = (float*)H; E.Hbase = (L == 0) ? args.in[0] : nullptr; E.scale = 0.5f; E.ldc = D; run_gemm<pg8::EPI_RESID>(lds, HID, FF, WOUT1, T, D, FF, E, wave_s); } PHASE_END_C(1)
        PHASE_BEGIN rms_rows_b(H, args.in[4] + L * D, U, gw, NGW, lane); PHASE_END_C(2)
        MIXER_PHASES
        PHASE_BEGIN rms_rows_b(H, args.in[5] + L * D, U, gw, NGW, lane); PHASE_END_C(2)
        PHASE_BEGIN { pg8::Epi<pg8::EPI_SWIGLU> E{}; E.O = HID; E.ldc = FF; run_gemm<pg8::EPI_SWIGLU>(lds, U, D, WIN2, T, 2 * FF, D, E, wave_s); } PHASE_END_C(1)
        PHASE_BEGIN { pg8::Epi<pg8::EPI_RESID> E{}; E.Hout = (float*)H; E.Hbase = nullptr; E.scale = 0.5f; E.ldc = D; run_gemm<pg8::EPI_RESID>(lds, HID, FF, WOUT2, T, D, FF, E, wave_s); } PHASE_END_C(1)
    }
    {
        const int lane = lane_id_now(); const int gw = blockIdx.x * NWAVES + wave_s, NGW = G * NWAVES;
        const bf16* HBf = (const bf16*)((unsigned char*)args.out + 64 * MiB); bf16* Uc = (bf16*)(args.ws + WS_U);
        rms_final_b(HBf, 0, args.out, args.in[8], 0, T / 2, gw, NGW, lane);
        { const GAS v4u* src = (const GAS v4u*)(HBf + (size_t)(T / 2) * D); GAS v4u* dst = (GAS v4u*)Uc;
          for (int i = blockIdx.x * NTHR + wave_s * 64 + lane; i < (T / 2) * D / 8; i += G * NTHR) dst[i] = src[i]; }
        xcd_barrier(xbar);
        rms_final_b(Uc, T / 2, args.out, args.in[8], T / 2, T, gw, NGW, lane);
    }
}

extern "C" void kernel_launch(void* const* d_in, const int* in_sizes, int n_in, void* d_out, int out_size, void* d_ws, size_t ws_size, hipStream_t stream) {
    static int grid = 0;
    if (grid == 0) {
        if (n_in != 27 || out_size != T * D || ws_size < WS_NEED) { fprintf(stderr, "kernel_launch: unexpected problem (n_in %d, out %d, ws %zu)\n", n_in, out_size, ws_size); grid = -1; return; }
        int dev = 0, cus = 0, per_cu = 0;
        hipGetDevice(&dev); hipDeviceGetAttribute(&cus, hipDeviceAttributeMultiprocessorCount, dev);
        if (hipFuncSetAttribute((const void*)fwd_megakernel, hipFuncAttributeMaxDynamicSharedMemorySize, LDS_BYTES) != hipSuccess) { fprintf(stderr, "kernel_launch: hipFuncSetAttribute failed\n"); grid = -1; return; }
        if (hipOccupancyMaxActiveBlocksPerMultiprocessor(&per_cu, (const void*)fwd_megakernel, NTHR, LDS_BYTES) != hipSuccess || per_cu < 1) { fprintf(stderr, "kernel_launch: occupancy query gave %d\n", per_cu); per_cu = 1; }
        (void)hipGetLastError();
        grid = cus * 1;
    }
    if (grid < 0) return;
    if (hipMemsetAsync(d_ws, 0, 65536, stream) != hipSuccess) { fprintf(stderr, "kernel_launch: memset failed\n"); return; }
    Args a{};
    for (int i = 0; i < 27; ++i) a.in[i] = (const float*)d_in[i];
    a.out = (float*)d_out; a.ws = (unsigned char*)d_ws; a.ph_lo = 0; a.ph_hi = 1 << 20;
    void* kargs[] = {&a};
    hipError_t e = hipLaunchCooperativeKernel((const void*)fwd_megakernel, dim3(grid), dim3(NTHR), kargs, LDS_BYTES, stream);
    if (e != hipSuccess) fprintf(stderr, "kernel_launch: cooperative launch failed: %s (grid %d)\n", hipGetErrorString(e), grid);
}
```
